# Optimizing an MI355X kernel written in HIP

```python
import math
import jax, jax.numpy as jnp
from jax import lax
import numpy as np

D_MODEL = 2048
BATCH = 4
SEQ = 2048
DEPTH = 2
DEC_BATCH = 128
DEC_SEQ = 1
PAST_LEN = 16384
PAGE_SIZE = 128

A_HEADS = 4
A_DK = 128
A_DV = 128
A_WIDTH = A_HEADS * A_DV
B_HEADS = 8
B_DK = 128
B_DV = 128
B_WIDTH = B_HEADS * B_DV
C_BLOCKS = 8
C_WIDTH = 512
C_BLOCK = C_WIDTH // C_BLOCKS
RG_C = 8.0
CONV_W = 4
MIX_WIDTH = A_WIDTH + B_WIDTH + C_WIDTH
D_FF = -(-8 * D_MODEL // (3 * 256)) * 256
CHUNK = 64
NORM_EPS = 1e-6
L2_EPS = 1e-6
IN_SIZES = (A_HEADS * A_DK, A_HEADS * A_DK, A_WIDTH, A_WIDTH,
            B_HEADS * B_DK, B_HEADS * B_DK, B_WIDTH, B_WIDTH,
            B_HEADS, B_HEADS,
            C_WIDTH, C_WIDTH)
IN_TOTAL = sum(IN_SIZES)

kernel_name = "hybrid_hgrn2_gdn_rglru_decode_step"


def _split_points():
    pts, acc = [], 0
    for s in IN_SIZES[:-1]:
        acc += s
        pts.append(acc)
    return pts


def rmsnorm(x, g):
    xf = x.astype(jnp.float32)
    return xf * lax.rsqrt(jnp.mean(xf * xf, axis=-1, keepdims=True) + NORM_EPS) * g.astype(jnp.float32)


def l2norm(x):
    return x * lax.rsqrt(jnp.sum(x * x, axis=-1, keepdims=True) + L2_EPS)


def causal_dwconv(x, buf, w, b):
    L = x.shape[1]
    xc = jnp.concatenate([buf.astype(jnp.float32), x], axis=1)
    w = w.astype(jnp.float32)
    y = w[0] * xc[:, 0:L]
    for j in range(1, CONV_W):
        y = y + w[j] * xc[:, j:j + L]
    if b is not None:
        y = y + b.astype(jnp.float32)
    return y, xc[:, L:]


def _to_chunks(t, C):
    Bn, L, H, d = t.shape
    return t.reshape(Bn, L // C, C, H, d).transpose(1, 0, 3, 2, 4)


def _from_chunks(o):
    n, Bn, H, C, e = o.shape
    return o.transpose(1, 0, 3, 2, 4).reshape(Bn, n * C, H, e)


def hgrn2_chunked(q, logf, v, S0):
    L = q.shape[1]
    C = math.gcd(L, CHUNK)
    k = -jnp.expm1(logf)
    qc, kc, vc, lc = (_to_chunks(t, C) for t in (q, k, v, logf))
    causal = jnp.tril(jnp.ones((C, C), dtype=bool))

    def step(S, inp):
        qi, ki, vi, li = inp
        b = jnp.cumsum(li, axis=-2)
        rel = b[..., :, None, :] - b[..., None, :, :]
        dec = jnp.exp(jnp.where(causal[:, :, None], rel, -jnp.inf))
        att = jnp.einsum('bhtd,bhsd,bhtsd->bhts', qi, ki, dec)
        o = (jnp.einsum('bhts,bhse->bhte', att, vi)
             + jnp.einsum('bhtd,bhde->bhte', qi * jnp.exp(b), S))
        b_last = b[..., -1:, :]
        S_new = (jnp.exp(b_last[..., 0, :])[..., None] * S
                 + jnp.einsum('bhsd,bhse->bhde', ki * jnp.exp(b_last - b), vi))
        return S_new, o

    S, o = lax.scan(step, S0, (qc, kc, vc, lc))
    return _from_chunks(o), S


def gated_delta_chunked(q, k, v, g, beta, S0):
    L = q.shape[1]
    DV = v.shape[-1]
    C = math.gcd(L, CHUNK)
    qc, kc, vc, gc, bc = (_to_chunks(t, C) for t in (q, k, v, g[..., None], beta[..., None]))
    causal = jnp.tril(jnp.ones((C, C), dtype=bool))
    strict = jnp.tril(jnp.ones((C, C), dtype=bool), -1)
    eye = jnp.eye(C, dtype=jnp.float32)

    def step(S, inp):
        qi, ki, vi, gi, bi = inp
        b = jnp.cumsum(gi[..., 0], axis=-1)
        gam = jnp.exp(jnp.where(causal, b[..., :, None] - b[..., None, :], -jnp.inf))
        A = jnp.where(strict, bi * jnp.einsum('bhtd,bhsd->bhts', ki, ki) * gam, 0.0)
        rhs = jnp.concatenate([bi * vi, bi * ki * jnp.exp(b)[..., None]], axis=-1)
        sol = lax.linalg.triangular_solve(eye + A, rhs, left_side=True, lower=True, unit_diagonal=True)
        u = sol[..., :DV] - jnp.einsum('bhtd,bhde->bhte', sol[..., DV:], S)
        qk = jnp.einsum('bhtd,bhsd->bhts', qi, ki) * gam
        o = (jnp.einsum('bhtd,bhde->bhte', qi * jnp.exp(b)[..., None], S)
             + jnp.einsum('bhts,bhse->bhte', qk, u))
        S_new = (jnp.exp(b[..., -1])[..., None, None] * S
                 + jnp.einsum('bhsd,bhse->bhde', ki * jnp.exp(b[..., -1:] - b)[..., None], u))
        return S_new, o

    S, o = lax.scan(step, S0, (qc, kc, vc, gc, bc))
    return _from_chunks(o), S


def _lin_combine(e1, e2):
    a1, b1 = e1
    a2, b2 = e2
    return a1 * a2, a2 * b1 + b2


def rglru(x, h0, w_a, b_a, w_x, b_x, lam, seq_start):
    Bn, L, _ = x.shape
    xb = x.reshape(Bn, L, C_BLOCKS, C_BLOCK)
    r = jax.nn.sigmoid(jnp.einsum('blni,nij->blnj', xb, w_a).reshape(Bn, L, C_WIDTH) + b_a)
    i = jax.nn.sigmoid(jnp.einsum('blni,nij->blnj', xb, w_x).reshape(Bn, L, C_WIDTH) + b_x)
    log_a = -RG_C * r * jax.nn.softplus(-lam.astype(jnp.float32))
    a = jnp.exp(log_a)
    mult = jnp.sqrt(-jnp.expm1(2.0 * log_a))
    if seq_start:
        mult = mult.at[:, 0].set(1.0)
    A_cum, B_cum = lax.associative_scan(_lin_combine, (a, mult * (i * x)), axis=1)
    h = B_cum + A_cum * h0[:, None, :]
    return h, h[:, -1]


def layer(x, S_a, S_b, buf_b, h_c, buf_c, lb, seq_start, prm):
    (g_mix_pre, g_mix_post, g_ffn_pre, g_ffn_post, w_in, w_out, a_norm,
     b_conv_w, b_A_log, b_dt_bias, b_norm, c_conv_w, c_conv_b, c_wa, c_ba, c_wx, c_bx, c_lam,
     w_gate, w_up, w_down) = prm
    f32 = jnp.float32
    Bn, L, _ = x.shape
    h = rmsnorm(x, g_mix_pre)
    proj = jnp.einsum('bld,de->ble', h, w_in)
    (aq, af, ai, ag, bq, bk, bv, bz, bb, ba, cx, cg) = jnp.split(proj, _split_points(), axis=-1)

    qa = jax.nn.silu(aq).reshape(Bn, L, A_HEADS, A_DK)
    lbf = lb.astype(f32)
    logf = jnp.logaddexp(jnp.log(lbf), jnp.log1p(-lbf) + jax.nn.log_sigmoid(af))
    oa, S_a_new = hgrn2_chunked(qa, logf.reshape(Bn, L, A_HEADS, A_DK),
                                ai.reshape(Bn, L, A_HEADS, A_DV), S_a.astype(f32))
    oa = (rmsnorm(oa, a_norm) * jax.nn.silu(ag.reshape(Bn, L, A_HEADS, A_DV))).reshape(Bn, L, A_WIDTH)

    qkv, buf_b_new = causal_dwconv(jnp.concatenate([bq, bk, bv], axis=-1), buf_b, b_conv_w, None)
    qb, kb, vb = jnp.split(jax.nn.silu(qkv), 3, axis=-1)
    qb = l2norm(qb.reshape(Bn, L, B_HEADS, B_DK)) * (B_DK ** -0.5)
    kb = l2norm(kb.reshape(Bn, L, B_HEADS, B_DK))
    vb = vb.reshape(Bn, L, B_HEADS, B_DV)
    beta = jax.nn.sigmoid(bb)
    gdec = -jnp.exp(b_A_log.astype(f32)) * jax.nn.softplus(ba + b_dt_bias)
    ob, S_b_new = gated_delta_chunked(qb, kb, vb, gdec, beta, S_b.astype(f32))
    ob = (rmsnorm(ob, b_norm) * jax.nn.silu(bz.reshape(Bn, L, B_HEADS, B_DV))).reshape(Bn, L, B_WIDTH)

    xcv, buf_c_new = causal_dwconv(cx, buf_c, c_conv_w, c_conv_b)
    hc, h_c_new = rglru(xcv, h_c.astype(f32), c_wa, c_ba, c_wx, c_bx, c_lam, seq_start)
    oc = hc * jax.nn.gelu(cg)

    mix = jnp.einsum('ble,ed->bld', jnp.concatenate([oa, ob, oc], axis=-1), w_out)
    x = x + rmsnorm(mix, g_mix_post).astype(x.dtype)
    h2 = rmsnorm(x, g_ffn_pre)
    ff = jnp.einsum('blf,fd->bld', jax.nn.silu(h2 @ w_gate) * (h2 @ w_up), w_down)
    x = x + rmsnorm(ff, g_ffn_post).astype(x.dtype)
    return x, (S_a_new, S_b_new, buf_b_new, h_c_new, buf_c_new)


def setup_inputs(seed: int = 0) -> dict:
    key = jax.random.key(seed)
    keys = jax.random.split(key, 40)
    cnt = [0]
    f32 = jnp.float32

    def nk():
        k = keys[cnt[0]]
        cnt[0] += 1
        return k

    def nrm(shape, s):
        return s * jax.random.normal(nk(), shape, f32)

    def gain(shape):
        return 1.0 + 0.05 * jax.random.normal(nk(), shape, f32)

    x_prompt = nrm((BATCH, SEQ, D_MODEL), 1.0)
    x_sample = nrm((DEC_BATCH, DEC_SEQ, D_MODEL), 1.0)
    state_hgrn = nrm((DEPTH, DEC_BATCH, A_HEADS, A_DK, A_DV), 0.5)
    state_gdn = nrm((DEPTH, DEC_BATCH, B_HEADS, B_DK, B_DV), 0.5)
    state_gdn_conv = nrm((DEPTH, DEC_BATCH, CONV_W - 1, 3 * B_WIDTH), 1.0)
    state_rglru_h = nrm((DEPTH, DEC_BATCH, C_WIDTH), 0.5)
    state_rglru_conv = nrm((DEPTH, DEC_BATCH, CONV_W - 1, C_WIDTH), 1.0)
    ln_mix_pre = gain((DEPTH, D_MODEL))
    ln_mix_post = gain((DEPTH, D_MODEL))
    ln_ffn_pre = gain((DEPTH, D_MODEL))
    ln_ffn_post = gain((DEPTH, D_MODEL))
    w_in = nrm((DEPTH, D_MODEL, IN_TOTAL), D_MODEL ** -0.5)
    w_out = nrm((DEPTH, MIX_WIDTH, D_MODEL), MIX_WIDTH ** -0.5)
    a_lb_logits = nrm((DEPTH, A_HEADS * A_DK), 0.5)
    a_norm = gain((DEPTH, A_DV))
    b_conv_w = nrm((DEPTH, CONV_W, 3 * B_WIDTH), CONV_W ** -0.5)
    b_A_log = jnp.log(jax.random.uniform(nk(), (DEPTH, B_HEADS), f32, 1.0, 16.0))
    dt = jnp.exp(jax.random.uniform(nk(), (DEPTH, B_HEADS), f32, math.log(1e-3), math.log(1e-1)))
    b_dt_bias = dt + jnp.log(-jnp.expm1(-dt))
    b_norm = gain((DEPTH, B_DV))
    c_conv_w = nrm((DEPTH, CONV_W, C_WIDTH), CONV_W ** -0.5)
    c_conv_b = nrm((DEPTH, C_WIDTH), 0.02)
    c_wa = nrm((DEPTH, C_BLOCKS, C_BLOCK, C_BLOCK), C_BLOCK ** -0.5)
    c_ba = nrm((DEPTH, C_WIDTH), 0.1)
    c_wx = nrm((DEPTH, C_BLOCKS, C_BLOCK, C_BLOCK), C_BLOCK ** -0.5)
    c_bx = nrm((DEPTH, C_WIDTH), 0.1)
    u = jax.random.uniform(nk(), (DEPTH, C_WIDTH), f32, 0.9, 0.999)
    a_base = u ** (1.0 / RG_C)
    c_lam = jnp.log(a_base) - jnp.log1p(-a_base)
    w_gate = nrm((DEPTH, D_MODEL, D_FF), D_MODEL ** -0.5)
    w_up = nrm((DEPTH, D_MODEL, D_FF), D_MODEL ** -0.5)
    w_down = nrm((DEPTH, D_FF, D_MODEL), D_FF ** -0.5)
    return {"x_prompt": x_prompt, "x_sample": x_sample,
            "state_hgrn": state_hgrn, "state_gdn": state_gdn, "state_gdn_conv": state_gdn_conv,
            "state_rglru_h": state_rglru_h, "state_rglru_conv": state_rglru_conv,
            "ln_mix_pre": ln_mix_pre, "ln_mix_post": ln_mix_post,
            "ln_ffn_pre": ln_ffn_pre, "ln_ffn_post": ln_ffn_post,
            "w_in": w_in, "w_out": w_out, "a_lb_logits": a_lb_logits, "a_norm": a_norm,
            "b_conv_w": b_conv_w, "b_A_log": b_A_log, "b_dt_bias": b_dt_bias, "b_norm": b_norm,
            "c_conv_w": c_conv_w, "c_conv_b": c_conv_b, "c_wa": c_wa, "c_ba": c_ba,
            "c_wx": c_wx, "c_bx": c_bx, "c_lam": c_lam,
            "w_gate": w_gate, "w_up": w_up, "w_down": w_down}


def reference(x_prompt, x_sample, state_hgrn, state_gdn, state_gdn_conv, state_rglru_h, state_rglru_conv,
              ln_mix_pre, ln_mix_post, ln_ffn_pre, ln_ffn_post, w_in, w_out, a_lb_logits, a_norm,
              b_conv_w, b_A_log, b_dt_bias, b_norm, c_conv_w, c_conv_b, c_wa, c_ba, c_wx, c_bx, c_lam,
              w_gate, w_up, w_down):
    f32 = jnp.float32
    lbs = jnp.cumsum(jax.nn.softmax(a_lb_logits.astype(f32), axis=0), axis=0)
    lbs = lbs - lbs[0:1]
    xp, xs = x_prompt, x_sample
    Bp = x_prompt.shape[0]
    new_p, new_s = [], []
    for l in range(DEPTH):
        prm = (ln_mix_pre[l], ln_mix_post[l], ln_ffn_pre[l], ln_ffn_post[l], w_in[l], w_out[l], a_norm[l],
               b_conv_w[l], b_A_log[l], b_dt_bias[l], b_norm[l], c_conv_w[l], c_conv_b[l],
               c_wa[l], c_ba[l], c_wx[l], c_bx[l], c_lam[l], w_gate[l], w_up[l], w_down[l])
        xp, sp = layer(xp,
                       jnp.zeros((Bp, A_HEADS, A_DK, A_DV), f32),
                       jnp.zeros((Bp, B_HEADS, B_DK, B_DV), f32),
                       jnp.zeros((Bp, CONV_W - 1, 3 * B_WIDTH), f32),
                       jnp.zeros((Bp, C_WIDTH), f32),
                       jnp.zeros((Bp, CONV_W - 1, C_WIDTH), f32),
                       lbs[l], True, prm)
        xs, ss = layer(xs, state_hgrn[l], state_gdn[l], state_gdn_conv[l], state_rglru_h[l],
                       state_rglru_conv[l], lbs[l], False, prm)
        new_p.append(sp)
        new_s.append(ss)

    def stk(lst, i, dt):
        return jnp.stack([s[i] for s in lst], axis=0).astype(dt)

    return (xp, xs,
            stk(new_p, 0, state_hgrn.dtype), stk(new_s, 0, state_hgrn.dtype),
            stk(new_p, 1, state_gdn.dtype), stk(new_s, 1, state_gdn.dtype),
            stk(new_p, 2, state_gdn_conv.dtype), stk(new_s, 2, state_gdn_conv.dtype),
            stk(new_p, 3, state_rglru_h.dtype), stk(new_s, 3, state_rglru_h.dtype),
            stk(new_p, 4, state_rglru_conv.dtype), stk(new_s, 4, state_rglru_conv.dtype))
```

```cpp
#include <hip/hip_runtime.h>
#include <hip/hip_cooperative_groups.h>
#include <cstdio>
#include <cstdint>
namespace cg = cooperative_groups;

#ifndef MK_MULTI
#define MK_MULTI 0
#endif

#define DI __device__ __forceinline__
#define LAS __attribute__((address_space(3)))
#define GAS __attribute__((address_space(1)))
typedef unsigned short bf16_t;
typedef float f32x4 __attribute__((ext_vector_type(4)));
typedef float f32x2 __attribute__((ext_vector_type(2)));
typedef unsigned u32x4 __attribute__((ext_vector_type(4)));
typedef unsigned u32x2 __attribute__((ext_vector_type(2)));
typedef short bf16x8 __attribute__((ext_vector_type(8)));
typedef __bf16 bf16v2 __attribute__((ext_vector_type(2)));

constexpr int D = 2048, SEQ = 2048, BATCH = 4, NP = BATCH * SEQ, NS = 128, MT = NP + NS, MPAD = 8448;
constexpr int NIN = 7184, NINP = 7424, DFF = 5632, NGU = 2 * DFF;
constexpr int C_AQ = 0, C_AF = 512, C_AI = 1024, C_AG = 1536, C_BQ = 2048, C_BK = 3072, C_BV = 4096, C_BZ = 5120, C_BB = 6144, C_BA = 6152, C_CX = 6160, C_CG = 6672;
constexpr int ORAW_W = 1536;
constexpr float NORM_EPS = 1e-6f, L2_EPS = 1e-6f;
constexpr int NPHASE = 17;

constexpr size_t O_YP = 0, O_YS = O_YP + (size_t)NP * D, O_HGP = O_YS + (size_t)NS * D, O_HGS = O_HGP + 2ull * 4 * 4 * 16384,
                 O_GDP = O_HGS + 2ull * 128 * 4 * 16384, O_GDS = O_GDP + 2ull * 4 * 8 * 16384, O_GCP = O_GDS + 2ull * 128 * 8 * 16384,
                 O_GCS = O_GCP + 2ull * 4 * 3 * 3072, O_RHP = O_GCS + 2ull * 128 * 3 * 3072, O_RHS = O_RHP + 2ull * 4 * 512,
                 O_RCP = O_RHS + 2ull * 128 * 512, O_RCS = O_RCP + 2ull * 4 * 3 * 512, O_END = O_RCS + 2ull * 128 * 3 * 512;

constexpr size_t MiB = 1ull << 20;
constexpr size_t WS_CTL = 0, CTL_BYTES = 1 * MiB;
constexpr size_t WS_WIN = 1 * MiB, SZ_WIN = 29 * MiB, WS_WOUT = WS_WIN + 2 * SZ_WIN, SZ_WOUT = 8 * MiB, WS_WGU = WS_WOUT + 2 * SZ_WOUT, SZ_WGU = 44 * MiB,
                 WS_WDN = WS_WGU + 2 * SZ_WGU, SZ_WDN = 22 * MiB;
constexpr size_t WS_PROJ = WS_WDN + 2 * SZ_WDN, SZ_PROJ = 240 * MiB;
constexpr size_t WS_HBUF = WS_PROJ + SZ_PROJ, SZ_HBUF = 33 * MiB;
constexpr size_t WS_MIXO = WS_HBUF + SZ_HBUF;
constexpr size_t WS_MIXF = WS_MIXO + SZ_HBUF, SZ_MIXF = 66 * MiB;
constexpr size_t WS_X1 = WS_MIXF + SZ_MIXF, WS_END = WS_X1 + SZ_MIXF;
static_assert((size_t)NINP * D * 2 == SZ_WIN && (size_t)NGU * D * 2 == SZ_WGU && (size_t)D * DFF * 2 == SZ_WDN && (size_t)D * D * 2 == SZ_WOUT, "weight sizes");
static_assert((size_t)MPAD * NINP * 4 <= SZ_PROJ && (size_t)MPAD * D * 2 <= SZ_HBUF && (size_t)MPAD * D * 4 <= SZ_MIXF, "ws map");

constexpr int LDS_BYTES = 147456;

DI unsigned pk2(float lo, float hi) { f32x2 x = {lo, hi}; bf16v2 y = __builtin_convertvector(x, bf16v2); return __builtin_bit_cast(unsigned, y); }
DI float wave_sum(float v) {
#pragma unroll
    for (int o = 1; o < 64; o <<= 1) v += __shfl_xor(v, o);
    return v;
}
template <int CTRL> DI float dpp_mov(float v) { return __int_as_float(__builtin_amdgcn_update_dpp(0, __float_as_int(v), CTRL, 0xF, 0xF, true)); }
DI float row16_sum(float v) {
    v += dpp_mov<0xB1>(v); v += dpp_mov<0x4E>(v); v += dpp_mov<0x124>(v); v += dpp_mov<0x128>(v); return v;
}
DI float sigm(float x) { return 1.f / (1.f + __expf(-x)); }
DI float silu(float x) { return x / (1.f + __expf(-x)); }
DI float softplus(float x) { return x > 20.f ? x : log1pf(__expf(x)); }
DI float gelu_tanh(float x) { const float y = 0.7978845608028654f * (x + 0.044715f * x * x * x); return 0.5f * x * (1.f + tanhf(y)); }
#define LDS_WAIT() asm volatile("s_waitcnt lgkmcnt(0)" ::: "memory")

namespace pg8 {
#define PG8_LAS __attribute__((address_space(3)))
constexpr int BM = 256, BK = 64, HALF = 128, HTB = HALF * BK * 2, STAGE_BYTES = 8 * HTB, NXCD = 8, WGM = 8;
__host__ __device__ __forceinline__ int lds_byte(int r, int c) { const int st = (r >> 4) * 2 + (c >> 5), rr = r & 15, cc = c & 31, ob = rr * 64 + cc * 2; return st * 1024 + (ob ^ (((ob >> 9) & 1) << 5)); }
__host__ __device__ __forceinline__ void stage_rc(int b, int& R, int& C) { const int st = b / 1024, sb = b % 1024, swz = sb ^ (((sb >> 9) & 1) << 5); R = (st >> 1) * 16 + swz / 64; C = (st & 1) * 32 + (swz % 64) / 2; }
struct Unit { int pm, pn; };
struct Gemm { const bf16_t* A; const bf16_t* Bt; int M, N, K; };
struct StaticOrder {
    int nM, nN, nwg, G, c;
    __host__ __device__ void init(int M, int N, int G_, int c_) { nM = M / BM; nN = N / BM; nwg = nM * nN; G = G_; c = c_; }
    __host__ __device__ bool next(int i, Unit& u) const {
        const long L = (long)i * G + c; if (L >= nwg) return false;
        int wgid = (int)L; { const int q = nwg / NXCD, r = nwg % NXCD, xcd = wgid % NXCD, off = wgid / NXCD; wgid = (xcd < r ? xcd * (q + 1) : r * (q + 1) + (xcd - r) * q) + off; }
        const int nig = WGM * nN, gid = wgid / nig, fm = gid * WGM, gsz = (nM - fm) < WGM ? (nM - fm) : WGM;
        u.pm = fm + ((wgid % nig) % gsz); u.pn = (wgid % nig) / gsz; return true;
    }
    __device__ __forceinline__ void a_ready(const Unit&) const {}
    __device__ __forceinline__ void done(const Unit&) const {}
};
struct EpiAny {
    static constexpr bool PERM = false, AFTER_DRAIN = false;
    int mode; float* C; bf16_t* O; int ldc;
    __device__ __forceinline__ void operator()(const f32x4 (&acc)[2][2][4][2], const Unit& u, int wr, int wc, int fr, int fq) const {
        const int row0 = u.pm * BM + wr * 64 + fr;
        if (mode == 0) {
            const int col0 = u.pn * BM + wc * 32 + 4 * fq;
#pragma unroll
            for (int ai = 0; ai < 2; ++ai)
#pragma unroll
                for (int m = 0; m < 4; ++m) { float* rowp = C + (size_t)(row0 + ai * HALF + m * 16) * ldc + col0;
#pragma unroll
                    for (int bj = 0; bj < 2; ++bj)
#pragma unroll
                        for (int n = 0; n < 2; ++n) *(f32x4*)(rowp + bj * HALF + n * 16) = acc[ai][bj][m][n]; }
        } else {
#pragma unroll
            for (int ai = 0; ai < 2; ++ai)
#pragma unroll
                for (int m = 0; m < 4; ++m) { bf16_t* rowp = O + (size_t)(row0 + ai * HALF + m * 16) * ldc;
#pragma unroll
                    for (int bj = 0; bj < 2; ++bj) { const int G = 8 * u.pn + 4 * bj + wc; const f32x4 g = acc[ai][bj][m][0], up = acc[ai][bj][m][1];
                        u32x2 w; w.x = pk2(silu(g[0]) * up[0], silu(g[1]) * up[1]); w.y = pk2(silu(g[2]) * up[2], silu(g[3]) * up[3]);
                        *(u32x2*)(rowp + 16 * G + 4 * fq) = w; } }
        }
    }
};

template <class Epi, class Sched, bool ALIGN_EPI = false, bool SP2 = false>
__device__ __forceinline__ void gemm_phase(PG8_LAS unsigned char* lds, const Gemm g, const Sched& S, const Epi& E) {
    const int tid = threadIdx.x, wid = __builtin_amdgcn_readfirstlane(tid >> 6), lane = tid & 63, wr = wid >> 2, wc = wid & 3, fr = lane & 15, fq = lane >> 4;
    const int K = g.K, nt = K / BK;
    unsigned voffA[2], voffB[2];
#pragma unroll
    for (int i = 0; i < 2; ++i) { int R, C; stage_rc(tid * 16 + i * 8192, R, C); voffA[i] = (unsigned)(R * K + C) * 2u; voffB[i] = (unsigned)(R * K + C) * 2u; }
    const size_t kstep = (size_t)(BK * 2);
    const size_t hstep = (size_t)HALF * K * 2;
    const size_t tstep = 2 * hstep;
    const unsigned ldsw = (unsigned)wid * 1024u;
    const int aoff = lds_byte(wr * 64 + fr, fq * 8), boff = lds_byte(wc * 32 + fr, fq * 8);
#define PG8_SA(b, h) (((b) * 2 + (h)) * HTB)
#define PG8_SB(b, h) ((4 + (b) * 2 + (h)) * HTB)
#define PG8_STAGE(bufoff, gbase, voff) do { _Pragma("unroll") for (int _i = 0; _i < 2; ++_i) \
        __builtin_amdgcn_global_load_lds((const unsigned*)((const char*)(gbase) + (voff)[_i]), (PG8_LAS unsigned*)(lds + (bufoff) + ldsw + _i * 8192), 16, 0, 0); } while (0)
#define PG8_LDA(dst, b, h) do { _Pragma("unroll") for (int m = 0; m < 4; ++m) _Pragma("unroll") for (int k = 0; k < 2; ++k) dst[m][k] = *(const PG8_LAS bf16x8*)(lds + PG8_SA(b, h) + aoff + m * 2048 + k * 1024); } while (0)
#define PG8_LDB(dst, b, h) do { _Pragma("unroll") for (int n = 0; n < 2; ++n) _Pragma("unroll") for (int k = 0; k < 2; ++k) dst[n][k] = *(const PG8_LAS bf16x8*)(lds + PG8_SB(b, h) + boff + n * 2048 + k * 1024); } while (0)
#define PG8_MMA(ai, bj, At, Bt) do { __builtin_amdgcn_s_setprio(1); _Pragma("unroll") for (int m = 0; m < 4; ++m) _Pragma("unroll") for (int n = 0; n < 2; ++n) _Pragma("unroll") for (int k = 0; k < 2; ++k) \
        acc[ai][bj][m][n] = __builtin_amdgcn_mfma_f32_16x16x32_bf16(Bt[n][k], At[m][k], acc[ai][bj][m][n], 0, 0, 0); __builtin_amdgcn_s_setprio(0); } while (0)
#define PG8_WAIT_V(n) asm volatile("s_waitcnt vmcnt(" #n ")" ::: "memory")
#define PG8_WAIT_L(n) asm volatile("s_waitcnt lgkmcnt(" #n ")" ::: "memory")
#define PG8_BAR __builtin_amdgcn_s_barrier()
#define PG8_SCHED __builtin_amdgcn_sched_barrier(0)
    Unit cur, nxt; int ui = 0;
    if (!S.next(0, cur)) return;
    f32x4 acc[2][2][4][2];
#pragma unroll
    for (int a = 0; a < 2; ++a)
#pragma unroll
        for (int b = 0; b < 2; ++b)
#pragma unroll
            for (int m = 0; m < 4; ++m)
#pragma unroll
                for (int n = 0; n < 2; ++n) acc[a][b][m][n] = (f32x4){0.f, 0.f, 0.f, 0.f};
    bf16x8 At[4][2], B0[2][2], B1[2][2];
    const char* cA = (const char*)g.A + (size_t)cur.pm * tstep; const char* cB = (const char*)g.Bt + (size_t)cur.pn * tstep;
    S.a_ready(cur);
    if constexpr (SP2) {
        PG8_STAGE(PG8_SB(0, 0), cB, voffB); PG8_STAGE(PG8_SB(0, 1), cB + hstep, voffB); PG8_STAGE(PG8_SA(0, 0), cA, voffA); PG8_STAGE(PG8_SA(0, 1), cA + hstep, voffA);
        if (wr == 1) PG8_BAR;
        PG8_WAIT_V(2); PG8_BAR;
        PG8_STAGE(PG8_SB(1, 0), cB + kstep, voffB); PG8_STAGE(PG8_SA(1, 0), cA + kstep, voffA); PG8_STAGE(PG8_SB(1, 1), cB + hstep + kstep, voffB);
        PG8_WAIT_V(6); PG8_BAR;
    } else {
        PG8_STAGE(PG8_SB(0, 0), cB, voffB); PG8_STAGE(PG8_SA(0, 0), cA, voffA); PG8_STAGE(PG8_SB(0, 1), cB + hstep, voffB); PG8_STAGE(PG8_SA(0, 1), cA + hstep, voffA);
        if (wr == 1) PG8_BAR;
        PG8_WAIT_V(4); PG8_BAR;
        PG8_STAGE(PG8_SB(1, 0), cB + kstep, voffB); PG8_STAGE(PG8_SA(1, 0), cA + kstep, voffA); PG8_STAGE(PG8_SB(1, 1), cB + hstep + kstep, voffB);
        PG8_WAIT_V(6); PG8_BAR;
    }
    for (;;) {
        const bool has_next = S.next(ui + 1, nxt);
        const char* nA = has_next ? (const char*)g.A + (size_t)nxt.pm * tstep : cA; const char* nB = has_next ? (const char*)g.Bt + (size_t)nxt.pn * tstep : cB;
        for (int t = 0; t < nt; t += 2) {
            const bool last = (t == nt - 2);
            const char* a1 = cA + (size_t)(t + 1) * kstep;
            const char* a2 = last ? nA : cA + (size_t)(t + 2) * kstep; const char* b2 = last ? nB : cB + (size_t)(t + 2) * kstep;
            const char* a3 = a2 + kstep; const char* b3 = b2 + kstep;
            if (last && has_next) S.a_ready(nxt);
            if constexpr (SP2) {
            PG8_LDB(B0, 0, 0); PG8_LDB(B1, 0, 1); PG8_SCHED; PG8_LDA(At, 0, 0); PG8_STAGE(PG8_SA(1, 1), a1 + hstep, voffA);
            PG8_WAIT_V(8); PG8_WAIT_L(0); PG8_BAR; PG8_MMA(0, 0, At, B0); PG8_MMA(0, 1, At, B1); PG8_BAR; PG8_SCHED;
            PG8_LDA(At, 0, 1); PG8_STAGE(PG8_SB(0, 0), b2, voffB); PG8_STAGE(PG8_SB(0, 1), b2 + hstep, voffB); PG8_STAGE(PG8_SA(0, 0), a2, voffA);
            PG8_WAIT_V(8); PG8_WAIT_L(0); PG8_BAR; PG8_MMA(1, 0, At, B0); PG8_MMA(1, 1, At, B1); PG8_BAR; PG8_SCHED;
            PG8_LDB(B0, 1, 0); PG8_LDB(B1, 1, 1); PG8_SCHED; PG8_LDA(At, 1, 0); PG8_STAGE(PG8_SA(0, 1), a2 + hstep, voffA);
            PG8_WAIT_V(8); PG8_WAIT_L(0); PG8_BAR; PG8_MMA(0, 0, At, B0); PG8_MMA(0, 1, At, B1); PG8_BAR; PG8_SCHED;
            PG8_LDA(At, 1, 1); PG8_STAGE(PG8_SB(1, 0), b3, voffB); PG8_STAGE(PG8_SB(1, 1), b3 + hstep, voffB); PG8_STAGE(PG8_SA(1, 0), a3, voffA);
            PG8_WAIT_V(8); PG8_WAIT_L(0); PG8_BAR; PG8_MMA(1, 0, At, B0); PG8_MMA(1, 1, At, B1); PG8_BAR; PG8_SCHED;
            } else {
            PG8_LDB(B0, 0, 0); PG8_SCHED; PG8_LDA(At, 0, 0); PG8_STAGE(PG8_SA(1, 1), a1 + hstep, voffA);
            PG8_WAIT_L(8); PG8_BAR; PG8_WAIT_L(0); PG8_MMA(0, 0, At, B0); PG8_BAR; PG8_SCHED;
            PG8_LDB(B1, 0, 1); PG8_STAGE(PG8_SB(0, 0), b2, voffB);
            PG8_BAR; PG8_WAIT_L(0); PG8_MMA(0, 1, At, B1); PG8_BAR;
            PG8_LDA(At, 0, 1); PG8_STAGE(PG8_SA(0, 0), a2, voffA);
            PG8_BAR; PG8_WAIT_L(0); PG8_MMA(1, 0, At, B0); PG8_BAR; PG8_SCHED;
            PG8_STAGE(PG8_SB(0, 1), b2 + hstep, voffB);
            PG8_WAIT_V(6); PG8_BAR; PG8_MMA(1, 1, At, B1); PG8_BAR;
            PG8_LDB(B0, 1, 0); PG8_SCHED; PG8_LDA(At, 1, 0); PG8_STAGE(PG8_SA(0, 1), a2 + hstep, voffA);
            PG8_WAIT_L(8); PG8_BAR; PG8_WAIT_L(0); PG8_MMA(0, 0, At, B0); PG8_BAR; PG8_SCHED;
            PG8_LDB(B1, 1, 1); PG8_STAGE(PG8_SB(1, 0), b3, voffB);
            PG8_BAR; PG8_WAIT_L(0); PG8_MMA(0, 1, At, B1); PG8_BAR;
            PG8_LDA(At, 1, 1); PG8_STAGE(PG8_SA(1, 0), a3, voffA);
            PG8_BAR; PG8_WAIT_L(0); PG8_MMA(1, 0, At, B0); PG8_BAR; PG8_SCHED;
            PG8_STAGE(PG8_SB(1, 1), b3 + hstep, voffB);
            PG8_WAIT_V(6); PG8_BAR; PG8_MMA(1, 1, At, B1); PG8_BAR;
            }
        }
        if constexpr (ALIGN_EPI) { if (wr == 0) PG8_BAR; }
        if constexpr (!Epi::AFTER_DRAIN) { E(acc, cur, wr, wc, fr, fq); S.done(cur); }
        if (!has_next) break;
#pragma unroll
        for (int a = 0; a < 2; ++a)
#pragma unroll
            for (int b = 0; b < 2; ++b)
#pragma unroll
                for (int m = 0; m < 4; ++m)
#pragma unroll
                    for (int n = 0; n < 2; ++n) acc[a][b][m][n] = (f32x4){0.f, 0.f, 0.f, 0.f};
        cur = nxt; cA = nA; cB = nB; ++ui;
        if constexpr (ALIGN_EPI) { if (wr == 1) PG8_BAR; }
    }
    PG8_WAIT_V(0);
    if constexpr (!ALIGN_EPI) { if (wr == 0) PG8_BAR; }
    PG8_BAR;
#undef PG8_SA
#undef PG8_SB
#undef PG8_STAGE
#undef PG8_LDA
#undef PG8_LDB
#undef PG8_MMA
#undef PG8_WAIT_V
#undef PG8_WAIT_L
#undef PG8_BAR
#undef PG8_SCHED
}
}

struct Args { const float* in[29]; float* out; unsigned char* ws; int ph_lo, ph_hi; };
enum { I_XP = 0, I_XS, I_SHG, I_SGD, I_SGC, I_SRH, I_SRC, I_LN1, I_LN2, I_LN3, I_LN4, I_WIN, I_WOUT, I_LB, I_ANORM, I_BCW, I_BALOG, I_BDT, I_BNORM,
       I_CCW, I_CCB, I_CWA, I_CBA, I_CWX, I_CBX, I_CLAM, I_WG, I_WU, I_WD };

struct Ctx {
    const Args* a; unsigned char* ws; float* out; LAS unsigned char* lds; int tid, lane, wave, G, bid;
};
DI Ctx fresh(const Ctx& o) {
    Ctx c = o; int t = threadIdx.x; asm volatile("" : "+v"(t)); c.tid = t; c.lane = t & 63; c.wave = __builtin_amdgcn_readfirstlane(t >> 6);
    unsigned char* w = o.a->ws; asm volatile("" : "+s"(w)); c.ws = w; float* q = o.a->out; asm volatile("" : "+s"(q)); c.out = q;
    int b = blockIdx.x; asm volatile("" : "+s"(b)); c.bid = b; return c;
}
DI const float* inp(const Args& a, int idx) { int z = idx; asm volatile("" : "+s"(z)); return a.in[z]; }

template <int MODE>
DI void transpose_item(const float* W, int K, int Nsrc, int nblk, bf16_t* WT, LAS float* scr, int item, int lane) {
    const int kb = item / nblk, nb = item - kb * nblk, k0 = 64 * kb, n0 = 32 * nb;
    const int nn = n0 + (lane & 31); const bool ok = nn < Nsrc;
#pragma unroll 8
    for (int i = 0; i < 32; ++i) { const int kk = 2 * i + (lane >> 5); scr[kk * 33 + (lane & 31)] = ok ? W[(size_t)(k0 + kk) * Nsrc + nn] : 0.f; }
    LDS_WAIT(); asm volatile("" ::: "memory");
    const int c = lane & 7;
#pragma unroll
    for (int j = 0; j < 4; ++j) { const int nl = (lane >> 3) + 8 * j; const LAS float* s = scr + (8 * c) * 33 + nl;
        u32x4 o; o.x = pk2(s[0 * 33], s[1 * 33]); o.y = pk2(s[2 * 33], s[3 * 33]); o.z = pk2(s[4 * 33], s[5 * 33]); o.w = pk2(s[6 * 33], s[7 * 33]);
        const int n = n0 + nl; const int drow = (MODE == 0) ? n : ((n >> 4) * 32 + (n & 15) + (MODE == 2 ? 16 : 0));
        *(u32x4*)(WT + (size_t)drow * K + k0 + 8 * c) = o; }
    LDS_WAIT(); asm volatile("" ::: "memory");
}
DI void norm_row_to_bf16(const float* xr, const float* g, bf16_t* orow, int lane) {
    f32x4 v[8]; float s = 0.f;
#pragma unroll
    for (int j = 0; j < 8; ++j) { v[j] = ((const f32x4*)xr)[lane + 64 * j]; s += (v[j].x * v[j].x + v[j].y * v[j].y) + (v[j].z * v[j].z + v[j].w * v[j].w); }
    const float r = rsqrtf(wave_sum(s) * (1.f / D) + NORM_EPS);
#pragma unroll
    for (int j = 0; j < 8; ++j) { const f32x4 gg = ((const f32x4*)g)[lane + 64 * j]; u32x2 w; w.x = pk2(v[j].x * r * gg.x, v[j].y * r * gg.y); w.y = pk2(v[j].z * r * gg.z, v[j].w * r * gg.w);
        ((u32x2*)orow)[lane + 64 * j] = w; }
}
DI void phase_p0(const Ctx& c0) {
    const Ctx c = fresh(c0);
    const Args& a = *c.a;
    LAS float* scr = (LAS float*)(c.lds + c.wave * 16384);
    const int gw = c.bid * 8 + c.wave, NGW = c.G * 8;
    constexpr int I_IN = (D / 64) * (NINP / 32), I_OUT = (D / 64) * (D / 32), I_G = (D / 64) * (DFF / 32), I_D = (DFF / 64) * (D / 32);
    constexpr int PER_LAYER = I_IN + I_OUT + 2 * I_G + I_D;
    for (int it = gw; it < 2 * PER_LAYER; it += NGW) {
        const int l = it / PER_LAYER; int r = it - l * PER_LAYER;
        if (r < I_IN) { transpose_item<0>(inp(a, I_WIN) + (size_t)l * D * NIN, D, NIN, NINP / 32, (bf16_t*)(c.ws + WS_WIN + l * SZ_WIN), scr, r, c.lane); continue; } r -= I_IN;
        if (r < I_OUT) { transpose_item<0>(inp(a, I_WOUT) + (size_t)l * D * D, D, D, D / 32, (bf16_t*)(c.ws + WS_WOUT + l * SZ_WOUT), scr, r, c.lane); continue; } r -= I_OUT;
        if (r < I_G) { transpose_item<1>(inp(a, I_WG) + (size_t)l * D * DFF, D, DFF, DFF / 32, (bf16_t*)(c.ws + WS_WGU + l * SZ_WGU), scr, r, c.lane); continue; } r -= I_G;
        if (r < I_G) { transpose_item<2>(inp(a, I_WU) + (size_t)l * D * DFF, D, DFF, DFF / 32, (bf16_t*)(c.ws + WS_WGU + l * SZ_WGU), scr, r, c.lane); continue; } r -= I_G;
        transpose_item<0>(inp(a, I_WD) + (size_t)l * DFF * D, DFF, D, D / 32, (bf16_t*)(c.ws + WS_WDN + l * SZ_WDN), scr, r, c.lane);
    }
    bf16_t* hb = (bf16_t*)(c.ws + WS_HBUF);
    { const float* xp = inp(a, I_XP); const float* xs = inp(a, I_XS); const float* g1 = inp(a, I_LN1);
      for (int m = gw; m < MT; m += NGW) norm_row_to_bf16(m < NP ? xp + (size_t)m * D : xs + (size_t)(m - NP) * D, g1, hb + (size_t)m * D, c.lane); }
    for (int i = gw * 64 + c.lane; i < (MPAD - MT) * D / 8; i += NGW * 64) {
        ((u32x4*)(hb + (size_t)MT * D))[i] = (u32x4){0u, 0u, 0u, 0u};
        ((u32x4*)((bf16_t*)(c.ws + WS_MIXO) + (size_t)MT * D))[i] = (u32x4){0u, 0u, 0u, 0u};
    }
}

DI void row_phase(const Ctx& c0, const float* y, const float* xa, const float* xb, float* xout, const float* g_post, const float* g_next, bf16_t* hb) {
    const Ctx c = fresh(c0);
    const int gw = c.bid * 8 + c.wave, NGW = c.G * 8, lane = c.lane;
    for (int m = gw; m < MT; m += NGW) {
        const float* yr = y + (size_t)m * D; const float* xr = m < NP ? xa + (size_t)m * D : xb + (size_t)(m - NP) * D;
        f32x4 v[8]; float s = 0.f;
#pragma unroll
        for (int j = 0; j < 8; ++j) { v[j] = ((const f32x4*)yr)[lane + 64 * j]; s += (v[j].x * v[j].x + v[j].y * v[j].y) + (v[j].z * v[j].z + v[j].w * v[j].w); }
        const float r = rsqrtf(wave_sum(s) * (1.f / D) + NORM_EPS);
        float s2 = 0.f;
#pragma unroll
        for (int j = 0; j < 8; ++j) { const f32x4 gg = ((const f32x4*)g_post)[lane + 64 * j]; const f32x4 xx = ((const f32x4*)xr)[lane + 64 * j];
            v[j] = xx + v[j] * r * gg; s2 += (v[j].x * v[j].x + v[j].y * v[j].y) + (v[j].z * v[j].z + v[j].w * v[j].w);
            ((f32x4*)(xout + (size_t)m * D))[lane + 64 * j] = v[j]; }
        if (g_next) {
            const float r2 = rsqrtf(wave_sum(s2) * (1.f / D) + NORM_EPS);
#pragma unroll
            for (int j = 0; j < 8; ++j) { const f32x4 gg = ((const f32x4*)g_next)[lane + 64 * j]; u32x2 w; w.x = pk2(v[j].x * r2 * gg.x, v[j].y * r2 * gg.y); w.y = pk2(v[j].z * r2 * gg.z, v[j].w * r2 * gg.w);
                ((u32x2*)(hb + (size_t)m * D))[lane + 64 * j] = w; }
        }
    }
}

DI int permd(int d) { return ((d & 7) >> 2) * 64 + (d >> 3) * 4 + (d & 3); }
DI float lb_of(const Args& a, int l, int c) { if (l == 0) return 0.f; const float l0 = inp(a, I_LB)[c], l1 = inp(a, I_LB)[512 + c]; return 1.f / (1.f + __expf(l0 - l1)); }

DI void unit_b_prompt(const Ctx& c0, int l, int b, int h, int sl) {
    const Ctx c = fresh(c0);
    const Args& a = *c.a; const int tid = c.tid, lane = c.lane, wave = c.wave;
    constexpr int TT = 64;
    LAS float* kq = (LAS float*)c.lds;
    LAS float* vt = kq + TT * 256;
    LAS float* sc = vt + TT * 32;
    LAS float* ob = sc + TT * 4;
    const float* proj = (const float*)(c.ws + WS_PROJ);
    float* oraw = (float*)(c.ws + WS_MIXF);
    const int e0 = sl * 32, dg = lane & 15, e = wave * 4 + (lane >> 4);
    const float* cw = inp(a, I_BCW) + (size_t)l * 4 * 3072;
    const float alog = inp(a, I_BALOG)[l * 8 + h], dtb = inp(a, I_BDT)[l * 8 + h];
    float S[8];
#pragma unroll
    for (int i = 0; i < 8; ++i) S[i] = 0.f;
    const int cqk = tid & 255, th = tid >> 8;
    const int colqk = (cqk < 128) ? (C_BQ + h * 128 + cqk) : (C_BK + h * 128 + (cqk - 128));
    const int ccqk = (cqk < 128) ? (h * 128 + cqk) : (1024 + h * 128 + (cqk - 128));
    const float wq0 = cw[ccqk], wq1 = cw[3072 + ccqk], wq2 = cw[2 * 3072 + ccqk], wq3 = cw[3 * 3072 + ccqk];
    const int posqk = (cqk < 128) ? permd(cqk) : 128 + permd(cqk - 128);
    const int ev = tid & 31, tg = tid >> 5;
    const int colv = C_BV + h * 128 + e0 + ev, ccv = 2048 + h * 128 + e0 + ev;
    const float wv0 = cw[ccv], wv1 = cw[3072 + ccv], wv2 = cw[2 * 3072 + ccv], wv3 = cw[3 * 3072 + ccv];
    const size_t rowb = (size_t)b * SEQ;
    for (int t0 = 0; t0 < SEQ; t0 += TT) {
        {
            const int ts = t0 + th * 32;
            float x0 = ts >= 3 ? proj[(rowb + ts - 3) * NINP + colqk] : 0.f, x1 = ts >= 2 ? proj[(rowb + ts - 2) * NINP + colqk] : 0.f, x2 = ts >= 1 ? proj[(rowb + ts - 1) * NINP + colqk] : 0.f;
#pragma unroll 8
            for (int i = 0; i < 32; ++i) { const float x3 = proj[(rowb + ts + i) * NINP + colqk];
                kq[(th * 32 + i) * 256 + posqk] = silu(wq0 * x0 + wq1 * x1 + wq2 * x2 + wq3 * x3); x0 = x1; x1 = x2; x2 = x3; }
        }
        {
            const int ts = t0 + tg * 4;
            float x0 = ts >= 3 ? proj[(rowb + ts - 3) * NINP + colv] : 0.f, x1 = ts >= 2 ? proj[(rowb + ts - 2) * NINP + colv] : 0.f, x2 = ts >= 1 ? proj[(rowb + ts - 1) * NINP + colv] : 0.f;
#pragma unroll
            for (int i = 0; i < 4; ++i) { const float x3 = proj[(rowb + ts + i) * NINP + colv];
                vt[(tg * 4 + i) * 32 + ev] = silu(wv0 * x0 + wv1 * x1 + wv2 * x2 + wv3 * x3); x0 = x1; x1 = x2; x2 = x3; }
        }
        if (tid < TT) { const float bb = proj[(rowb + t0 + tid) * NINP + C_BB + h], ba = proj[(rowb + t0 + tid) * NINP + C_BA + h];
            sc[tid * 4 + 0] = sigm(bb); sc[tid * 4 + 1] = __expf(-__expf(alog) * softplus(ba + dtb)); }
        __syncthreads();
        for (int i = 0; i < 8; ++i) { const int tt = wave * 8 + i; const float q0 = kq[tt * 256 + lane], q1 = kq[tt * 256 + 64 + lane], k0 = kq[tt * 256 + 128 + lane], k1 = kq[tt * 256 + 192 + lane];
            const float sq = wave_sum(q0 * q0 + q1 * q1), sk = wave_sum(k0 * k0 + k1 * k1);
            if (lane == 0) { sc[tt * 4 + 2] = rsqrtf(sq + L2_EPS) * 0.08838834764831845f; sc[tt * 4 + 3] = rsqrtf(sk + L2_EPS); } }
        __syncthreads();
        for (int t = 0; t < TT; ++t) {
            const LAS float* row = kq + t * 256;
            const f32x4 qa = *(const LAS f32x4*)(row + dg * 4), qb = *(const LAS f32x4*)(row + 64 + dg * 4);
            const f32x4 ka = *(const LAS f32x4*)(row + 128 + dg * 4), kb = *(const LAS f32x4*)(row + 192 + dg * 4);
            const f32x4 s4 = *(const LAS f32x4*)(sc + t * 4); const float v = vt[t * 32 + wave * 4 + (lane >> 4)];
            float p0 = ka.x * S[0] + ka.z * S[2], p1 = ka.y * S[1] + ka.w * S[3];
            p0 += kb.x * S[4] + kb.z * S[6]; p1 += kb.y * S[5] + kb.w * S[7];
            const float ks = row16_sum(p0 + p1) * s4.w;
            const float us = s4.x * (v - s4.y * ks) * s4.w;
            S[0] = s4.y * S[0] + ka.x * us; S[1] = s4.y * S[1] + ka.y * us; S[2] = s4.y * S[2] + ka.z * us; S[3] = s4.y * S[3] + ka.w * us;
            S[4] = s4.y * S[4] + kb.x * us; S[5] = s4.y * S[5] + kb.y * us; S[6] = s4.y * S[6] + kb.z * us; S[7] = s4.y * S[7] + kb.w * us;
            float o0 = qa.x * S[0] + qa.z * S[2], o1 = qa.y * S[1] + qa.w * S[3];
            o0 += qb.x * S[4] + qb.z * S[6]; o1 += qb.y * S[5] + qb.w * S[7];
            const float o = row16_sum(o0 + o1) * s4.z;
            if (dg == 0) ob[t * 32 + e] = o;
        }
        __syncthreads();
        { const int t = tid >> 3, e4 = (tid & 7) * 4; *(f32x4*)(oraw + (rowb + t0 + t) * ORAW_W + 512 + h * 128 + e0 + e4) = *(const LAS f32x4*)(ob + t * 32 + e4); }
        __syncthreads();
    }
    float* so = c.out + O_GDP + (((size_t)l * BATCH + b) * 8 + h) * 16384;
#pragma unroll
    for (int i = 0; i < 8; ++i) so[(size_t)(dg * 8 + i) * 128 + e0 + e] = S[i];
}

DI void unit_a_prompt(const Ctx& c0, int l, int b, int h, int sl) {
    const Ctx c = fresh(c0);
    const Args& a = *c.a; const int tid = c.tid, lane = c.lane, wave = c.wave;
    constexpr int TT = 64;
    LAS float* fq = (LAS float*)c.lds;
    LAS float* vt = fq + TT * 256;
    LAS float* ob = vt + TT * 32;
    const float* proj = (const float*)(c.ws + WS_PROJ);
    float* oraw = (float*)(c.ws + WS_MIXF);
    const int e0 = sl * 32, dg = lane & 15, e = wave * 4 + (lane >> 4);
    float S[8];
#pragma unroll
    for (int i = 0; i < 8; ++i) S[i] = 0.f;
    const int cfq = tid & 255, th = tid >> 8;
    const int colfq = (cfq < 128) ? (C_AF + h * 128 + cfq) : (C_AQ + h * 128 + (cfq - 128));
    const float lb = (cfq < 128) ? lb_of(a, l, h * 128 + cfq) : 0.f;
    const int posfq = (cfq < 128) ? permd(cfq) : 128 + permd(cfq - 128);
    const int ev = tid & 31, tg = tid >> 5;
    const int colv = C_AI + h * 128 + e0 + ev;
    const size_t rowb = (size_t)b * SEQ;
    for (int t0 = 0; t0 < SEQ; t0 += TT) {
#pragma unroll 8
        for (int i = 0; i < 32; ++i) { const float x = proj[(rowb + t0 + th * 32 + i) * NINP + colfq];
            fq[(th * 32 + i) * 256 + posfq] = (cfq < 128) ? (lb + (1.f - lb) * sigm(x)) : silu(x); }
#pragma unroll
        for (int i = 0; i < 4; ++i) vt[(tg * 4 + i) * 32 + ev] = proj[(rowb + t0 + tg * 4 + i) * NINP + colv];
        __syncthreads();
        for (int t = 0; t < TT; ++t) {
            const LAS float* row = fq + t * 256;
            const f32x4 fa = *(const LAS f32x4*)(row + dg * 4), fb = *(const LAS f32x4*)(row + 64 + dg * 4);
            const f32x4 qa = *(const LAS f32x4*)(row + 128 + dg * 4), qb = *(const LAS f32x4*)(row + 192 + dg * 4);
            const float v = vt[t * 32 + wave * 4 + (lane >> 4)];
            S[0] = fa.x * S[0] + (1.f - fa.x) * v; S[1] = fa.y * S[1] + (1.f - fa.y) * v; S[2] = fa.z * S[2] + (1.f - fa.z) * v; S[3] = fa.w * S[3] + (1.f - fa.w) * v;
            S[4] = fb.x * S[4] + (1.f - fb.x) * v; S[5] = fb.y * S[5] + (1.f - fb.y) * v; S[6] = fb.z * S[6] + (1.f - fb.z) * v; S[7] = fb.w * S[7] + (1.f - fb.w) * v;
            float o0 = qa.x * S[0] + qa.z * S[2], o1 = qa.y * S[1] + qa.w * S[3];
            o0 += qb.x * S[4] + qb.z * S[6]; o1 += qb.y * S[5] + qb.w * S[7];
            const float o = row16_sum(o0 + o1);
            if (dg == 0) ob[t * 32 + e] = o;
        }
        __syncthreads();
        { const int t = tid >> 3, e4 = (tid & 7) * 4; *(f32x4*)(oraw + (rowb + t0 + t) * ORAW_W + h * 128 + e0 + e4) = *(const LAS f32x4*)(ob + t * 32 + e4); }
        __syncthreads();
    }
    float* so = c.out + O_HGP + (((size_t)l * BATCH + b) * 4 + h) * 16384;
#pragma unroll
    for (int i = 0; i < 8; ++i) so[(size_t)(dg * 8 + i) * 128 + e0 + e] = S[i];
}

DI void unit_c_prompt(const Ctx& c0, int l, int b, int n) {
    const Ctx c = fresh(c0);
    const Args& a = *c.a; const int tid = c.tid;
    constexpr int TT = 128;
    LAS float* xcv = (LAS float*)c.lds;
    LAS float* ra = xcv + TT * 64;
    LAS float* ia = ra + TT * 64;
    LAS float* segA = ia + TT * 64;
    LAS float* segB = segA + 512;
    LAS float* carry = segB + 512;
    const float* proj = (const float*)(c.ws + WS_PROJ);
    bf16_t* mixo = (bf16_t*)(c.ws + WS_MIXO);
    const size_t rowb = (size_t)b * SEQ;
    const int j = tid & 63, g = (tid >> 6) & 1, tg = tid >> 7;
    const float* wsrc = (g ? inp(a, I_CWX) : inp(a, I_CWA)) + ((size_t)l * 8 + n) * 4096 + j;
    float wreg[64];
#pragma unroll
    for (int i = 0; i < 64; ++i) wreg[i] = wsrc[i * 64];
    const float gbias = (g ? inp(a, I_CBX) : inp(a, I_CBA))[l * 512 + n * 64 + j];
    const int cch = tid & 63, seg = tid >> 6, chg = n * 64 + cch;
    const float* ccw = inp(a, I_CCW) + (size_t)l * 4 * 512;
    const float w0 = ccw[chg], w1 = ccw[512 + chg], w2 = ccw[1024 + chg], w3 = ccw[1536 + chg], cb = inp(a, I_CCB)[l * 512 + chg];
    const float spl = softplus(-inp(a, I_CLAM)[l * 512 + chg]);
    if (tid < 128) carry[tid] = 0.f;
    float hlast = 0.f;
    for (int t0 = 0, tile = 0; t0 < SEQ; t0 += TT, ++tile) {
        {
            const int ts = t0 + seg * 16; const int col = C_CX + chg;
            float x0 = ts >= 3 ? proj[(rowb + ts - 3) * NINP + col] : 0.f, x1 = ts >= 2 ? proj[(rowb + ts - 2) * NINP + col] : 0.f, x2 = ts >= 1 ? proj[(rowb + ts - 1) * NINP + col] : 0.f;
#pragma unroll 4
            for (int i = 0; i < 16; ++i) { const float x3 = proj[(rowb + ts + i) * NINP + col]; xcv[(seg * 16 + i) * 64 + cch] = w0 * x0 + w1 * x1 + w2 * x2 + w3 * x3 + cb; x0 = x1; x1 = x2; x2 = x3; }
        }
        __syncthreads();
        for (int tt = tg * 32; tt < tg * 32 + 32; ++tt) {
            float acc0 = 0.f, acc1 = 0.f;
#pragma unroll
            for (int i = 0; i < 64; i += 4) { const f32x4 x = *(const LAS f32x4*)(xcv + tt * 64 + i); acc0 += x.x * wreg[i] + x.z * wreg[i + 2]; acc1 += x.y * wreg[i + 1] + x.w * wreg[i + 3]; }
            (g ? ia : ra)[tt * 64 + j] = sigm(acc0 + acc1 + gbias);
        }
        __syncthreads();
        {
            float A = 1.f, B = 0.f;
            for (int i = 0; i < 16; ++i) { const int tt = seg * 16 + i; const float r = ra[tt * 64 + cch], ig = ia[tt * 64 + cch], x = xcv[tt * 64 + cch];
                const float la = -8.f * r * spl; const float at = __expf(la); float mult = sqrtf(fmaxf(0.f, -expm1f(2.f * la)));
                if (t0 + tt == 0) mult = 1.f;
                const float bt = mult * (ig * x); ra[tt * 64 + cch] = at; ia[tt * 64 + cch] = bt; A *= at; B = at * B + bt; }
            segA[seg * 64 + cch] = A; segB[seg * 64 + cch] = B;
        }
        __syncthreads();
        {
            float hh = carry[(tile & 1) * 64 + cch];
            for (int s = 0; s < seg; ++s) hh = segA[s * 64 + cch] * hh + segB[s * 64 + cch];
            for (int i = 0; i < 16; ++i) { const int tt = seg * 16 + i; hh = ra[tt * 64 + cch] * hh + ia[tt * 64 + cch];
                const float cg_ = proj[(rowb + t0 + tt) * NINP + C_CG + chg];
                const unsigned w = pk2(hh * gelu_tanh(cg_), 0.f); mixo[(rowb + t0 + tt) * D + 1536 + chg] = (bf16_t)(w & 0xffffu); }
            if (seg == 7) { carry[((tile + 1) & 1) * 64 + cch] = hh; hlast = hh; }
        }
        __syncthreads();
    }
    if (seg == 7) c.out[O_RHP + ((size_t)l * BATCH + b) * 512 + chg] = hlast;
}

DI void block_reduce_cols(LAS float* red, LAS float* full, const float (&p)[4], int tid, float scale) {
    const int e4 = (tid & 31) * 4, dgp = tid >> 5;
    *(LAS f32x4*)(red + dgp * 128 + e4) = (f32x4){p[0], p[1], p[2], p[3]};
    __syncthreads();
    if (tid < 128) { float s = 0.f;
#pragma unroll
        for (int k = 0; k < 16; ++k) s += red[k * 128 + tid];
        full[tid] = s * scale; }
    __syncthreads();
}
DI void unit_b_sample(const Ctx& c0, int l, int b, int h) {
    const Ctx c = fresh(c0);
    const Args& a = *c.a; const int tid = c.tid, lane = c.lane, wave = c.wave;
    LAS float* qkv = (LAS float*)c.lds;
    LAS float* scl = qkv + 384;
    LAS float* red = scl + 8;
    LAS float* full = red + 2048;
    LAS float* uu = full + 128;
    const float* proj = (const float*)(c.ws + WS_PROJ) + (size_t)(NP + b) * NINP;
    if (tid < 384) { const int part = tid >> 7, idx = tid & 127, cc = part * 1024 + h * 128 + idx;
        const float* cw = inp(a, I_BCW) + (size_t)l * 4 * 3072; const float* st = inp(a, I_SGC) + (((size_t)l * NS + b) * 3) * 3072;
        const float x0 = st[cc], x1 = st[3072 + cc], x2 = st[2 * 3072 + cc], x3 = proj[C_BQ + cc];
        qkv[tid] = silu(cw[cc] * x0 + cw[3072 + cc] * x1 + cw[2 * 3072 + cc] * x2 + cw[3 * 3072 + cc] * x3);
        float* so = c.out + O_GCS + (((size_t)l * NS + b) * 3) * 3072; so[cc] = x1; so[3072 + cc] = x2; so[2 * 3072 + cc] = x3; }
    if (tid == 384) { const float bb = proj[C_BB + h], ba = proj[C_BA + h]; scl[0] = sigm(bb); scl[1] = __expf(-__expf(inp(a, I_BALOG)[l * 8 + h]) * softplus(ba + inp(a, I_BDT)[l * 8 + h])); }
    __syncthreads();
    if (wave < 2) { const float x0 = qkv[wave * 128 + lane], x1 = qkv[wave * 128 + 64 + lane]; const float ss = wave_sum(x0 * x0 + x1 * x1);
        if (lane == 0) scl[2 + wave] = rsqrtf(ss + L2_EPS) * (wave == 0 ? 0.08838834764831845f : 1.f); }
    __syncthreads();
    const float beta = scl[0], eg = scl[1], sq = scl[2], sk = scl[3];
    const int e4 = (tid & 31) * 4, d0 = (tid >> 5) * 8;
    const size_t sidx = (((size_t)l * NS + b) * 8 + h) * 16384;
    const float* Sin = inp(a, I_SGD) + sidx; float* Sout = c.out + O_GDS + sidx;
    f32x4 S[8]; float p[4] = {0.f, 0.f, 0.f, 0.f};
#pragma unroll
    for (int i = 0; i < 8; ++i) { S[i] = *(const f32x4*)(Sin + (size_t)(d0 + i) * 128 + e4); const float k = qkv[128 + d0 + i]; p[0] += k * S[i].x; p[1] += k * S[i].y; p[2] += k * S[i].z; p[3] += k * S[i].w; }
    block_reduce_cols(red, full, p, tid, sk);
    if (tid < 128) uu[tid] = beta * (qkv[256 + tid] - eg * full[tid]) * sk;
    __syncthreads();
    const f32x4 u4 = *(const LAS f32x4*)(uu + e4);
    float po[4] = {0.f, 0.f, 0.f, 0.f};
#pragma unroll
    for (int i = 0; i < 8; ++i) { const float k = qkv[128 + d0 + i], q = qkv[d0 + i]; S[i] = S[i] * eg + u4 * k; *(f32x4*)(Sout + (size_t)(d0 + i) * 128 + e4) = S[i];
        po[0] += q * S[i].x; po[1] += q * S[i].y; po[2] += q * S[i].z; po[3] += q * S[i].w; }
    block_reduce_cols(red, full, po, tid, sq);
    if (wave < 2) { const float o = full[wave * 64 + lane]; const float ss = wave_sum(o * o); if (lane == 0) scl[4 + wave] = ss; }
    __syncthreads();
    if (tid < 128) { const float rms = rsqrtf((scl[4] + scl[5]) * (1.f / 128.f) + NORM_EPS);
        const float o = full[tid] * rms * inp(a, I_BNORM)[l * 128 + tid] * silu(proj[C_BZ + h * 128 + tid]);
        ((bf16_t*)(c.ws + WS_MIXO))[(size_t)(NP + b) * D + 512 + h * 128 + tid] = (bf16_t)(pk2(o, 0.f) & 0xffffu); }
    __syncthreads();
}
DI void unit_a_sample(const Ctx& c0, int l, int b, int h) {
    const Ctx c = fresh(c0);
    const Args& a = *c.a; const int tid = c.tid, lane = c.lane, wave = c.wave;
    LAS float* fqv = (LAS float*)c.lds;
    LAS float* scl = fqv + 384;
    LAS float* red = scl + 8;
    LAS float* full = red + 2048;
    const float* proj = (const float*)(c.ws + WS_PROJ) + (size_t)(NP + b) * NINP;
    if (tid < 384) { const int part = tid >> 7, idx = tid & 127;
        if (part == 0) { const float lb = lb_of(a, l, h * 128 + idx); fqv[tid] = lb + (1.f - lb) * sigm(proj[C_AF + h * 128 + idx]); }
        else if (part == 1) fqv[tid] = silu(proj[C_AQ + h * 128 + idx]);
        else fqv[tid] = proj[C_AI + h * 128 + idx]; }
    __syncthreads();
    const int e4 = (tid & 31) * 4, d0 = (tid >> 5) * 8;
    const size_t sidx = (((size_t)l * NS + b) * 4 + h) * 16384;
    const float* Sin = inp(a, I_SHG) + sidx; float* Sout = c.out + O_HGS + sidx;
    const f32x4 v4 = *(const LAS f32x4*)(fqv + 256 + e4);
    float po[4] = {0.f, 0.f, 0.f, 0.f};
#pragma unroll
    for (int i = 0; i < 8; ++i) { const float f = fqv[d0 + i], q = fqv[128 + d0 + i]; f32x4 S = *(const f32x4*)(Sin + (size_t)(d0 + i) * 128 + e4);
        S = S * f + v4 * (1.f - f); *(f32x4*)(Sout + (size_t)(d0 + i) * 128 + e4) = S;
        po[0] += q * S.x; po[1] += q * S.y; po[2] += q * S.z; po[3] += q * S.w; }
    block_reduce_cols(red, full, po, tid, 1.f);
    if (wave < 2) { const float o = full[wave * 64 + lane]; const float ss = wave_sum(o * o); if (lane == 0) scl[4 + wave] = ss; }
    __syncthreads();
    if (tid < 128) { const float rms = rsqrtf((scl[4] + scl[5]) * (1.f / 128.f) + NORM_EPS);
        const float o = full[tid] * rms * inp(a, I_ANORM)[l * 128 + tid] * silu(proj[C_AG + h * 128 + tid]);
        ((bf16_t*)(c.ws + WS_MIXO))[(size_t)(NP + b) * D + h * 128 + tid] = (bf16_t)(pk2(o, 0.f) & 0xffffu); }
    __syncthreads();
}
DI void unit_c_sample(const Ctx& c0, int l, int b) {
    const Ctx c = fresh(c0);
    const Args& a = *c.a; const int tid = c.tid;
    LAS float* xc = (LAS float*)c.lds;
    const float* proj = (const float*)(c.ws + WS_PROJ) + (size_t)(NP + b) * NINP;
    const float* ccw = inp(a, I_CCW) + (size_t)l * 4 * 512; const float* st = inp(a, I_SRC) + (((size_t)l * NS + b) * 3) * 512;
    const float x0 = st[tid], x1 = st[512 + tid], x2 = st[1024 + tid], x3 = proj[C_CX + tid];
    const float xv = ccw[tid] * x0 + ccw[512 + tid] * x1 + ccw[1024 + tid] * x2 + ccw[1536 + tid] * x3 + inp(a, I_CCB)[l * 512 + tid];
    xc[tid] = xv;
    { float* so = c.out + O_RCS + (((size_t)l * NS + b) * 3) * 512; so[tid] = x1; so[512 + tid] = x2; so[1024 + tid] = x3; }
    __syncthreads();
    const int n = tid >> 6, j = tid & 63;
    const float* wa = inp(a, I_CWA) + ((size_t)l * 8 + n) * 4096 + j; const float* wx = inp(a, I_CWX) + ((size_t)l * 8 + n) * 4096 + j;
    float sa = 0.f, sx = 0.f;
#pragma unroll 8
    for (int i = 0; i < 64; ++i) { const float x = xc[n * 64 + i]; sa += x * wa[i * 64]; sx += x * wx[i * 64]; }
    const float r = sigm(sa + inp(a, I_CBA)[l * 512 + tid]), ig = sigm(sx + inp(a, I_CBX)[l * 512 + tid]);
    const float la = -8.f * r * softplus(-inp(a, I_CLAM)[l * 512 + tid]); const float at = __expf(la); const float mult = sqrtf(fmaxf(0.f, -expm1f(2.f * la)));
    const float h0 = inp(a, I_SRH)[((size_t)l * NS + b) * 512 + tid];
    const float hh = at * h0 + mult * (ig * xv);
    c.out[O_RHS + ((size_t)l * NS + b) * 512 + tid] = hh;
    ((bf16_t*)(c.ws + WS_MIXO))[(size_t)(NP + b) * D + 1536 + tid] = (bf16_t)(pk2(hh * gelu_tanh(proj[C_CG + tid]), 0.f) & 0xffffu);
    __syncthreads();
}

DI void phase_mix(const Ctx& c, int l) {
    int w = blockIdx.x; asm volatile("" : "+s"(w));
    if (w < 128) unit_b_prompt(c, l, w >> 5, (w >> 2) & 7, w & 3);
    else if (w < 192) { const int u = w - 128; unit_a_prompt(c, l, u >> 4, (u >> 2) & 3, u & 3); }
    else if (w < 224) { const int u = w - 192; unit_c_prompt(c, l, u >> 3, u & 7); }
    if (w >= 128) {
        const int nw = c.G - 128;
        __syncthreads();
        for (int u = w - 128; u < 1664; u += nw) {
            if (u < 1024) unit_b_sample(c, l, u >> 3, u & 7);
            else if (u < 1536) { const int v = u - 1024; unit_a_sample(c, l, v >> 2, v & 3); }
            else unit_c_sample(c, l, u - 1536);
        }
    }
}

DI void phase_m3(const Ctx& c0, int l) {
    const Ctx c = fresh(c0);
    const Args& a = *c.a; const int lane = c.lane;
    const int gw = c.bid * 8 + c.wave, NGW = c.G * 8;
    const float* proj = (const float*)(c.ws + WS_PROJ); const float* oraw = (const float*)(c.ws + WS_MIXF); bf16_t* mixo = (bf16_t*)(c.ws + WS_MIXO);
    for (int m = gw; m < NP; m += NGW) {
#pragma unroll 4
        for (int hh = 0; hh < 12; ++hh) {
            const f32x2 v = *(const f32x2*)(oraw + (size_t)m * ORAW_W + hh * 128 + 2 * lane);
            const float r = rsqrtf(wave_sum(v.x * v.x + v.y * v.y) * (1.f / 128.f) + NORM_EPS);
            const float* nw = (hh < 4 ? inp(a, I_ANORM) : inp(a, I_BNORM)) + l * 128 + 2 * lane;
            const int gcol = (hh < 4) ? (C_AG + hh * 128) : (C_BZ + (hh - 4) * 128);
            const f32x2 gt = *(const f32x2*)(proj + (size_t)m * NINP + gcol + 2 * lane);
            *(unsigned*)(mixo + (size_t)m * D + hh * 128 + 2 * lane) = pk2(v.x * r * nw[0] * silu(gt.x), v.y * r * nw[1] * silu(gt.y));
        }
    }
    const int gt_ = (c.bid * 512 + c.tid), NT = c.G * 512;
    for (int i = gt_; i < BATCH * 3 * 3072; i += NT) { const int b = i / (3 * 3072), r = i - b * 3 * 3072, j = r / 3072, cc = r - j * 3072;
        c.out[O_GCP + (size_t)l * BATCH * 3 * 3072 + i] = proj[((size_t)b * SEQ + SEQ - 3 + j) * NINP + C_BQ + cc]; }
    for (int i = gt_; i < BATCH * 3 * 512; i += NT) { const int b = i / (3 * 512), r = i - b * 3 * 512, j = r / 512, cc = r - j * 512;
        c.out[O_RCP + (size_t)l * BATCH * 3 * 512 + i] = proj[((size_t)b * SEQ + SEQ - 3 + j) * NINP + C_CX + cc]; }
}

__global__ void __launch_bounds__(512, 2) fwd_megakernel(Args args) {
    extern __shared__ __attribute__((aligned(16))) unsigned char lds_raw[];
    Ctx c0; c0.a = &args; c0.ws = nullptr; c0.out = nullptr; c0.lds = (LAS unsigned char*)lds_raw; c0.tid = 0; c0.lane = 0; c0.wave = 0; c0.G = gridDim.x; c0.bid = 0;
    const int lo = args.ph_lo, hi = args.ph_hi;
#pragma unroll 1
    for (int ph = lo; ph < hi; ++ph) {
        const int l = (ph - 1) >> 3, k = (ph == 0) ? -1 : ((ph - 1) & 7);
        if (k == -1) phase_p0(c0);
        else if (k == 0 || k == 3 || k == 5 || k == 6) {
            const Ctx c = fresh(c0); unsigned char* ws = c.ws;
            pg8::Gemm g; pg8::EpiAny E; E.mode = 0; E.C = (float*)(ws + WS_MIXF); E.O = nullptr; E.ldc = D;
            if (k == 0)      { g.A = (const bf16_t*)(ws + WS_HBUF); g.Bt = (const bf16_t*)(ws + WS_WIN + l * SZ_WIN);   g.N = NINP; g.K = D;   E.C = (float*)(ws + WS_PROJ); E.ldc = NINP; }
            else if (k == 3) { g.A = (const bf16_t*)(ws + WS_MIXO); g.Bt = (const bf16_t*)(ws + WS_WOUT + l * SZ_WOUT); g.N = D;    g.K = D; }
            else if (k == 5) { g.A = (const bf16_t*)(ws + WS_HBUF); g.Bt = (const bf16_t*)(ws + WS_WGU + l * SZ_WGU);   g.N = NGU;  g.K = D;   E.mode = 1; E.O = (bf16_t*)(ws + WS_PROJ); E.ldc = DFF; }
            else             { g.A = (const bf16_t*)(ws + WS_PROJ); g.Bt = (const bf16_t*)(ws + WS_WDN + l * SZ_WDN);   g.N = D;    g.K = DFF; }
            g.M = MPAD;
            pg8::StaticOrder S; S.init(MPAD, g.N, c.G, c.bid);
            pg8::gemm_phase<pg8::EpiAny, pg8::StaticOrder, true, true>(c.lds, g, S, E);
        }
        else if (k == 1) phase_mix(c0, l);
        else if (k == 2) phase_m3(c0, l);
        else {
            const Ctx c = fresh(c0); unsigned char* ws = c.ws;
            float* mixf = (float*)(ws + WS_MIXF); float* x1 = (float*)(ws + WS_X1); bf16_t* hb = (bf16_t*)(ws + WS_HBUF);
            if (k == 4) {
                const float* xa = (l == 0) ? inp(args, I_XP) : c.out; const float* xb = (l == 0) ? inp(args, I_XS) : c.out + (size_t)NP * D;
                row_phase(c0, mixf, xa, xb, x1, inp(args, I_LN2) + l * D, inp(args, I_LN3) + l * D, hb);
            } else {
                row_phase(c0, mixf, x1, x1 + (size_t)NP * D, c.out, inp(args, I_LN4) + l * D, l == 0 ? inp(args, I_LN1) + D : nullptr, hb);
            }
        }
        if (ph + 1 < hi) cg::this_grid().sync();
    }
}

extern "C" void kernel_launch(void* const* d_in, const int* in_sizes, int n_in, void* d_out, int out_size, void* d_ws, size_t ws_size, hipStream_t stream) {
    static int grid = 0;
    if (grid == 0) {
        if (n_in != 29 || (size_t)out_size != O_END || ws_size < WS_END) { fprintf(stderr, "kernel_launch: unexpected shapes: n_in %d out %d ws %zu (need %zu)\n", n_in, out_size, ws_size, (size_t)WS_END); grid = -1; return; }
        int dev = 0, cus = 0, per_cu = 0;
        hipGetDevice(&dev); hipDeviceGetAttribute(&cus, hipDeviceAttributeMultiprocessorCount, dev);
        if (hipFuncSetAttribute((const void*)fwd_megakernel, hipFuncAttributeMaxDynamicSharedMemorySize, LDS_BYTES) != hipSuccess) { fprintf(stderr, "kernel_launch: hipFuncSetAttribute failed\n"); grid = -1; return; }
        if (hipOccupancyMaxActiveBlocksPerMultiprocessor(&per_cu, (const void*)fwd_megakernel, 512, LDS_BYTES) != hipSuccess || per_cu < 1) { fprintf(stderr, "kernel_launch: occupancy query says %d\n", per_cu); grid = -1; return; }
        grid = cus;
        if (grid < 224) { fprintf(stderr, "kernel_launch: needs >= 224 CUs, got %d\n", grid); grid = -1; return; }
    }
    if (grid < 0) return;
    hipMemsetAsync((char*)d_ws + WS_CTL, 0, CTL_BYTES, stream);
    Args a{};
    for (int i = 0; i < 29; ++i) a.in[i] = (const float*)d_in[i];
    a.out = (float*)d_out; a.ws = (unsigned char*)d_ws;
#if MK_MULTI
    for (int ph = 0; ph < NPHASE; ++ph) { a.ph_lo = ph; a.ph_hi = ph + 1; hipLaunchKernelGGL(fwd_megakernel, dim3(grid), dim3(512), LDS_BYTES, stream, a); }
#else
    a.ph_lo = 0; a.ph_hi = NPHASE;
    void* kargs[] = {&a};
    hipError_t e = hipLaunchCooperativeKernel((const void*)fwd_megakernel, dim3(grid), dim3(512), kargs, LDS_BYTES, stream);
    if (e != hipSuccess) fprintf(stderr, "cooperative launch failed: %s (grid %d)\n", hipGetErrorString(e), grid);
#endif
}
```

```cpp
#include <hip/hip_runtime.h>
#include <hip/hip_cooperative_groups.h>
#include <cstdio>
#include <cstdint>
namespace cg = cooperative_groups;

#ifndef MK_MULTI
#define MK_MULTI 0
#endif

#ifndef PROBE_REP
#define PROBE_REP (-2)
#endif
#define DI __device__ __forceinline__
#define LAS __attribute__((address_space(3)))
#define GAS __attribute__((address_space(1)))
typedef unsigned short bf16_t;
typedef float f32x4 __attribute__((ext_vector_type(4)));
typedef float f32x2 __attribute__((ext_vector_type(2)));
typedef unsigned u32x4 __attribute__((ext_vector_type(4)));
typedef unsigned u32x2 __attribute__((ext_vector_type(2)));
typedef short bf16x8 __attribute__((ext_vector_type(8)));
typedef __bf16 bf16v2 __attribute__((ext_vector_type(2)));

constexpr int D = 2048, SEQ = 2048, BATCH = 4, NP = BATCH * SEQ, NS = 128, MT = NP + NS, MPAD = 8448;
constexpr int NIN = 7184, NINP = 7424, DFF = 5632, NGU = 2 * DFF;
constexpr int C_AQ = 0, C_AF = 512, C_AI = 1024, C_AG = 1536, C_BQ = 2048, C_BK = 3072, C_BV = 4096, C_BZ = 5120, C_BB = 6144, C_BA = 6152, C_CX = 6160, C_CG = 6672;
constexpr float NORM_EPS = 1e-6f, L2_EPS = 1e-6f;
constexpr int NPHASE = 17;

constexpr size_t O_YP = 0, O_YS = O_YP + (size_t)NP * D, O_HGP = O_YS + (size_t)NS * D, O_HGS = O_HGP + 2ull * 4 * 4 * 16384,
                 O_GDP = O_HGS + 2ull * 128 * 4 * 16384, O_GDS = O_GDP + 2ull * 4 * 8 * 16384, O_GCP = O_GDS + 2ull * 128 * 8 * 16384,
                 O_GCS = O_GCP + 2ull * 4 * 3 * 3072, O_RHP = O_GCS + 2ull * 128 * 3 * 3072, O_RHS = O_RHP + 2ull * 4 * 512,
                 O_RCP = O_RHS + 2ull * 128 * 512, O_RCS = O_RCP + 2ull * 4 * 3 * 512, O_END = O_RCS + 2ull * 128 * 3 * 512;

constexpr size_t MiB = 1ull << 20;
constexpr size_t WS_CTL = 0, CTL_BYTES = 1 * MiB;
constexpr size_t WS_WIN = 1 * MiB, SZ_WIN = 29 * MiB, WS_WOUT = WS_WIN + 2 * SZ_WIN, SZ_WOUT = 8 * MiB, WS_WGU = WS_WOUT + 2 * SZ_WOUT, SZ_WGU = 44 * MiB,
                 WS_WDN = WS_WGU + 2 * SZ_WGU, SZ_WDN = 22 * MiB;
constexpr size_t WS_PROJ = WS_WDN + 2 * SZ_WDN, SZ_PROJ = 240 * MiB;
constexpr size_t WS_HBUF = WS_PROJ + SZ_PROJ, SZ_HBUF = 33 * MiB;
constexpr size_t WS_MIXO = WS_HBUF + SZ_HBUF;
constexpr size_t WS_MIXF = WS_MIXO + SZ_HBUF, SZ_MIXF = 66 * MiB;
constexpr size_t WS_X1 = WS_MIXF + SZ_MIXF, WS_END = WS_X1 + SZ_MIXF + 25 * MiB;
static_assert((size_t)NINP * D * 2 == SZ_WIN && (size_t)NGU * D * 2 == SZ_WGU && (size_t)D * DFF * 2 == SZ_WDN && (size_t)D * D * 2 == SZ_WOUT, "weight sizes");
static_assert((size_t)MPAD * NINP * 4 <= SZ_PROJ && (size_t)MPAD * D * 2 <= SZ_HBUF && (size_t)MPAD * D * 4 <= SZ_MIXF, "ws map");

constexpr int LDS_BYTES = 147456;

DI unsigned pk2(float lo, float hi) { f32x2 x = {lo, hi}; bf16v2 y = __builtin_convertvector(x, bf16v2); return __builtin_bit_cast(unsigned, y); }
DI float wave_sum(float v) {
#pragma unroll
    for (int o = 1; o < 64; o <<= 1) v += __shfl_xor(v, o);
    return v;
}
template <int CTRL> DI float dpp_mov(float v) { return __int_as_float(__builtin_amdgcn_update_dpp(0, __float_as_int(v), CTRL, 0xF, 0xF, true)); }
DI float row16_sum(float v) {
    v += dpp_mov<0xB1>(v); v += dpp_mov<0x4E>(v); v += dpp_mov<0x124>(v); v += dpp_mov<0x128>(v); return v;
}
DI float sigm(float x) { return 1.f / (1.f + __expf(-x)); }
DI float silu(float x) { return x / (1.f + __expf(-x)); }
DI float softplus(float x) { return x > 20.f ? x : log1pf(__expf(x)); }
DI float gelu_tanh(float x) { const float y = 0.7978845608028654f * (x + 0.044715f * x * x * x); return 0.5f * x * (1.f + tanhf(y)); }
#define LDS_WAIT() asm volatile("s_waitcnt lgkmcnt(0)" ::: "memory")

namespace pg8 {
#define PG8_LAS __attribute__((address_space(3)))
constexpr int BM = 256, BK = 64, HALF = 128, HTB = HALF * BK * 2, STAGE_BYTES = 8 * HTB, NXCD = 8, WGM = 8;
__host__ __device__ __forceinline__ int lds_byte(int r, int c) { const int st = (r >> 4) * 2 + (c >> 5), rr = r & 15, cc = c & 31, ob = rr * 64 + cc * 2; return st * 1024 + (ob ^ (((ob >> 9) & 1) << 5)); }
__host__ __device__ __forceinline__ void stage_rc(int b, int& R, int& C) { const int st = b / 1024, sb = b % 1024, swz = sb ^ (((sb >> 9) & 1) << 5); R = (st >> 1) * 16 + swz / 64; C = (st & 1) * 32 + (swz % 64) / 2; }
struct Unit { int pm, pn; };
struct Gemm { const bf16_t* A; const bf16_t* Bt; int M, N, K; };
struct StaticOrder {
    int nM, nN, nwg, G, c;
    __host__ __device__ void init(int M, int N, int G_, int c_) { nM = M / BM; nN = N / BM; nwg = nM * nN; G = G_; c = c_; }
    __host__ __device__ bool next(int i, Unit& u) const {
        const long L = (long)i * G + c; if (L >= nwg) return false;
        int wgid = (int)L; { const int q = nwg / NXCD, r = nwg % NXCD, xcd = wgid % NXCD, off = wgid / NXCD; wgid = (xcd < r ? xcd * (q + 1) : r * (q + 1) + (xcd - r) * q) + off; }
        const int nig = WGM * nN, gid = wgid / nig, fm = gid * WGM, gsz = (nM - fm) < WGM ? (nM - fm) : WGM;
        u.pm = fm + ((wgid % nig) % gsz); u.pn = (wgid % nig) / gsz; return true;
    }
    __device__ __forceinline__ void a_ready(const Unit&) const {}
    __device__ __forceinline__ void done(const Unit&) const {}
};
struct EpiAny {
    static constexpr bool PERM = false, AFTER_DRAIN = false;
    int mode; float* C; bf16_t* O; int ldc;
    __device__ __forceinline__ void operator()(const f32x4 (&acc)[2][2][4][2], const Unit& u, int wr, int wc, int fr, int fq) const {
        const int row0 = u.pm * BM + wr * 64 + fr;
        if (mode == 0) {
            const int col0 = u.pn * BM + wc * 32 + 4 * fq;
#pragma unroll
            for (int ai = 0; ai < 2; ++ai)
#pragma unroll
                for (int m = 0; m < 4; ++m) { float* rowp = C + (size_t)(row0 + ai * HALF + m * 16) * ldc + col0;
#pragma unroll
                    for (int bj = 0; bj < 2; ++bj)
#pragma unroll
                        for (int n = 0; n < 2; ++n) *(f32x4*)(rowp + bj * HALF + n * 16) = acc[ai][bj][m][n]; }
        } else {
#pragma unroll
            for (int ai = 0; ai < 2; ++ai)
#pragma unroll
                for (int m = 0; m < 4; ++m) { bf16_t* rowp = O + (size_t)(row0 + ai * HALF + m * 16) * ldc;
#pragma unroll
                    for (int bj = 0; bj < 2; ++bj) { const int G = 8 * u.pn + 4 * bj + wc; const f32x4 g = acc[ai][bj][m][0], up = acc[ai][bj][m][1];
                        u32x2 w; w.x = pk2(silu(g[0]) * up[0], silu(g[1]) * up[1]); w.y = pk2(silu(g[2]) * up[2], silu(g[3]) * up[3]);
                        *(u32x2*)(rowp + 16 * G + 4 * fq) = w; } }
        }
    }
};

template <class Epi, class Sched, bool ALIGN_EPI = false, bool SP2 = false>
__device__ __forceinline__ void gemm_phase(PG8_LAS unsigned char* lds, const Gemm g, const Sched& S, const Epi& E) {
    int tid_ = threadIdx.x; asm volatile("" : "+v"(tid_));
    const int tid = tid_, wid = __builtin_amdgcn_readfirstlane(tid >> 6), lane = tid & 63, wr = wid >> 2, wc = wid & 3, fr = lane & 15, fq = lane >> 4;
    const int K = g.K, nt = K / BK;
    unsigned voffA[2], voffB[2];
#pragma unroll
    for (int i = 0; i < 2; ++i) { int R, C; stage_rc(tid * 16 + i * 8192, R, C); voffA[i] = (unsigned)(R * K + C) * 2u; voffB[i] = (unsigned)(R * K + C) * 2u; }
    const size_t kstep = (size_t)(BK * 2);
    const size_t hstep = (size_t)HALF * K * 2;
    const size_t tstep = 2 * hstep;
    const unsigned ldsw = (unsigned)wid * 1024u;
    const int aoff = lds_byte(wr * 64 + fr, fq * 8), boff = lds_byte(wc * 32 + fr, fq * 8);
#define PG8_SA(b, h) (((b) * 2 + (h)) * HTB)
#define PG8_SB(b, h) ((4 + (b) * 2 + (h)) * HTB)
#define PG8_STAGE(bufoff, gbase, voff) do { _Pragma("unroll") for (int _i = 0; _i < 2; ++_i) \
        __builtin_amdgcn_global_load_lds((const unsigned*)((const char*)(gbase) + (voff)[_i]), (PG8_LAS unsigned*)(lds + (bufoff) + ldsw + _i * 8192), 16, 0, 0); } while (0)
#define PG8_LDA(dst, b, h) do { _Pragma("unroll") for (int m = 0; m < 4; ++m) _Pragma("unroll") for (int k = 0; k < 2; ++k) dst[m][k] = *(const PG8_LAS bf16x8*)(lds + PG8_SA(b, h) + aoff + m * 2048 + k * 1024); } while (0)
#define PG8_LDB(dst, b, h) do { _Pragma("unroll") for (int n = 0; n < 2; ++n) _Pragma("unroll") for (int k = 0; k < 2; ++k) dst[n][k] = *(const PG8_LAS bf16x8*)(lds + PG8_SB(b, h) + boff + n * 2048 + k * 1024); } while (0)
#define PG8_MMA(ai, bj, At, Bt) do { __builtin_amdgcn_s_setprio(1); _Pragma("unroll") for (int m = 0; m < 4; ++m) _Pragma("unroll") for (int n = 0; n < 2; ++n) _Pragma("unroll") for (int k = 0; k < 2; ++k) \
        acc[ai][bj][m][n] = __builtin_amdgcn_mfma_f32_16x16x32_bf16(Bt[n][k], At[m][k], acc[ai][bj][m][n], 0, 0, 0); __builtin_amdgcn_s_setprio(0); } while (0)
#define PG8_WAIT_V(n) asm volatile("s_waitcnt vmcnt(" #n ")" ::: "memory")
#define PG8_WAIT_L(n) asm volatile("s_waitcnt lgkmcnt(" #n ")" ::: "memory")
#define PG8_BAR __builtin_amdgcn_s_barrier()
#define PG8_SCHED __builtin_amdgcn_sched_barrier(0)
    Unit cur, nxt; int ui = 0;
    if (!S.next(0, cur)) return;
    f32x4 acc[2][2][4][2];
#pragma unroll
    for (int a = 0; a < 2; ++a)
#pragma unroll
        for (int b = 0; b < 2; ++b)
#pragma unroll
            for (int m = 0; m < 4; ++m)
#pragma unroll
                for (int n = 0; n < 2; ++n) acc[a][b][m][n] = (f32x4){0.f, 0.f, 0.f, 0.f};
    bf16x8 At[4][2], B0[2][2], B1[2][2];
    const char* cA = (const char*)g.A + (size_t)cur.pm * tstep; const char* cB = (const char*)g.Bt + (size_t)cur.pn * tstep;
    S.a_ready(cur);
    if constexpr (SP2) {
        PG8_STAGE(PG8_SB(0, 0), cB, voffB); PG8_STAGE(PG8_SB(0, 1), cB + hstep, voffB); PG8_STAGE(PG8_SA(0, 0), cA, voffA); PG8_STAGE(PG8_SA(0, 1), cA + hstep, voffA);
        if (wr == 1) PG8_BAR;
        PG8_WAIT_V(2); PG8_BAR;
        PG8_STAGE(PG8_SB(1, 0), cB + kstep, voffB); PG8_STAGE(PG8_SA(1, 0), cA + kstep, voffA); PG8_STAGE(PG8_SB(1, 1), cB + hstep + kstep, voffB);
        PG8_WAIT_V(6); PG8_BAR;
    } else {
        PG8_STAGE(PG8_SB(0, 0), cB, voffB); PG8_STAGE(PG8_SA(0, 0), cA, voffA); PG8_STAGE(PG8_SB(0, 1), cB + hstep, voffB); PG8_STAGE(PG8_SA(0, 1), cA + hstep, voffA);
        if (wr == 1) PG8_BAR;
        PG8_WAIT_V(4); PG8_BAR;
        PG8_STAGE(PG8_SB(1, 0), cB + kstep, voffB); PG8_STAGE(PG8_SA(1, 0), cA + kstep, voffA); PG8_STAGE(PG8_SB(1, 1), cB + hstep + kstep, voffB);
        PG8_WAIT_V(6); PG8_BAR;
    }
    for (;;) {
        const bool has_next = S.next(ui + 1, nxt);
        const char* nA = has_next ? (const char*)g.A + (size_t)nxt.pm * tstep : cA; const char* nB = has_next ? (const char*)g.Bt + (size_t)nxt.pn * tstep : cB;
        for (int t = 0; t < nt; t += 2) {
            const bool last = (t == nt - 2);
            const char* a1 = cA + (size_t)(t + 1) * kstep;
            const char* a2 = last ? nA : cA + (size_t)(t + 2) * kstep; const char* b2 = last ? nB : cB + (size_t)(t + 2) * kstep;
            const char* a3 = a2 + kstep; const char* b3 = b2 + kstep;
            if (last && has_next) S.a_ready(nxt);
            if constexpr (SP2) {
            PG8_LDB(B0, 0, 0); PG8_LDB(B1, 0, 1); PG8_SCHED; PG8_LDA(At, 0, 0); PG8_STAGE(PG8_SA(1, 1), a1 + hstep, voffA);
            PG8_WAIT_V(8); PG8_WAIT_L(0); PG8_BAR; PG8_MMA(0, 0, At, B0); PG8_MMA(0, 1, At, B1); PG8_BAR; PG8_SCHED;
            PG8_LDA(At, 0, 1); PG8_STAGE(PG8_SB(0, 0), b2, voffB); PG8_STAGE(PG8_SB(0, 1), b2 + hstep, voffB); PG8_STAGE(PG8_SA(0, 0), a2, voffA);
            PG8_WAIT_V(8); PG8_WAIT_L(0); PG8_BAR; PG8_MMA(1, 0, At, B0); PG8_MMA(1, 1, At, B1); PG8_BAR; PG8_SCHED;
            PG8_LDB(B0, 1, 0); PG8_LDB(B1, 1, 1); PG8_SCHED; PG8_LDA(At, 1, 0); PG8_STAGE(PG8_SA(0, 1), a2 + hstep, voffA);
            PG8_WAIT_V(8); PG8_WAIT_L(0); PG8_BAR; PG8_MMA(0, 0, At, B0); PG8_MMA(0, 1, At, B1); PG8_BAR; PG8_SCHED;
            PG8_LDA(At, 1, 1); PG8_STAGE(PG8_SB(1, 0), b3, voffB); PG8_STAGE(PG8_SB(1, 1), b3 + hstep, voffB); PG8_STAGE(PG8_SA(1, 0), a3, voffA);
            PG8_WAIT_V(8); PG8_WAIT_L(0); PG8_BAR; PG8_MMA(1, 0, At, B0); PG8_MMA(1, 1, At, B1); PG8_BAR; PG8_SCHED;
            } else {
            PG8_LDB(B0, 0, 0); PG8_SCHED; PG8_LDA(At, 0, 0); PG8_STAGE(PG8_SA(1, 1), a1 + hstep, voffA);
            PG8_WAIT_L(8); PG8_BAR; PG8_WAIT_L(0); PG8_MMA(0, 0, At, B0); PG8_BAR; PG8_SCHED;
            PG8_LDB(B1, 0, 1); PG8_STAGE(PG8_SB(0, 0), b2, voffB);
            PG8_BAR; PG8_WAIT_L(0); PG8_MMA(0, 1, At, B1); PG8_BAR;
            PG8_LDA(At, 0, 1); PG8_STAGE(PG8_SA(0, 0), a2, voffA);
            PG8_BAR; PG8_WAIT_L(0); PG8_MMA(1, 0, At, B0); PG8_BAR; PG8_SCHED;
            PG8_STAGE(PG8_SB(0, 1), b2 + hstep, voffB);
            PG8_WAIT_V(6); PG8_BAR; PG8_MMA(1, 1, At, B1); PG8_BAR;
            PG8_LDB(B0, 1, 0); PG8_SCHED; PG8_LDA(At, 1, 0); PG8_STAGE(PG8_SA(0, 1), a2 + hstep, voffA);
            PG8_WAIT_L(8); PG8_BAR; PG8_WAIT_L(0); PG8_MMA(0, 0, At, B0); PG8_BAR; PG8_SCHED;
            PG8_LDB(B1, 1, 1); PG8_STAGE(PG8_SB(1, 0), b3, voffB);
            PG8_BAR; PG8_WAIT_L(0); PG8_MMA(0, 1, At, B1); PG8_BAR;
            PG8_LDA(At, 1, 1); PG8_STAGE(PG8_SA(1, 0), a3, voffA);
            PG8_BAR; PG8_WAIT_L(0); PG8_MMA(1, 0, At, B0); PG8_BAR; PG8_SCHED;
            PG8_STAGE(PG8_SB(1, 1), b3 + hstep, voffB);
            PG8_WAIT_V(6); PG8_BAR; PG8_MMA(1, 1, At, B1); PG8_BAR;
            }
        }
        if constexpr (ALIGN_EPI) { if (wr == 0) PG8_BAR; }
        if constexpr (!Epi::AFTER_DRAIN) { E(acc, cur, wr, wc, fr, fq); S.done(cur); }
        if (!has_next) break;
#pragma unroll
        for (int a = 0; a < 2; ++a)
#pragma unroll
            for (int b = 0; b < 2; ++b)
#pragma unroll
                for (int m = 0; m < 4; ++m)
#pragma unroll
                    for (int n = 0; n < 2; ++n) acc[a][b][m][n] = (f32x4){0.f, 0.f, 0.f, 0.f};
        cur = nxt; cA = nA; cB = nB; ++ui;
        if constexpr (ALIGN_EPI) { if (wr == 1) PG8_BAR; }
    }
    PG8_WAIT_V(0);
    if constexpr (!ALIGN_EPI) { if (wr == 0) PG8_BAR; }
    PG8_BAR;
#undef PG8_SA
#undef PG8_SB
#undef PG8_STAGE
#undef PG8_LDA
#undef PG8_LDB
#undef PG8_MMA
#undef PG8_WAIT_V
#undef PG8_WAIT_L
#undef PG8_BAR
#undef PG8_SCHED
}
}

struct Args { const float* in[29]; float* out; unsigned char* ws; int ph_lo, ph_hi; };
enum { I_XP = 0, I_XS, I_SHG, I_SGD, I_SGC, I_SRH, I_SRC, I_LN1, I_LN2, I_LN3, I_LN4, I_WIN, I_WOUT, I_LB, I_ANORM, I_BCW, I_BALOG, I_BDT, I_BNORM,
       I_CCW, I_CCB, I_CWA, I_CBA, I_CWX, I_CBX, I_CLAM, I_WG, I_WU, I_WD };

struct Ctx {
    const Args* a; unsigned char* ws; float* out; LAS unsigned char* lds; int tid, lane, wave, G, bid;
};
DI Ctx fresh(const Ctx& o) {
    Ctx c = o; int t = threadIdx.x; asm volatile("" : "+v"(t)); c.tid = t; c.lane = t & 63; c.wave = __builtin_amdgcn_readfirstlane(t >> 6);
    unsigned char* w = o.a->ws; asm volatile("" : "+s"(w)); c.ws = w; float* q = o.a->out; asm volatile("" : "+s"(q)); c.out = q;
    int b = blockIdx.x; asm volatile("" : "+s"(b)); c.bid = b; return c;
}
DI const float* inp(const Args& a, int idx) { int z = idx; asm volatile("" : "+s"(z)); return a.in[z]; }

template <int MODE>
DI void transpose_item(const float* W, int K, int Nsrc, int nblk, bf16_t* WT, LAS float* scr, int item, int lane) {
    const int kb = item / nblk, nb = item - kb * nblk, k0 = 64 * kb, n0 = 32 * nb;
    const int nn = n0 + (lane & 31); const bool ok = nn < Nsrc;
#pragma unroll 8
    for (int i = 0; i < 32; ++i) { const int kk = 2 * i + (lane >> 5); scr[kk * 33 + (lane & 31)] = ok ? W[(size_t)(k0 + kk) * Nsrc + nn] : 0.f; }
    LDS_WAIT(); asm volatile("" ::: "memory");
    const int c = lane & 7;
#pragma unroll
    for (int j = 0; j < 4; ++j) { const int nl = (lane >> 3) + 8 * j; const LAS float* s = scr + (8 * c) * 33 + nl;
        u32x4 o; o.x = pk2(s[0 * 33], s[1 * 33]); o.y = pk2(s[2 * 33], s[3 * 33]); o.z = pk2(s[4 * 33], s[5 * 33]); o.w = pk2(s[6 * 33], s[7 * 33]);
        const int n = n0 + nl; const int drow = (MODE == 0) ? n : ((n >> 4) * 32 + (n & 15) + (MODE == 2 ? 16 : 0));
        *(u32x4*)(WT + (size_t)drow * K + k0 + 8 * c) = o; }
    LDS_WAIT(); asm volatile("" ::: "memory");
}
DI void norm_row_to_bf16(const float* xr, const float* g, bf16_t* orow, int lane) {
    f32x4 v[8]; float s = 0.f;
#pragma unroll
    for (int j = 0; j < 8; ++j) { v[j] = ((const f32x4*)xr)[lane + 64 * j]; s += (v[j].x * v[j].x + v[j].y * v[j].y) + (v[j].z * v[j].z + v[j].w * v[j].w); }
    const float r = rsqrtf(wave_sum(s) * (1.f / D) + NORM_EPS);
#pragma unroll
    for (int j = 0; j < 8; ++j) { const f32x4 gg = ((const f32x4*)g)[lane + 64 * j]; u32x2 w; w.x = pk2(v[j].x * r * gg.x, v[j].y * r * gg.y); w.y = pk2(v[j].z * r * gg.z, v[j].w * r * gg.w);
        ((u32x2*)orow)[lane + 64 * j] = w; }
}
DI void phase_p0(const Ctx& c0) {
    const Ctx c = fresh(c0);
    const Args& a = *c.a;
    LAS float* scr = (LAS float*)(c.lds + c.wave * 16384);
    const int gw = c.bid * 8 + c.wave, NGW = c.G * 8;
    constexpr int I_IN = (D / 64) * (NINP / 32), I_OUT = (D / 64) * (D / 32), I_G = (D / 64) * (DFF / 32), I_D = (DFF / 64) * (D / 32);
    constexpr int PER_LAYER = I_IN + I_OUT + 2 * I_G + I_D;
    for (int it = gw; it < 2 * PER_LAYER; it += NGW) {
        const int l = it / PER_LAYER; int r = it - l * PER_LAYER;
        if (r < I_IN) { transpose_item<0>(inp(a, I_WIN) + (size_t)l * D * NIN, D, NIN, NINP / 32, (bf16_t*)(c.ws + WS_WIN + l * SZ_WIN), scr, r, c.lane); continue; } r -= I_IN;
        if (r < I_OUT) { transpose_item<0>(inp(a, I_WOUT) + (size_t)l * D * D, D, D, D / 32, (bf16_t*)(c.ws + WS_WOUT + l * SZ_WOUT), scr, r, c.lane); continue; } r -= I_OUT;
        if (r < I_G) { transpose_item<1>(inp(a, I_WG) + (size_t)l * D * DFF, D, DFF, DFF / 32, (bf16_t*)(c.ws + WS_WGU + l * SZ_WGU), scr, r, c.lane); continue; } r -= I_G;
        if (r < I_G) { transpose_item<2>(inp(a, I_WU) + (size_t)l * D * DFF, D, DFF, DFF / 32, (bf16_t*)(c.ws + WS_WGU + l * SZ_WGU), scr, r, c.lane); continue; } r -= I_G;
        transpose_item<0>(inp(a, I_WD) + (size_t)l * DFF * D, DFF, D, D / 32, (bf16_t*)(c.ws + WS_WDN + l * SZ_WDN), scr, r, c.lane);
    }
    bf16_t* hb = (bf16_t*)(c.ws + WS_HBUF);
    { const float* xp = inp(a, I_XP); const float* xs = inp(a, I_XS); const float* g1 = inp(a, I_LN1);
      for (int m = gw; m < MT; m += NGW) norm_row_to_bf16(m < NP ? xp + (size_t)m * D : xs + (size_t)(m - NP) * D, g1, hb + (size_t)m * D, c.lane); }
    for (int i = gw * 64 + c.lane; i < (MPAD - MT) * D / 8; i += NGW * 64) {
        ((u32x4*)(hb + (size_t)MT * D))[i] = (u32x4){0u, 0u, 0u, 0u};
        ((u32x4*)((bf16_t*)(c.ws + WS_MIXO) + (size_t)MT * D))[i] = (u32x4){0u, 0u, 0u, 0u};
    }
}

DI void row_phase(const Ctx& c0, const float* y, const float* xa, const float* xb, float* xout, const float* g_post, const float* g_next, bf16_t* hb) {
    const Ctx c = fresh(c0);
    const int gw = c.bid * 8 + c.wave, NGW = c.G * 8, lane = c.lane;
    for (int m = gw; m < MT; m += NGW) {
        const float* yr = y + (size_t)m * D; const float* xr = m < NP ? xa + (size_t)m * D : xb + (size_t)(m - NP) * D;
        f32x4 v[8]; float s = 0.f;
#pragma unroll
        for (int j = 0; j < 8; ++j) { v[j] = ((const f32x4*)yr)[lane + 64 * j]; s += (v[j].x * v[j].x + v[j].y * v[j].y) + (v[j].z * v[j].z + v[j].w * v[j].w); }
        const float r = rsqrtf(wave_sum(s) * (1.f / D) + NORM_EPS);
        float s2 = 0.f;
#pragma unroll
        for (int j = 0; j < 8; ++j) { const f32x4 gg = ((const f32x4*)g_post)[lane + 64 * j]; const f32x4 xx = ((const f32x4*)xr)[lane + 64 * j];
            v[j] = xx + v[j] * r * gg; s2 += (v[j].x * v[j].x + v[j].y * v[j].y) + (v[j].z * v[j].z + v[j].w * v[j].w);
            ((f32x4*)(xout + (size_t)m * D))[lane + 64 * j] = v[j]; }
        if (g_next) {
            const float r2 = rsqrtf(wave_sum(s2) * (1.f / D) + NORM_EPS);
#pragma unroll
            for (int j = 0; j < 8; ++j) { const f32x4 gg = ((const f32x4*)g_next)[lane + 64 * j]; u32x2 w; w.x = pk2(v[j].x * r2 * gg.x, v[j].y * r2 * gg.y); w.y = pk2(v[j].z * r2 * gg.z, v[j].w * r2 * gg.w);
                ((u32x2*)(hb + (size_t)m * D))[lane + 64 * j] = w; }
        }
    }
}

DI int perm32(int x) { return 8 * ((x >> 2) & 3) + 4 * (x >> 4) + (x & 3); }
DI int kpos(int k) { return (k & ~31) + perm32(k & 31); }
DI float lb_of(const Args& a, int l, int c) { if (l == 0) return 0.f; const float l0 = inp(a, I_LB)[c], l1 = inp(a, I_LB)[512 + c]; return 1.f / (1.f + __expf(l0 - l1)); }
DI bf16_t bf1(float x) { return (bf16_t)(pk2(x, 0.f) & 0xffffu); }
#define MFMA16(a, b, c) __builtin_amdgcn_mfma_f32_16x16x32_bf16((a), (b), (c), 0, 0, 0)

constexpr size_t IB_W = WS_MIXF, IB_Q = IB_W + 16 * MiB, IB_KT = IB_Q + 16 * MiB, IB_P = IB_KT + 16 * MiB, IB_U0 = IB_P + 8 * MiB,
                 IA_Q = IB_U0 + 32 * MiB, IA_KT = IA_Q + 8 * MiB, IA_P = IA_KT + 8 * MiB, IA_V = IA_P + 4 * MiB,
                 IC_A = IA_V + 16 * MiB, IC_B = IC_A + 16 * MiB, IMISC = IC_B + 16 * MiB, IB_DEC = IMISC, IA_DEC = IMISC + 65536, IC_TOT = IMISC + 524288, I_END = IMISC + 1 * MiB;
static_assert(I_END <= WS_END, "mixer intermediates must fit");

DI void m1_unit_b(const Ctx& c0, int l, int u) {
    const Ctx c = fresh(c0); const Args& a = *c.a; const int tid = c.tid, lane = c.lane, wave = c.wave;
    const int b = u >> 8, h = (u >> 5) & 7, ci = u & 31;
    LAS float* Kf = (LAS float*)c.lds;
    LAS float* Vf = Kf + 8192;
    LAS float* Qf = Vf + 8192;
    LAS float* Amat = Qf;
    LAS bf16_t* Pl = (LAS bf16_t*)(Qf + 64 * 68);
    LAS bf16_t* Qb = (LAS bf16_t*)(Qf + 8192);
    LAS bf16_t* Kb = Qb + 64 * 136;
    LAS float* scal = (LAS float*)(Kb + 64 * 136);
    const float* proj = (const float*)(c.ws + WS_PROJ);
    const long rowb = (long)b * SEQ + 64 * ci; const int tg0 = 64 * ci;
    {
        const float* cw = inp(a, I_BCW) + (size_t)l * 4 * 3072;
#pragma unroll 2
        for (int k = 0; k < 12; ++k) {
            const int task = tid + 512 * k, tg = task / 384, cc = task - tg * 384, part = cc >> 7, idx = cc & 127;
            const int ch = part * 1024 + h * 128 + idx, col = C_BQ + ch;
            const float w0 = cw[ch], w1 = cw[3072 + ch], w2 = cw[2 * 3072 + ch], w3 = cw[3 * 3072 + ch];
            float x[7];
#pragma unroll
            for (int j = 0; j < 7; ++j) { const int t = 4 * tg - 3 + j; x[j] = (tg0 + t >= 0) ? proj[(rowb + t) * NINP + col] : 0.f; }
            LAS float* dst = (part == 0 ? Qf : (part == 1 ? Kf : Vf)) + idx;
#pragma unroll
            for (int ii = 0; ii < 4; ++ii) dst[(4 * tg + ii) * 128] = silu(w0 * x[ii] + w1 * x[ii + 1] + w2 * x[ii + 2] + w3 * x[ii + 3]);
        }
    }
    __syncthreads();
    for (int i = 0; i < 8; ++i) { const int t = wave * 8 + i; const float q0 = Qf[t * 128 + lane], q1 = Qf[t * 128 + 64 + lane], k0 = Kf[t * 128 + lane], k1 = Kf[t * 128 + 64 + lane];
        const float sq = wave_sum(q0 * q0 + q1 * q1), sk = wave_sum(k0 * k0 + k1 * k1);
        if (lane == 0) { scal[t * 8 + 3] = rsqrtf(sq + L2_EPS) * 0.08838834764831845f; scal[t * 8 + 4] = rsqrtf(sk + L2_EPS); } }
    if (wave == 0) { const int t = lane; const float bb = proj[(rowb + t) * NINP + C_BB + h], ba = proj[(rowb + t) * NINP + C_BA + h];
        const float gt = -__expf(inp(a, I_BALOG)[l * 8 + h]) * softplus(ba + inp(a, I_BDT)[l * 8 + h]);
        float x = gt;
#pragma unroll
        for (int o = 1; o < 64; o <<= 1) { const float y = __shfl_up(x, o); if (lane >= o) x += y; }
        const float bC = __shfl(x, 63);
        scal[t * 8 + 0] = sigm(bb); scal[t * 8 + 1] = x; scal[t * 8 + 2] = __expf(x); scal[t * 8 + 5] = __expf(bC - x);
        if (lane == 63) ((float*)(c.ws + IB_DEC))[u] = __expf(x); }
    __syncthreads();
    {
        const int t = tid >> 3, d0 = (tid & 7) * 16; const float sq = scal[t * 8 + 3], sk = scal[t * 8 + 4], s2 = sq * scal[t * 8 + 2];
        bf16_t* gq = (bf16_t*)(c.ws + IB_Q) + ((size_t)u * 64 + t) * 128;
#pragma unroll
        for (int m = 0; m < 4; ++m) { const int d = d0 + 4 * m; const f32x4 q = *(const LAS f32x4*)(Qf + t * 128 + d), k = *(const LAS f32x4*)(Kf + t * 128 + d);
            *(LAS u32x2*)(Qb + t * 136 + d) = (u32x2){pk2(q.x * sq, q.y * sq), pk2(q.z * sq, q.w * sq)};
            *(LAS u32x2*)(Kb + t * 136 + d) = (u32x2){pk2(k.x * sk, k.y * sk), pk2(k.z * sk, k.w * sk)};
            *(u32x2*)(gq + kpos(d)) = (u32x2){pk2(q.x * s2, q.y * s2), pk2(q.z * s2, q.w * s2)}; }
        const int d = tid & 127, s0 = (tid >> 7) * 16; bf16_t* gk = (bf16_t*)(c.ws + IB_KT) + ((size_t)u * 128 + d) * 64;
#pragma unroll
        for (int m = 0; m < 4; ++m) { float v[4];
#pragma unroll
            for (int j = 0; j < 4; ++j) { const int s = s0 + 4 * m + j; v[j] = Kf[s * 128 + d] * scal[s * 8 + 4] * scal[s * 8 + 5]; }
            *(u32x2*)(gk + kpos(s0 + 4 * m)) = (u32x2){pk2(v[0], v[1]), pk2(v[2], v[3])}; }
    }
    __syncthreads();
    {
        const int i = lane & 15, g = lane >> 4;
#pragma unroll
        for (int q2 = 0; q2 < 2; ++q2) { const int idx = 2 * wave + q2, tt = idx >> 2, st = idx & 3; const int s = 16 * st + i;
            if (st <= tt) {
                f32x4 akk = {0.f, 0.f, 0.f, 0.f}, aqk = {0.f, 0.f, 0.f, 0.f};
#pragma unroll
                for (int ks = 0; ks < 4; ++ks) { const bf16x8 bk = *(const LAS bf16x8*)(Kb + (16 * st + i) * 136 + 32 * ks + 8 * g);
                    const bf16x8 ak = *(const LAS bf16x8*)(Kb + (16 * tt + i) * 136 + 32 * ks + 8 * g), aq = *(const LAS bf16x8*)(Qb + (16 * tt + i) * 136 + 32 * ks + 8 * g);
                    akk = MFMA16(ak, bk, akk); aqk = MFMA16(aq, bk, aqk); }
                const float bs = scal[s * 8 + 1];
#pragma unroll
                for (int r = 0; r < 4; ++r) { const int t = 16 * tt + 4 * g + r; const float gam = __expf(fminf(scal[t * 8 + 1] - bs, 0.f));
                    Amat[t * 68 + s] = (s < t) ? scal[t * 8 + 0] * akk[r] * gam : 0.f;
                    Pl[t * 72 + kpos(s)] = bf1((s <= t) ? aqk[r] * gam : 0.f); }
            } else {
#pragma unroll
                for (int r = 0; r < 4; ++r) Pl[(16 * tt + 4 * g + r) * 72 + kpos(s)] = 0;
            }
        }
    }
    __syncthreads();
    if (tid < 256) {
        float R[64];
        int zoff = 0; asm volatile("" : "+v"(zoff));
        const LAS float* Am = Amat + zoff; const LAS float* sc = scal + zoff;
        if (tid < 128) {
#pragma unroll
            for (int t = 0; t < 64; ++t) R[t] = sc[t * 8 + 0] * Vf[t * 128 + tid];
        } else {
#pragma unroll
            for (int t = 0; t < 64; ++t) R[t] = sc[t * 8 + 0] * sc[t * 8 + 2] * sc[t * 8 + 4] * Kf[t * 128 + tid - 128];
        }
#pragma unroll
        for (int t = 1; t < 64; ++t) { float acc = R[t];
#pragma unroll
            for (int s4 = 0; s4 < (t + 3) / 4; ++s4) { const f32x4 a4 = *(const LAS f32x4*)(Am + t * 68 + 4 * s4);
                acc -= a4.x * R[4 * s4];
                if (4 * s4 + 1 < t) acc -= a4.y * R[4 * s4 + 1];
                if (4 * s4 + 2 < t) acc -= a4.z * R[4 * s4 + 2];
                if (4 * s4 + 3 < t) acc -= a4.w * R[4 * s4 + 3]; }
            R[t] = acc; }
        if (tid < 128) { const int w = tid >> 4, i = tid & 15; float* g0 = (float*)(c.ws + IB_U0) + (size_t)u * 8192;
#pragma unroll
            for (int st = 0; st < 4; ++st)
#pragma unroll
                for (int g = 0; g < 4; ++g) *(f32x4*)(g0 + ((st * 8 + w) * 64 + i + 16 * g) * 4) = (f32x4){R[16 * st + 4 * g], R[16 * st + 4 * g + 1], R[16 * st + 4 * g + 2], R[16 * st + 4 * g + 3]};
        } else { bf16_t* gw = (bf16_t*)(c.ws + IB_W) + (size_t)u * 8192 + kpos(tid - 128);
#pragma unroll
            for (int t = 0; t < 64; ++t) gw[t * 128] = bf1(R[t]); }
    } else {
#pragma unroll
        for (int k = 0; k < 2; ++k) { const int p = (tid - 256) + 256 * k, row = p >> 3, c16 = p & 7;
            *(u32x4*)((bf16_t*)(c.ws + IB_P) + (size_t)u * 4096 + row * 64 + c16 * 8) = *(const LAS u32x4*)(Pl + row * 72 + c16 * 8); }
    }
    __syncthreads();
}

DI void m1_unit_a(const Ctx& c0, int l, int u) {
    const Ctx c = fresh(c0); const Args& a = *c.a; const int tid = c.tid, lane = c.lane, wave = c.wave;
    const int b = u >> 7, h = (u >> 5) & 3, ci = u & 31;
    LAS float* Bf = (LAS float*)c.lds;
    LAS float* Qf = Bf + 8192;
    LAS float* Kf = Qf + 8192;
    LAS bf16_t* Pl = (LAS bf16_t*)Qf;
    LAS bf16_t* Qh = (LAS bf16_t*)(Kf + 8192);
    LAS bf16_t* Kd = Qh + 64 * 136;
    LAS bf16_t* Ko = Kd + 64 * 136;
    LAS float* tot = (LAS float*)(Ko + 32 * 136);
    const float* proj = (const float*)(c.ws + WS_PROJ);
    const long rowb = (long)b * SEQ + 64 * ci;
    {
        float* gv = (float*)(c.ws + IA_V) + (size_t)u * 8192;
#pragma unroll 4
        for (int k = 0; k < 48; ++k) { const int task = tid + 512 * k, t = task / 384, cc = task - t * 384, part = cc >> 7, idx = cc & 127;
            const float x = proj[(rowb + t) * NINP + (part == 0 ? C_AF : (part == 1 ? C_AQ : C_AI)) + h * 128 + idx];
            if (part == 0) { const float lb = lb_of(a, l, h * 128 + idx); const float f = lb + (1.f - lb) * sigm(x); Bf[t * 128 + idx] = fmaxf(__logf(f), -80.f); Kf[t * 128 + idx] = 1.f - f; }
            else if (part == 1) Qf[t * 128 + idx] = silu(x);
            else gv[(((t >> 4) * 8 + (idx >> 4)) * 64 + (idx & 15) + 16 * ((t >> 2) & 3)) * 4 + (t & 3)] = x; }
    }
    __syncthreads();
    {
        const int d = tid & 127, q4 = tid >> 7; float run = 0.f;
#pragma unroll
        for (int i = 0; i < 16; ++i) { run += Bf[(16 * q4 + i) * 128 + d]; Bf[(16 * q4 + i) * 128 + d] = run; }
        tot[q4 * 128 + d] = run;
        __syncthreads();
        float off = 0.f;
        for (int q = 0; q < q4; ++q) off += tot[q * 128 + d];
        if (q4 > 0) {
#pragma unroll
            for (int i = 0; i < 16; ++i) Bf[(16 * q4 + i) * 128 + d] += off; }
    }
    __syncthreads();
    {
        const int t = tid >> 3, d0 = (tid & 7) * 16; bf16_t* gq = (bf16_t*)(c.ws + IA_Q) + ((size_t)u * 64 + t) * 128;
#pragma unroll
        for (int m = 0; m < 4; ++m) { const int d = d0 + 4 * m; const f32x4 bb = *(const LAS f32x4*)(Bf + t * 128 + d), q = *(const LAS f32x4*)(Qf + t * 128 + d), k = *(const LAS f32x4*)(Kf + t * 128 + d);
            const f32x4 b31 = *(const LAS f32x4*)(Bf + 31 * 128 + d); const f32x4 rr = (t >= 32) ? b31 : (f32x4){0.f, 0.f, 0.f, 0.f};
            *(u32x2*)(gq + kpos(d)) = (u32x2){pk2(q.x * __expf(bb.x), q.y * __expf(bb.y)), pk2(q.z * __expf(bb.z), q.w * __expf(bb.w))};
            *(LAS u32x2*)(Qh + t * 136 + d) = (u32x2){pk2(q.x * __expf(bb.x - rr.x), q.y * __expf(bb.y - rr.y)), pk2(q.z * __expf(bb.z - rr.z), q.w * __expf(bb.w - rr.w))};
            *(LAS u32x2*)(Kd + t * 136 + d) = (u32x2){pk2(k.x * __expf(fminf(rr.x - bb.x, 80.f)), k.y * __expf(fminf(rr.y - bb.y, 80.f))), pk2(k.z * __expf(fminf(rr.z - bb.z, 80.f)), k.w * __expf(fminf(rr.w - bb.w, 80.f)))};
            if (t < 32) *(LAS u32x2*)(Ko + t * 136 + d) = (u32x2){pk2(k.x * __expf(b31.x - bb.x), k.y * __expf(b31.y - bb.y)), pk2(k.z * __expf(b31.z - bb.z), k.w * __expf(b31.w - bb.w))}; }
        const int d = tid & 127, s0 = (tid >> 7) * 16; bf16_t* gk = (bf16_t*)(c.ws + IA_KT) + ((size_t)u * 128 + d) * 64; const float bC = Bf[63 * 128 + d];
#pragma unroll
        for (int m = 0; m < 4; ++m) { float v[4];
#pragma unroll
            for (int j = 0; j < 4; ++j) { const int s = s0 + 4 * m + j; v[j] = Kf[s * 128 + d] * __expf(bC - Bf[s * 128 + d]); }
            *(u32x2*)(gk + kpos(s0 + 4 * m)) = (u32x2){pk2(v[0], v[1]), pk2(v[2], v[3])}; }
        if (tid < 128) ((float*)(c.ws + IA_DEC))[(size_t)u * 128 + tid] = __expf(bC);
    }
    __syncthreads();
    {
        const int i = lane & 15, g = lane >> 4;
#pragma unroll
        for (int q2 = 0; q2 < 2; ++q2) { const int idx = 2 * wave + q2, tt = idx >> 2, st = idx & 3, I = tt >> 1, J = st >> 1; const int s = 16 * st + i;
            if (J <= I) {
                const LAS bf16_t* bsrc = (I == J ? Kd : Ko) + (16 * st + i) * 136;
                f32x4 acc = {0.f, 0.f, 0.f, 0.f};
#pragma unroll
                for (int ks = 0; ks < 4; ++ks) acc = MFMA16(*(const LAS bf16x8*)(Qh + (16 * tt + i) * 136 + 32 * ks + 8 * g), *(const LAS bf16x8*)(bsrc + 32 * ks + 8 * g), acc);
#pragma unroll
                for (int r = 0; r < 4; ++r) { const int t = 16 * tt + 4 * g + r; Pl[t * 72 + kpos(s)] = bf1((s <= t) ? acc[r] : 0.f); }
            } else {
#pragma unroll
                for (int r = 0; r < 4; ++r) Pl[(16 * tt + 4 * g + r) * 72 + kpos(s)] = 0;
            }
        }
    }
    __syncthreads();
    { const int row = tid >> 3, c16 = tid & 7; *(u32x4*)((bf16_t*)(c.ws + IA_P) + (size_t)u * 4096 + row * 64 + c16 * 8) = *(const LAS u32x4*)(Pl + row * 72 + c16 * 8); }
    __syncthreads();
}

DI void m1_unit_c(const Ctx& c0, int l, int u) {
    const Ctx c = fresh(c0); const Args& a = *c.a; const int tid = c.tid;
    const int b = u >> 7, n = (u >> 4) & 7, ti = u & 15;
    constexpr int TT = 128;
    LAS float* xcv = (LAS float*)c.lds;
    LAS float* ra = xcv + TT * 64;
    LAS float* ia = ra + TT * 64;
    LAS float* segA = ia + TT * 64;
    LAS float* segB = segA + 512;
    const float* proj = (const float*)(c.ws + WS_PROJ);
    const long rowb = (long)b * SEQ + TT * ti; const int tg0 = TT * ti;
    const int j = tid & 63, g = (tid >> 6) & 1, tg = tid >> 7;
    const float* wsrc = (g ? inp(a, I_CWX) : inp(a, I_CWA)) + ((size_t)l * 8 + n) * 4096 + j;
    float wreg[64];
#pragma unroll
    for (int i = 0; i < 64; ++i) wreg[i] = wsrc[i * 64];
    const float gbias = (g ? inp(a, I_CBX) : inp(a, I_CBA))[l * 512 + n * 64 + j];
    const int cch = tid & 63, seg = tid >> 6, chg = n * 64 + cch;
    {
        const float* ccw = inp(a, I_CCW) + (size_t)l * 4 * 512;
        const float w0 = ccw[chg], w1 = ccw[512 + chg], w2 = ccw[1024 + chg], w3 = ccw[1536 + chg], cb = inp(a, I_CCB)[l * 512 + chg];
        const int ts = seg * 16; const int col = C_CX + chg;
        float x0 = (tg0 + ts >= 3) ? proj[(rowb + ts - 3) * NINP + col] : 0.f, x1 = (tg0 + ts >= 2) ? proj[(rowb + ts - 2) * NINP + col] : 0.f, x2 = (tg0 + ts >= 1) ? proj[(rowb + ts - 1) * NINP + col] : 0.f;
#pragma unroll 8
        for (int i = 0; i < 16; ++i) { const float x3 = proj[(rowb + ts + i) * NINP + col]; xcv[(ts + i) * 64 + cch] = w0 * x0 + w1 * x1 + w2 * x2 + w3 * x3 + cb; x0 = x1; x1 = x2; x2 = x3; }
    }
    __syncthreads();
    for (int tt = tg * 32; tt < tg * 32 + 32; ++tt) {
        float acc0 = 0.f, acc1 = 0.f;
#pragma unroll
        for (int i = 0; i < 64; i += 4) { const f32x4 x = *(const LAS f32x4*)(xcv + tt * 64 + i); acc0 += x.x * wreg[i] + x.z * wreg[i + 2]; acc1 += x.y * wreg[i + 1] + x.w * wreg[i + 3]; }
        (g ? ia : ra)[tt * 64 + j] = sigm(acc0 + acc1 + gbias);
    }
    __syncthreads();
    const float spl = softplus(-inp(a, I_CLAM)[l * 512 + chg]);
    {
        float A = 1.f, B = 0.f;
        for (int i = 0; i < 16; ++i) { const int tt = seg * 16 + i; const float r = ra[tt * 64 + cch], ig = ia[tt * 64 + cch], x = xcv[tt * 64 + cch];
            const float la = -8.f * r * spl; const float at = __expf(la); float mult = sqrtf(fmaxf(0.f, -expm1f(2.f * la)));
            if (tg0 + tt == 0) mult = 1.f;
            const float bt = mult * (ig * x); ra[tt * 64 + cch] = at; ia[tt * 64 + cch] = bt; A *= at; B = at * B + bt; }
        segA[seg * 64 + cch] = A; segB[seg * 64 + cch] = B;
    }
    __syncthreads();
    {
        float Ac = 1.f, Bc = 0.f;
        for (int s = 0; s < seg; ++s) { const float sa = segA[s * 64 + cch], sb = segB[s * 64 + cch]; Bc = sa * Bc + sb; Ac *= sa; }
        float* ga = (float*)(c.ws + IC_A); float* gb = (float*)(c.ws + IC_B);
        for (int i = 0; i < 16; ++i) { const int tt = seg * 16 + i; const float at = ra[tt * 64 + cch], bt = ia[tt * 64 + cch]; Ac *= at; Bc = at * Bc + bt;
            ga[(rowb + tt) * 512 + chg] = Ac; gb[(rowb + tt) * 512 + chg] = Bc; }
        if (seg == 7) { float* gt = (float*)(c.ws + IC_TOT) + (((size_t)b * 16 + ti) * 2) * 512; gt[chg] = Ac; gt[512 + chg] = Bc; }
    }
    __syncthreads();
}

DI void phase_m1(const Ctx& c, int l) {
    int w = blockIdx.x; asm volatile("" : "+s"(w));
    for (int u = w; u < 1024; u += c.G) m1_unit_b(c, l, u);
    for (int u = w; u < 512; u += c.G) m1_unit_a(c, l, u);
    for (int u = w; u < 512; u += c.G) m1_unit_c(c, l, u);
}

DI void m2_unit_head(const Ctx& c0, int l, int isB, int b, int h) {
    const Ctx c = fresh(c0); const Args& a = *c.a; const int tid = c.tid, lane = c.lane, wave = c.wave;
    LAS unsigned char* Wl = c.lds;
    LAS unsigned char* Ql = Wl + 64 * 272;
    LAS unsigned char* KTl = Ql + 64 * 272;
    LAS unsigned char* Pl = KTl + 128 * 144;
    LAS float* ob = (LAS float*)(Pl + 64 * 144);
    const int i = lane & 15, g = lane >> 4, e0 = 16 * wave;
    const int ubase = isB ? ((b * 8 + h) * 32) : ((b * 4 + h) * 32);
    const unsigned char* gW = c.ws + IB_W; const unsigned char* gQ = c.ws + (isB ? IB_Q : IA_Q); const unsigned char* gKT = c.ws + (isB ? IB_KT : IA_KT);
    const unsigned char* gP = c.ws + (isB ? IB_P : IA_P); const float* gU = (const float*)(c.ws + (isB ? IB_U0 : IA_V));
    const float* proj = (const float*)(c.ws + WS_PROJ); bf16_t* mixo = (bf16_t*)(c.ws + WS_MIXO);
    const float* nw = (isB ? inp(a, I_BNORM) : inp(a, I_ANORM)) + l * 128;
    const int gcol = isB ? (C_BZ + h * 128) : (C_AG + h * 128), ocol = isB ? (512 + h * 128) : (h * 128);
    const float nw0 = nw[2 * lane], nw1 = nw[2 * lane + 1];
    f32x4 S[8];
#pragma unroll
    for (int dt = 0; dt < 8; ++dt) S[dt] = (f32x4){0.f, 0.f, 0.f, 0.f};
    u32x4 pw[2], pq[2], pk[2], pp;
    const int r16 = tid >> 4, c16 = tid & 15, r8 = tid >> 3, c8 = tid & 7;
#define M2_LOAD(ch) do { const size_t uu = (size_t)(ubase + (ch)); \
        if (isB) { pw[0] = *(const u32x4*)(gW + uu * 16384 + tid * 16); pw[1] = *(const u32x4*)(gW + uu * 16384 + (tid + 512) * 16); } \
        pq[0] = *(const u32x4*)(gQ + uu * 16384 + tid * 16); pq[1] = *(const u32x4*)(gQ + uu * 16384 + (tid + 512) * 16); \
        pk[0] = *(const u32x4*)(gKT + uu * 16384 + tid * 16); pk[1] = *(const u32x4*)(gKT + uu * 16384 + (tid + 512) * 16); \
        pp = *(const u32x4*)(gP + uu * 8192 + tid * 16); } while (0)
#define M2_STORE() do { \
        if (isB) { *(LAS u32x4*)(Wl + r16 * 272 + c16 * 16) = pw[0]; *(LAS u32x4*)(Wl + (r16 + 32) * 272 + c16 * 16) = pw[1]; } \
        *(LAS u32x4*)(Ql + r16 * 272 + c16 * 16) = pq[0]; *(LAS u32x4*)(Ql + (r16 + 32) * 272 + c16 * 16) = pq[1]; \
        *(LAS u32x4*)(KTl + r8 * 144 + c8 * 16) = pk[0]; *(LAS u32x4*)(KTl + (r8 + 64) * 144 + c8 * 16) = pk[1]; \
        *(LAS u32x4*)(Pl + r8 * 144 + c8 * 16) = pp; } while (0)
    M2_LOAD(0);
    M2_STORE();
    __syncthreads();
    for (int ci = 0; ci < 32; ++ci) {
        const size_t uu = (size_t)(ubase + ci); const long row0 = (long)b * SEQ + 64 * ci;
        if (ci + 1 < 32) M2_LOAD(ci + 1);
        f32x2 gt[8];
#pragma unroll
        for (int k = 0; k < 8; ++k) gt[k] = *(const f32x2*)(proj + (row0 + 8 * wave + k) * NINP + gcol + 2 * lane);
        f32x4 U[4];
#pragma unroll
        for (int tt = 0; tt < 4; ++tt) U[tt] = *(const f32x4*)(gU + uu * 8192 + ((tt * 8 + wave) * 64 + lane) * 4);
        bf16x8 Sb[4];
#pragma unroll
        for (int ks = 0; ks < 4; ++ks) { u32x4 p; p.x = pk2(S[2 * ks][0], S[2 * ks][1]); p.y = pk2(S[2 * ks][2], S[2 * ks][3]); p.z = pk2(S[2 * ks + 1][0], S[2 * ks + 1][1]); p.w = pk2(S[2 * ks + 1][2], S[2 * ks + 1][3]); Sb[ks] = __builtin_bit_cast(bf16x8, p); }
        if (isB) {
#pragma unroll
            for (int tt = 0; tt < 4; ++tt) { f32x4 acc = {0.f, 0.f, 0.f, 0.f};
#pragma unroll
                for (int ks = 0; ks < 4; ++ks) acc = MFMA16(*(const LAS bf16x8*)(Wl + (16 * tt + i) * 272 + (32 * ks + 8 * g) * 2), Sb[ks], acc);
                U[tt] = U[tt] - acc; }
        }
        bf16x8 Ub[2];
#pragma unroll
        for (int k = 0; k < 2; ++k) { u32x4 p; p.x = pk2(U[2 * k][0], U[2 * k][1]); p.y = pk2(U[2 * k][2], U[2 * k][3]); p.z = pk2(U[2 * k + 1][0], U[2 * k + 1][1]); p.w = pk2(U[2 * k + 1][2], U[2 * k + 1][3]); Ub[k] = __builtin_bit_cast(bf16x8, p); }
#pragma unroll
        for (int tt = 0; tt < 4; ++tt) { f32x4 acc = {0.f, 0.f, 0.f, 0.f};
#pragma unroll
            for (int ks = 0; ks < 4; ++ks) acc = MFMA16(*(const LAS bf16x8*)(Ql + (16 * tt + i) * 272 + (32 * ks + 8 * g) * 2), Sb[ks], acc);
#pragma unroll
            for (int k = 0; k < 2; ++k) acc = MFMA16(*(const LAS bf16x8*)(Pl + (16 * tt + i) * 144 + (32 * k + 8 * g) * 2), Ub[k], acc);
#pragma unroll
            for (int r = 0; r < 4; ++r) ob[(16 * tt + 4 * g + r) * 132 + e0 + i] = acc[r]; }
        if (isB) { const float dec = ((const float*)(c.ws + IB_DEC))[uu];
#pragma unroll
            for (int dt = 0; dt < 8; ++dt) S[dt] = S[dt] * dec;
        } else { const float* dv = (const float*)(c.ws + IA_DEC) + uu * 128;
#pragma unroll
            for (int dt = 0; dt < 8; ++dt) S[dt] = S[dt] * *(const f32x4*)(dv + 16 * dt + 4 * g); }
#pragma unroll
        for (int dt = 0; dt < 8; ++dt) {
#pragma unroll
            for (int k = 0; k < 2; ++k) S[dt] = MFMA16(*(const LAS bf16x8*)(KTl + (16 * dt + i) * 144 + (32 * k + 8 * g) * 2), Ub[k], S[dt]); }
        __syncthreads();
#pragma unroll
        for (int k = 0; k < 8; ++k) { const int t = 8 * wave + k; const f32x2 v = *(const LAS f32x2*)(ob + t * 132 + 2 * lane);
            const float r = rsqrtf(wave_sum(v.x * v.x + v.y * v.y) * (1.f / 128.f) + NORM_EPS);
            *(unsigned*)(mixo + (row0 + t) * D + ocol + 2 * lane) = pk2(v.x * r * nw0 * silu(gt[k].x), v.y * r * nw1 * silu(gt[k].y)); }
        if (ci + 1 < 32) M2_STORE();
        __syncthreads();
    }
#undef M2_LOAD
#undef M2_STORE
    float* so = c.out + (isB ? O_GDP + (((size_t)l * BATCH + b) * 8 + h) * 16384 : O_HGP + (((size_t)l * BATCH + b) * 4 + h) * 16384);
#pragma unroll
    for (int dt = 0; dt < 8; ++dt)
#pragma unroll
        for (int r = 0; r < 4; ++r) so[(size_t)(16 * dt + 4 * g + r) * 128 + e0 + i] = S[dt][r];
}

DI void m2_unit_cfin(const Ctx& c0, int l, int u) {
    const Ctx c = fresh(c0); const int tid = c.tid;
    const int b = u >> 7, n = (u >> 4) & 7, ti = u & 15;
    const int cch = tid & 63, seg = tid >> 6, chg = n * 64 + cch;
    const float* proj = (const float*)(c.ws + WS_PROJ); bf16_t* mixo = (bf16_t*)(c.ws + WS_MIXO);
    const float* ga = (const float*)(c.ws + IC_A); const float* gb = (const float*)(c.ws + IC_B);
    const float* gt = (const float*)(c.ws + IC_TOT) + ((size_t)b * 16 * 2) * 512;
    float hs = 0.f;
    for (int k = 0; k < ti; ++k) hs = gt[(k * 2) * 512 + chg] * hs + gt[(k * 2 + 1) * 512 + chg];
    const long rowb = (long)b * SEQ + 128 * ti;
    float hh = 0.f;
#pragma unroll 4
    for (int i = 0; i < 16; ++i) { const long row = rowb + seg * 16 + i; hh = gb[row * 512 + chg] + ga[row * 512 + chg] * hs;
        mixo[row * D + 1536 + chg] = bf1(hh * gelu_tanh(proj[row * NINP + C_CG + chg])); }
    if (ti == 15 && seg == 7) c.out[O_RHP + ((size_t)l * BATCH + b) * 512 + chg] = hh;
}

DI void block_reduce_cols(LAS float* red, LAS float* full, const float (&p)[4], int tid, float scale) {
    const int e4 = (tid & 31) * 4, dgp = tid >> 5;
    *(LAS f32x4*)(red + dgp * 128 + e4) = (f32x4){p[0], p[1], p[2], p[3]};
    __syncthreads();
    if (tid < 128) { float s = 0.f;
#pragma unroll
        for (int k = 0; k < 16; ++k) s += red[k * 128 + tid];
        full[tid] = s * scale; }
    __syncthreads();
}
DI void unit_b_sample(const Ctx& c0, int l, int b, int h) {
    const Ctx c = fresh(c0);
    const Args& a = *c.a; const int tid = c.tid, lane = c.lane, wave = c.wave;
    LAS float* qkv = (LAS float*)c.lds;
    LAS float* scl = qkv + 384;
    LAS float* red = scl + 8;
    LAS float* full = red + 2048;
    LAS float* uu = full + 128;
    const float* proj = (const float*)(c.ws + WS_PROJ) + (size_t)(NP + b) * NINP;
    if (tid < 384) { const int part = tid >> 7, idx = tid & 127, cc = part * 1024 + h * 128 + idx;
        const float* cw = inp(a, I_BCW) + (size_t)l * 4 * 3072; const float* st = inp(a, I_SGC) + (((size_t)l * NS + b) * 3) * 3072;
        const float x0 = st[cc], x1 = st[3072 + cc], x2 = st[2 * 3072 + cc], x3 = proj[C_BQ + cc];
        qkv[tid] = silu(cw[cc] * x0 + cw[3072 + cc] * x1 + cw[2 * 3072 + cc] * x2 + cw[3 * 3072 + cc] * x3);
        float* so = c.out + O_GCS + (((size_t)l * NS + b) * 3) * 3072; so[cc] = x1; so[3072 + cc] = x2; so[2 * 3072 + cc] = x3; }
    if (tid == 384) { const float bb = proj[C_BB + h], ba = proj[C_BA + h]; scl[0] = sigm(bb); scl[1] = __expf(-__expf(inp(a, I_BALOG)[l * 8 + h]) * softplus(ba + inp(a, I_BDT)[l * 8 + h])); }
    __syncthreads();
    if (wave < 2) { const float x0 = qkv[wave * 128 + lane], x1 = qkv[wave * 128 + 64 + lane]; const float ss = wave_sum(x0 * x0 + x1 * x1);
        if (lane == 0) scl[2 + wave] = rsqrtf(ss + L2_EPS) * (wave == 0 ? 0.08838834764831845f : 1.f); }
    __syncthreads();
    const float beta = scl[0], eg = scl[1], sq = scl[2], sk = scl[3];
    const int e4 = (tid & 31) * 4, d0 = (tid >> 5) * 8;
    const size_t sidx = (((size_t)l * NS + b) * 8 + h) * 16384;
    const float* Sin = inp(a, I_SGD) + sidx; float* Sout = c.out + O_GDS + sidx;
    f32x4 S[8]; float p[4] = {0.f, 0.f, 0.f, 0.f};
#pragma unroll
    for (int i = 0; i < 8; ++i) { S[i] = *(const f32x4*)(Sin + (size_t)(d0 + i) * 128 + e4); const float k = qkv[128 + d0 + i]; p[0] += k * S[i].x; p[1] += k * S[i].y; p[2] += k * S[i].z; p[3] += k * S[i].w; }
    block_reduce_cols(red, full, p, tid, sk);
    if (tid < 128) uu[tid] = beta * (qkv[256 + tid] - eg * full[tid]) * sk;
    __syncthreads();
    const f32x4 u4 = *(const LAS f32x4*)(uu + e4);
    float po[4] = {0.f, 0.f, 0.f, 0.f};
#pragma unroll
    for (int i = 0; i < 8; ++i) { const float k = qkv[128 + d0 + i], q = qkv[d0 + i]; S[i] = S[i] * eg + u4 * k; *(f32x4*)(Sout + (size_t)(d0 + i) * 128 + e4) = S[i];
        po[0] += q * S[i].x; po[1] += q * S[i].y; po[2] += q * S[i].z; po[3] += q * S[i].w; }
    block_reduce_cols(red, full, po, tid, sq);
    if (wave < 2) { const float o = full[wave * 64 + lane]; const float ss = wave_sum(o * o); if (lane == 0) scl[4 + wave] = ss; }
    __syncthreads();
    if (tid < 128) { const float rms = rsqrtf((scl[4] + scl[5]) * (1.f / 128.f) + NORM_EPS);
        const float o = full[tid] * rms * inp(a, I_BNORM)[l * 128 + tid] * silu(proj[C_BZ + h * 128 + tid]);
        ((bf16_t*)(c.ws + WS_MIXO))[(size_t)(NP + b) * D + 512 + h * 128 + tid] = (bf16_t)(pk2(o, 0.f) & 0xffffu); }
    __syncthreads();
}
DI void unit_a_sample(const Ctx& c0, int l, int b, int h) {
    const Ctx c = fresh(c0);
    const Args& a = *c.a; const int tid = c.tid, lane = c.lane, wave = c.wave;
    LAS float* fqv = (LAS float*)c.lds;
    LAS float* scl = fqv + 384;
    LAS float* red = scl + 8;
    LAS float* full = red + 2048;
    const float* proj = (const float*)(c.ws + WS_PROJ) + (size_t)(NP + b) * NINP;
    if (tid < 384) { const int part = tid >> 7, idx = tid & 127;
        if (part == 0) { const float lb = lb_of(a, l, h * 128 + idx); fqv[tid] = lb + (1.f - lb) * sigm(proj[C_AF + h * 128 + idx]); }
        else if (part == 1) fqv[tid] = silu(proj[C_AQ + h * 128 + idx]);
        else fqv[tid] = proj[C_AI + h * 128 + idx]; }
    __syncthreads();
    const int e4 = (tid & 31) * 4, d0 = (tid >> 5) * 8;
    const size_t sidx = (((size_t)l * NS + b) * 4 + h) * 16384;
    const float* Sin = inp(a, I_SHG) + sidx; float* Sout = c.out + O_HGS + sidx;
    const f32x4 v4 = *(const LAS f32x4*)(fqv + 256 + e4);
    float po[4] = {0.f, 0.f, 0.f, 0.f};
#pragma unroll
    for (int i = 0; i < 8; ++i) { const float f = fqv[d0 + i], q = fqv[128 + d0 + i]; f32x4 S = *(const f32x4*)(Sin + (size_t)(d0 + i) * 128 + e4);
        S = S * f + v4 * (1.f - f); *(f32x4*)(Sout + (size_t)(d0 + i) * 128 + e4) = S;
        po[0] += q * S.x; po[1] += q * S.y; po[2] += q * S.z; po[3] += q * S.w; }
    block_reduce_cols(red, full, po, tid, 1.f);
    if (wave < 2) { const float o = full[wave * 64 + lane]; const float ss = wave_sum(o * o); if (lane == 0) scl[4 + wave] = ss; }
    __syncthreads();
    if (tid < 128) { const float rms = rsqrtf((scl[4] + scl[5]) * (1.f / 128.f) + NORM_EPS);
        const float o = full[tid] * rms * inp(a, I_ANORM)[l * 128 + tid] * silu(proj[C_AG + h * 128 + tid]);
        ((bf16_t*)(c.ws + WS_MIXO))[(size_t)(NP + b) * D + h * 128 + tid] = (bf16_t)(pk2(o, 0.f) & 0xffffu); }
    __syncthreads();
}
DI void unit_c_sample(const Ctx& c0, int l, int b) {
    const Ctx c = fresh(c0);
    const Args& a = *c.a; const int tid = c.tid;
    LAS float* xc = (LAS float*)c.lds;
    const float* proj = (const float*)(c.ws + WS_PROJ) + (size_t)(NP + b) * NINP;
    const float* ccw = inp(a, I_CCW) + (size_t)l * 4 * 512; const float* st = inp(a, I_SRC) + (((size_t)l * NS + b) * 3) * 512;
    const float x0 = st[tid], x1 = st[512 + tid], x2 = st[1024 + tid], x3 = proj[C_CX + tid];
    const float xv = ccw[tid] * x0 + ccw[512 + tid] * x1 + ccw[1024 + tid] * x2 + ccw[1536 + tid] * x3 + inp(a, I_CCB)[l * 512 + tid];
    xc[tid] = xv;
    { float* so = c.out + O_RCS + (((size_t)l * NS + b) * 3) * 512; so[tid] = x1; so[512 + tid] = x2; so[1024 + tid] = x3; }
    __syncthreads();
    const int n = tid >> 6, j = tid & 63;
    const float* wa = inp(a, I_CWA) + ((size_t)l * 8 + n) * 4096 + j; const float* wx = inp(a, I_CWX) + ((size_t)l * 8 + n) * 4096 + j;
    float sa = 0.f, sx = 0.f;
#pragma unroll 8
    for (int i = 0; i < 64; ++i) { const float x = xc[n * 64 + i]; sa += x * wa[i * 64]; sx += x * wx[i * 64]; }
    const float r = sigm(sa + inp(a, I_CBA)[l * 512 + tid]), ig = sigm(sx + inp(a, I_CBX)[l * 512 + tid]);
    const float la = -8.f * r * softplus(-inp(a, I_CLAM)[l * 512 + tid]); const float at = __expf(la); const float mult = sqrtf(fmaxf(0.f, -expm1f(2.f * la)));
    const float h0 = inp(a, I_SRH)[((size_t)l * NS + b) * 512 + tid];
    const float hh = at * h0 + mult * (ig * xv);
    c.out[O_RHS + ((size_t)l * NS + b) * 512 + tid] = hh;
    ((bf16_t*)(c.ws + WS_MIXO))[(size_t)(NP + b) * D + 1536 + tid] = (bf16_t)(pk2(hh * gelu_tanh(proj[C_CG + tid]), 0.f) & 0xffffu);
    __syncthreads();
}


DI void phase_m2(const Ctx& c, int l) {
    int w = blockIdx.x; asm volatile("" : "+s"(w));
    if (w < 48) {
        const int isB = w < 32; const int u = isB ? w : w - 32;
        m2_unit_head(c, l, isB, isB ? (u >> 3) : (u >> 2), isB ? (u & 7) : (u & 3));
    } else {
        const int nw = c.G - 48;
        for (int u = w - 48; u < 512 + 1664; u += nw) {
            if (u < 512) m2_unit_cfin(c, l, u);
            else { const int v = u - 512;
                if (v < 1024) unit_b_sample(c, l, v >> 3, v & 7);
                else if (v < 1536) { const int x = v - 1024; unit_a_sample(c, l, x >> 2, x & 3); }
                else unit_c_sample(c, l, v - 1536); }
        }
        const Ctx cc = fresh(c); const float* proj = (const float*)(cc.ws + WS_PROJ);
        const int gt_ = (w - 48) * 512 + cc.tid, NT = nw * 512;
        for (int i = gt_; i < BATCH * 3 * 3072; i += NT) { const int b = i / (3 * 3072), r = i - b * 3 * 3072, j = r / 3072, ch = r - j * 3072;
            cc.out[O_GCP + (size_t)l * BATCH * 3 * 3072 + i] = proj[((size_t)b * SEQ + SEQ - 3 + j) * NINP + C_BQ + ch]; }
        for (int i = gt_; i < BATCH * 3 * 512; i += NT) { const int b = i / (3 * 512), r = i - b * 3 * 512, j = r / 512, ch = r - j * 512;
            cc.out[O_RCP + (size_t)l * BATCH * 3 * 512 + i] = proj[((size_t)b * SEQ + SEQ - 3 + j) * NINP + C_CX + ch]; }
    }
}

__global__ void __launch_bounds__(512, 2) fwd_megakernel(Args args) {
    extern __shared__ __attribute__((aligned(16))) unsigned char lds_raw[];
    Ctx c0; c0.a = &args; c0.ws = nullptr; c0.out = nullptr; c0.lds = (LAS unsigned char*)lds_raw; c0.tid = 0; c0.lane = 0; c0.wave = 0; c0.G = gridDim.x; c0.bid = 0;
    const int lo = args.ph_lo, hi = args.ph_hi;
#pragma unroll 1
    for (int ph2 = 2 * lo; ph2 < 2 * hi; ++ph2) {
        const int ph = ph2 >> 1;
        const int l = (ph - 1) >> 3, k = (ph == 0) ? -1 : ((ph - 1) & 7);
        if ((ph2 & 1) && k != PROBE_REP) continue;
        if (k == -1) phase_p0(c0);
        else if (k == 0 || k == 3 || k == 5 || k == 6) {
            const Ctx c = fresh(c0); unsigned char* ws = c.ws;
            pg8::Gemm g; pg8::EpiAny E; E.mode = 0; E.C = (float*)(ws + WS_MIXF); E.O = nullptr; E.ldc = D;
            if (k == 0)      { g.A = (const bf16_t*)(ws + WS_HBUF); g.Bt = (const bf16_t*)(ws + WS_WIN + l * SZ_WIN);   g.N = NINP; g.K = D;   E.C = (float*)(ws + WS_PROJ); E.ldc = NINP; }
            else if (k == 3) { g.A = (const bf16_t*)(ws + WS_MIXO); g.Bt = (const bf16_t*)(ws + WS_WOUT + l * SZ_WOUT); g.N = D;    g.K = D; }
            else if (k == 5) { g.A = (const bf16_t*)(ws + WS_HBUF); g.Bt = (const bf16_t*)(ws + WS_WGU + l * SZ_WGU);   g.N = NGU;  g.K = D;   E.mode = 1; E.O = (bf16_t*)(ws + WS_PROJ); E.ldc = DFF; }
            else             { g.A = (const bf16_t*)(ws + WS_PROJ); g.Bt = (const bf16_t*)(ws + WS_WDN + l * SZ_WDN);   g.N = D;    g.K = DFF; }
            g.M = MPAD;
            pg8::StaticOrder S; S.init(MPAD, g.N, c.G, c.bid);
            pg8::gemm_phase<pg8::EpiAny, pg8::StaticOrder, true, true>(c.lds, g, S, E);
        }
        else if (k == 1) phase_m1(c0, l);
        else if (k == 2) phase_m2(c0, l);
        else {
            const Ctx c = fresh(c0); unsigned char* ws = c.ws;
            float* mixf = (float*)(ws + WS_MIXF); float* x1 = (float*)(ws + WS_X1); bf16_t* hb = (bf16_t*)(ws + WS_HBUF);
            if (k == 4) {
                const float* xa = (l == 0) ? inp(args, I_XP) : c.out; const float* xb = (l == 0) ? inp(args, I_XS) : c.out + (size_t)NP * D;
                row_phase(c0, mixf, xa, xb, x1, inp(args, I_LN2) + l * D, inp(args, I_LN3) + l * D, hb);
            } else {
                row_phase(c0, mixf, x1, x1 + (size_t)NP * D, c.out, inp(args, I_LN4) + l * D, l == 0 ? inp(args, I_LN1) + D : nullptr, hb);
            }
        }
        if (ph2 + 1 < 2 * hi) cg::this_grid().sync();
    }
}

extern "C" void kernel_launch(void* const* d_in, const int* in_sizes, int n_in, void* d_out, int out_size, void* d_ws, size_t ws_size, hipStream_t stream) {
    static int grid = 0;
    if (grid == 0) {
        if (n_in != 29 || (size_t)out_size != O_END || ws_size < WS_END) { fprintf(stderr, "kernel_launch: unexpected shapes: n_in %d out %d ws %zu (need %zu)\n", n_in, out_size, ws_size, (size_t)WS_END); grid = -1; return; }
        int dev = 0, cus = 0, per_cu = 0;
        hipGetDevice(&dev); hipDeviceGetAttribute(&cus, hipDeviceAttributeMultiprocessorCount, dev);
        if (hipFuncSetAttribute((const void*)fwd_megakernel, hipFuncAttributeMaxDynamicSharedMemorySize, LDS_BYTES) != hipSuccess) { fprintf(stderr, "kernel_launch: hipFuncSetAttribute failed\n"); grid = -1; return; }
        if (hipOccupancyMaxActiveBlocksPerMultiprocessor(&per_cu, (const void*)fwd_megakernel, 512, LDS_BYTES) != hipSuccess || per_cu < 1) { fprintf(stderr, "kernel_launch: occupancy query says %d\n", per_cu); grid = -1; return; }
        grid = cus;
        if (grid < 224) { fprintf(stderr, "kernel_launch: needs >= 224 CUs, got %d\n", grid); grid = -1; return; }
    }
    if (grid < 0) return;
    hipMemsetAsync((char*)d_ws + WS_CTL, 0, CTL_BYTES, stream);
    Args a{};
    for (int i = 0; i < 29; ++i) a.in[i] = (const float*)d_in[i];
    a.out = (float*)d_out; a.ws = (unsigned char*)d_ws;
#if MK_MULTI
    for (int ph = 0; ph < NPHASE; ++ph) { a.ph_lo = ph; a.ph_hi = ph + 1; hipLaunchKernelGGL(fwd_megakernel, dim3(grid), dim3(512), LDS_BYTES, stream, a); }
#else
    a.ph_lo = 0; a.ph_hi = NPHASE;
    void* kargs[] = {&a};
    hipError_t e = hipLaunchCooperativeKernel((const void*)fwd_megakernel, dim3(grid), dim3(512), kargs, LDS_BYTES, stream);
    if (e != hipSuccess) fprintf(stderr, "cooperative launch failed: %s (grid %d)\n", hipGetErrorString(e), grid);
#endif
}
```

```cpp
#include <hip/hip_runtime.h>
#include <hip/hip_cooperative_groups.h>
#include <cstdio>
#include <cstdint>
namespace cg = cooperative_groups;

#ifndef MK_MULTI
#define MK_MULTI 0
#endif

#ifndef PROBE_REP
#define PROBE_REP (-2)
#endif
#ifndef PROBE_SUB
#define PROBE_SUB 0
#endif
#define DI __device__ __forceinline__
#define LAS __attribute__((address_space(3)))
#define GAS __attribute__((address_space(1)))
typedef unsigned short bf16_t;
typedef float f32x4 __attribute__((ext_vector_type(4)));
typedef float f32x2 __attribute__((ext_vector_type(2)));
typedef unsigned u32x4 __attribute__((ext_vector_type(4)));
typedef unsigned u32x2 __attribute__((ext_vector_type(2)));
typedef short bf16x8 __attribute__((ext_vector_type(8)));
typedef __bf16 bf16v2 __attribute__((ext_vector_type(2)));

constexpr int D = 2048, SEQ = 2048, BATCH = 4, NP = BATCH * SEQ, NS = 128, MT = NP + NS, MPAD = 8448;
constexpr int NIN = 7184, NINP = 7424, DFF = 5632, NGU = 2 * DFF;
constexpr int C_AQ = 0, C_AF = 512, C_AI = 1024, C_AG = 1536, C_BQ = 2048, C_BK = 3072, C_BV = 4096, C_BZ = 5120, C_BB = 6144, C_BA = 6152, C_CX = 6160, C_CG = 6672;
constexpr float NORM_EPS = 1e-6f, L2_EPS = 1e-6f;
constexpr int NPHASE = 17;

constexpr size_t O_YP = 0, O_YS = O_YP + (size_t)NP * D, O_HGP = O_YS + (size_t)NS * D, O_HGS = O_HGP + 2ull * 4 * 4 * 16384,
                 O_GDP = O_HGS + 2ull * 128 * 4 * 16384, O_GDS = O_GDP + 2ull * 4 * 8 * 16384, O_GCP = O_GDS + 2ull * 128 * 8 * 16384,
                 O_GCS = O_GCP + 2ull * 4 * 3 * 3072, O_RHP = O_GCS + 2ull * 128 * 3 * 3072, O_RHS = O_RHP + 2ull * 4 * 512,
                 O_RCP = O_RHS + 2ull * 128 * 512, O_RCS = O_RCP + 2ull * 4 * 3 * 512, O_END = O_RCS + 2ull * 128 * 3 * 512;

constexpr size_t MiB = 1ull << 20;
constexpr size_t WS_CTL = 0, CTL_BYTES = 1 * MiB;
constexpr size_t WS_WIN = 1 * MiB, SZ_WIN = 29 * MiB, WS_WOUT = WS_WIN + 2 * SZ_WIN, SZ_WOUT = 8 * MiB, WS_WGU = WS_WOUT + 2 * SZ_WOUT, SZ_WGU = 44 * MiB,
                 WS_WDN = WS_WGU + 2 * SZ_WGU, SZ_WDN = 22 * MiB;
constexpr size_t WS_PROJ = WS_WDN + 2 * SZ_WDN, SZ_PROJ = 240 * MiB;
constexpr size_t WS_HBUF = WS_PROJ + SZ_PROJ, SZ_HBUF = 33 * MiB;
constexpr size_t WS_MIXO = WS_HBUF + SZ_HBUF;
constexpr size_t WS_MIXF = WS_MIXO + SZ_HBUF, SZ_MIXF = 66 * MiB;
constexpr size_t WS_X1 = WS_MIXF + SZ_MIXF, WS_END = WS_X1 + SZ_MIXF + 25 * MiB;
static_assert((size_t)NINP * D * 2 == SZ_WIN && (size_t)NGU * D * 2 == SZ_WGU && (size_t)D * DFF * 2 == SZ_WDN && (size_t)D * D * 2 == SZ_WOUT, "weight sizes");
static_assert((size_t)MPAD * NINP * 4 <= SZ_PROJ && (size_t)MPAD * D * 2 <= SZ_HBUF && (size_t)MPAD * D * 4 <= SZ_MIXF, "ws map");

constexpr int LDS_BYTES = 147456;

DI unsigned pk2(float lo, float hi) { f32x2 x = {lo, hi}; bf16v2 y = __builtin_convertvector(x, bf16v2); return __builtin_bit_cast(unsigned, y); }
DI float wave_sum(float v) {
#pragma unroll
    for (int o = 1; o < 64; o <<= 1) v += __shfl_xor(v, o);
    return v;
}
template <int CTRL> DI float dpp_mov(float v) { return __int_as_float(__builtin_amdgcn_update_dpp(0, __float_as_int(v), CTRL, 0xF, 0xF, true)); }
DI float row16_sum(float v) {
    v += dpp_mov<0xB1>(v); v += dpp_mov<0x4E>(v); v += dpp_mov<0x124>(v); v += dpp_mov<0x128>(v); return v;
}
DI float sigm(float x) { return 1.f / (1.f + __expf(-x)); }
DI float silu(float x) { return x / (1.f + __expf(-x)); }
DI float softplus(float x) { return x > 20.f ? x : log1pf(__expf(x)); }
DI float gelu_tanh(float x) { const float y = 0.7978845608028654f * (x + 0.044715f * x * x * x); return 0.5f * x * (1.f + tanhf(y)); }
#define LDS_WAIT() asm volatile("s_waitcnt lgkmcnt(0)" ::: "memory")

namespace pg8 {
#define PG8_LAS __attribute__((address_space(3)))
constexpr int BM = 256, BK = 64, HALF = 128, HTB = HALF * BK * 2, STAGE_BYTES = 8 * HTB, NXCD = 8, WGM = 8;
__host__ __device__ __forceinline__ int lds_byte(int r, int c) { const int st = (r >> 4) * 2 + (c >> 5), rr = r & 15, cc = c & 31, ob = rr * 64 + cc * 2; return st * 1024 + (ob ^ (((ob >> 9) & 1) << 5)); }
__host__ __device__ __forceinline__ void stage_rc(int b, int& R, int& C) { const int st = b / 1024, sb = b % 1024, swz = sb ^ (((sb >> 9) & 1) << 5); R = (st >> 1) * 16 + swz / 64; C = (st & 1) * 32 + (swz % 64) / 2; }
struct Unit { int pm, pn; };
struct Gemm { const bf16_t* A; const bf16_t* Bt; int M, N, K; };
struct StaticOrder {
    int nM, nN, nwg, G, c;
    __host__ __device__ void init(int M, int N, int G_, int c_) { nM = M / BM; nN = N / BM; nwg = nM * nN; G = G_; c = c_; }
    __host__ __device__ bool next(int i, Unit& u) const {
        const long L = (long)i * G + c; if (L >= nwg) return false;
        int wgid = (int)L; { const int q = nwg / NXCD, r = nwg % NXCD, xcd = wgid % NXCD, off = wgid / NXCD; wgid = (xcd < r ? xcd * (q + 1) : r * (q + 1) + (xcd - r) * q) + off; }
        const int nig = WGM * nN, gid = wgid / nig, fm = gid * WGM, gsz = (nM - fm) < WGM ? (nM - fm) : WGM;
        u.pm = fm + ((wgid % nig) % gsz); u.pn = (wgid % nig) / gsz; return true;
    }
    __device__ __forceinline__ void a_ready(const Unit&) const {}
    __device__ __forceinline__ void done(const Unit&) const {}
};
struct EpiAny {
    static constexpr bool PERM = false, AFTER_DRAIN = false;
    int mode; float* C; bf16_t* O; int ldc;
    __device__ __forceinline__ void operator()(const f32x4 (&acc)[2][2][4][2], const Unit& u, int wr, int wc, int fr, int fq) const {
        const int row0 = u.pm * BM + wr * 64 + fr;
        if (mode == 0) {
            const int col0 = u.pn * BM + wc * 32 + 4 * fq;
#pragma unroll
            for (int ai = 0; ai < 2; ++ai)
#pragma unroll
                for (int m = 0; m < 4; ++m) { float* rowp = C + (size_t)(row0 + ai * HALF + m * 16) * ldc + col0;
#pragma unroll
                    for (int bj = 0; bj < 2; ++bj)
#pragma unroll
                        for (int n = 0; n < 2; ++n) *(f32x4*)(rowp + bj * HALF + n * 16) = acc[ai][bj][m][n]; }
        } else {
#pragma unroll
            for (int ai = 0; ai < 2; ++ai)
#pragma unroll
                for (int m = 0; m < 4; ++m) { bf16_t* rowp = O + (size_t)(row0 + ai * HALF + m * 16) * ldc;
#pragma unroll
                    for (int bj = 0; bj < 2; ++bj) { const int G = 8 * u.pn + 4 * bj + wc; const f32x4 g = acc[ai][bj][m][0], up = acc[ai][bj][m][1];
                        u32x2 w; w.x = pk2(silu(g[0]) * up[0], silu(g[1]) * up[1]); w.y = pk2(silu(g[2]) * up[2], silu(g[3]) * up[3]);
                        *(u32x2*)(rowp + 16 * G + 4 * fq) = w; } }
        }
    }
};

template <class Epi, class Sched, bool ALIGN_EPI = false, bool SP2 = false>
__device__ __forceinline__ void gemm_phase(PG8_LAS unsigned char* lds, const Gemm g, const Sched& S, const Epi& E) {
    int tid_ = threadIdx.x; asm volatile("" : "+v"(tid_));
    const int tid = tid_, wid = __builtin_amdgcn_readfirstlane(tid >> 6), lane = tid & 63, wr = wid >> 2, wc = wid & 3, fr = lane & 15, fq = lane >> 4;
    const int K = g.K, nt = K / BK;
    unsigned voffA[2], voffB[2];
#pragma unroll
    for (int i = 0; i < 2; ++i) { int R, C; stage_rc(tid * 16 + i * 8192, R, C); voffA[i] = (unsigned)(R * K + C) * 2u; voffB[i] = (unsigned)(R * K + C) * 2u; }
    const size_t kstep = (size_t)(BK * 2);
    const size_t hstep = (size_t)HALF * K * 2;
    const size_t tstep = 2 * hstep;
    const unsigned ldsw = (unsigned)wid * 1024u;
    const int aoff = lds_byte(wr * 64 + fr, fq * 8), boff = lds_byte(wc * 32 + fr, fq * 8);
#define PG8_SA(b, h) (((b) * 2 + (h)) * HTB)
#define PG8_SB(b, h) ((4 + (b) * 2 + (h)) * HTB)
#define PG8_STAGE(bufoff, gbase, voff) do { _Pragma("unroll") for (int _i = 0; _i < 2; ++_i) \
        __builtin_amdgcn_global_load_lds((const unsigned*)((const char*)(gbase) + (voff)[_i]), (PG8_LAS unsigned*)(lds + (bufoff) + ldsw + _i * 8192), 16, 0, 0); } while (0)
#define PG8_LDA(dst, b, h) do { _Pragma("unroll") for (int m = 0; m < 4; ++m) _Pragma("unroll") for (int k = 0; k < 2; ++k) dst[m][k] = *(const PG8_LAS bf16x8*)(lds + PG8_SA(b, h) + aoff + m * 2048 + k * 1024); } while (0)
#define PG8_LDB(dst, b, h) do { _Pragma("unroll") for (int n = 0; n < 2; ++n) _Pragma("unroll") for (int k = 0; k < 2; ++k) dst[n][k] = *(const PG8_LAS bf16x8*)(lds + PG8_SB(b, h) + boff + n * 2048 + k * 1024); } while (0)
#define PG8_MMA(ai, bj, At, Bt) do { __builtin_amdgcn_s_setprio(1); _Pragma("unroll") for (int m = 0; m < 4; ++m) _Pragma("unroll") for (int n = 0; n < 2; ++n) _Pragma("unroll") for (int k = 0; k < 2; ++k) \
        acc[ai][bj][m][n] = __builtin_amdgcn_mfma_f32_16x16x32_bf16(Bt[n][k], At[m][k], acc[ai][bj][m][n], 0, 0, 0); __builtin_amdgcn_s_setprio(0); } while (0)
#define PG8_WAIT_V(n) asm volatile("s_waitcnt vmcnt(" #n ")" ::: "memory")
#define PG8_WAIT_L(n) asm volatile("s_waitcnt lgkmcnt(" #n ")" ::: "memory")
#define PG8_BAR __builtin_amdgcn_s_barrier()
#define PG8_SCHED __builtin_amdgcn_sched_barrier(0)
    Unit cur, nxt; int ui = 0;
    if (!S.next(0, cur)) return;
    f32x4 acc[2][2][4][2];
#pragma unroll
    for (int a = 0; a < 2; ++a)
#pragma unroll
        for (int b = 0; b < 2; ++b)
#pragma unroll
            for (int m = 0; m < 4; ++m)
#pragma unroll
                for (int n = 0; n < 2; ++n) acc[a][b][m][n] = (f32x4){0.f, 0.f, 0.f, 0.f};
    bf16x8 At[4][2], B0[2][2], B1[2][2];
    const char* cA = (const char*)g.A + (size_t)cur.pm * tstep; const char* cB = (const char*)g.Bt + (size_t)cur.pn * tstep;
    S.a_ready(cur);
    if constexpr (SP2) {
        PG8_STAGE(PG8_SB(0, 0), cB, voffB); PG8_STAGE(PG8_SB(0, 1), cB + hstep, voffB); PG8_STAGE(PG8_SA(0, 0), cA, voffA); PG8_STAGE(PG8_SA(0, 1), cA + hstep, voffA);
        if (wr == 1) PG8_BAR;
        PG8_WAIT_V(2); PG8_BAR;
        PG8_STAGE(PG8_SB(1, 0), cB + kstep, voffB); PG8_STAGE(PG8_SA(1, 0), cA + kstep, voffA); PG8_STAGE(PG8_SB(1, 1), cB + hstep + kstep, voffB);
        PG8_WAIT_V(6); PG8_BAR;
    } else {
        PG8_STAGE(PG8_SB(0, 0), cB, voffB); PG8_STAGE(PG8_SA(0, 0), cA, voffA); PG8_STAGE(PG8_SB(0, 1), cB + hstep, voffB); PG8_STAGE(PG8_SA(0, 1), cA + hstep, voffA);
        if (wr == 1) PG8_BAR;
        PG8_WAIT_V(4); PG8_BAR;
        PG8_STAGE(PG8_SB(1, 0), cB + kstep, voffB); PG8_STAGE(PG8_SA(1, 0), cA + kstep, voffA); PG8_STAGE(PG8_SB(1, 1), cB + hstep + kstep, voffB);
        PG8_WAIT_V(6); PG8_BAR;
    }
    for (;;) {
        const bool has_next = S.next(ui + 1, nxt);
        const char* nA = has_next ? (const char*)g.A + (size_t)nxt.pm * tstep : cA; const char* nB = has_next ? (const char*)g.Bt + (size_t)nxt.pn * tstep : cB;
        for (int t = 0; t < nt; t += 2) {
            const bool last = (t == nt - 2);
            const char* a1 = cA + (size_t)(t + 1) * kstep;
            const char* a2 = last ? nA : cA + (size_t)(t + 2) * kstep; const char* b2 = last ? nB : cB + (size_t)(t + 2) * kstep;
            const char* a3 = a2 + kstep; const char* b3 = b2 + kstep;
            if (last && has_next) S.a_ready(nxt);
            if constexpr (SP2) {
            PG8_LDB(B0, 0, 0); PG8_LDB(B1, 0, 1); PG8_SCHED; PG8_LDA(At, 0, 0); PG8_STAGE(PG8_SA(1, 1), a1 + hstep, voffA);
            PG8_WAIT_V(8); PG8_WAIT_L(0); PG8_BAR; PG8_MMA(0, 0, At, B0); PG8_MMA(0, 1, At, B1); PG8_BAR; PG8_SCHED;
            PG8_LDA(At, 0, 1); PG8_STAGE(PG8_SB(0, 0), b2, voffB); PG8_STAGE(PG8_SB(0, 1), b2 + hstep, voffB); PG8_STAGE(PG8_SA(0, 0), a2, voffA);
            PG8_WAIT_V(8); PG8_WAIT_L(0); PG8_BAR; PG8_MMA(1, 0, At, B0); PG8_MMA(1, 1, At, B1); PG8_BAR; PG8_SCHED;
            PG8_LDB(B0, 1, 0); PG8_LDB(B1, 1, 1); PG8_SCHED; PG8_LDA(At, 1, 0); PG8_STAGE(PG8_SA(0, 1), a2 + hstep, voffA);
            PG8_WAIT_V(8); PG8_WAIT_L(0); PG8_BAR; PG8_MMA(0, 0, At, B0); PG8_MMA(0, 1, At, B1); PG8_BAR; PG8_SCHED;
            PG8_LDA(At, 1, 1); PG8_STAGE(PG8_SB(1, 0), b3, voffB); PG8_STAGE(PG8_SB(1, 1), b3 + hstep, voffB); PG8_STAGE(PG8_SA(1, 0), a3, voffA);
            PG8_WAIT_V(8); PG8_WAIT_L(0); PG8_BAR; PG8_MMA(1, 0, At, B0); PG8_MMA(1, 1, At, B1); PG8_BAR; PG8_SCHED;
            } else {
            PG8_LDB(B0, 0, 0); PG8_SCHED; PG8_LDA(At, 0, 0); PG8_STAGE(PG8_SA(1, 1), a1 + hstep, voffA);
            PG8_WAIT_L(8); PG8_BAR; PG8_WAIT_L(0); PG8_MMA(0, 0, At, B0); PG8_BAR; PG8_SCHED;
            PG8_LDB(B1, 0, 1); PG8_STAGE(PG8_SB(0, 0), b2, voffB);
            PG8_BAR; PG8_WAIT_L(0); PG8_MMA(0, 1, At, B1); PG8_BAR;
            PG8_LDA(At, 0, 1); PG8_STAGE(PG8_SA(0, 0), a2, voffA);
            PG8_BAR; PG8_WAIT_L(0); PG8_MMA(1, 0, At, B0); PG8_BAR; PG8_SCHED;
            PG8_STAGE(PG8_SB(0, 1), b2 + hstep, voffB);
            PG8_WAIT_V(6); PG8_BAR; PG8_MMA(1, 1, At, B1); PG8_BAR;
            PG8_LDB(B0, 1, 0); PG8_SCHED; PG8_LDA(At, 1, 0); PG8_STAGE(PG8_SA(0, 1), a2 + hstep, voffA);
            PG8_WAIT_L(8); PG8_BAR; PG8_WAIT_L(0); PG8_MMA(0, 0, At, B0); PG8_BAR; PG8_SCHED;
            PG8_LDB(B1, 1, 1); PG8_STAGE(PG8_SB(1, 0), b3, voffB);
            PG8_BAR; PG8_WAIT_L(0); PG8_MMA(0, 1, At, B1); PG8_BAR;
            PG8_LDA(At, 1, 1); PG8_STAGE(PG8_SA(1, 0), a3, voffA);
            PG8_BAR; PG8_WAIT_L(0); PG8_MMA(1, 0, At, B0); PG8_BAR; PG8_SCHED;
            PG8_STAGE(PG8_SB(1, 1), b3 + hstep, voffB);
            PG8_WAIT_V(6); PG8_BAR; PG8_MMA(1, 1, At, B1); PG8_BAR;
            }
        }
        if constexpr (ALIGN_EPI) { if (wr == 0) PG8_BAR; }
        if constexpr (!Epi::AFTER_DRAIN) { E(acc, cur, wr, wc, fr, fq); S.done(cur); }
        if (!has_next) break;
#pragma unroll
        for (int a = 0; a < 2; ++a)
#pragma unroll
            for (int b = 0; b < 2; ++b)
#pragma unroll
                for (int m = 0; m < 4; ++m)
#pragma unroll
                    for (int n = 0; n < 2; ++n) acc[a][b][m][n] = (f32x4){0.f, 0.f, 0.f, 0.f};
        cur = nxt; cA = nA; cB = nB; ++ui;
        if constexpr (ALIGN_EPI) { if (wr == 1) PG8_BAR; }
    }
    PG8_WAIT_V(0);
    if constexpr (!ALIGN_EPI) { if (wr == 0) PG8_BAR; }
    PG8_BAR;
#undef PG8_SA
#undef PG8_SB
#undef PG8_STAGE
#undef PG8_LDA
#undef PG8_LDB
#undef PG8_MMA
#undef PG8_WAIT_V
#undef PG8_WAIT_L
#undef PG8_BAR
#undef PG8_SCHED
}
}

struct Args { const float* in[29]; float* out; unsigned char* ws; int ph_lo, ph_hi; };
enum { I_XP = 0, I_XS, I_SHG, I_SGD, I_SGC, I_SRH, I_SRC, I_LN1, I_LN2, I_LN3, I_LN4, I_WIN, I_WOUT, I_LB, I_ANORM, I_BCW, I_BALOG, I_BDT, I_BNORM,
       I_CCW, I_CCB, I_CWA, I_CBA, I_CWX, I_CBX, I_CLAM, I_WG, I_WU, I_WD };

struct Ctx {
    const Args* a; unsigned char* ws; float* out; LAS unsigned char* lds; int tid, lane, wave, G, bid;
};
DI Ctx fresh(const Ctx& o) {
    Ctx c = o; int t = threadIdx.x; asm volatile("" : "+v"(t)); c.tid = t; c.lane = t & 63; c.wave = __builtin_amdgcn_readfirstlane(t >> 6);
    unsigned char* w = o.a->ws; asm volatile("" : "+s"(w)); c.ws = w; float* q = o.a->out; asm volatile("" : "+s"(q)); c.out = q;
    int b = blockIdx.x; asm volatile("" : "+s"(b)); c.bid = b; return c;
}
DI const float* inp(const Args& a, int idx) { int z = idx; asm volatile("" : "+s"(z)); return a.in[z]; }

template <int MODE>
DI void transpose_item(const float* W, int K, int Nsrc, int nblk, bf16_t* WT, LAS float* scr, int item, int lane) {
    const int kb = item / nblk, nb = item - kb * nblk, k0 = 64 * kb, n0 = 32 * nb;
    const int nn = n0 + (lane & 31); const bool ok = nn < Nsrc;
#pragma unroll 8
    for (int i = 0; i < 32; ++i) { const int kk = 2 * i + (lane >> 5); scr[kk * 33 + (lane & 31)] = ok ? W[(size_t)(k0 + kk) * Nsrc + nn] : 0.f; }
    LDS_WAIT(); asm volatile("" ::: "memory");
    const int c = lane & 7;
#pragma unroll
    for (int j = 0; j < 4; ++j) { const int nl = (lane >> 3) + 8 * j; const LAS float* s = scr + (8 * c) * 33 + nl;
        u32x4 o; o.x = pk2(s[0 * 33], s[1 * 33]); o.y = pk2(s[2 * 33], s[3 * 33]); o.z = pk2(s[4 * 33], s[5 * 33]); o.w = pk2(s[6 * 33], s[7 * 33]);
        const int n = n0 + nl; const int drow = (MODE == 0) ? n : ((n >> 4) * 32 + (n & 15) + (MODE == 2 ? 16 : 0));
        *(u32x4*)(WT + (size_t)drow * K + k0 + 8 * c) = o; }
    LDS_WAIT(); asm volatile("" ::: "memory");
}
DI void norm_row_to_bf16(const float* xr, const float* g, bf16_t* orow, int lane) {
    f32x4 v[8]; float s = 0.f;
#pragma unroll
    for (int j = 0; j < 8; ++j) { v[j] = ((const f32x4*)xr)[lane + 64 * j]; s += (v[j].x * v[j].x + v[j].y * v[j].y) + (v[j].z * v[j].z + v[j].w * v[j].w); }
    const float r = rsqrtf(wave_sum(s) * (1.f / D) + NORM_EPS);
#pragma unroll
    for (int j = 0; j < 8; ++j) { const f32x4 gg = ((const f32x4*)g)[lane + 64 * j]; u32x2 w; w.x = pk2(v[j].x * r * gg.x, v[j].y * r * gg.y); w.y = pk2(v[j].z * r * gg.z, v[j].w * r * gg.w);
        ((u32x2*)orow)[lane + 64 * j] = w; }
}
DI void phase_p0(const Ctx& c0) {
    const Ctx c = fresh(c0);
    const Args& a = *c.a;
    LAS float* scr = (LAS float*)(c.lds + c.wave * 16384);
    const int gw = c.bid * 8 + c.wave, NGW = c.G * 8;
    constexpr int I_IN = (D / 64) * (NINP / 32), I_OUT = (D / 64) * (D / 32), I_G = (D / 64) * (DFF / 32), I_D = (DFF / 64) * (D / 32);
    constexpr int PER_LAYER = I_IN + I_OUT + 2 * I_G + I_D;
    for (int it = gw; it < 2 * PER_LAYER; it += NGW) {
        const int l = it / PER_LAYER; int r = it - l * PER_LAYER;
        if (r < I_IN) { transpose_item<0>(inp(a, I_WIN) + (size_t)l * D * NIN, D, NIN, NINP / 32, (bf16_t*)(c.ws + WS_WIN + l * SZ_WIN), scr, r, c.lane); continue; } r -= I_IN;
        if (r < I_OUT) { transpose_item<0>(inp(a, I_WOUT) + (size_t)l * D * D, D, D, D / 32, (bf16_t*)(c.ws + WS_WOUT + l * SZ_WOUT), scr, r, c.lane); continue; } r -= I_OUT;
        if (r < I_G) { transpose_item<1>(inp(a, I_WG) + (size_t)l * D * DFF, D, DFF, DFF / 32, (bf16_t*)(c.ws + WS_WGU + l * SZ_WGU), scr, r, c.lane); continue; } r -= I_G;
        if (r < I_G) { transpose_item<2>(inp(a, I_WU) + (size_t)l * D * DFF, D, DFF, DFF / 32, (bf16_t*)(c.ws + WS_WGU + l * SZ_WGU), scr, r, c.lane); continue; } r -= I_G;
        transpose_item<0>(inp(a, I_WD) + (size_t)l * DFF * D, DFF, D, D / 32, (bf16_t*)(c.ws + WS_WDN + l * SZ_WDN), scr, r, c.lane);
    }
    bf16_t* hb = (bf16_t*)(c.ws + WS_HBUF);
    { const float* xp = inp(a, I_XP); const float* xs = inp(a, I_XS); const float* g1 = inp(a, I_LN1);
      for (int m = gw; m < MT; m += NGW) norm_row_to_bf16(m < NP ? xp + (size_t)m * D : xs + (size_t)(m - NP) * D, g1, hb + (size_t)m * D, c.lane); }
    for (int i = gw * 64 + c.lane; i < (MPAD - MT) * D / 8; i += NGW * 64) {
        ((u32x4*)(hb + (size_t)MT * D))[i] = (u32x4){0u, 0u, 0u, 0u};
        ((u32x4*)((bf16_t*)(c.ws + WS_MIXO) + (size_t)MT * D))[i] = (u32x4){0u, 0u, 0u, 0u};
    }
}

DI void row_phase(const Ctx& c0, const float* y, const float* xa, const float* xb, float* xout, const float* g_post, const float* g_next, bf16_t* hb) {
    const Ctx c = fresh(c0);
    const int gw = c.bid * 8 + c.wave, NGW = c.G * 8, lane = c.lane;
    for (int m = gw; m < MT; m += NGW) {
        const float* yr = y + (size_t)m * D; const float* xr = m < NP ? xa + (size_t)m * D : xb + (size_t)(m - NP) * D;
        f32x4 v[8]; float s = 0.f;
#pragma unroll
        for (int j = 0; j < 8; ++j) { v[j] = ((const f32x4*)yr)[lane + 64 * j]; s += (v[j].x * v[j].x + v[j].y * v[j].y) + (v[j].z * v[j].z + v[j].w * v[j].w); }
        const float r = rsqrtf(wave_sum(s) * (1.f / D) + NORM_EPS);
        float s2 = 0.f;
#pragma unroll
        for (int j = 0; j < 8; ++j) { const f32x4 gg = ((const f32x4*)g_post)[lane + 64 * j]; const f32x4 xx = ((const f32x4*)xr)[lane + 64 * j];
            v[j] = xx + v[j] * r * gg; s2 += (v[j].x * v[j].x + v[j].y * v[j].y) + (v[j].z * v[j].z + v[j].w * v[j].w);
            ((f32x4*)(xout + (size_t)m * D))[lane + 64 * j] = v[j]; }
        if (g_next) {
            const float r2 = rsqrtf(wave_sum(s2) * (1.f / D) + NORM_EPS);
#pragma unroll
            for (int j = 0; j < 8; ++j) { const f32x4 gg = ((const f32x4*)g_next)[lane + 64 * j]; u32x2 w; w.x = pk2(v[j].x * r2 * gg.x, v[j].y * r2 * gg.y); w.y = pk2(v[j].z * r2 * gg.z, v[j].w * r2 * gg.w);
                ((u32x2*)(hb + (size_t)m * D))[lane + 64 * j] = w; }
        }
    }
}

DI int perm32(int x) { return 8 * ((x >> 2) & 3) + 4 * (x >> 4) + (x & 3); }
DI int kpos(int k) { return (k & ~31) + perm32(k & 31); }
DI float lb_of(const Args& a, int l, int c) { if (l == 0) return 0.f; const float l0 = inp(a, I_LB)[c], l1 = inp(a, I_LB)[512 + c]; return 1.f / (1.f + __expf(l0 - l1)); }
DI bf16_t bf1(float x) { return (bf16_t)(pk2(x, 0.f) & 0xffffu); }
#define MFMA16(a, b, c) __builtin_amdgcn_mfma_f32_16x16x32_bf16((a), (b), (c), 0, 0, 0)

constexpr size_t IB_W = WS_MIXF, IB_Q = IB_W + 16 * MiB, IB_KT = IB_Q + 16 * MiB, IB_P = IB_KT + 16 * MiB, IB_U0 = IB_P + 8 * MiB,
                 IA_Q = IB_U0 + 32 * MiB, IA_KT = IA_Q + 8 * MiB, IA_P = IA_KT + 8 * MiB, IA_V = IA_P + 4 * MiB,
                 IC_A = IA_V + 16 * MiB, IC_B = IC_A + 16 * MiB, IMISC = IC_B + 16 * MiB, IB_DEC = IMISC, IA_DEC = IMISC + 65536, IC_TOT = IMISC + 524288, I_END = IMISC + 1 * MiB;
static_assert(I_END <= WS_END, "mixer intermediates must fit");

DI void m1_unit_b(const Ctx& c0, int l, int u) {
    const Ctx c = fresh(c0); const Args& a = *c.a; const int tid = c.tid, lane = c.lane, wave = c.wave;
    const int b = u >> 8, h = (u >> 5) & 7, ci = u & 31;
    LAS float* Kf = (LAS float*)c.lds;
    LAS float* Vf = Kf + 8192;
    LAS float* Qf = Vf + 8192;
    LAS float* Amat = Qf;
    LAS bf16_t* Pl = (LAS bf16_t*)(Qf + 64 * 68);
    LAS bf16_t* Qb = (LAS bf16_t*)(Qf + 8192);
    LAS bf16_t* Kb = Qb + 64 * 136;
    LAS float* scal = (LAS float*)(Kb + 64 * 136);
    const float* proj = (const float*)(c.ws + WS_PROJ);
    const long rowb = (long)b * SEQ + 64 * ci; const int tg0 = 64 * ci;
    {
        const float* cw = inp(a, I_BCW) + (size_t)l * 4 * 3072;
        const int idx = tid & 127, tq = tid >> 7;
        float x[3][19], w[3][4];
#pragma unroll
        for (int p = 0; p < 3; ++p) { const int ch = p * 1024 + h * 128 + idx;
#pragma unroll
            for (int j = 0; j < 4; ++j) w[p][j] = cw[j * 3072 + ch];
#pragma unroll
            for (int j = 0; j < 19; ++j) { const int t = 16 * tq - 3 + j; x[p][j] = (tg0 + t >= 0) ? proj[(rowb + t) * NINP + C_BQ + ch] : 0.f; } }
#pragma unroll
        for (int p = 0; p < 3; ++p) { LAS float* dst = (p == 0 ? Qf : (p == 1 ? Kf : Vf)) + idx;
#pragma unroll
            for (int i = 0; i < 16; ++i) dst[(16 * tq + i) * 128] = silu(w[p][0] * x[p][i] + w[p][1] * x[p][i + 1] + w[p][2] * x[p][i + 2] + w[p][3] * x[p][i + 3]); }
    }
    __syncthreads();
    for (int i = 0; i < 8; ++i) { const int t = wave * 8 + i; const float q0 = Qf[t * 128 + lane], q1 = Qf[t * 128 + 64 + lane], k0 = Kf[t * 128 + lane], k1 = Kf[t * 128 + 64 + lane];
        const float sq = wave_sum(q0 * q0 + q1 * q1), sk = wave_sum(k0 * k0 + k1 * k1);
        if (lane == 0) { scal[t * 8 + 3] = rsqrtf(sq + L2_EPS) * 0.08838834764831845f; scal[t * 8 + 4] = rsqrtf(sk + L2_EPS); } }
    if (wave == 0) { const int t = lane; const float bb = proj[(rowb + t) * NINP + C_BB + h], ba = proj[(rowb + t) * NINP + C_BA + h];
        const float gt = -__expf(inp(a, I_BALOG)[l * 8 + h]) * softplus(ba + inp(a, I_BDT)[l * 8 + h]);
        float x = gt;
#pragma unroll
        for (int o = 1; o < 64; o <<= 1) { const float y = __shfl_up(x, o); if (lane >= o) x += y; }
        const float bC = __shfl(x, 63);
        scal[t * 8 + 0] = sigm(bb); scal[t * 8 + 1] = x; scal[t * 8 + 2] = __expf(x); scal[t * 8 + 5] = __expf(bC - x);
        if (lane == 63) ((float*)(c.ws + IB_DEC))[u] = __expf(x); }
    __syncthreads();
    {
        const int t = tid >> 3, d0 = (tid & 7) * 16; const float sq = scal[t * 8 + 3], sk = scal[t * 8 + 4], s2 = sq * scal[t * 8 + 2];
        bf16_t* gq = (bf16_t*)(c.ws + IB_Q) + ((size_t)u * 64 + t) * 128;
#pragma unroll
        for (int m = 0; m < 4; ++m) { const int d = d0 + 4 * m; const f32x4 q = *(const LAS f32x4*)(Qf + t * 128 + d), k = *(const LAS f32x4*)(Kf + t * 128 + d);
            *(LAS u32x2*)(Qb + t * 136 + d) = (u32x2){pk2(q.x * sq, q.y * sq), pk2(q.z * sq, q.w * sq)};
            *(LAS u32x2*)(Kb + t * 136 + d) = (u32x2){pk2(k.x * sk, k.y * sk), pk2(k.z * sk, k.w * sk)};
            *(u32x2*)(gq + kpos(d)) = (u32x2){pk2(q.x * s2, q.y * s2), pk2(q.z * s2, q.w * s2)}; }
    }
    __syncthreads();
    {
        const int i = lane & 15, g = lane >> 4;
#pragma unroll
        for (int q2 = 0; q2 < 2; ++q2) { const int idx = 2 * wave + q2, tt = idx >> 2, st = idx & 3; const int s = 16 * st + i;
            if (st <= tt) {
                f32x4 akk = {0.f, 0.f, 0.f, 0.f}, aqk = {0.f, 0.f, 0.f, 0.f};
#pragma unroll
                for (int ks = 0; ks < 4; ++ks) { const bf16x8 bk = *(const LAS bf16x8*)(Kb + (16 * st + i) * 136 + 32 * ks + 8 * g);
                    const bf16x8 ak = *(const LAS bf16x8*)(Kb + (16 * tt + i) * 136 + 32 * ks + 8 * g), aq = *(const LAS bf16x8*)(Qb + (16 * tt + i) * 136 + 32 * ks + 8 * g);
                    akk = MFMA16(ak, bk, akk); aqk = MFMA16(aq, bk, aqk); }
                const float bs = scal[s * 8 + 1];
#pragma unroll
                for (int r = 0; r < 4; ++r) { const int t = 16 * tt + 4 * g + r; const float gam = __expf(fminf(scal[t * 8 + 1] - bs, 0.f));
                    Amat[t * 68 + s] = (s < t) ? scal[t * 8 + 0] * akk[r] * gam : 0.f;
                    Pl[t * 72 + kpos(s)] = bf1((s <= t) ? aqk[r] * gam : 0.f); }
            } else {
#pragma unroll
                for (int r = 0; r < 4; ++r) Pl[(16 * tt + 4 * g + r) * 72 + kpos(s)] = 0;
            }
        }
    }
    __syncthreads();
    if (tid < 256) {
        float R[64];
        int zoff = 0; asm volatile("" : "+v"(zoff));
        const LAS float* Am = Amat + zoff; const LAS float* sc = scal + zoff;
        if (tid < 128) {
#pragma unroll
            for (int t = 0; t < 64; ++t) R[t] = sc[t * 8 + 0] * Vf[t * 128 + tid];
        } else {
#pragma unroll
            for (int t = 0; t < 64; ++t) R[t] = sc[t * 8 + 0] * sc[t * 8 + 2] * sc[t * 8 + 4] * Kf[t * 128 + tid - 128];
        }
#pragma unroll
        for (int t = 1; t < 64; ++t) { float acc = R[t];
#pragma unroll
            for (int s4 = 0; s4 < (t + 3) / 4; ++s4) { const f32x4 a4 = *(const LAS f32x4*)(Am + t * 68 + 4 * s4);
                acc -= a4.x * R[4 * s4];
                if (4 * s4 + 1 < t) acc -= a4.y * R[4 * s4 + 1];
                if (4 * s4 + 2 < t) acc -= a4.z * R[4 * s4 + 2];
                if (4 * s4 + 3 < t) acc -= a4.w * R[4 * s4 + 3]; }
            R[t] = acc; }
        if (tid < 128) { const int w = tid >> 4, i = tid & 15; float* g0 = (float*)(c.ws + IB_U0) + (size_t)u * 8192;
#pragma unroll
            for (int st = 0; st < 4; ++st)
#pragma unroll
                for (int g = 0; g < 4; ++g) *(f32x4*)(g0 + ((st * 8 + w) * 64 + i + 16 * g) * 4) = (f32x4){R[16 * st + 4 * g], R[16 * st + 4 * g + 1], R[16 * st + 4 * g + 2], R[16 * st + 4 * g + 3]};
        } else { bf16_t* gw = (bf16_t*)(c.ws + IB_W) + (size_t)u * 8192 + kpos(tid - 128);
#pragma unroll
            for (int t = 0; t < 64; ++t) gw[t * 128] = bf1(R[t]); }
    } else {
#pragma unroll
        for (int k = 0; k < 2; ++k) { const int p = (tid - 256) + 256 * k, row = p >> 3, c16 = p & 7;
            *(u32x4*)((bf16_t*)(c.ws + IB_P) + (size_t)u * 4096 + row * 64 + c16 * 8) = *(const LAS u32x4*)(Pl + row * 72 + c16 * 8); }
        LAS bf16_t* KTs = Qb; const int d = tid & 127, s0 = ((tid >> 7) & 1) * 32;
#pragma unroll
        for (int m = 0; m < 8; ++m) { float v[4];
#pragma unroll
            for (int j = 0; j < 4; ++j) { const int s = s0 + 4 * m + j; v[j] = Kf[s * 128 + d] * scal[s * 8 + 4] * scal[s * 8 + 5]; }
            *(LAS u32x2*)(KTs + d * 72 + kpos(s0 + 4 * m)) = (u32x2){pk2(v[0], v[1]), pk2(v[2], v[3])}; }
    }
    __syncthreads();
#pragma unroll
    for (int k = 0; k < 2; ++k) { const int p = tid + 512 * k, row = p >> 3, c16 = p & 7;
        *(u32x4*)((bf16_t*)(c.ws + IB_KT) + (size_t)u * 8192 + row * 64 + c16 * 8) = *(const LAS u32x4*)(Qb + row * 72 + c16 * 8); }
    __syncthreads();
}

DI void m1_unit_a(const Ctx& c0, int l, int u) {
    const Ctx c = fresh(c0); const Args& a = *c.a; const int tid = c.tid, lane = c.lane, wave = c.wave;
    const int b = u >> 7, h = (u >> 5) & 3, ci = u & 31;
    LAS float* Bf = (LAS float*)c.lds;
    LAS float* Qf = Bf + 8192;
    LAS float* Kf = Qf + 8192;
    LAS bf16_t* Pl = (LAS bf16_t*)Qf;
    LAS bf16_t* Qh = (LAS bf16_t*)(Kf + 8192);
    LAS bf16_t* Kd = Qh + 64 * 136;
    LAS bf16_t* Ko = Kd + 64 * 136;
    LAS float* tot = (LAS float*)(Ko + 32 * 136);
    const float* proj = (const float*)(c.ws + WS_PROJ);
    const long rowb = (long)b * SEQ + 64 * ci;
    {
        float* gv = (float*)(c.ws + IA_V) + (size_t)u * 8192;
        const int idx = tid & 127, tq = tid >> 7;
        float x[3][16];
#pragma unroll
        for (int i = 0; i < 16; ++i) { const float* pr = proj + (rowb + 16 * tq + i) * NINP + h * 128 + idx; x[0][i] = pr[C_AF]; x[1][i] = pr[C_AQ]; x[2][i] = pr[C_AI]; }
        const float lb = lb_of(a, l, h * 128 + idx);
#pragma unroll
        for (int i = 0; i < 16; ++i) { const int t = 16 * tq + i; const float f = lb + (1.f - lb) * sigm(x[0][i]);
            Bf[t * 128 + idx] = fmaxf(__logf(f), -80.f); Kf[t * 128 + idx] = 1.f - f; Qf[t * 128 + idx] = silu(x[1][i]);
            gv[(((t >> 4) * 8 + (idx >> 4)) * 64 + (idx & 15) + 16 * ((t >> 2) & 3)) * 4 + (t & 3)] = x[2][i]; }
    }
    __syncthreads();
    {
        const int d = tid & 127, q4 = tid >> 7; float run = 0.f;
#pragma unroll
        for (int i = 0; i < 16; ++i) { run += Bf[(16 * q4 + i) * 128 + d]; Bf[(16 * q4 + i) * 128 + d] = run; }
        tot[q4 * 128 + d] = run;
        __syncthreads();
        float off = 0.f;
        for (int q = 0; q < q4; ++q) off += tot[q * 128 + d];
        if (q4 > 0) {
#pragma unroll
            for (int i = 0; i < 16; ++i) Bf[(16 * q4 + i) * 128 + d] += off; }
    }
    __syncthreads();
    {
        const int t = tid >> 3, d0 = (tid & 7) * 16; bf16_t* gq = (bf16_t*)(c.ws + IA_Q) + ((size_t)u * 64 + t) * 128;
#pragma unroll
        for (int m = 0; m < 4; ++m) { const int d = d0 + 4 * m; const f32x4 bb = *(const LAS f32x4*)(Bf + t * 128 + d), q = *(const LAS f32x4*)(Qf + t * 128 + d), k = *(const LAS f32x4*)(Kf + t * 128 + d);
            const f32x4 b31 = *(const LAS f32x4*)(Bf + 31 * 128 + d); const f32x4 rr = (t >= 32) ? b31 : (f32x4){0.f, 0.f, 0.f, 0.f};
            *(u32x2*)(gq + kpos(d)) = (u32x2){pk2(q.x * __expf(bb.x), q.y * __expf(bb.y)), pk2(q.z * __expf(bb.z), q.w * __expf(bb.w))};
            *(LAS u32x2*)(Qh + t * 136 + d) = (u32x2){pk2(q.x * __expf(bb.x - rr.x), q.y * __expf(bb.y - rr.y)), pk2(q.z * __expf(bb.z - rr.z), q.w * __expf(bb.w - rr.w))};
            *(LAS u32x2*)(Kd + t * 136 + d) = (u32x2){pk2(k.x * __expf(fminf(rr.x - bb.x, 80.f)), k.y * __expf(fminf(rr.y - bb.y, 80.f))), pk2(k.z * __expf(fminf(rr.z - bb.z, 80.f)), k.w * __expf(fminf(rr.w - bb.w, 80.f)))};
            if (t < 32) *(LAS u32x2*)(Ko + t * 136 + d) = (u32x2){pk2(k.x * __expf(b31.x - bb.x), k.y * __expf(b31.y - bb.y)), pk2(k.z * __expf(b31.z - bb.z), k.w * __expf(b31.w - bb.w))}; }
        const int d = tid & 127, s0 = (tid >> 7) * 16; bf16_t* gk = (bf16_t*)(c.ws + IA_KT) + ((size_t)u * 128 + d) * 64; const float bC = Bf[63 * 128 + d];
#pragma unroll
        for (int m = 0; m < 4; ++m) { float v[4];
#pragma unroll
            for (int j = 0; j < 4; ++j) { const int s = s0 + 4 * m + j; v[j] = Kf[s * 128 + d] * __expf(bC - Bf[s * 128 + d]); }
            *(u32x2*)(gk + kpos(s0 + 4 * m)) = (u32x2){pk2(v[0], v[1]), pk2(v[2], v[3])}; }
        if (tid < 128) ((float*)(c.ws + IA_DEC))[(size_t)u * 128 + tid] = __expf(bC);
    }
    __syncthreads();
    {
        const int i = lane & 15, g = lane >> 4;
#pragma unroll
        for (int q2 = 0; q2 < 2; ++q2) { const int idx = 2 * wave + q2, tt = idx >> 2, st = idx & 3, I = tt >> 1, J = st >> 1; const int s = 16 * st + i;
            if (J <= I) {
                const LAS bf16_t* bsrc = (I == J ? Kd : Ko) + (16 * st + i) * 136;
                f32x4 acc = {0.f, 0.f, 0.f, 0.f};
#pragma unroll
                for (int ks = 0; ks < 4; ++ks) acc = MFMA16(*(const LAS bf16x8*)(Qh + (16 * tt + i) * 136 + 32 * ks + 8 * g), *(const LAS bf16x8*)(bsrc + 32 * ks + 8 * g), acc);
#pragma unroll
                for (int r = 0; r < 4; ++r) { const int t = 16 * tt + 4 * g + r; Pl[t * 72 + kpos(s)] = bf1((s <= t) ? acc[r] : 0.f); }
            } else {
#pragma unroll
                for (int r = 0; r < 4; ++r) Pl[(16 * tt + 4 * g + r) * 72 + kpos(s)] = 0;
            }
        }
    }
    __syncthreads();
    { const int row = tid >> 3, c16 = tid & 7; *(u32x4*)((bf16_t*)(c.ws + IA_P) + (size_t)u * 4096 + row * 64 + c16 * 8) = *(const LAS u32x4*)(Pl + row * 72 + c16 * 8); }
    __syncthreads();
}

DI void m1_unit_c(const Ctx& c0, int l, int u) {
    const Ctx c = fresh(c0); const Args& a = *c.a; const int tid = c.tid;
    const int b = u >> 7, n = (u >> 4) & 7, ti = u & 15;
    constexpr int TT = 128;
    LAS float* xcv = (LAS float*)c.lds;
    LAS float* ra = xcv + TT * 64;
    LAS float* ia = ra + TT * 64;
    LAS float* segA = ia + TT * 64;
    LAS float* segB = segA + 512;
    const float* proj = (const float*)(c.ws + WS_PROJ);
    const long rowb = (long)b * SEQ + TT * ti; const int tg0 = TT * ti;
    const int j = tid & 63, g = (tid >> 6) & 1, tg = tid >> 7;
    const float* wsrc = (g ? inp(a, I_CWX) : inp(a, I_CWA)) + ((size_t)l * 8 + n) * 4096 + j;
    float wreg[64];
#pragma unroll
    for (int i = 0; i < 64; ++i) wreg[i] = wsrc[i * 64];
    const float gbias = (g ? inp(a, I_CBX) : inp(a, I_CBA))[l * 512 + n * 64 + j];
    const int cch = tid & 63, seg = tid >> 6, chg = n * 64 + cch;
    {
        const float* ccw = inp(a, I_CCW) + (size_t)l * 4 * 512;
        const float w0 = ccw[chg], w1 = ccw[512 + chg], w2 = ccw[1024 + chg], w3 = ccw[1536 + chg], cb = inp(a, I_CCB)[l * 512 + chg];
        const int ts = seg * 16; const int col = C_CX + chg;
        float x[19];
#pragma unroll
        for (int jx = 0; jx < 19; ++jx) { const int t = ts - 3 + jx; x[jx] = (tg0 + t >= 0) ? proj[(rowb + t) * NINP + col] : 0.f; }
#pragma unroll
        for (int i = 0; i < 16; ++i) xcv[(ts + i) * 64 + cch] = w0 * x[i] + w1 * x[i + 1] + w2 * x[i + 2] + w3 * x[i + 3] + cb;
    }
    __syncthreads();
    for (int tt = tg * 32; tt < tg * 32 + 32; ++tt) {
        float acc0 = 0.f, acc1 = 0.f;
#pragma unroll
        for (int i = 0; i < 64; i += 4) { const f32x4 x = *(const LAS f32x4*)(xcv + tt * 64 + i); acc0 += x.x * wreg[i] + x.z * wreg[i + 2]; acc1 += x.y * wreg[i + 1] + x.w * wreg[i + 3]; }
        (g ? ia : ra)[tt * 64 + j] = sigm(acc0 + acc1 + gbias);
    }
    __syncthreads();
    const float spl = softplus(-inp(a, I_CLAM)[l * 512 + chg]);
    {
        float A = 1.f, B = 0.f;
        for (int i = 0; i < 16; ++i) { const int tt = seg * 16 + i; const float r = ra[tt * 64 + cch], ig = ia[tt * 64 + cch], x = xcv[tt * 64 + cch];
            const float la = -8.f * r * spl; const float at = __expf(la); float mult = sqrtf(fmaxf(0.f, -expm1f(2.f * la)));
            if (tg0 + tt == 0) mult = 1.f;
            const float bt = mult * (ig * x); ra[tt * 64 + cch] = at; ia[tt * 64 + cch] = bt; A *= at; B = at * B + bt; }
        segA[seg * 64 + cch] = A; segB[seg * 64 + cch] = B;
    }
    __syncthreads();
    {
        float Ac = 1.f, Bc = 0.f;
        for (int s = 0; s < seg; ++s) { const float sa = segA[s * 64 + cch], sb = segB[s * 64 + cch]; Bc = sa * Bc + sb; Ac *= sa; }
        float* ga = (float*)(c.ws + IC_A); float* gb = (float*)(c.ws + IC_B);
        for (int i = 0; i < 16; ++i) { const int tt = seg * 16 + i; const float at = ra[tt * 64 + cch], bt = ia[tt * 64 + cch]; Ac *= at; Bc = at * Bc + bt;
            ga[(rowb + tt) * 512 + chg] = Ac; gb[(rowb + tt) * 512 + chg] = Bc; }
        if (seg == 7) { float* gt = (float*)(c.ws + IC_TOT) + (((size_t)b * 16 + ti) * 2) * 512; gt[chg] = Ac; gt[512 + chg] = Bc; }
    }
    __syncthreads();
}

DI void phase_m1(const Ctx& c, int l) {
    int w = blockIdx.x; asm volatile("" : "+s"(w));
    for (int rep = 0; rep < (PROBE_SUB == 1 ? 2 : 1); ++rep) for (int u = w; u < 1024; u += c.G) m1_unit_b(c, l, u);
    for (int rep = 0; rep < (PROBE_SUB == 2 ? 2 : 1); ++rep) for (int u = w; u < 512; u += c.G) m1_unit_a(c, l, u);
    for (int rep = 0; rep < (PROBE_SUB == 3 ? 2 : 1); ++rep) for (int u = w; u < 512; u += c.G) m1_unit_c(c, l, u);
}

DI void m2_unit_head(const Ctx& c0, int l, int isB, int b, int h) {
    const Ctx c = fresh(c0); const Args& a = *c.a; const int tid = c.tid, lane = c.lane, wave = c.wave;
    LAS unsigned char* Wl = c.lds;
    LAS unsigned char* Ql = Wl + 64 * 272;
    LAS unsigned char* KTl = Ql + 64 * 272;
    LAS unsigned char* Pl = KTl + 128 * 144;
    LAS float* ob = (LAS float*)(Pl + 64 * 144);
    LAS float* decl = ob + 64 * 132;
    const int i = lane & 15, g = lane >> 4, e0 = 16 * wave;
    const int ubase = isB ? ((b * 8 + h) * 32) : ((b * 4 + h) * 32);
    const unsigned char* gW = c.ws + IB_W; const unsigned char* gQ = c.ws + (isB ? IB_Q : IA_Q); const unsigned char* gKT = c.ws + (isB ? IB_KT : IA_KT);
    const unsigned char* gP = c.ws + (isB ? IB_P : IA_P); const float* gU = (const float*)(c.ws + (isB ? IB_U0 : IA_V));
    const float* proj = (const float*)(c.ws + WS_PROJ); bf16_t* mixo = (bf16_t*)(c.ws + WS_MIXO);
    const float* nw = (isB ? inp(a, I_BNORM) : inp(a, I_ANORM)) + l * 128;
    const int gcol = isB ? (C_BZ + h * 128) : (C_AG + h * 128), ocol = isB ? (512 + h * 128) : (h * 128);
    const float nw0 = nw[2 * lane], nw1 = nw[2 * lane + 1];
    f32x4 S[8];
#pragma unroll
    for (int dt = 0; dt < 8; ++dt) S[dt] = (f32x4){0.f, 0.f, 0.f, 0.f};
    u32x4 pw[2], pq[2], pk[2], pp, pd = {0u, 0u, 0u, 0u};
    const int r16 = tid >> 4, c16 = tid & 15, r8 = tid >> 3, c8 = tid & 7;
#define M2_LOAD(ch) do { const size_t uu = (size_t)(ubase + (ch)); \
        if (isB) { pw[0] = *(const u32x4*)(gW + uu * 16384 + tid * 16); pw[1] = *(const u32x4*)(gW + uu * 16384 + (tid + 512) * 16); } \
        pq[0] = *(const u32x4*)(gQ + uu * 16384 + tid * 16); pq[1] = *(const u32x4*)(gQ + uu * 16384 + (tid + 512) * 16); \
        pk[0] = *(const u32x4*)(gKT + uu * 16384 + tid * 16); pk[1] = *(const u32x4*)(gKT + uu * 16384 + (tid + 512) * 16); \
        pp = *(const u32x4*)(gP + uu * 8192 + tid * 16); \
        if (!isB && tid < 32) pd = *(const u32x4*)(c.ws + IA_DEC + uu * 512 + tid * 16); } while (0)
#define M2_STORE() do { \
        if (isB) { *(LAS u32x4*)(Wl + r16 * 272 + c16 * 16) = pw[0]; *(LAS u32x4*)(Wl + (r16 + 32) * 272 + c16 * 16) = pw[1]; } \
        *(LAS u32x4*)(Ql + r16 * 272 + c16 * 16) = pq[0]; *(LAS u32x4*)(Ql + (r16 + 32) * 272 + c16 * 16) = pq[1]; \
        *(LAS u32x4*)(KTl + r8 * 144 + c8 * 16) = pk[0]; *(LAS u32x4*)(KTl + (r8 + 64) * 144 + c8 * 16) = pk[1]; \
        *(LAS u32x4*)(Pl + r8 * 144 + c8 * 16) = pp; \
        if (!isB && tid < 32) *(LAS u32x4*)((LAS unsigned char*)decl + tid * 16) = pd; } while (0)
    M2_LOAD(0);
    M2_STORE();
    f32x4 U[4], Un[4]; f32x2 gt[8], gtn[8]; float dec = 0.f, decn = 0.f;
#define M2_LOADR(ch, UU, GT, DEC) do { const size_t uu_ = (size_t)(ubase + (ch)); const long row_ = (long)b * SEQ + 64 * (ch); \
        _Pragma("unroll") for (int tt = 0; tt < 4; ++tt) UU[tt] = *(const f32x4*)(gU + uu_ * 8192 + ((tt * 8 + wave) * 64 + lane) * 4); \
        _Pragma("unroll") for (int k = 0; k < 8; ++k) GT[k] = *(const f32x2*)(proj + (row_ + 8 * wave + k) * NINP + gcol + 2 * lane); \
        if (isB) DEC = ((const float*)(c.ws + IB_DEC))[uu_]; } while (0)
    M2_LOADR(0, U, gt, dec);
    __syncthreads();
    for (int ci = 0; ci < 32; ++ci) {
        const long row0 = (long)b * SEQ + 64 * ci;
        if (ci + 1 < 32) { M2_LOAD(ci + 1); M2_LOADR(ci + 1, Un, gtn, decn); }
        bf16x8 Sb[4];
#pragma unroll
        for (int ks = 0; ks < 4; ++ks) { u32x4 p; p.x = pk2(S[2 * ks][0], S[2 * ks][1]); p.y = pk2(S[2 * ks][2], S[2 * ks][3]); p.z = pk2(S[2 * ks + 1][0], S[2 * ks + 1][1]); p.w = pk2(S[2 * ks + 1][2], S[2 * ks + 1][3]); Sb[ks] = __builtin_bit_cast(bf16x8, p); }
        if (isB) {
#pragma unroll
            for (int tt = 0; tt < 4; ++tt) { f32x4 acc = {0.f, 0.f, 0.f, 0.f};
#pragma unroll
                for (int ks = 0; ks < 4; ++ks) acc = MFMA16(*(const LAS bf16x8*)(Wl + (16 * tt + i) * 272 + (32 * ks + 8 * g) * 2), Sb[ks], acc);
                U[tt] = U[tt] - acc; }
        }
        bf16x8 Ub[2];
#pragma unroll
        for (int k = 0; k < 2; ++k) { u32x4 p; p.x = pk2(U[2 * k][0], U[2 * k][1]); p.y = pk2(U[2 * k][2], U[2 * k][3]); p.z = pk2(U[2 * k + 1][0], U[2 * k + 1][1]); p.w = pk2(U[2 * k + 1][2], U[2 * k + 1][3]); Ub[k] = __builtin_bit_cast(bf16x8, p); }
#pragma unroll
        for (int tt = 0; tt < 4; ++tt) { f32x4 acc = {0.f, 0.f, 0.f, 0.f};
#pragma unroll
            for (int ks = 0; ks < 4; ++ks) acc = MFMA16(*(const LAS bf16x8*)(Ql + (16 * tt + i) * 272 + (32 * ks + 8 * g) * 2), Sb[ks], acc);
#pragma unroll
            for (int k = 0; k < 2; ++k) acc = MFMA16(*(const LAS bf16x8*)(Pl + (16 * tt + i) * 144 + (32 * k + 8 * g) * 2), Ub[k], acc);
#pragma unroll
            for (int r = 0; r < 4; ++r) ob[(16 * tt + 4 * g + r) * 132 + e0 + i] = acc[r]; }
        if (isB) {
#pragma unroll
            for (int dt = 0; dt < 8; ++dt) S[dt] = S[dt] * dec;
        } else {
#pragma unroll
            for (int dt = 0; dt < 8; ++dt) S[dt] = S[dt] * *(const LAS f32x4*)(decl + 16 * dt + 4 * g); }
#pragma unroll
        for (int dt = 0; dt < 8; ++dt) {
#pragma unroll
            for (int k = 0; k < 2; ++k) S[dt] = MFMA16(*(const LAS bf16x8*)(KTl + (16 * dt + i) * 144 + (32 * k + 8 * g) * 2), Ub[k], S[dt]); }
        __syncthreads();
#pragma unroll
        for (int k = 0; k < 8; ++k) { const int t = 8 * wave + k; const f32x2 v = *(const LAS f32x2*)(ob + t * 132 + 2 * lane);
            float ss = row16_sum(v.x * v.x + v.y * v.y); ss += __shfl_xor(ss, 16); ss += __shfl_xor(ss, 32);
            const float r = rsqrtf(ss * (1.f / 128.f) + NORM_EPS);
            *(unsigned*)(mixo + (row0 + t) * D + ocol + 2 * lane) = pk2(v.x * r * nw0 * silu(gt[k].x), v.y * r * nw1 * silu(gt[k].y)); }
        if (ci + 1 < 32) { M2_STORE();
#pragma unroll
            for (int tt = 0; tt < 4; ++tt) U[tt] = Un[tt];
#pragma unroll
            for (int k = 0; k < 8; ++k) gt[k] = gtn[k];
            dec = decn; }
        __syncthreads();
    }
#undef M2_LOADR
#undef M2_LOAD
#undef M2_STORE
    float* so = c.out + (isB ? O_GDP + (((size_t)l * BATCH + b) * 8 + h) * 16384 : O_HGP + (((size_t)l * BATCH + b) * 4 + h) * 16384);
#pragma unroll
    for (int dt = 0; dt < 8; ++dt)
#pragma unroll
        for (int r = 0; r < 4; ++r) so[(size_t)(16 * dt + 4 * g + r) * 128 + e0 + i] = S[dt][r];
}

DI void m2_unit_cfin(const Ctx& c0, int l, int u) {
    const Ctx c = fresh(c0); const int tid = c.tid;
    const int b = u >> 7, n = (u >> 4) & 7, ti = u & 15;
    const int cch = tid & 63, seg = tid >> 6, chg = n * 64 + cch;
    const float* proj = (const float*)(c.ws + WS_PROJ); bf16_t* mixo = (bf16_t*)(c.ws + WS_MIXO);
    const float* ga = (const float*)(c.ws + IC_A); const float* gb = (const float*)(c.ws + IC_B);
    const float* gt = (const float*)(c.ws + IC_TOT) + ((size_t)b * 16 * 2) * 512;
    float hs = 0.f;
    for (int k = 0; k < ti; ++k) hs = gt[(k * 2) * 512 + chg] * hs + gt[(k * 2 + 1) * 512 + chg];
    const long rowb = (long)b * SEQ + 128 * ti;
    float hh = 0.f;
#pragma unroll 4
    for (int i = 0; i < 16; ++i) { const long row = rowb + seg * 16 + i; hh = gb[row * 512 + chg] + ga[row * 512 + chg] * hs;
        mixo[row * D + 1536 + chg] = bf1(hh * gelu_tanh(proj[row * NINP + C_CG + chg])); }
    if (ti == 15 && seg == 7) c.out[O_RHP + ((size_t)l * BATCH + b) * 512 + chg] = hh;
}

DI void block_reduce_cols(LAS float* red, LAS float* full, const float (&p)[4], int tid, float scale) {
    const int e4 = (tid & 31) * 4, dgp = tid >> 5;
    *(LAS f32x4*)(red + dgp * 128 + e4) = (f32x4){p[0], p[1], p[2], p[3]};
    __syncthreads();
    if (tid < 128) { float s = 0.f;
#pragma unroll
        for (int k = 0; k < 16; ++k) s += red[k * 128 + tid];
        full[tid] = s * scale; }
    __syncthreads();
}
DI void unit_b_sample(const Ctx& c0, int l, int b, int h) {
    const Ctx c = fresh(c0);
    const Args& a = *c.a; const int tid = c.tid, lane = c.lane, wave = c.wave;
    LAS float* qkv = (LAS float*)c.lds;
    LAS float* scl = qkv + 384;
    LAS float* red = scl + 8;
    LAS float* full = red + 2048;
    LAS float* uu = full + 128;
    const float* proj = (const float*)(c.ws + WS_PROJ) + (size_t)(NP + b) * NINP;
    if (tid < 384) { const int part = tid >> 7, idx = tid & 127, cc = part * 1024 + h * 128 + idx;
        const float* cw = inp(a, I_BCW) + (size_t)l * 4 * 3072; const float* st = inp(a, I_SGC) + (((size_t)l * NS + b) * 3) * 3072;
        const float x0 = st[cc], x1 = st[3072 + cc], x2 = st[2 * 3072 + cc], x3 = proj[C_BQ + cc];
        qkv[tid] = silu(cw[cc] * x0 + cw[3072 + cc] * x1 + cw[2 * 3072 + cc] * x2 + cw[3 * 3072 + cc] * x3);
        float* so = c.out + O_GCS + (((size_t)l * NS + b) * 3) * 3072; so[cc] = x1; so[3072 + cc] = x2; so[2 * 3072 + cc] = x3; }
    if (tid == 384) { const float bb = proj[C_BB + h], ba = proj[C_BA + h]; scl[0] = sigm(bb); scl[1] = __expf(-__expf(inp(a, I_BALOG)[l * 8 + h]) * softplus(ba + inp(a, I_BDT)[l * 8 + h])); }
    __syncthreads();
    if (wave < 2) { const float x0 = qkv[wave * 128 + lane], x1 = qkv[wave * 128 + 64 + lane]; const float ss = wave_sum(x0 * x0 + x1 * x1);
        if (lane == 0) scl[2 + wave] = rsqrtf(ss + L2_EPS) * (wave == 0 ? 0.08838834764831845f : 1.f); }
    __syncthreads();
    const float beta = scl[0], eg = scl[1], sq = scl[2], sk = scl[3];
    const int e4 = (tid & 31) * 4, d0 = (tid >> 5) * 8;
    const size_t sidx = (((size_t)l * NS + b) * 8 + h) * 16384;
    const float* Sin = inp(a, I_SGD) + sidx; float* Sout = c.out + O_GDS + sidx;
    f32x4 S[8]; float p[4] = {0.f, 0.f, 0.f, 0.f};
#pragma unroll
    for (int i = 0; i < 8; ++i) { S[i] = *(const f32x4*)(Sin + (size_t)(d0 + i) * 128 + e4); const float k = qkv[128 + d0 + i]; p[0] += k * S[i].x; p[1] += k * S[i].y; p[2] += k * S[i].z; p[3] += k * S[i].w; }
    block_reduce_cols(red, full, p, tid, sk);
    if (tid < 128) uu[tid] = beta * (qkv[256 + tid] - eg * full[tid]) * sk;
    __syncthreads();
    const f32x4 u4 = *(const LAS f32x4*)(uu + e4);
    float po[4] = {0.f, 0.f, 0.f, 0.f};
#pragma unroll
    for (int i = 0; i < 8; ++i) { const float k = qkv[128 + d0 + i], q = qkv[d0 + i]; S[i] = S[i] * eg + u4 * k; *(f32x4*)(Sout + (size_t)(d0 + i) * 128 + e4) = S[i];
        po[0] += q * S[i].x; po[1] += q * S[i].y; po[2] += q * S[i].z; po[3] += q * S[i].w; }
    block_reduce_cols(red, full, po, tid, sq);
    if (wave < 2) { const float o = full[wave * 64 + lane]; const float ss = wave_sum(o * o); if (lane == 0) scl[4 + wave] = ss; }
    __syncthreads();
    if (tid < 128) { const float rms = rsqrtf((scl[4] + scl[5]) * (1.f / 128.f) + NORM_EPS);
        const float o = full[tid] * rms * inp(a, I_BNORM)[l * 128 + tid] * silu(proj[C_BZ + h * 128 + tid]);
        ((bf16_t*)(c.ws + WS_MIXO))[(size_t)(NP + b) * D + 512 + h * 128 + tid] = (bf16_t)(pk2(o, 0.f) & 0xffffu); }
    __syncthreads();
}
DI void unit_a_sample(const Ctx& c0, int l, int b, int h) {
    const Ctx c = fresh(c0);
    const Args& a = *c.a; const int tid = c.tid, lane = c.lane, wave = c.wave;
    LAS float* fqv = (LAS float*)c.lds;
    LAS float* scl = fqv + 384;
    LAS float* red = scl + 8;
    LAS float* full = red + 2048;
    const float* proj = (const float*)(c.ws + WS_PROJ) + (size_t)(NP + b) * NINP;
    if (tid < 384) { const int part = tid >> 7, idx = tid & 127;
        if (part == 0) { const float lb = lb_of(a, l, h * 128 + idx); fqv[tid] = lb + (1.f - lb) * sigm(proj[C_AF + h * 128 + idx]); }
        else if (part == 1) fqv[tid] = silu(proj[C_AQ + h * 128 + idx]);
        else fqv[tid] = proj[C_AI + h * 128 + idx]; }
    __syncthreads();
    const int e4 = (tid & 31) * 4, d0 = (tid >> 5) * 8;
    const size_t sidx = (((size_t)l * NS + b) * 4 + h) * 16384;
    const float* Sin = inp(a, I_SHG) + sidx; float* Sout = c.out + O_HGS + sidx;
    const f32x4 v4 = *(const LAS f32x4*)(fqv + 256 + e4);
    float po[4] = {0.f, 0.f, 0.f, 0.f};
#pragma unroll
    for (int i = 0; i < 8; ++i) { const float f = fqv[d0 + i], q = fqv[128 + d0 + i]; f32x4 S = *(const f32x4*)(Sin + (size_t)(d0 + i) * 128 + e4);
        S = S * f + v4 * (1.f - f); *(f32x4*)(Sout + (size_t)(d0 + i) * 128 + e4) = S;
        po[0] += q * S.x; po[1] += q * S.y; po[2] += q * S.z; po[3] += q * S.w; }
    block_reduce_cols(red, full, po, tid, 1.f);
    if (wave < 2) { const float o = full[wave * 64 + lane]; const float ss = wave_sum(o * o); if (lane == 0) scl[4 + wave] = ss; }
    __syncthreads();
    if (tid < 128) { const float rms = rsqrtf((scl[4] + scl[5]) * (1.f / 128.f) + NORM_EPS);
        const float o = full[tid] * rms * inp(a, I_ANORM)[l * 128 + tid] * silu(proj[C_AG + h * 128 + tid]);
        ((bf16_t*)(c.ws + WS_MIXO))[(size_t)(NP + b) * D + h * 128 + tid] = (bf16_t)(pk2(o, 0.f) & 0xffffu); }
    __syncthreads();
}
DI void unit_c_sample(const Ctx& c0, int l, int b) {
    const Ctx c = fresh(c0);
    const Args& a = *c.a; const int tid = c.tid;
    LAS float* xc = (LAS float*)c.lds;
    const float* proj = (const float*)(c.ws + WS_PROJ) + (size_t)(NP + b) * NINP;
    const float* ccw = inp(a, I_CCW) + (size_t)l * 4 * 512; const float* st = inp(a, I_SRC) + (((size_t)l * NS + b) * 3) * 512;
    const float x0 = st[tid], x1 = st[512 + tid], x2 = st[1024 + tid], x3 = proj[C_CX + tid];
    const float xv = ccw[tid] * x0 + ccw[512 + tid] * x1 + ccw[1024 + tid] * x2 + ccw[1536 + tid] * x3 + inp(a, I_CCB)[l * 512 + tid];
    xc[tid] = xv;
    { float* so = c.out + O_RCS + (((size_t)l * NS + b) * 3) * 512; so[tid] = x1; so[512 + tid] = x2; so[1024 + tid] = x3; }
    __syncthreads();
    const int n = tid >> 6, j = tid & 63;
    const float* wa = inp(a, I_CWA) + ((size_t)l * 8 + n) * 4096 + j; const float* wx = inp(a, I_CWX) + ((size_t)l * 8 + n) * 4096 + j;
    float sa = 0.f, sx = 0.f;
#pragma unroll 8
    for (int i = 0; i < 64; ++i) { const float x = xc[n * 64 + i]; sa += x * wa[i * 64]; sx += x * wx[i * 64]; }
    const float r = sigm(sa + inp(a, I_CBA)[l * 512 + tid]), ig = sigm(sx + inp(a, I_CBX)[l * 512 + tid]);
    const float la = -8.f * r * softplus(-inp(a, I_CLAM)[l * 512 + tid]); const float at = __expf(la); const float mult = sqrtf(fmaxf(0.f, -expm1f(2.f * la)));
    const float h0 = inp(a, I_SRH)[((size_t)l * NS + b) * 512 + tid];
    const float hh = at * h0 + mult * (ig * xv);
    c.out[O_RHS + ((size_t)l * NS + b) * 512 + tid] = hh;
    ((bf16_t*)(c.ws + WS_MIXO))[(size_t)(NP + b) * D + 1536 + tid] = (bf16_t)(pk2(hh * gelu_tanh(proj[C_CG + tid]), 0.f) & 0xffffu);
    __syncthreads();
}


DI void phase_m2(const Ctx& c, int l) {
    int w = blockIdx.x; asm volatile("" : "+s"(w));
    if (w < 48) {
        const int isB = w < 32; const int u = isB ? w : w - 32;
        for (int rep = 0; rep < (PROBE_SUB == 4 ? 2 : 1); ++rep) m2_unit_head(c, l, isB, isB ? (u >> 3) : (u >> 2), isB ? (u & 7) : (u & 3));
    } else {
        const int nw = c.G - 48;
        for (int rep = 0; rep < (PROBE_SUB == 5 ? 2 : 1); ++rep)
        for (int u = w - 48; u < 512 + 1664; u += nw) {
            if (u < 512) m2_unit_cfin(c, l, u);
            else { const int v = u - 512;
                if (v < 1024) unit_b_sample(c, l, v >> 3, v & 7);
                else if (v < 1536) { const int x = v - 1024; unit_a_sample(c, l, x >> 2, x & 3); }
                else unit_c_sample(c, l, v - 1536); }
        }
        const Ctx cc = fresh(c); const float* proj = (const float*)(cc.ws + WS_PROJ);
        const int gt_ = (w - 48) * 512 + cc.tid, NT = nw * 512;
        for (int i = gt_; i < BATCH * 3 * 3072; i += NT) { const int b = i / (3 * 3072), r = i - b * 3 * 3072, j = r / 3072, ch = r - j * 3072;
            cc.out[O_GCP + (size_t)l * BATCH * 3 * 3072 + i] = proj[((size_t)b * SEQ + SEQ - 3 + j) * NINP + C_BQ + ch]; }
        for (int i = gt_; i < BATCH * 3 * 512; i += NT) { const int b = i / (3 * 512), r = i - b * 3 * 512, j = r / 512, ch = r - j * 512;
            cc.out[O_RCP + (size_t)l * BATCH * 3 * 512 + i] = proj[((size_t)b * SEQ + SEQ - 3 + j) * NINP + C_CX + ch]; }
    }
}


#define XB_TMO      128
#define XB_XCNT(j)  (256  + 64 * (j))
#define XB_XSUB(j)  (1280 + 64 * (j))
#define XB_XGEN(j)  (2304 + 64 * (j))
#define XB_TOP      3328
#define XB_TOPGEN   3392
#define XCD_BAR_WORDS 3456
#define XB_SPIN_CAP (1u << 20)
DI unsigned xb_ld(unsigned* p)              { return __hip_atomic_load(p, __ATOMIC_RELAXED, __HIP_MEMORY_SCOPE_AGENT); }
DI unsigned xb_add(unsigned* p, unsigned v) { return __hip_atomic_fetch_add(p, v, __ATOMIC_RELAXED, __HIP_MEMORY_SCOPE_AGENT); }
DI unsigned xb_xcc_id() { return (unsigned)__builtin_amdgcn_s_getreg((3 << 11) | 20) & 0xFu; }
#define XB_SPIN(cond, bar) do { unsigned _sp = 0; while (cond) { __builtin_amdgcn_s_sleep(1); \
    if ((++_sp & 255u) == 0u) { if (xb_ld(&(bar)[XB_TMO])) break; if (_sp > XB_SPIN_CAP) { atomicAdd(&(bar)[XB_TMO], 1u); break; } } } } while (0)
DI void xcd_barrier_post(unsigned* bar) { if (threadIdx.x == 0) (void)xb_add(&bar[XB_XCNT(xb_xcc_id())], 1u); }
DI void xcd_barrier_complete(unsigned* bar, unsigned x, unsigned& nloc, unsigned& nx) {
    const unsigned G = gridDim.x * gridDim.y * gridDim.z;
    unsigned sum, cnt, mine, sp = 0u;
    for (;;) {
        sum = 0u; cnt = 0u; mine = 0u;
#pragma unroll
        for (unsigned j = 0; j < 16; ++j) { const unsigned c = xb_ld(&bar[XB_XCNT(j)]); sum += c; cnt += (c > 0u) ? 1u : 0u; mine = (j == x) ? c : mine; }
        if (sum == G) break;
        __builtin_amdgcn_s_sleep(1);
        if ((++sp & 255u) == 0u) { if (xb_ld(&bar[XB_TMO])) break; if (sp > XB_SPIN_CAP) { atomicAdd(&bar[XB_TMO], 1u); break; } }
    }
    nloc = mine > 0u ? mine : 1u; nx = cnt > 0u ? cnt : 1u;
}
DI void xcd_barrier(unsigned* bar, volatile LAS unsigned* st) {
    asm volatile("s_waitcnt vmcnt(0)" ::: "memory");
    __syncthreads();
    if (threadIdx.x == 0) {
        const unsigned x = xb_xcc_id();
        __builtin_amdgcn_s_waitcnt(0);
        unsigned nloc = st[0], nx = st[1];
        if (nloc == 0u) { xcd_barrier_complete(bar, x, nloc, nx); st[0] = nloc; st[1] = nx; }
        const unsigned old = xb_add(&bar[XB_XSUB(x)], 1u);
        const unsigned gen = old / nloc;
        if (old + 1u == (gen + 1u) * nloc) {
            __builtin_amdgcn_fence(__ATOMIC_RELEASE, "agent");
            asm volatile("s_waitcnt vmcnt(0)" ::: "memory");
            const unsigned og = xb_add(&bar[XB_TOP], 1u);
            const unsigned tg = og / nx;
            if (og + 1u == (tg + 1u) * nx) xb_add(&bar[XB_TOPGEN], 1u);
            else XB_SPIN(xb_ld(&bar[XB_TOPGEN]) == tg, bar);
            __builtin_amdgcn_fence(__ATOMIC_ACQUIRE, "agent");
            xb_add(&bar[XB_XGEN(x)], 1u);
            asm volatile("s_waitcnt vmcnt(0)" ::: "memory");
        } else {
            XB_SPIN(xb_ld(&bar[XB_XGEN(x)]) == gen, bar);
            __builtin_amdgcn_fence(__ATOMIC_ACQUIRE, "agent");
            asm volatile("s_waitcnt vmcnt(0)" ::: "memory");
        }
    }
    __syncthreads();
}

__global__ void __launch_bounds__(512, 2) fwd_megakernel(Args args) {
    extern __shared__ __attribute__((aligned(16))) unsigned char lds_raw[];
    Ctx c0; c0.a = &args; c0.ws = nullptr; c0.out = nullptr; c0.lds = (LAS unsigned char*)lds_raw; c0.tid = 0; c0.lane = 0; c0.wave = 0; c0.G = gridDim.x; c0.bid = 0;
    const int lo = args.ph_lo, hi = args.ph_hi;
    volatile LAS unsigned* bst = (volatile LAS unsigned*)((LAS unsigned char*)lds_raw + LDS_BYTES - 16);
    if (threadIdx.x == 0) { bst[0] = 0u; bst[1] = 0u; }
    __syncthreads();
    xcd_barrier_post((unsigned*)(args.ws + WS_CTL) + 1024);
#pragma unroll 1
    for (int ph2 = 2 * lo; ph2 < 2 * hi; ++ph2) {
        const int ph = ph2 >> 1;
        const int l = (ph - 1) >> 3, k = (ph == 0) ? -1 : ((ph - 1) & 7);
        if ((ph2 & 1) && k != PROBE_REP) continue;
        if (k == -1) phase_p0(c0);
        else if (k == 0 || k == 3 || k == 5 || k == 6) {
            const Ctx c = fresh(c0); unsigned char* ws = c.ws;
            pg8::Gemm g; pg8::EpiAny E; E.mode = 0; E.C = (float*)(ws + WS_MIXF); E.O = nullptr; E.ldc = D;
            if (k == 0)      { g.A = (const bf16_t*)(ws + WS_HBUF); g.Bt = (const bf16_t*)(ws + WS_WIN + l * SZ_WIN);   g.N = NINP; g.K = D;   E.C = (float*)(ws + WS_PROJ); E.ldc = NINP; }
            else if (k == 3) { g.A = (const bf16_t*)(ws + WS_MIXO); g.Bt = (const bf16_t*)(ws + WS_WOUT + l * SZ_WOUT); g.N = D;    g.K = D; }
            else if (k == 5) { g.A = (const bf16_t*)(ws + WS_HBUF); g.Bt = (const bf16_t*)(ws + WS_WGU + l * SZ_WGU);   g.N = NGU;  g.K = D;   E.mode = 1; E.O = (bf16_t*)(ws + WS_PROJ); E.ldc = DFF; }
            else             { g.A = (const bf16_t*)(ws + WS_PROJ); g.Bt = (const bf16_t*)(ws + WS_WDN + l * SZ_WDN);   g.N = D;    g.K = DFF; }
            g.M = MPAD;
            pg8::StaticOrder S; S.init(MPAD, g.N, c.G, c.bid);
            pg8::gemm_phase<pg8::EpiAny, pg8::StaticOrder, true, true>(c.lds, g, S, E);
        }
        else if (k == 1) phase_m1(c0, l);
        else if (k == 2) phase_m2(c0, l);
        else {
            const Ctx c = fresh(c0); unsigned char* ws = c.ws;
            float* mixf = (float*)(ws + WS_MIXF); float* x1 = (float*)(ws + WS_X1); bf16_t* hb = (bf16_t*)(ws + WS_HBUF);
            if (k == 4) {
                const float* xa = (l == 0) ? inp(args, I_XP) : c.out; const float* xb = (l == 0) ? inp(args, I_XS) : c.out + (size_t)NP * D;
                row_phase(c0, mixf, xa, xb, x1, inp(args, I_LN2) + l * D, inp(args, I_LN3) + l * D, hb);
            } else {
                row_phase(c0, mixf, x1, x1 + (size_t)NP * D, c.out, inp(args, I_LN4) + l * D, l == 0 ? inp(args, I_LN1) + D : nullptr, hb);
            }
        }
        if (ph2 + 1 < 2 * hi) {
            if (ph2 == 2 * lo) cg::this_grid().sync();
            else xcd_barrier((unsigned*)(args.ws + WS_CTL) + 1024, bst);
        }
    }
}

extern "C" void kernel_launch(void* const* d_in, const int* in_sizes, int n_in, void* d_out, int out_size, void* d_ws, size_t ws_size, hipStream_t stream) {
    static int grid = 0;
    if (grid == 0) {
        if (n_in != 29 || (size_t)out_size != O_END || ws_size < WS_END) { fprintf(stderr, "kernel_launch: unexpected shapes: n_in %d out %d ws %zu (need %zu)\n", n_in, out_size, ws_size, (size_t)WS_END); grid = -1; return; }
        int dev = 0, cus = 0, per_cu = 0;
        hipGetDevice(&dev); hipDeviceGetAttribute(&cus, hipDeviceAttributeMultiprocessorCount, dev);
        if (hipFuncSetAttribute((const void*)fwd_megakernel, hipFuncAttributeMaxDynamicSharedMemorySize, LDS_BYTES) != hipSuccess) { fprintf(stderr, "kernel_launch: hipFuncSetAttribute failed\n"); grid = -1; return; }
        if (hipOccupancyMaxActiveBlocksPerMultiprocessor(&per_cu, (const void*)fwd_megakernel, 512, LDS_BYTES) != hipSuccess || per_cu < 1) { fprintf(stderr, "kernel_launch: occupancy query says %d\n", per_cu); grid = -1; return; }
        grid = cus;
        if (grid < 224) { fprintf(stderr, "kernel_launch: needs >= 224 CUs, got %d\n", grid); grid = -1; return; }
    }
    if (grid < 0) return;
    hipMemsetAsync((char*)d_ws + WS_CTL, 0, CTL_BYTES, stream);
    Args a{};
    for (int i = 0; i < 29; ++i) a.in[i] = (const float*)d_in[i];
    a.out = (float*)d_out; a.ws = (unsigned char*)d_ws;
#if MK_MULTI
    for (int ph = 0; ph < NPHASE; ++ph) { a.ph_lo = ph; a.ph_hi = ph + 1; hipLaunchKernelGGL(fwd_megakernel, dim3(grid), dim3(512), LDS_BYTES, stream, a); }
#else
    a.ph_lo = 0; a.ph_hi = NPHASE;
    void* kargs[] = {&a};
    hipError_t e = hipLaunchCooperativeKernel((const void*)fwd_megakernel, dim3(grid), dim3(512), kargs, LDS_BYTES, stream);
    if (e != hipSuccess) fprintf(stderr, "cooperative launch failed: %s (grid %d)\n", hipGetErrorString(e), grid);
#endif
}
```

```cpp
#include <hip/hip_runtime.h>
#include <hip/hip_cooperative_groups.h>
#include <cstdio>
#include <cstdint>
namespace cg = cooperative_groups;

#ifndef MK_MULTI
#define MK_MULTI 0
#endif

#ifndef PROBE_REP
#define PROBE_REP (-2)
#endif
#ifndef PROBE_SUB
#define PROBE_SUB 0
#endif
#define DI __device__ __forceinline__
#define LAS __attribute__((address_space(3)))
#define GAS __attribute__((address_space(1)))
typedef unsigned short bf16_t;
typedef float f32x4 __attribute__((ext_vector_type(4)));
typedef float f32x2 __attribute__((ext_vector_type(2)));
typedef unsigned u32x4 __attribute__((ext_vector_type(4)));
typedef unsigned u32x2 __attribute__((ext_vector_type(2)));
typedef short bf16x8 __attribute__((ext_vector_type(8)));
typedef __bf16 bf16v2 __attribute__((ext_vector_type(2)));

constexpr int D = 2048, SEQ = 2048, BATCH = 4, NP = BATCH * SEQ, NS = 128, MT = NP + NS, MPAD = 8448;
constexpr int NIN = 7184, NINP = 7424, DFF = 5632, NGU = 2 * DFF;
constexpr int C_AQ = 0, C_AF = 512, C_AI = 1024, C_AG = 1536, C_BQ = 2048, C_BK = 3072, C_BV = 4096, C_BZ = 5120, C_BB = 6144, C_BA = 6152, C_CX = 6160, C_CG = 6672;
constexpr float NORM_EPS = 1e-6f, L2_EPS = 1e-6f;
constexpr int NPHASE = 17;

constexpr size_t O_YP = 0, O_YS = O_YP + (size_t)NP * D, O_HGP = O_YS + (size_t)NS * D, O_HGS = O_HGP + 2ull * 4 * 4 * 16384,
                 O_GDP = O_HGS + 2ull * 128 * 4 * 16384, O_GDS = O_GDP + 2ull * 4 * 8 * 16384, O_GCP = O_GDS + 2ull * 128 * 8 * 16384,
                 O_GCS = O_GCP + 2ull * 4 * 3 * 3072, O_RHP = O_GCS + 2ull * 128 * 3 * 3072, O_RHS = O_RHP + 2ull * 4 * 512,
                 O_RCP = O_RHS + 2ull * 128 * 512, O_RCS = O_RCP + 2ull * 4 * 3 * 512, O_END = O_RCS + 2ull * 128 * 3 * 512;

constexpr size_t MiB = 1ull << 20;
constexpr size_t WS_CTL = 0, CTL_BYTES = 1 * MiB;
constexpr size_t WS_WIN = 1 * MiB, SZ_WIN = 29 * MiB, WS_WOUT = WS_WIN + 2 * SZ_WIN, SZ_WOUT = 8 * MiB, WS_WGU = WS_WOUT + 2 * SZ_WOUT, SZ_WGU = 44 * MiB,
                 WS_WDN = WS_WGU + 2 * SZ_WGU, SZ_WDN = 22 * MiB;
constexpr size_t WS_PROJ = WS_WDN + 2 * SZ_WDN, SZ_PROJ = 240 * MiB;
constexpr size_t WS_HBUF = WS_PROJ + SZ_PROJ, SZ_HBUF = 33 * MiB;
constexpr size_t WS_MIXO = WS_HBUF + SZ_HBUF;
constexpr size_t WS_MIXF = WS_MIXO + SZ_HBUF, SZ_MIXF = 66 * MiB;
constexpr size_t WS_X1 = WS_MIXF + SZ_MIXF, WS_END = WS_X1 + SZ_MIXF + 25 * MiB;
static_assert((size_t)NINP * D * 2 == SZ_WIN && (size_t)NGU * D * 2 == SZ_WGU && (size_t)D * DFF * 2 == SZ_WDN && (size_t)D * D * 2 == SZ_WOUT, "weight sizes");
static_assert((size_t)MPAD * NINP * 4 <= SZ_PROJ && (size_t)MPAD * D * 2 <= SZ_HBUF && (size_t)MPAD * D * 4 <= SZ_MIXF, "ws map");

constexpr int LDS_BYTES = 147456;

DI unsigned pk2(float lo, float hi) { f32x2 x = {lo, hi}; bf16v2 y = __builtin_convertvector(x, bf16v2); return __builtin_bit_cast(unsigned, y); }
DI float wave_sum(float v) {
#pragma unroll
    for (int o = 1; o < 64; o <<= 1) v += __shfl_xor(v, o);
    return v;
}
template <int CTRL> DI float dpp_mov(float v) { return __int_as_float(__builtin_amdgcn_update_dpp(0, __float_as_int(v), CTRL, 0xF, 0xF, true)); }
DI float row16_sum(float v) {
    v += dpp_mov<0xB1>(v); v += dpp_mov<0x4E>(v); v += dpp_mov<0x124>(v); v += dpp_mov<0x128>(v); return v;
}
DI float sigm(float x) { return 1.f / (1.f + __expf(-x)); }
DI float silu(float x) { return x / (1.f + __expf(-x)); }
DI float softplus(float x) { return x > 20.f ? x : log1pf(__expf(x)); }
DI float gelu_tanh(float x) { const float y = 0.7978845608028654f * (x + 0.044715f * x * x * x); return 0.5f * x * (1.f + tanhf(y)); }
#define LDS_WAIT() asm volatile("s_waitcnt lgkmcnt(0)" ::: "memory")

namespace pg8 {
#define PG8_LAS __attribute__((address_space(3)))
constexpr int BM = 256, BK = 64, HALF = 128, HTB = HALF * BK * 2, STAGE_BYTES = 8 * HTB, NXCD = 8, WGM = 8;
__host__ __device__ __forceinline__ int lds_byte(int r, int c) { const int st = (r >> 4) * 2 + (c >> 5), rr = r & 15, cc = c & 31, ob = rr * 64 + cc * 2; return st * 1024 + (ob ^ (((ob >> 9) & 1) << 5)); }
__host__ __device__ __forceinline__ void stage_rc(int b, int& R, int& C) { const int st = b / 1024, sb = b % 1024, swz = sb ^ (((sb >> 9) & 1) << 5); R = (st >> 1) * 16 + swz / 64; C = (st & 1) * 32 + (swz % 64) / 2; }
struct Unit { int pm, pn; };
struct Gemm { const bf16_t* A; const bf16_t* Bt; int M, N, K; };
struct StaticOrder {
    int nM, nN, nwg, G, c;
    __host__ __device__ void init(int M, int N, int G_, int c_) { nM = M / BM; nN = N / BM; nwg = nM * nN; G = G_; c = c_; }
    __host__ __device__ bool next(int i, Unit& u) const {
        const long L = (long)i * G + c; if (L >= nwg) return false;
        int wgid = (int)L; { const int q = nwg / NXCD, r = nwg % NXCD, xcd = wgid % NXCD, off = wgid / NXCD; wgid = (xcd < r ? xcd * (q + 1) : r * (q + 1) + (xcd - r) * q) + off; }
        const int nig = WGM * nN, gid = wgid / nig, fm = gid * WGM, gsz = (nM - fm) < WGM ? (nM - fm) : WGM;
        u.pm = fm + ((wgid % nig) % gsz); u.pn = (wgid % nig) / gsz; return true;
    }
    __device__ __forceinline__ void a_ready(const Unit&) const {}
    __device__ __forceinline__ void done(const Unit&) const {}
};
struct EpiAny {
    static constexpr bool PERM = false, AFTER_DRAIN = false;
    int mode; float* C; bf16_t* O; int ldc;
    __device__ __forceinline__ void operator()(const f32x4 (&acc)[2][2][4][2], const Unit& u, int wr, int wc, int fr, int fq) const {
        const int row0 = u.pm * BM + wr * 64 + fr;
        if (mode == 0) {
            const int col0 = u.pn * BM + wc * 32 + 4 * fq;
#pragma unroll
            for (int ai = 0; ai < 2; ++ai)
#pragma unroll
                for (int m = 0; m < 4; ++m) { float* rowp = C + (size_t)(row0 + ai * HALF + m * 16) * ldc + col0;
#pragma unroll
                    for (int bj = 0; bj < 2; ++bj)
#pragma unroll
                        for (int n = 0; n < 2; ++n) *(f32x4*)(rowp + bj * HALF + n * 16) = acc[ai][bj][m][n]; }
        } else {
#pragma unroll
            for (int ai = 0; ai < 2; ++ai)
#pragma unroll
                for (int m = 0; m < 4; ++m) { bf16_t* rowp = O + (size_t)(row0 + ai * HALF + m * 16) * ldc;
#pragma unroll
                    for (int bj = 0; bj < 2; ++bj) { const int G = 8 * u.pn + 4 * bj + wc; const f32x4 g = acc[ai][bj][m][0], up = acc[ai][bj][m][1];
                        u32x2 w; w.x = pk2(silu(g[0]) * up[0], silu(g[1]) * up[1]); w.y = pk2(silu(g[2]) * up[2], silu(g[3]) * up[3]);
                        *(u32x2*)(rowp + 16 * G + 4 * fq) = w; } }
        }
    }
};

template <class Epi, class Sched, bool ALIGN_EPI = false, bool SP2 = false>
__device__ __forceinline__ void gemm_phase(PG8_LAS unsigned char* lds, const Gemm g, const Sched& S, const Epi& E) {
    int tid_ = threadIdx.x; asm volatile("" : "+v"(tid_));
    const int tid = tid_, wid = __builtin_amdgcn_readfirstlane(tid >> 6), lane = tid & 63, wr = wid >> 2, wc = wid & 3, fr = lane & 15, fq = lane >> 4;
    const int K = g.K, nt = K / BK;
    unsigned voffA[2], voffB[2];
#pragma unroll
    for (int i = 0; i < 2; ++i) { int R, C; stage_rc(tid * 16 + i * 8192, R, C); voffA[i] = (unsigned)(R * K + C) * 2u; voffB[i] = (unsigned)(R * K + C) * 2u; }
    const size_t kstep = (size_t)(BK * 2);
    const size_t hstep = (size_t)HALF * K * 2;
    const size_t tstep = 2 * hstep;
    const unsigned ldsw = (unsigned)wid * 1024u;
    const int aoff = lds_byte(wr * 64 + fr, fq * 8), boff = lds_byte(wc * 32 + fr, fq * 8);
#define PG8_SA(b, h) (((b) * 2 + (h)) * HTB)
#define PG8_SB(b, h) ((4 + (b) * 2 + (h)) * HTB)
#define PG8_STAGE(bufoff, gbase, voff) do { _Pragma("unroll") for (int _i = 0; _i < 2; ++_i) \
        __builtin_amdgcn_global_load_lds((const unsigned*)((const char*)(gbase) + (voff)[_i]), (PG8_LAS unsigned*)(lds + (bufoff) + ldsw + _i * 8192), 16, 0, 0); } while (0)
#define PG8_LDA(dst, b, h) do { _Pragma("unroll") for (int m = 0; m < 4; ++m) _Pragma("unroll") for (int k = 0; k < 2; ++k) dst[m][k] = *(const PG8_LAS bf16x8*)(lds + PG8_SA(b, h) + aoff + m * 2048 + k * 1024); } while (0)
#define PG8_LDB(dst, b, h) do { _Pragma("unroll") for (int n = 0; n < 2; ++n) _Pragma("unroll") for (int k = 0; k < 2; ++k) dst[n][k] = *(const PG8_LAS bf16x8*)(lds + PG8_SB(b, h) + boff + n * 2048 + k * 1024); } while (0)
#define PG8_MMA(ai, bj, At, Bt) do { __builtin_amdgcn_s_setprio(1); _Pragma("unroll") for (int m = 0; m < 4; ++m) _Pragma("unroll") for (int n = 0; n < 2; ++n) _Pragma("unroll") for (int k = 0; k < 2; ++k) \
        acc[ai][bj][m][n] = __builtin_amdgcn_mfma_f32_16x16x32_bf16(Bt[n][k], At[m][k], acc[ai][bj][m][n], 0, 0, 0); __builtin_amdgcn_s_setprio(0); } while (0)
#define PG8_WAIT_V(n) asm volatile("s_waitcnt vmcnt(" #n ")" ::: "memory")
#define PG8_WAIT_L(n) asm volatile("s_waitcnt lgkmcnt(" #n ")" ::: "memory")
#define PG8_BAR __builtin_amdgcn_s_barrier()
#define PG8_SCHED __builtin_amdgcn_sched_barrier(0)
    Unit cur, nxt; int ui = 0;
    if (!S.next(0, cur)) return;
    f32x4 acc[2][2][4][2];
#pragma unroll
    for (int a = 0; a < 2; ++a)
#pragma unroll
        for (int b = 0; b < 2; ++b)
#pragma unroll
            for (int m = 0; m < 4; ++m)
#pragma unroll
                for (int n = 0; n < 2; ++n) acc[a][b][m][n] = (f32x4){0.f, 0.f, 0.f, 0.f};
    bf16x8 At[4][2], B0[2][2], B1[2][2];
    const char* cA = (const char*)g.A + (size_t)cur.pm * tstep; const char* cB = (const char*)g.Bt + (size_t)cur.pn * tstep;
    S.a_ready(cur);
    if constexpr (SP2) {
        PG8_STAGE(PG8_SB(0, 0), cB, voffB); PG8_STAGE(PG8_SB(0, 1), cB + hstep, voffB); PG8_STAGE(PG8_SA(0, 0), cA, voffA); PG8_STAGE(PG8_SA(0, 1), cA + hstep, voffA);
        if (wr == 1) PG8_BAR;
        PG8_WAIT_V(2); PG8_BAR;
        PG8_STAGE(PG8_SB(1, 0), cB + kstep, voffB); PG8_STAGE(PG8_SA(1, 0), cA + kstep, voffA); PG8_STAGE(PG8_SB(1, 1), cB + hstep + kstep, voffB);
        PG8_WAIT_V(6); PG8_BAR;
    } else {
        PG8_STAGE(PG8_SB(0, 0), cB, voffB); PG8_STAGE(PG8_SA(0, 0), cA, voffA); PG8_STAGE(PG8_SB(0, 1), cB + hstep, voffB); PG8_STAGE(PG8_SA(0, 1), cA + hstep, voffA);
        if (wr == 1) PG8_BAR;
        PG8_WAIT_V(4); PG8_BAR;
        PG8_STAGE(PG8_SB(1, 0), cB + kstep, voffB); PG8_STAGE(PG8_SA(1, 0), cA + kstep, voffA); PG8_STAGE(PG8_SB(1, 1), cB + hstep + kstep, voffB);
        PG8_WAIT_V(6); PG8_BAR;
    }
    for (;;) {
        const bool has_next = S.next(ui + 1, nxt);
        const char* nA = has_next ? (const char*)g.A + (size_t)nxt.pm * tstep : cA; const char* nB = has_next ? (const char*)g.Bt + (size_t)nxt.pn * tstep : cB;
        for (int t = 0; t < nt; t += 2) {
            const bool last = (t == nt - 2);
            const char* a1 = cA + (size_t)(t + 1) * kstep;
            const char* a2 = last ? nA : cA + (size_t)(t + 2) * kstep; const char* b2 = last ? nB : cB + (size_t)(t + 2) * kstep;
            const char* a3 = a2 + kstep; const char* b3 = b2 + kstep;
            if (last && has_next) S.a_ready(nxt);
            if constexpr (SP2) {
            PG8_LDB(B0, 0, 0); PG8_LDB(B1, 0, 1); PG8_SCHED; PG8_LDA(At, 0, 0); PG8_STAGE(PG8_SA(1, 1), a1 + hstep, voffA);
            PG8_WAIT_V(8); PG8_WAIT_L(0); PG8_BAR; PG8_MMA(0, 0, At, B0); PG8_MMA(0, 1, At, B1); PG8_BAR; PG8_SCHED;
            PG8_LDA(At, 0, 1); PG8_STAGE(PG8_SB(0, 0), b2, voffB); PG8_STAGE(PG8_SB(0, 1), b2 + hstep, voffB); PG8_STAGE(PG8_SA(0, 0), a2, voffA);
            PG8_WAIT_V(8); PG8_WAIT_L(0); PG8_BAR; PG8_MMA(1, 0, At, B0); PG8_MMA(1, 1, At, B1); PG8_BAR; PG8_SCHED;
            PG8_LDB(B0, 1, 0); PG8_LDB(B1, 1, 1); PG8_SCHED; PG8_LDA(At, 1, 0); PG8_STAGE(PG8_SA(0, 1), a2 + hstep, voffA);
            PG8_WAIT_V(8); PG8_WAIT_L(0); PG8_BAR; PG8_MMA(0, 0, At, B0); PG8_MMA(0, 1, At, B1); PG8_BAR; PG8_SCHED;
            PG8_LDA(At, 1, 1); PG8_STAGE(PG8_SB(1, 0), b3, voffB); PG8_STAGE(PG8_SB(1, 1), b3 + hstep, voffB); PG8_STAGE(PG8_SA(1, 0), a3, voffA);
            PG8_WAIT_V(8); PG8_WAIT_L(0); PG8_BAR; PG8_MMA(1, 0, At, B0); PG8_MMA(1, 1, At, B1); PG8_BAR; PG8_SCHED;
            } else {
            PG8_LDB(B0, 0, 0); PG8_SCHED; PG8_LDA(At, 0, 0); PG8_STAGE(PG8_SA(1, 1), a1 + hstep, voffA);
            PG8_WAIT_L(8); PG8_BAR; PG8_WAIT_L(0); PG8_MMA(0, 0, At, B0); PG8_BAR; PG8_SCHED;
            PG8_LDB(B1, 0, 1); PG8_STAGE(PG8_SB(0, 0), b2, voffB);
            PG8_BAR; PG8_WAIT_L(0); PG8_MMA(0, 1, At, B1); PG8_BAR;
            PG8_LDA(At, 0, 1); PG8_STAGE(PG8_SA(0, 0), a2, voffA);
            PG8_BAR; PG8_WAIT_L(0); PG8_MMA(1, 0, At, B0); PG8_BAR; PG8_SCHED;
            PG8_STAGE(PG8_SB(0, 1), b2 + hstep, voffB);
            PG8_WAIT_V(6); PG8_BAR; PG8_MMA(1, 1, At, B1); PG8_BAR;
            PG8_LDB(B0, 1, 0); PG8_SCHED; PG8_LDA(At, 1, 0); PG8_STAGE(PG8_SA(0, 1), a2 + hstep, voffA);
            PG8_WAIT_L(8); PG8_BAR; PG8_WAIT_L(0); PG8_MMA(0, 0, At, B0); PG8_BAR; PG8_SCHED;
            PG8_LDB(B1, 1, 1); PG8_STAGE(PG8_SB(1, 0), b3, voffB);
            PG8_BAR; PG8_WAIT_L(0); PG8_MMA(0, 1, At, B1); PG8_BAR;
            PG8_LDA(At, 1, 1); PG8_STAGE(PG8_SA(1, 0), a3, voffA);
            PG8_BAR; PG8_WAIT_L(0); PG8_MMA(1, 0, At, B0); PG8_BAR; PG8_SCHED;
            PG8_STAGE(PG8_SB(1, 1), b3 + hstep, voffB);
            PG8_WAIT_V(6); PG8_BAR; PG8_MMA(1, 1, At, B1); PG8_BAR;
            }
        }
        if constexpr (ALIGN_EPI) { if (wr == 0) PG8_BAR; }
        if constexpr (!Epi::AFTER_DRAIN) { E(acc, cur, wr, wc, fr, fq); S.done(cur); }
        if (!has_next) break;
#pragma unroll
        for (int a = 0; a < 2; ++a)
#pragma unroll
            for (int b = 0; b < 2; ++b)
#pragma unroll
                for (int m = 0; m < 4; ++m)
#pragma unroll
                    for (int n = 0; n < 2; ++n) acc[a][b][m][n] = (f32x4){0.f, 0.f, 0.f, 0.f};
        cur = nxt; cA = nA; cB = nB; ++ui;
        if constexpr (ALIGN_EPI) { if (wr == 1) PG8_BAR; }
    }
    PG8_WAIT_V(0);
    if constexpr (!ALIGN_EPI) { if (wr == 0) PG8_BAR; }
    PG8_BAR;
#undef PG8_SA
#undef PG8_SB
#undef PG8_STAGE
#undef PG8_LDA
#undef PG8_LDB
#undef PG8_MMA
#undef PG8_WAIT_V
#undef PG8_WAIT_L
#undef PG8_BAR
#undef PG8_SCHED
}
}

struct Args { const float* in[29]; float* out; unsigned char* ws; int ph_lo, ph_hi; };
enum { I_XP = 0, I_XS, I_SHG, I_SGD, I_SGC, I_SRH, I_SRC, I_LN1, I_LN2, I_LN3, I_LN4, I_WIN, I_WOUT, I_LB, I_ANORM, I_BCW, I_BALOG, I_BDT, I_BNORM,
       I_CCW, I_CCB, I_CWA, I_CBA, I_CWX, I_CBX, I_CLAM, I_WG, I_WU, I_WD };

struct Ctx {
    const Args* a; unsigned char* ws; float* out; LAS unsigned char* lds; int tid, lane, wave, G, bid;
};
DI Ctx fresh(const Ctx& o) {
    Ctx c = o; int t = threadIdx.x; asm volatile("" : "+v"(t)); c.tid = t; c.lane = t & 63; c.wave = __builtin_amdgcn_readfirstlane(t >> 6);
    size_t z = 0; asm volatile("" : "+s"(z)); c.ws = o.a->ws + z; c.out = o.a->out + z;
    int b = blockIdx.x; asm volatile("" : "+s"(b)); c.bid = b; return c;
}
DI const float* inp(const Args& a, int idx) { int z = idx; asm volatile("" : "+s"(z)); return (const float*)(const GAS float*)a.in[z]; }

template <int MODE>
DI void transpose_item(const float* W, int K, int Nsrc, int nblk, bf16_t* WT, LAS float* scr, int item, int lane) {
    const int kb = item / nblk, nb = item - kb * nblk, k0 = 64 * kb, n0 = 32 * nb;
    const int nn = n0 + (lane & 31); const bool ok = nn < Nsrc;
    float v[32];
#pragma unroll
    for (int i = 0; i < 32; ++i) { const int kk = 2 * i + (lane >> 5); v[i] = ok ? W[(size_t)(k0 + kk) * Nsrc + nn] : 0.f; }
#pragma unroll
    for (int i = 0; i < 32; ++i) { const int kk = 2 * i + (lane >> 5); scr[kk * 33 + (lane & 31)] = v[i]; }
    LDS_WAIT(); asm volatile("" ::: "memory");
    const int c = lane & 7;
#pragma unroll
    for (int j = 0; j < 4; ++j) { const int nl = (lane >> 3) + 8 * j; const LAS float* s = scr + (8 * c) * 33 + nl;
        u32x4 o; o.x = pk2(s[0 * 33], s[1 * 33]); o.y = pk2(s[2 * 33], s[3 * 33]); o.z = pk2(s[4 * 33], s[5 * 33]); o.w = pk2(s[6 * 33], s[7 * 33]);
        const int n = n0 + nl; const int drow = (MODE == 0) ? n : ((n >> 4) * 32 + (n & 15) + (MODE == 2 ? 16 : 0));
        *(u32x4*)(WT + (size_t)drow * K + k0 + 8 * c) = o; }
    LDS_WAIT(); asm volatile("" ::: "memory");
}
DI void norm_row_to_bf16(const float* xr, const float* g, bf16_t* orow, int lane) {
    f32x4 v[8]; float s = 0.f;
#pragma unroll
    for (int j = 0; j < 8; ++j) { v[j] = ((const f32x4*)xr)[lane + 64 * j]; s += (v[j].x * v[j].x + v[j].y * v[j].y) + (v[j].z * v[j].z + v[j].w * v[j].w); }
    const float r = rsqrtf(wave_sum(s) * (1.f / D) + NORM_EPS);
#pragma unroll
    for (int j = 0; j < 8; ++j) { const f32x4 gg = ((const f32x4*)g)[lane + 64 * j]; u32x2 w; w.x = pk2(v[j].x * r * gg.x, v[j].y * r * gg.y); w.y = pk2(v[j].z * r * gg.z, v[j].w * r * gg.w);
        ((u32x2*)orow)[lane + 64 * j] = w; }
}
constexpr int CV_IN = (D / 64) * (NINP / 32), CV_OUT = (D / 64) * (D / 32), CV_G = (D / 64) * (DFF / 32), CV_D = (DFF / 64) * (D / 32), CV_LAYER = CV_IN + CV_OUT + 2 * CV_G + CV_D;
DI void convert_range(const Ctx& c, int lo, int hi, int gw, int NGW) {
    const Args& a = *c.a;
    LAS float* scr = (LAS float*)(c.lds + c.wave * 16384);
    for (int it = lo + gw; it < hi; it += NGW) {
        const int l = it / CV_LAYER; int r = it - l * CV_LAYER;
        if (r < CV_IN) { transpose_item<0>(inp(a, I_WIN) + (size_t)l * D * NIN, D, NIN, NINP / 32, (bf16_t*)(c.ws + WS_WIN + l * SZ_WIN), scr, r, c.lane); continue; } r -= CV_IN;
        if (r < CV_OUT) { transpose_item<0>(inp(a, I_WOUT) + (size_t)l * D * D, D, D, D / 32, (bf16_t*)(c.ws + WS_WOUT + l * SZ_WOUT), scr, r, c.lane); continue; } r -= CV_OUT;
        if (r < CV_G) { transpose_item<1>(inp(a, I_WG) + (size_t)l * D * DFF, D, DFF, DFF / 32, (bf16_t*)(c.ws + WS_WGU + l * SZ_WGU), scr, r, c.lane); continue; } r -= CV_G;
        if (r < CV_G) { transpose_item<2>(inp(a, I_WU) + (size_t)l * D * DFF, D, DFF, DFF / 32, (bf16_t*)(c.ws + WS_WGU + l * SZ_WGU), scr, r, c.lane); continue; } r -= CV_G;
        transpose_item<0>(inp(a, I_WD) + (size_t)l * DFF * D, DFF, D, D / 32, (bf16_t*)(c.ws + WS_WDN + l * SZ_WDN), scr, r, c.lane);
    }
}
DI void phase_p0(const Ctx& c0) {
    const Ctx c = fresh(c0);
    const Args& a = *c.a;
    const int gw = c.bid * 8 + c.wave, NGW = c.G * 8;
    convert_range(c, 0, CV_IN, gw, NGW);
    bf16_t* hb = (bf16_t*)(c.ws + WS_HBUF);
    { const float* xp = inp(a, I_XP); const float* xs = inp(a, I_XS); const float* g1 = inp(a, I_LN1);
      for (int m = gw; m < MT; m += NGW) norm_row_to_bf16(m < NP ? xp + (size_t)m * D : xs + (size_t)(m - NP) * D, g1, hb + (size_t)m * D, c.lane); }
    for (int i = gw * 64 + c.lane; i < (MPAD - MT) * D / 8; i += NGW * 64) {
        ((u32x4*)(hb + (size_t)MT * D))[i] = (u32x4){0u, 0u, 0u, 0u};
        ((u32x4*)((bf16_t*)(c.ws + WS_MIXO) + (size_t)MT * D))[i] = (u32x4){0u, 0u, 0u, 0u};
    }
}

DI void row_phase(const Ctx& c0, const float* y, const float* xa, const float* xb, float* xout, const float* g_post, const float* g_next, bf16_t* hb) {
    const Ctx c = fresh(c0);
    const int gw = c.bid * 8 + c.wave, NGW = c.G * 8, lane = c.lane;
    for (int m = gw; m < MT; m += NGW) {
        const float* yr = y + (size_t)m * D; const float* xr = m < NP ? xa + (size_t)m * D : xb + (size_t)(m - NP) * D;
        f32x4 v[8]; float s = 0.f;
#pragma unroll
        for (int j = 0; j < 8; ++j) { v[j] = ((const f32x4*)yr)[lane + 64 * j]; s += (v[j].x * v[j].x + v[j].y * v[j].y) + (v[j].z * v[j].z + v[j].w * v[j].w); }
        const float r = rsqrtf(wave_sum(s) * (1.f / D) + NORM_EPS);
        float s2 = 0.f;
#pragma unroll
        for (int j = 0; j < 8; ++j) { const f32x4 gg = ((const f32x4*)g_post)[lane + 64 * j]; const f32x4 xx = ((const f32x4*)xr)[lane + 64 * j];
            v[j] = xx + v[j] * r * gg; s2 += (v[j].x * v[j].x + v[j].y * v[j].y) + (v[j].z * v[j].z + v[j].w * v[j].w);
            ((f32x4*)(xout + (size_t)m * D))[lane + 64 * j] = v[j]; }
        if (g_next) {
            const float r2 = rsqrtf(wave_sum(s2) * (1.f / D) + NORM_EPS);
#pragma unroll
            for (int j = 0; j < 8; ++j) { const f32x4 gg = ((const f32x4*)g_next)[lane + 64 * j]; u32x2 w; w.x = pk2(v[j].x * r2 * gg.x, v[j].y * r2 * gg.y); w.y = pk2(v[j].z * r2 * gg.z, v[j].w * r2 * gg.w);
                ((u32x2*)(hb + (size_t)m * D))[lane + 64 * j] = w; }
        }
    }
}

DI int perm32(int x) { return 8 * ((x >> 2) & 3) + 4 * (x >> 4) + (x & 3); }
DI int kpos(int k) { return (k & ~31) + perm32(k & 31); }
DI float lb_of(const Args& a, int l, int c) { if (l == 0) return 0.f; const float l0 = inp(a, I_LB)[c], l1 = inp(a, I_LB)[512 + c]; return 1.f / (1.f + __expf(l0 - l1)); }
DI bf16_t bf1(float x) { return (bf16_t)(pk2(x, 0.f) & 0xffffu); }
#define MFMA16(a, b, c) __builtin_amdgcn_mfma_f32_16x16x32_bf16((a), (b), (c), 0, 0, 0)

constexpr size_t IB_W = WS_MIXF, IB_Q = IB_W + 16 * MiB, IB_KT = IB_Q + 16 * MiB, IB_P = IB_KT + 16 * MiB, IB_U0 = IB_P + 8 * MiB,
                 IA_Q = IB_U0 + 32 * MiB, IA_KT = IA_Q + 8 * MiB, IA_P = IA_KT + 8 * MiB, IA_V = IA_P + 4 * MiB,
                 IC_A = IA_V + 16 * MiB, IC_B = IC_A + 16 * MiB, IMISC = IC_B + 16 * MiB, IB_DEC = IMISC, IA_DEC = IMISC + 65536, IC_TOT = IMISC + 524288, I_END = IMISC + 1 * MiB;
static_assert(I_END <= WS_END, "mixer intermediates must fit");

DI void m1_unit_b(const Ctx& c0, int l, int u) {
    const Ctx c = fresh(c0); const Args& a = *c.a; const int tid = c.tid, lane = c.lane, wave = c.wave;
    const int b = u >> 8, h = (u >> 5) & 7, ci = u & 31;
    LAS float* Kf = (LAS float*)c.lds;
    LAS float* Vf = Kf + 8192;
    LAS float* Qf = Vf + 8192;
    LAS float* Amat = Qf;
    LAS bf16_t* Pl = (LAS bf16_t*)(Qf + 64 * 68);
    LAS bf16_t* Qb = (LAS bf16_t*)(Qf + 8192);
    LAS bf16_t* Kb = Qb + 64 * 136;
    LAS float* scal = (LAS float*)(Kb + 64 * 136);
    const float* proj = (const float*)(c.ws + WS_PROJ);
    const long rowb = (long)b * SEQ + 64 * ci; const int tg0 = 64 * ci;
    {
        const float* cw = inp(a, I_BCW) + (size_t)l * 4 * 3072;
        const int idx = tid & 127, tq = tid >> 7;
        float x[3][19], w[3][4];
#pragma unroll
        for (int p = 0; p < 3; ++p) { const int ch = p * 1024 + h * 128 + idx;
#pragma unroll
            for (int j = 0; j < 4; ++j) w[p][j] = cw[j * 3072 + ch];
#pragma unroll
            for (int j = 0; j < 19; ++j) { const int t = 16 * tq - 3 + j; x[p][j] = (tg0 + t >= 0) ? proj[(rowb + t) * NINP + C_BQ + ch] : 0.f; } }
#pragma unroll
        for (int p = 0; p < 3; ++p) { LAS float* dst = (p == 0 ? Qf : (p == 1 ? Kf : Vf)) + idx;
#pragma unroll
            for (int i = 0; i < 16; ++i) dst[(16 * tq + i) * 128] = silu(w[p][0] * x[p][i] + w[p][1] * x[p][i + 1] + w[p][2] * x[p][i + 2] + w[p][3] * x[p][i + 3]); }
    }
    __syncthreads();
    for (int i = 0; i < 8; ++i) { const int t = wave * 8 + i; const float q0 = Qf[t * 128 + lane], q1 = Qf[t * 128 + 64 + lane], k0 = Kf[t * 128 + lane], k1 = Kf[t * 128 + 64 + lane];
        const float sq = wave_sum(q0 * q0 + q1 * q1), sk = wave_sum(k0 * k0 + k1 * k1);
        if (lane == 0) { scal[t * 8 + 3] = rsqrtf(sq + L2_EPS) * 0.08838834764831845f; scal[t * 8 + 4] = rsqrtf(sk + L2_EPS); } }
    if (wave == 0) { const int t = lane; const float bb = proj[(rowb + t) * NINP + C_BB + h], ba = proj[(rowb + t) * NINP + C_BA + h];
        const float gt = -__expf(inp(a, I_BALOG)[l * 8 + h]) * softplus(ba + inp(a, I_BDT)[l * 8 + h]);
        float x = gt;
#pragma unroll
        for (int o = 1; o < 64; o <<= 1) { const float y = __shfl_up(x, o); if (lane >= o) x += y; }
        const float bC = __shfl(x, 63);
        scal[t * 8 + 0] = sigm(bb); scal[t * 8 + 1] = x; scal[t * 8 + 2] = __expf(x); scal[t * 8 + 5] = __expf(bC - x);
        if (lane == 63) ((float*)(c.ws + IB_DEC))[u] = __expf(x); }
    __syncthreads();
    {
        const int t = tid >> 3, d0 = (tid & 7) * 16; const float sq = scal[t * 8 + 3], sk = scal[t * 8 + 4], s2 = sq * scal[t * 8 + 2];
        bf16_t* gq = (bf16_t*)(c.ws + IB_Q) + ((size_t)u * 64 + t) * 128;
#pragma unroll
        for (int m = 0; m < 4; ++m) { const int d = d0 + 4 * m; const f32x4 q = *(const LAS f32x4*)(Qf + t * 128 + d), k = *(const LAS f32x4*)(Kf + t * 128 + d);
            *(LAS u32x2*)(Qb + t * 136 + d) = (u32x2){pk2(q.x * sq, q.y * sq), pk2(q.z * sq, q.w * sq)};
            *(LAS u32x2*)(Kb + t * 136 + d) = (u32x2){pk2(k.x * sk, k.y * sk), pk2(k.z * sk, k.w * sk)};
            *(u32x2*)(gq + kpos(d)) = (u32x2){pk2(q.x * s2, q.y * s2), pk2(q.z * s2, q.w * s2)}; }
    }
    __syncthreads();
    {
        const int i = lane & 15, g = lane >> 4;
#pragma unroll
        for (int q2 = 0; q2 < 2; ++q2) { const int idx = 2 * wave + q2, tt = idx >> 2, st = idx & 3; const int s = 16 * st + i;
            if (st <= tt) {
                f32x4 akk = {0.f, 0.f, 0.f, 0.f}, aqk = {0.f, 0.f, 0.f, 0.f};
#pragma unroll
                for (int ks = 0; ks < 4; ++ks) { const bf16x8 bk = *(const LAS bf16x8*)(Kb + (16 * st + i) * 136 + 32 * ks + 8 * g);
                    const bf16x8 ak = *(const LAS bf16x8*)(Kb + (16 * tt + i) * 136 + 32 * ks + 8 * g), aq = *(const LAS bf16x8*)(Qb + (16 * tt + i) * 136 + 32 * ks + 8 * g);
                    akk = MFMA16(ak, bk, akk); aqk = MFMA16(aq, bk, aqk); }
                const float bs = scal[s * 8 + 1];
#pragma unroll
                for (int r = 0; r < 4; ++r) { const int t = 16 * tt + 4 * g + r; const float gam = __expf(fminf(scal[t * 8 + 1] - bs, 0.f));
                    Amat[t * 68 + s] = (s < t) ? scal[t * 8 + 0] * akk[r] * gam : 0.f;
                    Pl[t * 72 + kpos(s)] = bf1((s <= t) ? aqk[r] * gam : 0.f); }
            } else {
#pragma unroll
                for (int r = 0; r < 4; ++r) Pl[(16 * tt + 4 * g + r) * 72 + kpos(s)] = 0;
            }
        }
    }
    __syncthreads();
    if (tid < 256) {
        float R[64];
        int zoff = 0; asm volatile("" : "+v"(zoff));
        const LAS float* Am = Amat + zoff; const LAS float* sc = scal + zoff;
        if (tid < 128) {
#pragma unroll
            for (int t = 0; t < 64; ++t) R[t] = sc[t * 8 + 0] * Vf[t * 128 + tid];
        } else {
#pragma unroll
            for (int t = 0; t < 64; ++t) R[t] = sc[t * 8 + 0] * sc[t * 8 + 2] * sc[t * 8 + 4] * Kf[t * 128 + tid - 128];
        }
#pragma unroll
        for (int t = 1; t < 64; ++t) { float acc = R[t];
#pragma unroll
            for (int s4 = 0; s4 < (t + 3) / 4; ++s4) { const f32x4 a4 = *(const LAS f32x4*)(Am + t * 68 + 4 * s4);
                acc -= a4.x * R[4 * s4];
                if (4 * s4 + 1 < t) acc -= a4.y * R[4 * s4 + 1];
                if (4 * s4 + 2 < t) acc -= a4.z * R[4 * s4 + 2];
                if (4 * s4 + 3 < t) acc -= a4.w * R[4 * s4 + 3]; }
            R[t] = acc; }
        if (tid < 128) { const int w = tid >> 4, i = tid & 15; float* g0 = (float*)(c.ws + IB_U0) + (size_t)u * 8192;
#pragma unroll
            for (int st = 0; st < 4; ++st)
#pragma unroll
                for (int g = 0; g < 4; ++g) *(f32x4*)(g0 + ((st * 8 + w) * 64 + i + 16 * g) * 4) = (f32x4){R[16 * st + 4 * g], R[16 * st + 4 * g + 1], R[16 * st + 4 * g + 2], R[16 * st + 4 * g + 3]};
        } else { bf16_t* gw = (bf16_t*)(c.ws + IB_W) + (size_t)u * 8192 + kpos(tid - 128);
#pragma unroll
            for (int t = 0; t < 64; ++t) gw[t * 128] = bf1(R[t]); }
    } else {
#pragma unroll
        for (int k = 0; k < 2; ++k) { const int p = (tid - 256) + 256 * k, row = p >> 3, c16 = p & 7;
            *(u32x4*)((bf16_t*)(c.ws + IB_P) + (size_t)u * 4096 + row * 64 + c16 * 8) = *(const LAS u32x4*)(Pl + row * 72 + c16 * 8); }
        LAS bf16_t* KTs = Qb; const int d = tid & 127, s0 = ((tid >> 7) & 1) * 32;
#pragma unroll
        for (int m = 0; m < 8; ++m) { float v[4];
#pragma unroll
            for (int j = 0; j < 4; ++j) { const int s = s0 + 4 * m + j; v[j] = Kf[s * 128 + d] * scal[s * 8 + 4] * scal[s * 8 + 5]; }
            *(LAS u32x2*)(KTs + d * 72 + kpos(s0 + 4 * m)) = (u32x2){pk2(v[0], v[1]), pk2(v[2], v[3])}; }
    }
    __syncthreads();
#pragma unroll
    for (int k = 0; k < 2; ++k) { const int p = tid + 512 * k, row = p >> 3, c16 = p & 7;
        *(u32x4*)((bf16_t*)(c.ws + IB_KT) + (size_t)u * 8192 + row * 64 + c16 * 8) = *(const LAS u32x4*)(Qb + row * 72 + c16 * 8); }
    __syncthreads();
}

DI void m1_unit_a(const Ctx& c0, int l, int u) {
    const Ctx c = fresh(c0); const Args& a = *c.a; const int tid = c.tid, lane = c.lane, wave = c.wave;
    const int b = u >> 7, h = (u >> 5) & 3, ci = u & 31;
    LAS float* Bf = (LAS float*)c.lds;
    LAS float* Qf = Bf + 8192;
    LAS float* Kf = Qf + 8192;
    LAS bf16_t* Pl = (LAS bf16_t*)Qf;
    LAS bf16_t* Qh = (LAS bf16_t*)(Kf + 8192);
    LAS bf16_t* Kd = Qh + 64 * 136;
    LAS bf16_t* Ko = Kd + 64 * 136;
    LAS float* tot = (LAS float*)(Ko + 32 * 136);
    const float* proj = (const float*)(c.ws + WS_PROJ);
    const long rowb = (long)b * SEQ + 64 * ci;
    {
        float* gv = (float*)(c.ws + IA_V) + (size_t)u * 8192;
        const int idx = tid & 127, tq = tid >> 7;
        float x[3][16];
#pragma unroll
        for (int i = 0; i < 16; ++i) { const float* pr = proj + (rowb + 16 * tq + i) * NINP + h * 128 + idx; x[0][i] = pr[C_AF]; x[1][i] = pr[C_AQ]; x[2][i] = pr[C_AI]; }
        const float lb = lb_of(a, l, h * 128 + idx);
#pragma unroll
        for (int i = 0; i < 16; ++i) { const int t = 16 * tq + i; const float f = lb + (1.f - lb) * sigm(x[0][i]);
            Bf[t * 128 + idx] = fmaxf(__logf(f), -80.f); Kf[t * 128 + idx] = 1.f - f; Qf[t * 128 + idx] = silu(x[1][i]);
            gv[(((t >> 4) * 8 + (idx >> 4)) * 64 + (idx & 15) + 16 * ((t >> 2) & 3)) * 4 + (t & 3)] = x[2][i]; }
    }
    __syncthreads();
    {
        const int d = tid & 127, q4 = tid >> 7; float run = 0.f;
#pragma unroll
        for (int i = 0; i < 16; ++i) { run += Bf[(16 * q4 + i) * 128 + d]; Bf[(16 * q4 + i) * 128 + d] = run; }
        tot[q4 * 128 + d] = run;
        __syncthreads();
        float off = 0.f;
        for (int q = 0; q < q4; ++q) off += tot[q * 128 + d];
        if (q4 > 0) {
#pragma unroll
            for (int i = 0; i < 16; ++i) Bf[(16 * q4 + i) * 128 + d] += off; }
    }
    __syncthreads();
    {
        const int t = tid >> 3, d0 = (tid & 7) * 16; bf16_t* gq = (bf16_t*)(c.ws + IA_Q) + ((size_t)u * 64 + t) * 128;
#pragma unroll
        for (int m = 0; m < 4; ++m) { const int d = d0 + 4 * m; const f32x4 bb = *(const LAS f32x4*)(Bf + t * 128 + d), q = *(const LAS f32x4*)(Qf + t * 128 + d), k = *(const LAS f32x4*)(Kf + t * 128 + d);
            const f32x4 b31 = *(const LAS f32x4*)(Bf + 31 * 128 + d); const f32x4 rr = (t >= 32) ? b31 : (f32x4){0.f, 0.f, 0.f, 0.f};
            *(u32x2*)(gq + kpos(d)) = (u32x2){pk2(q.x * __expf(bb.x), q.y * __expf(bb.y)), pk2(q.z * __expf(bb.z), q.w * __expf(bb.w))};
            *(LAS u32x2*)(Qh + t * 136 + d) = (u32x2){pk2(q.x * __expf(bb.x - rr.x), q.y * __expf(bb.y - rr.y)), pk2(q.z * __expf(bb.z - rr.z), q.w * __expf(bb.w - rr.w))};
            *(LAS u32x2*)(Kd + t * 136 + d) = (u32x2){pk2(k.x * __expf(fminf(rr.x - bb.x, 80.f)), k.y * __expf(fminf(rr.y - bb.y, 80.f))), pk2(k.z * __expf(fminf(rr.z - bb.z, 80.f)), k.w * __expf(fminf(rr.w - bb.w, 80.f)))};
            if (t < 32) *(LAS u32x2*)(Ko + t * 136 + d) = (u32x2){pk2(k.x * __expf(b31.x - bb.x), k.y * __expf(b31.y - bb.y)), pk2(k.z * __expf(b31.z - bb.z), k.w * __expf(b31.w - bb.w))}; }
        const int d = tid & 127, s0 = (tid >> 7) * 16; bf16_t* gk = (bf16_t*)(c.ws + IA_KT) + ((size_t)u * 128 + d) * 64; const float bC = Bf[63 * 128 + d];
#pragma unroll
        for (int m = 0; m < 4; ++m) { float v[4];
#pragma unroll
            for (int j = 0; j < 4; ++j) { const int s = s0 + 4 * m + j; v[j] = Kf[s * 128 + d] * __expf(bC - Bf[s * 128 + d]); }
            *(u32x2*)(gk + kpos(s0 + 4 * m)) = (u32x2){pk2(v[0], v[1]), pk2(v[2], v[3])}; }
        if (tid < 128) ((float*)(c.ws + IA_DEC))[(size_t)u * 128 + tid] = __expf(bC);
    }
    __syncthreads();
    {
        const int i = lane & 15, g = lane >> 4;
#pragma unroll
        for (int q2 = 0; q2 < 2; ++q2) { const int idx = 2 * wave + q2, tt = idx >> 2, st = idx & 3, I = tt >> 1, J = st >> 1; const int s = 16 * st + i;
            if (J <= I) {
                const LAS bf16_t* bsrc = (I == J ? Kd : Ko) + (16 * st + i) * 136;
                f32x4 acc = {0.f, 0.f, 0.f, 0.f};
#pragma unroll
                for (int ks = 0; ks < 4; ++ks) acc = MFMA16(*(const LAS bf16x8*)(Qh + (16 * tt + i) * 136 + 32 * ks + 8 * g), *(const LAS bf16x8*)(bsrc + 32 * ks + 8 * g), acc);
#pragma unroll
                for (int r = 0; r < 4; ++r) { const int t = 16 * tt + 4 * g + r; Pl[t * 72 + kpos(s)] = bf1((s <= t) ? acc[r] : 0.f); }
            } else {
#pragma unroll
                for (int r = 0; r < 4; ++r) Pl[(16 * tt + 4 * g + r) * 72 + kpos(s)] = 0;
            }
        }
    }
    __syncthreads();
    { const int row = tid >> 3, c16 = tid & 7; *(u32x4*)((bf16_t*)(c.ws + IA_P) + (size_t)u * 4096 + row * 64 + c16 * 8) = *(const LAS u32x4*)(Pl + row * 72 + c16 * 8); }
    __syncthreads();
}

DI void m1_unit_c(const Ctx& c0, int l, int u) {
    const Ctx c = fresh(c0); const Args& a = *c.a; const int tid = c.tid;
    const int b = u >> 7, n = (u >> 4) & 7, ti = u & 15;
    constexpr int TT = 128;
    LAS float* xcv = (LAS float*)c.lds;
    LAS float* ra = xcv + TT * 64;
    LAS float* ia = ra + TT * 64;
    LAS float* segA = ia + TT * 64;
    LAS float* segB = segA + 512;
    const float* proj = (const float*)(c.ws + WS_PROJ);
    const long rowb = (long)b * SEQ + TT * ti; const int tg0 = TT * ti;
    const int j = tid & 63, g = (tid >> 6) & 1, tg = tid >> 7;
    const float* wsrc = (g ? inp(a, I_CWX) : inp(a, I_CWA)) + ((size_t)l * 8 + n) * 4096 + j;
    float wreg[64];
#pragma unroll
    for (int i = 0; i < 64; ++i) wreg[i] = wsrc[i * 64];
    const float gbias = (g ? inp(a, I_CBX) : inp(a, I_CBA))[l * 512 + n * 64 + j];
    const int cch = tid & 63, seg = tid >> 6, chg = n * 64 + cch;
    {
        const float* ccw = inp(a, I_CCW) + (size_t)l * 4 * 512;
        const float w0 = ccw[chg], w1 = ccw[512 + chg], w2 = ccw[1024 + chg], w3 = ccw[1536 + chg], cb = inp(a, I_CCB)[l * 512 + chg];
        const int ts = seg * 16; const int col = C_CX + chg;
        float x[19];
#pragma unroll
        for (int jx = 0; jx < 19; ++jx) { const int t = ts - 3 + jx; x[jx] = (tg0 + t >= 0) ? proj[(rowb + t) * NINP + col] : 0.f; }
#pragma unroll
        for (int i = 0; i < 16; ++i) xcv[(ts + i) * 64 + cch] = w0 * x[i] + w1 * x[i + 1] + w2 * x[i + 2] + w3 * x[i + 3] + cb;
    }
    __syncthreads();
    for (int tt = tg * 32; tt < tg * 32 + 32; ++tt) {
        float acc0 = 0.f, acc1 = 0.f;
#pragma unroll
        for (int i = 0; i < 64; i += 4) { const f32x4 x = *(const LAS f32x4*)(xcv + tt * 64 + i); acc0 += x.x * wreg[i] + x.z * wreg[i + 2]; acc1 += x.y * wreg[i + 1] + x.w * wreg[i + 3]; }
        (g ? ia : ra)[tt * 64 + j] = sigm(acc0 + acc1 + gbias);
    }
    __syncthreads();
    const float spl = softplus(-inp(a, I_CLAM)[l * 512 + chg]);
    {
        float A = 1.f, B = 0.f;
        for (int i = 0; i < 16; ++i) { const int tt = seg * 16 + i; const float r = ra[tt * 64 + cch], ig = ia[tt * 64 + cch], x = xcv[tt * 64 + cch];
            const float la = -8.f * r * spl; const float at = __expf(la); float mult = sqrtf(fmaxf(0.f, -expm1f(2.f * la)));
            if (tg0 + tt == 0) mult = 1.f;
            const float bt = mult * (ig * x); ra[tt * 64 + cch] = at; ia[tt * 64 + cch] = bt; A *= at; B = at * B + bt; }
        segA[seg * 64 + cch] = A; segB[seg * 64 + cch] = B;
    }
    __syncthreads();
    {
        float Ac = 1.f, Bc = 0.f;
        for (int s = 0; s < seg; ++s) { const float sa = segA[s * 64 + cch], sb = segB[s * 64 + cch]; Bc = sa * Bc + sb; Ac *= sa; }
        float* ga = (float*)(c.ws + IC_A); float* gb = (float*)(c.ws + IC_B);
        for (int i = 0; i < 16; ++i) { const int tt = seg * 16 + i; const float at = ra[tt * 64 + cch], bt = ia[tt * 64 + cch]; Ac *= at; Bc = at * Bc + bt;
            ga[(rowb + tt) * 512 + chg] = Ac; gb[(rowb + tt) * 512 + chg] = Bc; }
        if (seg == 7) { float* gt = (float*)(c.ws + IC_TOT) + (((size_t)b * 16 + ti) * 2) * 512; gt[chg] = Ac; gt[512 + chg] = Bc; }
    }
    __syncthreads();
}

DI void phase_m1(const Ctx& c, int l) {
    int w = blockIdx.x; asm volatile("" : "+s"(w));
    for (int rep = 0; rep < (PROBE_SUB == 1 ? 2 : 1); ++rep) for (int u = w; u < 1024; u += c.G) m1_unit_b(c, l, u);
    for (int rep = 0; rep < (PROBE_SUB == 2 ? 2 : 1); ++rep) for (int u = w; u < 512; u += c.G) m1_unit_a(c, l, u);
    for (int rep = 0; rep < (PROBE_SUB == 3 ? 2 : 1); ++rep) for (int u = w; u < 512; u += c.G) m1_unit_c(c, l, u);
}

DI void m2_unit_head(const Ctx& c0, int l, int isB, int b, int h) {
    const Ctx c = fresh(c0); const Args& a = *c.a; const int tid = c.tid, lane = c.lane, wave = c.wave;
    LAS unsigned char* Wl = c.lds;
    LAS unsigned char* Ql = Wl + 64 * 272;
    LAS unsigned char* KTl = Ql + 64 * 272;
    LAS unsigned char* Pl = KTl + 128 * 144;
    LAS float* ob = (LAS float*)(Pl + 64 * 144);
    LAS float* decl = ob + 64 * 132;
    const int i = lane & 15, g = lane >> 4, e0 = 16 * wave;
    const int ubase = isB ? ((b * 8 + h) * 32) : ((b * 4 + h) * 32);
    const unsigned char* gW = c.ws + IB_W; const unsigned char* gQ = c.ws + (isB ? IB_Q : IA_Q); const unsigned char* gKT = c.ws + (isB ? IB_KT : IA_KT);
    const unsigned char* gP = c.ws + (isB ? IB_P : IA_P); const float* gU = (const float*)(c.ws + (isB ? IB_U0 : IA_V));
    const float* proj = (const float*)(c.ws + WS_PROJ); bf16_t* mixo = (bf16_t*)(c.ws + WS_MIXO);
    const float* nw = (isB ? inp(a, I_BNORM) : inp(a, I_ANORM)) + l * 128;
    const int gcol = isB ? (C_BZ + h * 128) : (C_AG + h * 128), ocol = isB ? (512 + h * 128) : (h * 128);
    const float nw0 = nw[2 * lane], nw1 = nw[2 * lane + 1];
    f32x4 S[8];
#pragma unroll
    for (int dt = 0; dt < 8; ++dt) S[dt] = (f32x4){0.f, 0.f, 0.f, 0.f};
    u32x4 pw[2], pq[2], pk[2], pp, pd = {0u, 0u, 0u, 0u};
    const int r16 = tid >> 4, c16 = tid & 15, r8 = tid >> 3, c8 = tid & 7;
#define M2_LOAD(ch) do { const size_t uu = (size_t)(ubase + (ch)); \
        if (isB) { pw[0] = *(const u32x4*)(gW + uu * 16384 + tid * 16); pw[1] = *(const u32x4*)(gW + uu * 16384 + (tid + 512) * 16); } \
        pq[0] = *(const u32x4*)(gQ + uu * 16384 + tid * 16); pq[1] = *(const u32x4*)(gQ + uu * 16384 + (tid + 512) * 16); \
        pk[0] = *(const u32x4*)(gKT + uu * 16384 + tid * 16); pk[1] = *(const u32x4*)(gKT + uu * 16384 + (tid + 512) * 16); \
        pp = *(const u32x4*)(gP + uu * 8192 + tid * 16); \
        if (!isB && tid < 32) pd = *(const u32x4*)(c.ws + IA_DEC + uu * 512 + tid * 16); } while (0)
#define M2_STORE() do { \
        if (isB) { *(LAS u32x4*)(Wl + r16 * 272 + c16 * 16) = pw[0]; *(LAS u32x4*)(Wl + (r16 + 32) * 272 + c16 * 16) = pw[1]; } \
        *(LAS u32x4*)(Ql + r16 * 272 + c16 * 16) = pq[0]; *(LAS u32x4*)(Ql + (r16 + 32) * 272 + c16 * 16) = pq[1]; \
        *(LAS u32x4*)(KTl + r8 * 144 + c8 * 16) = pk[0]; *(LAS u32x4*)(KTl + (r8 + 64) * 144 + c8 * 16) = pk[1]; \
        *(LAS u32x4*)(Pl + r8 * 144 + c8 * 16) = pp; \
        if (!isB && tid < 32) *(LAS u32x4*)((LAS unsigned char*)decl + tid * 16) = pd; } while (0)
    M2_LOAD(0);
    M2_STORE();
    f32x4 U[4], Un[4]; f32x2 gt[8], gtn[8]; float dec = 0.f, decn = 0.f;
#define M2_LOADR(ch, UU, GT, DEC) do { const size_t uu_ = (size_t)(ubase + (ch)); const long row_ = (long)b * SEQ + 64 * (ch); \
        _Pragma("unroll") for (int tt = 0; tt < 4; ++tt) UU[tt] = *(const f32x4*)(gU + uu_ * 8192 + ((tt * 8 + wave) * 64 + lane) * 4); \
        _Pragma("unroll") for (int k = 0; k < 8; ++k) GT[k] = *(const f32x2*)(proj + (row_ + 8 * wave + k) * NINP + gcol + 2 * lane); \
        if (isB) DEC = ((const float*)(c.ws + IB_DEC))[uu_]; } while (0)
    M2_LOADR(0, U, gt, dec);
    __syncthreads();
    for (int ci = 0; ci < 32; ++ci) {
        const long row0 = (long)b * SEQ + 64 * ci;
        asm volatile("" : "+v"(U[0]), "+v"(U[1]), "+v"(U[2]), "+v"(U[3]), "+v"(dec));
        asm volatile("" : "+v"(gt[0]), "+v"(gt[1]), "+v"(gt[2]), "+v"(gt[3]), "+v"(gt[4]), "+v"(gt[5]), "+v"(gt[6]), "+v"(gt[7]));
        if (ci + 1 < 32) { M2_LOAD(ci + 1); M2_LOADR(ci + 1, Un, gtn, decn); }
        bf16x8 Sb[4];
#pragma unroll
        for (int ks = 0; ks < 4; ++ks) { u32x4 p; p.x = pk2(S[2 * ks][0], S[2 * ks][1]); p.y = pk2(S[2 * ks][2], S[2 * ks][3]); p.z = pk2(S[2 * ks + 1][0], S[2 * ks + 1][1]); p.w = pk2(S[2 * ks + 1][2], S[2 * ks + 1][3]); Sb[ks] = __builtin_bit_cast(bf16x8, p); }
        if (isB) {
#pragma unroll
            for (int tt = 0; tt < 4; ++tt) { f32x4 acc = {0.f, 0.f, 0.f, 0.f};
#pragma unroll
                for (int ks = 0; ks < 4; ++ks) acc = MFMA16(*(const LAS bf16x8*)(Wl + (16 * tt + i) * 272 + (32 * ks + 8 * g) * 2), Sb[ks], acc);
                U[tt] = U[tt] - acc; }
        }
        bf16x8 Ub[2];
#pragma unroll
        for (int k = 0; k < 2; ++k) { u32x4 p; p.x = pk2(U[2 * k][0], U[2 * k][1]); p.y = pk2(U[2 * k][2], U[2 * k][3]); p.z = pk2(U[2 * k + 1][0], U[2 * k + 1][1]); p.w = pk2(U[2 * k + 1][2], U[2 * k + 1][3]); Ub[k] = __builtin_bit_cast(bf16x8, p); }
#pragma unroll
        for (int tt = 0; tt < 4; ++tt) { f32x4 acc = {0.f, 0.f, 0.f, 0.f};
#pragma unroll
            for (int ks = 0; ks < 4; ++ks) acc = MFMA16(*(const LAS bf16x8*)(Ql + (16 * tt + i) * 272 + (32 * ks + 8 * g) * 2), Sb[ks], acc);
#pragma unroll
            for (int k = 0; k < 2; ++k) acc = MFMA16(*(const LAS bf16x8*)(Pl + (16 * tt + i) * 144 + (32 * k + 8 * g) * 2), Ub[k], acc);
#pragma unroll
            for (int r = 0; r < 4; ++r) ob[(16 * tt + 4 * g + r) * 132 + e0 + i] = acc[r]; }
        if (isB) {
#pragma unroll
            for (int dt = 0; dt < 8; ++dt) S[dt] = S[dt] * dec;
        } else {
#pragma unroll
            for (int dt = 0; dt < 8; ++dt) S[dt] = S[dt] * *(const LAS f32x4*)(decl + 16 * dt + 4 * g); }
#pragma unroll
        for (int dt = 0; dt < 8; ++dt) {
#pragma unroll
            for (int k = 0; k < 2; ++k) S[dt] = MFMA16(*(const LAS bf16x8*)(KTl + (16 * dt + i) * 144 + (32 * k + 8 * g) * 2), Ub[k], S[dt]); }
        __syncthreads();
        { f32x2 vv[8]; float ss[8];
#pragma unroll
          for (int k = 0; k < 8; ++k) vv[k] = *(const LAS f32x2*)(ob + (8 * wave + k) * 132 + 2 * lane);
#pragma unroll
          for (int k = 0; k < 8; ++k) ss[k] = row16_sum(vv[k].x * vv[k].x + vv[k].y * vv[k].y);
#pragma unroll
          for (int k = 0; k < 8; ++k) ss[k] = __int_as_float(__builtin_amdgcn_readlane(__float_as_int(ss[k]), 0)) + __int_as_float(__builtin_amdgcn_readlane(__float_as_int(ss[k]), 16)) +
              __int_as_float(__builtin_amdgcn_readlane(__float_as_int(ss[k]), 32)) + __int_as_float(__builtin_amdgcn_readlane(__float_as_int(ss[k]), 48));
#pragma unroll
          for (int k = 0; k < 8; ++k) { const float r = rsqrtf(ss[k] * (1.f / 128.f) + NORM_EPS);
            *(unsigned*)(mixo + (row0 + 8 * wave + k) * D + ocol + 2 * lane) = pk2(vv[k].x * r * nw0 * silu(gt[k].x), vv[k].y * r * nw1 * silu(gt[k].y)); } }
        if (ci + 1 < 32) { M2_STORE();
#pragma unroll
            for (int tt = 0; tt < 4; ++tt) U[tt] = Un[tt];
#pragma unroll
            for (int k = 0; k < 8; ++k) gt[k] = gtn[k];
            dec = decn; }
        __syncthreads();
    }
#undef M2_LOADR
#undef M2_LOAD
#undef M2_STORE
    float* so = c.out + (isB ? O_GDP + (((size_t)l * BATCH + b) * 8 + h) * 16384 : O_HGP + (((size_t)l * BATCH + b) * 4 + h) * 16384);
#pragma unroll
    for (int dt = 0; dt < 8; ++dt)
#pragma unroll
        for (int r = 0; r < 4; ++r) so[(size_t)(16 * dt + 4 * g + r) * 128 + e0 + i] = S[dt][r];
}

DI void m2_unit_cfin(const Ctx& c0, int l, int u) {
    const Ctx c = fresh(c0); const int tid = c.tid;
    const int b = u >> 7, n = (u >> 4) & 7, ti = u & 15;
    const int cch = tid & 63, seg = tid >> 6, chg = n * 64 + cch;
    const float* proj = (const float*)(c.ws + WS_PROJ); bf16_t* mixo = (bf16_t*)(c.ws + WS_MIXO);
    const float* ga = (const float*)(c.ws + IC_A); const float* gb = (const float*)(c.ws + IC_B);
    const float* gt = (const float*)(c.ws + IC_TOT) + ((size_t)b * 16 * 2) * 512;
    float hs = 0.f;
    for (int k = 0; k < ti; ++k) hs = gt[(k * 2) * 512 + chg] * hs + gt[(k * 2 + 1) * 512 + chg];
    const long rowb = (long)b * SEQ + 128 * ti;
    float hh = 0.f;
#pragma unroll 4
    for (int i = 0; i < 16; ++i) { const long row = rowb + seg * 16 + i; hh = gb[row * 512 + chg] + ga[row * 512 + chg] * hs;
        mixo[row * D + 1536 + chg] = bf1(hh * gelu_tanh(proj[row * NINP + C_CG + chg])); }
    if (ti == 15 && seg == 7) c.out[O_RHP + ((size_t)l * BATCH + b) * 512 + chg] = hh;
}

DI void block_reduce_cols(LAS float* red, LAS float* full, const float (&p)[4], int tid, float scale) {
    const int e4 = (tid & 31) * 4, dgp = tid >> 5;
    *(LAS f32x4*)(red + dgp * 128 + e4) = (f32x4){p[0], p[1], p[2], p[3]};
    __syncthreads();
    if (tid < 128) { float s = 0.f;
#pragma unroll
        for (int k = 0; k < 16; ++k) s += red[k * 128 + tid];
        full[tid] = s * scale; }
    __syncthreads();
}
DI void unit_b_sample(const Ctx& c0, int l, int b, int h) {
    const Ctx c = fresh(c0);
    const Args& a = *c.a; const int tid = c.tid, lane = c.lane, wave = c.wave;
    LAS float* qkv = (LAS float*)c.lds;
    LAS float* scl = qkv + 384;
    LAS float* red = scl + 8;
    LAS float* full = red + 2048;
    LAS float* uu = full + 128;
    const float* proj = (const float*)(c.ws + WS_PROJ) + (size_t)(NP + b) * NINP;
    if (tid < 384) { const int part = tid >> 7, idx = tid & 127, cc = part * 1024 + h * 128 + idx;
        const float* cw = inp(a, I_BCW) + (size_t)l * 4 * 3072; const float* st = inp(a, I_SGC) + (((size_t)l * NS + b) * 3) * 3072;
        const float x0 = st[cc], x1 = st[3072 + cc], x2 = st[2 * 3072 + cc], x3 = proj[C_BQ + cc];
        qkv[tid] = silu(cw[cc] * x0 + cw[3072 + cc] * x1 + cw[2 * 3072 + cc] * x2 + cw[3 * 3072 + cc] * x3);
        float* so = c.out + O_GCS + (((size_t)l * NS + b) * 3) * 3072; so[cc] = x1; so[3072 + cc] = x2; so[2 * 3072 + cc] = x3; }
    if (tid == 384) { const float bb = proj[C_BB + h], ba = proj[C_BA + h]; scl[0] = sigm(bb); scl[1] = __expf(-__expf(inp(a, I_BALOG)[l * 8 + h]) * softplus(ba + inp(a, I_BDT)[l * 8 + h])); }
    __syncthreads();
    if (wave < 2) { const float x0 = qkv[wave * 128 + lane], x1 = qkv[wave * 128 + 64 + lane]; const float ss = wave_sum(x0 * x0 + x1 * x1);
        if (lane == 0) scl[2 + wave] = rsqrtf(ss + L2_EPS) * (wave == 0 ? 0.08838834764831845f : 1.f); }
    __syncthreads();
    const float beta = scl[0], eg = scl[1], sq = scl[2], sk = scl[3];
    const int e4 = (tid & 31) * 4, d0 = (tid >> 5) * 8;
    const size_t sidx = (((size_t)l * NS + b) * 8 + h) * 16384;
    const float* Sin = inp(a, I_SGD) + sidx; float* Sout = c.out + O_GDS + sidx;
    f32x4 S[8]; float p[4] = {0.f, 0.f, 0.f, 0.f};
#pragma unroll
    for (int i = 0; i < 8; ++i) { S[i] = *(const f32x4*)(Sin + (size_t)(d0 + i) * 128 + e4); const float k = qkv[128 + d0 + i]; p[0] += k * S[i].x; p[1] += k * S[i].y; p[2] += k * S[i].z; p[3] += k * S[i].w; }
    block_reduce_cols(red, full, p, tid, sk);
    if (tid < 128) uu[tid] = beta * (qkv[256 + tid] - eg * full[tid]) * sk;
    __syncthreads();
    const f32x4 u4 = *(const LAS f32x4*)(uu + e4);
    float po[4] = {0.f, 0.f, 0.f, 0.f};
#pragma unroll
    for (int i = 0; i < 8; ++i) { const float k = qkv[128 + d0 + i], q = qkv[d0 + i]; S[i] = S[i] * eg + u4 * k; *(f32x4*)(Sout + (size_t)(d0 + i) * 128 + e4) = S[i];
        po[0] += q * S[i].x; po[1] += q * S[i].y; po[2] += q * S[i].z; po[3] += q * S[i].w; }
    block_reduce_cols(red, full, po, tid, sq);
    if (wave < 2) { const float o = full[wave * 64 + lane]; const float ss = wave_sum(o * o); if (lane == 0) scl[4 + wave] = ss; }
    __syncthreads();
    if (tid < 128) { const float rms = rsqrtf((scl[4] + scl[5]) * (1.f / 128.f) + NORM_EPS);
        const float o = full[tid] * rms * inp(a, I_BNORM)[l * 128 + tid] * silu(proj[C_BZ + h * 128 + tid]);
        ((bf16_t*)(c.ws + WS_MIXO))[(size_t)(NP + b) * D + 512 + h * 128 + tid] = (bf16_t)(pk2(o, 0.f) & 0xffffu); }
    __syncthreads();
}
DI void unit_a_sample(const Ctx& c0, int l, int b, int h) {
    const Ctx c = fresh(c0);
    const Args& a = *c.a; const int tid = c.tid, lane = c.lane, wave = c.wave;
    LAS float* fqv = (LAS float*)c.lds;
    LAS float* scl = fqv + 384;
    LAS float* red = scl + 8;
    LAS float* full = red + 2048;
    const float* proj = (const float*)(c.ws + WS_PROJ) + (size_t)(NP + b) * NINP;
    if (tid < 384) { const int part = tid >> 7, idx = tid & 127;
        if (part == 0) { const float lb = lb_of(a, l, h * 128 + idx); fqv[tid] = lb + (1.f - lb) * sigm(proj[C_AF + h * 128 + idx]); }
        else if (part == 1) fqv[tid] = silu(proj[C_AQ + h * 128 + idx]);
        else fqv[tid] = proj[C_AI + h * 128 + idx]; }
    __syncthreads();
    const int e4 = (tid & 31) * 4, d0 = (tid >> 5) * 8;
    const size_t sidx = (((size_t)l * NS + b) * 4 + h) * 16384;
    const float* Sin = inp(a, I_SHG) + sidx; float* Sout = c.out + O_HGS + sidx;
    const f32x4 v4 = *(const LAS f32x4*)(fqv + 256 + e4);
    float po[4] = {0.f, 0.f, 0.f, 0.f};
#pragma unroll
    for (int i = 0; i < 8; ++i) { const float f = fqv[d0 + i], q = fqv[128 + d0 + i]; f32x4 S = *(const f32x4*)(Sin + (size_t)(d0 + i) * 128 + e4);
        S = S * f + v4 * (1.f - f); *(f32x4*)(Sout + (size_t)(d0 + i) * 128 + e4) = S;
        po[0] += q * S.x; po[1] += q * S.y; po[2] += q * S.z; po[3] += q * S.w; }
    block_reduce_cols(red, full, po, tid, 1.f);
    if (wave < 2) { const float o = full[wave * 64 + lane]; const float ss = wave_sum(o * o); if (lane == 0) scl[4 + wave] = ss; }
    __syncthreads();
    if (tid < 128) { const float rms = rsqrtf((scl[4] + scl[5]) * (1.f / 128.f) + NORM_EPS);
        const float o = full[tid] * rms * inp(a, I_ANORM)[l * 128 + tid] * silu(proj[C_AG + h * 128 + tid]);
        ((bf16_t*)(c.ws + WS_MIXO))[(size_t)(NP + b) * D + h * 128 + tid] = (bf16_t)(pk2(o, 0.f) & 0xffffu); }
    __syncthreads();
}
DI void unit_c_sample(const Ctx& c0, int l, int b) {
    const Ctx c = fresh(c0);
    const Args& a = *c.a; const int tid = c.tid;
    LAS float* xc = (LAS float*)c.lds;
    const float* proj = (const float*)(c.ws + WS_PROJ) + (size_t)(NP + b) * NINP;
    const float* ccw = inp(a, I_CCW) + (size_t)l * 4 * 512; const float* st = inp(a, I_SRC) + (((size_t)l * NS + b) * 3) * 512;
    const float x0 = st[tid], x1 = st[512 + tid], x2 = st[1024 + tid], x3 = proj[C_CX + tid];
    const float xv = ccw[tid] * x0 + ccw[512 + tid] * x1 + ccw[1024 + tid] * x2 + ccw[1536 + tid] * x3 + inp(a, I_CCB)[l * 512 + tid];
    xc[tid] = xv;
    { float* so = c.out + O_RCS + (((size_t)l * NS + b) * 3) * 512; so[tid] = x1; so[512 + tid] = x2; so[1024 + tid] = x3; }
    __syncthreads();
    const int n = tid >> 6, j = tid & 63;
    const float* wa = inp(a, I_CWA) + ((size_t)l * 8 + n) * 4096 + j; const float* wx = inp(a, I_CWX) + ((size_t)l * 8 + n) * 4096 + j;
    float sa = 0.f, sx = 0.f;
#pragma unroll 8
    for (int i = 0; i < 64; ++i) { const float x = xc[n * 64 + i]; sa += x * wa[i * 64]; sx += x * wx[i * 64]; }
    const float r = sigm(sa + inp(a, I_CBA)[l * 512 + tid]), ig = sigm(sx + inp(a, I_CBX)[l * 512 + tid]);
    const float la = -8.f * r * softplus(-inp(a, I_CLAM)[l * 512 + tid]); const float at = __expf(la); const float mult = sqrtf(fmaxf(0.f, -expm1f(2.f * la)));
    const float h0 = inp(a, I_SRH)[((size_t)l * NS + b) * 512 + tid];
    const float hh = at * h0 + mult * (ig * xv);
    c.out[O_RHS + ((size_t)l * NS + b) * 512 + tid] = hh;
    ((bf16_t*)(c.ws + WS_MIXO))[(size_t)(NP + b) * D + 1536 + tid] = (bf16_t)(pk2(hh * gelu_tanh(proj[C_CG + tid]), 0.f) & 0xffffu);
    __syncthreads();
}


DI void phase_m2(const Ctx& c, int l) {
    int w = blockIdx.x; asm volatile("" : "+s"(w));
    if (w < 48) {
        const int isB = w < 32; const int u = isB ? w : w - 32;
        for (int rep = 0; rep < (PROBE_SUB == 4 ? 2 : 1); ++rep) m2_unit_head(c, l, isB, isB ? (u >> 3) : (u >> 2), isB ? (u & 7) : (u & 3));
    } else {
        const int nw = c.G - 48;
        for (int rep = 0; rep < (PROBE_SUB == 5 ? 2 : 1); ++rep)
        for (int u = w - 48; u < 512 + 1664; u += nw) {
            if (u < 512) m2_unit_cfin(c, l, u);
            else { const int v = u - 512;
                if (v < 1024) unit_b_sample(c, l, v >> 3, v & 7);
                else if (v < 1536) { const int x = v - 1024; unit_a_sample(c, l, x >> 2, x & 3); }
                else unit_c_sample(c, l, v - 1536); }
        }
        { const Ctx cv = fresh(c); __syncthreads();
          convert_range(cv, l == 0 ? CV_IN : CV_LAYER + CV_IN, l == 0 ? CV_LAYER + CV_IN : 2 * CV_LAYER, (w - 48) * 8 + cv.wave, nw * 8); }
        const Ctx cc = fresh(c); const float* proj = (const float*)(cc.ws + WS_PROJ);
        const int gt_ = (w - 48) * 512 + cc.tid, NT = nw * 512;
        for (int i = gt_; i < BATCH * 3 * 3072; i += NT) { const int b = i / (3 * 3072), r = i - b * 3 * 3072, j = r / 3072, ch = r - j * 3072;
            cc.out[O_GCP + (size_t)l * BATCH * 3 * 3072 + i] = proj[((size_t)b * SEQ + SEQ - 3 + j) * NINP + C_BQ + ch]; }
        for (int i = gt_; i < BATCH * 3 * 512; i += NT) { const int b = i / (3 * 512), r = i - b * 3 * 512, j = r / 512, ch = r - j * 512;
            cc.out[O_RCP + (size_t)l * BATCH * 3 * 512 + i] = proj[((size_t)b * SEQ + SEQ - 3 + j) * NINP + C_CX + ch]; }
    }
}


#define XB_TMO      128
#define XB_XCNT(j)  (256  + 64 * (j))
#define XB_XSUB(j)  (1280 + 64 * (j))
#define XB_XGEN(j)  (2304 + 64 * (j))
#define XB_TOP      3328
#define XB_TOPGEN   3392
#define XCD_BAR_WORDS 3456
#define XB_SPIN_CAP (1u << 20)
DI unsigned xb_ld(unsigned* p)              { return __hip_atomic_load(p, __ATOMIC_RELAXED, __HIP_MEMORY_SCOPE_AGENT); }
DI unsigned xb_add(unsigned* p, unsigned v) { return __hip_atomic_fetch_add(p, v, __ATOMIC_RELAXED, __HIP_MEMORY_SCOPE_AGENT); }
DI unsigned xb_xcc_id() { return (unsigned)__builtin_amdgcn_s_getreg((3 << 11) | 20) & 0xFu; }
#define XB_SPIN(cond, bar) do { unsigned _sp = 0; while (cond) { __builtin_amdgcn_s_sleep(1); \
    if ((++_sp & 255u) == 0u) { if (xb_ld(&(bar)[XB_TMO])) break; if (_sp > XB_SPIN_CAP) { atomicAdd(&(bar)[XB_TMO], 1u); break; } } } } while (0)
DI void xcd_barrier_post(unsigned* bar) { if (threadIdx.x == 0) (void)xb_add(&bar[XB_XCNT(xb_xcc_id())], 1u); }
DI void xcd_barrier_complete(unsigned* bar, unsigned x, unsigned& nloc, unsigned& nx) {
    const unsigned G = gridDim.x * gridDim.y * gridDim.z;
    unsigned sum, cnt, mine, sp = 0u;
    for (;;) {
        sum = 0u; cnt = 0u; mine = 0u;
#pragma unroll
        for (unsigned j = 0; j < 16; ++j) { const unsigned c = xb_ld(&bar[XB_XCNT(j)]); sum += c; cnt += (c > 0u) ? 1u : 0u; mine = (j == x) ? c : mine; }
        if (sum == G) break;
        __builtin_amdgcn_s_sleep(1);
        if ((++sp & 255u) == 0u) { if (xb_ld(&bar[XB_TMO])) break; if (sp > XB_SPIN_CAP) { atomicAdd(&bar[XB_TMO], 1u); break; } }
    }
    nloc = mine > 0u ? mine : 1u; nx = cnt > 0u ? cnt : 1u;
}
DI void xcd_barrier(unsigned* bar, volatile LAS unsigned* st) {
    asm volatile("s_waitcnt vmcnt(0)" ::: "memory");
    __syncthreads();
    if (threadIdx.x == 0) {
        const unsigned x = xb_xcc_id();
        __builtin_amdgcn_s_waitcnt(0);
        unsigned nloc = st[0], nx = st[1];
        if (nloc == 0u) { xcd_barrier_complete(bar, x, nloc, nx); st[0] = nloc; st[1] = nx; }
        const unsigned old = xb_add(&bar[XB_XSUB(x)], 1u);
        const unsigned gen = old / nloc;
        if (old + 1u == (gen + 1u) * nloc) {
            __builtin_amdgcn_fence(__ATOMIC_RELEASE, "agent");
            asm volatile("s_waitcnt vmcnt(0)" ::: "memory");
            const unsigned og = xb_add(&bar[XB_TOP], 1u);
            const unsigned tg = og / nx;
            if (og + 1u == (tg + 1u) * nx) xb_add(&bar[XB_TOPGEN], 1u);
            else XB_SPIN(xb_ld(&bar[XB_TOPGEN]) == tg, bar);
            __builtin_amdgcn_fence(__ATOMIC_ACQUIRE, "agent");
            xb_add(&bar[XB_XGEN(x)], 1u);
            asm volatile("s_waitcnt vmcnt(0)" ::: "memory");
        } else {
            XB_SPIN(xb_ld(&bar[XB_XGEN(x)]) == gen, bar);
            __builtin_amdgcn_fence(__ATOMIC_ACQUIRE, "agent");
            asm volatile("s_waitcnt vmcnt(0)" ::: "memory");
        }
    }
    __syncthreads();
}

__global__ void __launch_bounds__(512, 2) fwd_megakernel(Args args) {
    extern __shared__ __attribute__((aligned(16))) unsigned char lds_raw[];
    Ctx c0; c0.a = &args; c0.ws = nullptr; c0.out = nullptr; c0.lds = (LAS unsigned char*)lds_raw; c0.tid = 0; c0.lane = 0; c0.wave = 0; c0.G = gridDim.x; c0.bid = 0;
    const int lo = args.ph_lo, hi = args.ph_hi;
    volatile LAS unsigned* bst = (volatile LAS unsigned*)((LAS unsigned char*)lds_raw + LDS_BYTES - 16);
    if (threadIdx.x == 0) { bst[0] = 0u; bst[1] = 0u; }
    __syncthreads();
    xcd_barrier_post((unsigned*)(args.ws + WS_CTL) + 1024);
#pragma unroll 1
    for (int ph2 = 2 * lo; ph2 < 2 * hi; ++ph2) {
        const int ph = ph2 >> 1;
        const int l = (ph - 1) >> 3, k = (ph == 0) ? -1 : ((ph - 1) & 7);
        if ((ph2 & 1) && k != PROBE_REP) continue;
        if (k == -1) phase_p0(c0);
        else if (k == 0 || k == 3 || k == 5 || k == 6) {
            const Ctx c = fresh(c0); unsigned char* ws = c.ws;
            pg8::Gemm g; pg8::EpiAny E; E.mode = 0; E.C = (float*)(ws + WS_MIXF); E.O = nullptr; E.ldc = D;
            if (k == 0)      { g.A = (const bf16_t*)(ws + WS_HBUF); g.Bt = (const bf16_t*)(ws + WS_WIN + l * SZ_WIN);   g.N = NINP; g.K = D;   E.C = (float*)(ws + WS_PROJ); E.ldc = NINP; }
            else if (k == 3) { g.A = (const bf16_t*)(ws + WS_MIXO); g.Bt = (const bf16_t*)(ws + WS_WOUT + l * SZ_WOUT); g.N = D;    g.K = D; }
            else if (k == 5) { g.A = (const bf16_t*)(ws + WS_HBUF); g.Bt = (const bf16_t*)(ws + WS_WGU + l * SZ_WGU);   g.N = NGU;  g.K = D;   E.mode = 1; E.O = (bf16_t*)(ws + WS_PROJ); E.ldc = DFF; }
            else             { g.A = (const bf16_t*)(ws + WS_PROJ); g.Bt = (const bf16_t*)(ws + WS_WDN + l * SZ_WDN);   g.N = D;    g.K = DFF; }
            g.M = MPAD;
            pg8::StaticOrder S; S.init(MPAD, g.N, c.G, c.bid);
            pg8::gemm_phase<pg8::EpiAny, pg8::StaticOrder, true, true>(c.lds, g, S, E);
        }
        else if (k == 1) phase_m1(c0, l);
        else if (k == 2) phase_m2(c0, l);
        else {
            const Ctx c = fresh(c0); unsigned char* ws = c.ws;
            float* mixf = (float*)(ws + WS_MIXF); float* x1 = (float*)(ws + WS_X1); bf16_t* hb = (bf16_t*)(ws + WS_HBUF);
            if (k == 4) {
                const float* xa = (l == 0) ? inp(args, I_XP) : c.out; const float* xb = (l == 0) ? inp(args, I_XS) : c.out + (size_t)NP * D;
                row_phase(c0, mixf, xa, xb, x1, inp(args, I_LN2) + l * D, inp(args, I_LN3) + l * D, hb);
            } else {
                row_phase(c0, mixf, x1, x1 + (size_t)NP * D, c.out, inp(args, I_LN4) + l * D, l == 0 ? inp(args, I_LN1) + D : nullptr, hb);
            }
        }
        if (ph2 + 1 < 2 * hi) {
            if (ph2 == 2 * lo) cg::this_grid().sync();
            else xcd_barrier((unsigned*)(args.ws + WS_CTL) + 1024, bst);
        }
    }
}

extern "C" void kernel_launch(void* const* d_in, const int* in_sizes, int n_in, void* d_out, int out_size, void* d_ws, size_t ws_size, hipStream_t stream) {
    static int grid = 0;
    if (grid == 0) {
        if (n_in != 29 || (size_t)out_size != O_END || ws_size < WS_END) { fprintf(stderr, "kernel_launch: unexpected shapes: n_in %d out %d ws %zu (need %zu)\n", n_in, out_size, ws_size, (size_t)WS_END); grid = -1; return; }
        int dev = 0, cus = 0, per_cu = 0;
        hipGetDevice(&dev); hipDeviceGetAttribute(&cus, hipDeviceAttributeMultiprocessorCount, dev);
        if (hipFuncSetAttribute((const void*)fwd_megakernel, hipFuncAttributeMaxDynamicSharedMemorySize, LDS_BYTES) != hipSuccess) { fprintf(stderr, "kernel_launch: hipFuncSetAttribute failed\n"); grid = -1; return; }
        if (hipOccupancyMaxActiveBlocksPerMultiprocessor(&per_cu, (const void*)fwd_megakernel, 512, LDS_BYTES) != hipSuccess || per_cu < 1) { fprintf(stderr, "kernel_launch: occupancy query says %d\n", per_cu); grid = -1; return; }
        grid = cus;
        if (grid < 224) { fprintf(stderr, "kernel_launch: needs >= 224 CUs, got %d\n", grid); grid = -1; return; }
    }
    if (grid < 0) return;
    hipMemsetAsync((char*)d_ws + WS_CTL, 0, CTL_BYTES, stream);
    Args a{};
    for (int i = 0; i < 29; ++i) a.in[i] = (const float*)d_in[i];
    a.out = (float*)d_out; a.ws = (unsigned char*)d_ws;
#if MK_MULTI
    for (int ph = 0; ph < NPHASE; ++ph) { a.ph_lo = ph; a.ph_hi = ph + 1; hipLaunchKernelGGL(fwd_megakernel, dim3(grid), dim3(512), LDS_BYTES, stream, a); }
#else
    a.ph_lo = 0; a.ph_hi = NPHASE;
    void* kargs[] = {&a};
    hipError_t e = hipLaunchCooperativeKernel((const void*)fwd_megakernel, dim3(grid), dim3(512), kargs, LDS_BYTES, stream);
    if (e != hipSuccess) fprintf(stderr, "cooperative launch failed: %s (grid %d)\n", hipGetErrorString(e), grid);
#endif
}
```

```cpp
#include <hip/hip_runtime.h>
#include <hip/hip_cooperative_groups.h>
#include <cstdio>
#include <cstdint>
namespace cg = cooperative_groups;

#ifndef MK_MULTI
#define MK_MULTI 0
#endif

#ifndef PROBE_REP
#define PROBE_REP (-2)
#endif
#ifndef PROBE_SUB
#define PROBE_SUB 0
#endif
#define DI __device__ __forceinline__
#define LAS __attribute__((address_space(3)))
#define GAS __attribute__((address_space(1)))
typedef unsigned short bf16_t;
typedef float f32x4 __attribute__((ext_vector_type(4)));
typedef float f32x2 __attribute__((ext_vector_type(2)));
typedef unsigned u32x4 __attribute__((ext_vector_type(4)));
typedef unsigned u32x2 __attribute__((ext_vector_type(2)));
typedef short bf16x8 __attribute__((ext_vector_type(8)));
typedef __bf16 bf16v2 __attribute__((ext_vector_type(2)));

constexpr int D = 2048, SEQ = 2048, BATCH = 4, NP = BATCH * SEQ, NS = 128, MT = NP + NS, MPAD = 8448;
constexpr int NIN = 7184, NINP = 7424, DFF = 5632, NGU = 2 * DFF;
constexpr int C_AQ = 0, C_AF = 512, C_AI = 1024, C_AG = 1536, C_BQ = 2048, C_BK = 3072, C_BV = 4096, C_BZ = 5120, C_BB = 6144, C_BA = 6152, C_CX = 6160, C_CG = 6672;
constexpr float NORM_EPS = 1e-6f, L2_EPS = 1e-6f;
constexpr int NPHASE = 17;

constexpr size_t O_YP = 0, O_YS = O_YP + (size_t)NP * D, O_HGP = O_YS + (size_t)NS * D, O_HGS = O_HGP + 2ull * 4 * 4 * 16384,
                 O_GDP = O_HGS + 2ull * 128 * 4 * 16384, O_GDS = O_GDP + 2ull * 4 * 8 * 16384, O_GCP = O_GDS + 2ull * 128 * 8 * 16384,
                 O_GCS = O_GCP + 2ull * 4 * 3 * 3072, O_RHP = O_GCS + 2ull * 128 * 3 * 3072, O_RHS = O_RHP + 2ull * 4 * 512,
                 O_RCP = O_RHS + 2ull * 128 * 512, O_RCS = O_RCP + 2ull * 4 * 3 * 512, O_END = O_RCS + 2ull * 128 * 3 * 512;

constexpr size_t MiB = 1ull << 20;
constexpr size_t WS_CTL = 0, CTL_BYTES = 1 * MiB;
constexpr size_t WS_WIN = 1 * MiB, SZ_WIN = 29 * MiB, WS_WOUT = WS_WIN + 2 * SZ_WIN, SZ_WOUT = 8 * MiB, WS_WGU = WS_WOUT + 2 * SZ_WOUT, SZ_WGU = 44 * MiB,
                 WS_WDN = WS_WGU + 2 * SZ_WGU, SZ_WDN = 22 * MiB;
constexpr size_t WS_PROJ = WS_WDN + 2 * SZ_WDN, SZ_PROJ = 240 * MiB;
constexpr size_t WS_HBUF = WS_PROJ + SZ_PROJ, SZ_HBUF = 33 * MiB;
constexpr size_t WS_MIXO = WS_HBUF + SZ_HBUF;
constexpr size_t WS_MIXF = WS_MIXO + SZ_HBUF, SZ_MIXF = 66 * MiB;
constexpr size_t WS_X1 = WS_MIXF + SZ_MIXF, WS_END = WS_X1 + SZ_MIXF + 25 * MiB;
static_assert((size_t)NINP * D * 2 == SZ_WIN && (size_t)NGU * D * 2 == SZ_WGU && (size_t)D * DFF * 2 == SZ_WDN && (size_t)D * D * 2 == SZ_WOUT, "weight sizes");
static_assert((size_t)MPAD * NINP * 4 <= SZ_PROJ && (size_t)MPAD * D * 2 <= SZ_HBUF && (size_t)MPAD * D * 4 <= SZ_MIXF, "ws map");

constexpr int LDS_BYTES = 147456;

DI unsigned pk2(float lo, float hi) { f32x2 x = {lo, hi}; bf16v2 y = __builtin_convertvector(x, bf16v2); return __builtin_bit_cast(unsigned, y); }
DI float wave_sum(float v) {
#pragma unroll
    for (int o = 1; o < 64; o <<= 1) v += __shfl_xor(v, o);
    return v;
}
template <int CTRL> DI float dpp_mov(float v) { return __int_as_float(__builtin_amdgcn_update_dpp(0, __float_as_int(v), CTRL, 0xF, 0xF, true)); }
DI float row16_sum(float v) {
    v += dpp_mov<0xB1>(v); v += dpp_mov<0x4E>(v); v += dpp_mov<0x124>(v); v += dpp_mov<0x128>(v); return v;
}
DI float sigm(float x) { return 1.f / (1.f + __expf(-x)); }
DI float silu(float x) { return x / (1.f + __expf(-x)); }
DI float softplus(float x) { return x > 20.f ? x : log1pf(__expf(x)); }
DI float gelu_tanh(float x) { const float y = 0.7978845608028654f * (x + 0.044715f * x * x * x); return 0.5f * x * (1.f + tanhf(y)); }
#define LDS_WAIT() asm volatile("s_waitcnt lgkmcnt(0)" ::: "memory")
#define MFMA16(a, b, c) __builtin_amdgcn_mfma_f32_16x16x32_bf16((a), (b), (c), 0, 0, 0)

namespace pg8 {
#define PG8_LAS __attribute__((address_space(3)))
constexpr int BM = 256, BK = 64, HALF = 128, HTB = HALF * BK * 2, STAGE_BYTES = 8 * HTB, NXCD = 8, WGM = 8;
__host__ __device__ __forceinline__ int lds_byte(int r, int c) { const int st = (r >> 4) * 2 + (c >> 5), rr = r & 15, cc = c & 31, ob = rr * 64 + cc * 2; return st * 1024 + (ob ^ (((ob >> 9) & 1) << 5)); }
__host__ __device__ __forceinline__ void stage_rc(int b, int& R, int& C) { const int st = b / 1024, sb = b % 1024, swz = sb ^ (((sb >> 9) & 1) << 5); R = (st >> 1) * 16 + swz / 64; C = (st & 1) * 32 + (swz % 64) / 2; }
struct Unit { int pm, pn; };
struct Gemm { const bf16_t* A; const bf16_t* Bt; int M, N, K; };
struct StaticOrder {
    int nM, nN, nwg, G, c;
    __host__ __device__ void init(int M, int N, int G_, int c_) { nM = M / BM; nN = N / BM; nwg = nM * nN; G = G_; c = c_; }
    __host__ __device__ bool next(int i, Unit& u) const {
        const long L = (long)i * G + c; if (L >= nwg) return false;
        int wgid = (int)L; { const int q = nwg / NXCD, r = nwg % NXCD, xcd = wgid % NXCD, off = wgid / NXCD; wgid = (xcd < r ? xcd * (q + 1) : r * (q + 1) + (xcd - r) * q) + off; }
        const int nig = WGM * nN, gid = wgid / nig, fm = gid * WGM, gsz = (nM - fm) < WGM ? (nM - fm) : WGM;
        u.pm = fm + ((wgid % nig) % gsz); u.pn = (wgid % nig) / gsz; return true;
    }
    __device__ __forceinline__ void a_ready(const Unit&) const {}
    __device__ __forceinline__ void done(const Unit&) const {}
};
struct EpiAny {
    static constexpr bool PERM = false, AFTER_DRAIN = false;
    int mode; float* C; bf16_t* O; int ldc;
    __device__ __forceinline__ void operator()(const f32x4 (&acc)[2][2][4][2], const Unit& u, int wr, int wc, int fr, int fq) const {
        const int row0 = u.pm * BM + wr * 64 + fr;
        if (mode == 0) {
            const int col0 = u.pn * BM + wc * 32 + 4 * fq;
#pragma unroll
            for (int ai = 0; ai < 2; ++ai)
#pragma unroll
                for (int m = 0; m < 4; ++m) { float* rowp = C + (size_t)(row0 + ai * HALF + m * 16) * ldc + col0;
#pragma unroll
                    for (int bj = 0; bj < 2; ++bj)
#pragma unroll
                        for (int n = 0; n < 2; ++n) *(f32x4*)(rowp + bj * HALF + n * 16) = acc[ai][bj][m][n]; }
        } else {
#pragma unroll
            for (int ai = 0; ai < 2; ++ai)
#pragma unroll
                for (int m = 0; m < 4; ++m) { bf16_t* rowp = O + (size_t)(row0 + ai * HALF + m * 16) * ldc;
#pragma unroll
                    for (int bj = 0; bj < 2; ++bj) { const int G = 8 * u.pn + 4 * bj + wc; const f32x4 g = acc[ai][bj][m][0], up = acc[ai][bj][m][1];
                        u32x2 w; w.x = pk2(silu(g[0]) * up[0], silu(g[1]) * up[1]); w.y = pk2(silu(g[2]) * up[2], silu(g[3]) * up[3]);
                        *(u32x2*)(rowp + 16 * G + 4 * fq) = w; } }
        }
    }
};

template <class Epi, class Sched, bool ALIGN_EPI = false, bool SP2 = false>
__device__ __forceinline__ void gemm_phase(PG8_LAS unsigned char* lds, const Gemm g, const Sched& S, const Epi& E) {
    int tid_ = threadIdx.x; asm volatile("" : "+v"(tid_));
    const int tid = tid_, wid = __builtin_amdgcn_readfirstlane(tid >> 6), lane = tid & 63, wr = wid >> 2, wc = wid & 3, fr = lane & 15, fq = lane >> 4;
    const int K = g.K, nt = K / BK;
    unsigned voffA[2], voffB[2];
#pragma unroll
    for (int i = 0; i < 2; ++i) { int R, C; stage_rc(tid * 16 + i * 8192, R, C); voffA[i] = (unsigned)(R * K + C) * 2u; voffB[i] = (unsigned)(R * K + C) * 2u; }
    const size_t kstep = (size_t)(BK * 2);
    const size_t hstep = (size_t)HALF * K * 2;
    const size_t tstep = 2 * hstep;
    const unsigned ldsw = (unsigned)wid * 1024u;
    const int aoff = lds_byte(wr * 64 + fr, fq * 8), boff = lds_byte(wc * 32 + fr, fq * 8);
#define PG8_SA(b, h) (((b) * 2 + (h)) * HTB)
#define PG8_SB(b, h) ((4 + (b) * 2 + (h)) * HTB)
#define PG8_STAGE(bufoff, gbase, voff) do { _Pragma("unroll") for (int _i = 0; _i < 2; ++_i) \
        __builtin_amdgcn_global_load_lds((const unsigned*)((const char*)(gbase) + (voff)[_i]), (PG8_LAS unsigned*)(lds + (bufoff) + ldsw + _i * 8192), 16, 0, 0); } while (0)
#define PG8_LDA(dst, b, h) do { _Pragma("unroll") for (int m = 0; m < 4; ++m) _Pragma("unroll") for (int k = 0; k < 2; ++k) dst[m][k] = *(const PG8_LAS bf16x8*)(lds + PG8_SA(b, h) + aoff + m * 2048 + k * 1024); } while (0)
#define PG8_LDB(dst, b, h) do { _Pragma("unroll") for (int n = 0; n < 2; ++n) _Pragma("unroll") for (int k = 0; k < 2; ++k) dst[n][k] = *(const PG8_LAS bf16x8*)(lds + PG8_SB(b, h) + boff + n * 2048 + k * 1024); } while (0)
#define PG8_MMA(ai, bj, At, Bt) do { __builtin_amdgcn_s_setprio(1); _Pragma("unroll") for (int m = 0; m < 4; ++m) _Pragma("unroll") for (int n = 0; n < 2; ++n) _Pragma("unroll") for (int k = 0; k < 2; ++k) \
        acc[ai][bj][m][n] = __builtin_amdgcn_mfma_f32_16x16x32_bf16(Bt[n][k], At[m][k], acc[ai][bj][m][n], 0, 0, 0); __builtin_amdgcn_s_setprio(0); } while (0)
#define PG8_WAIT_V(n) asm volatile("s_waitcnt vmcnt(" #n ")" ::: "memory")
#define PG8_WAIT_L(n) asm volatile("s_waitcnt lgkmcnt(" #n ")" ::: "memory")
#define PG8_BAR __builtin_amdgcn_s_barrier()
#define PG8_SCHED __builtin_amdgcn_sched_barrier(0)
    Unit cur, nxt; int ui = 0;
    if (!S.next(0, cur)) return;
    f32x4 acc[2][2][4][2];
#pragma unroll
    for (int a = 0; a < 2; ++a)
#pragma unroll
        for (int b = 0; b < 2; ++b)
#pragma unroll
            for (int m = 0; m < 4; ++m)
#pragma unroll
                for (int n = 0; n < 2; ++n) acc[a][b][m][n] = (f32x4){0.f, 0.f, 0.f, 0.f};
    bf16x8 At[4][2], B0[2][2], B1[2][2];
    const char* cA = (const char*)g.A + (size_t)cur.pm * tstep; const char* cB = (const char*)g.Bt + (size_t)cur.pn * tstep;
    S.a_ready(cur);
    if constexpr (SP2) {
        PG8_STAGE(PG8_SB(0, 0), cB, voffB); PG8_STAGE(PG8_SB(0, 1), cB + hstep, voffB); PG8_STAGE(PG8_SA(0, 0), cA, voffA); PG8_STAGE(PG8_SA(0, 1), cA + hstep, voffA);
        if (wr == 1) PG8_BAR;
        PG8_WAIT_V(2); PG8_BAR;
        PG8_STAGE(PG8_SB(1, 0), cB + kstep, voffB); PG8_STAGE(PG8_SA(1, 0), cA + kstep, voffA); PG8_STAGE(PG8_SB(1, 1), cB + hstep + kstep, voffB);
        PG8_WAIT_V(6); PG8_BAR;
    } else {
        PG8_STAGE(PG8_SB(0, 0), cB, voffB); PG8_STAGE(PG8_SA(0, 0), cA, voffA); PG8_STAGE(PG8_SB(0, 1), cB + hstep, voffB); PG8_STAGE(PG8_SA(0, 1), cA + hstep, voffA);
        if (wr == 1) PG8_BAR;
        PG8_WAIT_V(4); PG8_BAR;
        PG8_STAGE(PG8_SB(1, 0), cB + kstep, voffB); PG8_STAGE(PG8_SA(1, 0), cA + kstep, voffA); PG8_STAGE(PG8_SB(1, 1), cB + hstep + kstep, voffB);
        PG8_WAIT_V(6); PG8_BAR;
    }
    for (;;) {
        const bool has_next = S.next(ui + 1, nxt);
        const char* nA = has_next ? (const char*)g.A + (size_t)nxt.pm * tstep : cA; const char* nB = has_next ? (const char*)g.Bt + (size_t)nxt.pn * tstep : cB;
        for (int t = 0; t < nt; t += 2) {
            const bool last = (t == nt - 2);
            const char* a1 = cA + (size_t)(t + 1) * kstep;
            const char* a2 = last ? nA : cA + (size_t)(t + 2) * kstep; const char* b2 = last ? nB : cB + (size_t)(t + 2) * kstep;
            const char* a3 = a2 + kstep; const char* b3 = b2 + kstep;
            if (last && has_next) S.a_ready(nxt);
            if constexpr (SP2) {
            PG8_LDB(B0, 0, 0); PG8_LDB(B1, 0, 1); PG8_SCHED; PG8_LDA(At, 0, 0); PG8_STAGE(PG8_SA(1, 1), a1 + hstep, voffA);
            PG8_WAIT_V(8); PG8_WAIT_L(0); PG8_BAR; PG8_MMA(0, 0, At, B0); PG8_MMA(0, 1, At, B1); PG8_BAR; PG8_SCHED;
            PG8_LDA(At, 0, 1); PG8_STAGE(PG8_SB(0, 0), b2, voffB); PG8_STAGE(PG8_SB(0, 1), b2 + hstep, voffB); PG8_STAGE(PG8_SA(0, 0), a2, voffA);
            PG8_WAIT_V(8); PG8_WAIT_L(0); PG8_BAR; PG8_MMA(1, 0, At, B0); PG8_MMA(1, 1, At, B1); PG8_BAR; PG8_SCHED;
            PG8_LDB(B0, 1, 0); PG8_LDB(B1, 1, 1); PG8_SCHED; PG8_LDA(At, 1, 0); PG8_STAGE(PG8_SA(0, 1), a2 + hstep, voffA);
            PG8_WAIT_V(8); PG8_WAIT_L(0); PG8_BAR; PG8_MMA(0, 0, At, B0); PG8_MMA(0, 1, At, B1); PG8_BAR; PG8_SCHED;
            PG8_LDA(At, 1, 1); PG8_STAGE(PG8_SB(1, 0), b3, voffB); PG8_STAGE(PG8_SB(1, 1), b3 + hstep, voffB); PG8_STAGE(PG8_SA(1, 0), a3, voffA);
            PG8_WAIT_V(8); PG8_WAIT_L(0); PG8_BAR; PG8_MMA(1, 0, At, B0); PG8_MMA(1, 1, At, B1); PG8_BAR; PG8_SCHED;
            } else {
            PG8_LDB(B0, 0, 0); PG8_SCHED; PG8_LDA(At, 0, 0); PG8_STAGE(PG8_SA(1, 1), a1 + hstep, voffA);
            PG8_WAIT_L(8); PG8_BAR; PG8_WAIT_L(0); PG8_MMA(0, 0, At, B0); PG8_BAR; PG8_SCHED;
            PG8_LDB(B1, 0, 1); PG8_STAGE(PG8_SB(0, 0), b2, voffB);
            PG8_BAR; PG8_WAIT_L(0); PG8_MMA(0, 1, At, B1); PG8_BAR;
            PG8_LDA(At, 0, 1); PG8_STAGE(PG8_SA(0, 0), a2, voffA);
            PG8_BAR; PG8_WAIT_L(0); PG8_MMA(1, 0, At, B0); PG8_BAR; PG8_SCHED;
            PG8_STAGE(PG8_SB(0, 1), b2 + hstep, voffB);
            PG8_WAIT_V(6); PG8_BAR; PG8_MMA(1, 1, At, B1); PG8_BAR;
            PG8_LDB(B0, 1, 0); PG8_SCHED; PG8_LDA(At, 1, 0); PG8_STAGE(PG8_SA(0, 1), a2 + hstep, voffA);
            PG8_WAIT_L(8); PG8_BAR; PG8_WAIT_L(0); PG8_MMA(0, 0, At, B0); PG8_BAR; PG8_SCHED;
            PG8_LDB(B1, 1, 1); PG8_STAGE(PG8_SB(1, 0), b3, voffB);
            PG8_BAR; PG8_WAIT_L(0); PG8_MMA(0, 1, At, B1); PG8_BAR;
            PG8_LDA(At, 1, 1); PG8_STAGE(PG8_SA(1, 0), a3, voffA);
            PG8_BAR; PG8_WAIT_L(0); PG8_MMA(1, 0, At, B0); PG8_BAR; PG8_SCHED;
            PG8_STAGE(PG8_SB(1, 1), b3 + hstep, voffB);
            PG8_WAIT_V(6); PG8_BAR; PG8_MMA(1, 1, At, B1); PG8_BAR;
            }
        }
        if constexpr (ALIGN_EPI) { if (wr == 0) PG8_BAR; }
        if constexpr (!Epi::AFTER_DRAIN) { E(acc, cur, wr, wc, fr, fq); S.done(cur); }
        if (!has_next) break;
#pragma unroll
        for (int a = 0; a < 2; ++a)
#pragma unroll
            for (int b = 0; b < 2; ++b)
#pragma unroll
                for (int m = 0; m < 4; ++m)
#pragma unroll
                    for (int n = 0; n < 2; ++n) acc[a][b][m][n] = (f32x4){0.f, 0.f, 0.f, 0.f};
        cur = nxt; cA = nA; cB = nB; ++ui;
        if constexpr (ALIGN_EPI) { if (wr == 1) PG8_BAR; }
    }
    PG8_WAIT_V(0);
    if constexpr (!ALIGN_EPI) { if (wr == 0) PG8_BAR; }
    PG8_BAR;
#undef PG8_SA
#undef PG8_SB
#undef PG8_STAGE
#undef PG8_LDA
#undef PG8_LDB
#undef PG8_MMA
#undef PG8_WAIT_V
#undef PG8_WAIT_L
#undef PG8_BAR
#undef PG8_SCHED
}
}

struct Args { const float* in[29]; float* out; unsigned char* ws; int ph_lo, ph_hi; };
enum { I_XP = 0, I_XS, I_SHG, I_SGD, I_SGC, I_SRH, I_SRC, I_LN1, I_LN2, I_LN3, I_LN4, I_WIN, I_WOUT, I_LB, I_ANORM, I_BCW, I_BALOG, I_BDT, I_BNORM,
       I_CCW, I_CCB, I_CWA, I_CBA, I_CWX, I_CBX, I_CLAM, I_WG, I_WU, I_WD };

struct Ctx {
    const Args* a; unsigned char* ws; float* out; LAS unsigned char* lds; int tid, lane, wave, G, bid;
};
DI Ctx fresh(const Ctx& o) {
    Ctx c = o; int t = threadIdx.x; asm volatile("" : "+v"(t)); c.tid = t; c.lane = t & 63; c.wave = __builtin_amdgcn_readfirstlane(t >> 6);
    size_t z = 0; asm volatile("" : "+s"(z)); c.ws = o.a->ws + z; c.out = o.a->out + z;
    int b = blockIdx.x; asm volatile("" : "+s"(b)); c.bid = b; return c;
}
DI const float* inp(const Args& a, int idx) { int z = idx; asm volatile("" : "+s"(z)); return (const float*)(const GAS float*)a.in[z]; }

template <int MODE>
DI void transpose_item(const float* W, int K, int Nsrc, int nblk, bf16_t* WT, LAS float* scr, int item, int lane) {
    const int kb = item / nblk, nb = item - kb * nblk, k0 = 64 * kb, n0 = 32 * nb;
    const int nn = n0 + (lane & 31); const bool ok = nn < Nsrc;
    float v[32];
#pragma unroll
    for (int i = 0; i < 32; ++i) { const int kk = 2 * i + (lane >> 5); v[i] = ok ? W[(size_t)(k0 + kk) * Nsrc + nn] : 0.f; }
#pragma unroll
    for (int i = 0; i < 32; ++i) { const int kk = 2 * i + (lane >> 5); scr[kk * 33 + (lane & 31)] = v[i]; }
    LDS_WAIT(); asm volatile("" ::: "memory");
    const int c = lane & 7;
#pragma unroll
    for (int j = 0; j < 4; ++j) { const int nl = (lane >> 3) + 8 * j; const LAS float* s = scr + (8 * c) * 33 + nl;
        u32x4 o; o.x = pk2(s[0 * 33], s[1 * 33]); o.y = pk2(s[2 * 33], s[3 * 33]); o.z = pk2(s[4 * 33], s[5 * 33]); o.w = pk2(s[6 * 33], s[7 * 33]);
        const int n = n0 + nl; const int drow = (MODE == 0) ? n : ((n >> 4) * 32 + (n & 15) + (MODE == 2 ? 16 : 0));
        *(u32x4*)(WT + (size_t)drow * K + k0 + 8 * c) = o; }
    LDS_WAIT(); asm volatile("" ::: "memory");
}
DI void norm_row_to_bf16(const float* xr, const float* g, bf16_t* orow, int lane) {
    f32x4 v[8]; float s = 0.f;
#pragma unroll
    for (int j = 0; j < 8; ++j) { v[j] = ((const f32x4*)xr)[lane + 64 * j]; s += (v[j].x * v[j].x + v[j].y * v[j].y) + (v[j].z * v[j].z + v[j].w * v[j].w); }
    const float r = rsqrtf(wave_sum(s) * (1.f / D) + NORM_EPS);
#pragma unroll
    for (int j = 0; j < 8; ++j) { const f32x4 gg = ((const f32x4*)g)[lane + 64 * j]; u32x2 w; w.x = pk2(v[j].x * r * gg.x, v[j].y * r * gg.y); w.y = pk2(v[j].z * r * gg.z, v[j].w * r * gg.w);
        ((u32x2*)orow)[lane + 64 * j] = w; }
}
constexpr int CV_IN = (D / 64) * (NINP / 32), CV_OUT = (D / 64) * (D / 32), CV_G = (D / 64) * (DFF / 32), CV_D = (DFF / 64) * (D / 32), CV_LAYER = CV_IN + CV_OUT + 2 * CV_G + CV_D;
DI void convert_range(const Ctx& c, int lo, int hi, int gw, int NGW) {
    const Args& a = *c.a;
    LAS float* scr = (LAS float*)(c.lds + c.wave * 16384);
    for (int it = lo + gw; it < hi; it += NGW) {
        const int l = it / CV_LAYER; int r = it - l * CV_LAYER;
        if (r < CV_IN) { transpose_item<0>(inp(a, I_WIN) + (size_t)l * D * NIN, D, NIN, NINP / 32, (bf16_t*)(c.ws + WS_WIN + l * SZ_WIN), scr, r, c.lane); continue; } r -= CV_IN;
        if (r < CV_OUT) { transpose_item<0>(inp(a, I_WOUT) + (size_t)l * D * D, D, D, D / 32, (bf16_t*)(c.ws + WS_WOUT + l * SZ_WOUT), scr, r, c.lane); continue; } r -= CV_OUT;
        if (r < CV_G) { transpose_item<1>(inp(a, I_WG) + (size_t)l * D * DFF, D, DFF, DFF / 32, (bf16_t*)(c.ws + WS_WGU + l * SZ_WGU), scr, r, c.lane); continue; } r -= CV_G;
        if (r < CV_G) { transpose_item<2>(inp(a, I_WU) + (size_t)l * D * DFF, D, DFF, DFF / 32, (bf16_t*)(c.ws + WS_WGU + l * SZ_WGU), scr, r, c.lane); continue; } r -= CV_G;
        transpose_item<0>(inp(a, I_WD) + (size_t)l * DFF * D, DFF, D, D / 32, (bf16_t*)(c.ws + WS_WDN + l * SZ_WDN), scr, r, c.lane);
    }
}
DI void phase_p0(const Ctx& c0) {
    const Ctx c = fresh(c0);
    const Args& a = *c.a;
    const int gw = c.bid * 8 + c.wave, NGW = c.G * 8;
    convert_range(c, 0, CV_IN, gw, NGW);
    bf16_t* hb = (bf16_t*)(c.ws + WS_HBUF);
    { const float* xp = inp(a, I_XP); const float* xs = inp(a, I_XS); const float* g1 = inp(a, I_LN1);
      for (int m = gw; m < MT; m += NGW) norm_row_to_bf16(m < NP ? xp + (size_t)m * D : xs + (size_t)(m - NP) * D, g1, hb + (size_t)m * D, c.lane); }
    for (int i = gw * 64 + c.lane; i < (MPAD - MT) * D / 8; i += NGW * 64) {
        ((u32x4*)(hb + (size_t)MT * D))[i] = (u32x4){0u, 0u, 0u, 0u};
        ((u32x4*)((bf16_t*)(c.ws + WS_MIXO) + (size_t)MT * D))[i] = (u32x4){0u, 0u, 0u, 0u};
    }
}

DI void row_phase(const Ctx& c0, const float* y, const float* slabs, const float* xa, const float* xb, float* xout, const float* g_post, const float* g_next, bf16_t* hb) {
    const Ctx c = fresh(c0);
    const int gw = c.bid * 8 + c.wave, NGW = c.G * 8, lane = c.lane;
    for (int m = gw; m < MT; m += NGW) {
        const float* xr = m < NP ? xa + (size_t)m * D : xb + (size_t)(m - NP) * D;
        f32x4 v[8]; float s = 0.f;
        if (m < NP) { const float* yr = y + (size_t)m * D;
#pragma unroll
            for (int j = 0; j < 8; ++j) v[j] = ((const f32x4*)yr)[lane + 64 * j];
        } else { const float* yr = slabs + (size_t)(m - NP) * D;
#pragma unroll
            for (int j = 0; j < 8; ++j) v[j] = ((const f32x4*)yr)[lane + 64 * j];
#pragma unroll 1
            for (int ks = 1; ks < 8; ++ks) {
#pragma unroll
                for (int j = 0; j < 8; ++j) v[j] = v[j] + ((const f32x4*)(yr + (size_t)ks * NS * D))[lane + 64 * j]; }
        }
#pragma unroll
        for (int j = 0; j < 8; ++j) s += (v[j].x * v[j].x + v[j].y * v[j].y) + (v[j].z * v[j].z + v[j].w * v[j].w);
        const float r = rsqrtf(wave_sum(s) * (1.f / D) + NORM_EPS);
        float s2 = 0.f;
#pragma unroll
        for (int j = 0; j < 8; ++j) { const f32x4 gg = ((const f32x4*)g_post)[lane + 64 * j]; const f32x4 xx = ((const f32x4*)xr)[lane + 64 * j];
            v[j] = xx + v[j] * r * gg; s2 += (v[j].x * v[j].x + v[j].y * v[j].y) + (v[j].z * v[j].z + v[j].w * v[j].w);
            ((f32x4*)(xout + (size_t)m * D))[lane + 64 * j] = v[j]; }
        if (g_next) {
            const float r2 = rsqrtf(wave_sum(s2) * (1.f / D) + NORM_EPS);
#pragma unroll
            for (int j = 0; j < 8; ++j) { const f32x4 gg = ((const f32x4*)g_next)[lane + 64 * j]; u32x2 w; w.x = pk2(v[j].x * r2 * gg.x, v[j].y * r2 * gg.y); w.y = pk2(v[j].z * r2 * gg.z, v[j].w * r2 * gg.w);
                ((u32x2*)(hb + (size_t)m * D))[lane + 64 * j] = w; }
        }
    }
}

DI void sample_pieces(const Ctx& c0, const bf16_t* A  , const bf16_t* Bt  , int K, float* slabs) {
    const Ctx c = fresh(c0); const int lane = c.lane, wave = c.wave, i = lane & 15, g = lane >> 4;
    const int klen = K / 8;
    for (int p = c.bid; p < 256; p += c.G) {
        const int jt = p & 31, ks = p >> 5, k0 = ks * klen;
        const bf16_t* ap = A + (size_t)(16 * wave + i) * K + k0 + 8 * g;
        const bf16_t* bp = Bt + (size_t)(64 * jt + i) * K + k0 + 8 * g;
        f32x4 acc[4];
#pragma unroll
        for (int q = 0; q < 4; ++q) acc[q] = (f32x4){0.f, 0.f, 0.f, 0.f};
#pragma unroll 4
        for (int kk = 0; kk < klen; kk += 32) {
            const bf16x8 av = *(const bf16x8*)(ap + kk);
#pragma unroll
            for (int q = 0; q < 4; ++q) acc[q] = MFMA16(av, *(const bf16x8*)(bp + (size_t)16 * q * K + kk), acc[q]);
        }
        float* so = slabs + (size_t)ks * NS * D + (size_t)(16 * wave + 4 * g) * D + 64 * jt + i;
#pragma unroll
        for (int q = 0; q < 4; ++q)
#pragma unroll
            for (int r = 0; r < 4; ++r) so[(size_t)r * D + 16 * q] = acc[q][r];
    }
}

DI int perm32(int x) { return 8 * ((x >> 2) & 3) + 4 * (x >> 4) + (x & 3); }
DI int kpos(int k) { return (k & ~31) + perm32(k & 31); }
DI float lb_of(const Args& a, int l, int c) { if (l == 0) return 0.f; const float l0 = inp(a, I_LB)[c], l1 = inp(a, I_LB)[512 + c]; return 1.f / (1.f + __expf(l0 - l1)); }
DI bf16_t bf1(float x) { return (bf16_t)(pk2(x, 0.f) & 0xffffu); }

constexpr size_t IB_W = WS_MIXF, IB_Q = IB_W + 16 * MiB, IB_KT = IB_Q + 16 * MiB, IB_P = IB_KT + 16 * MiB, IB_U0 = IB_P + 8 * MiB,
                 IA_Q = IB_U0 + 32 * MiB, IA_KT = IA_Q + 8 * MiB, IA_P = IA_KT + 8 * MiB, IA_V = IA_P + 4 * MiB,
                 IC_A = IA_V + 16 * MiB, IC_B = IC_A + 16 * MiB, IMISC = IC_B + 16 * MiB, IB_DEC = IMISC, IA_DEC = IMISC + 65536, IC_TOT = IMISC + 524288, I_END = IMISC + 1 * MiB;
static_assert(I_END <= WS_END, "mixer intermediates must fit");
constexpr size_t WS_SLAB = WS_X1 + SZ_MIXF;
static_assert(WS_SLAB + 8 * MiB <= WS_END, "slabs");

DI void m1_unit_b(const Ctx& c0, int l, int u) {
    const Ctx c = fresh(c0); const Args& a = *c.a; const int tid = c.tid, lane = c.lane, wave = c.wave;
    const int b = u >> 8, h = (u >> 5) & 7, ci = u & 31;
    LAS float* Kf = (LAS float*)c.lds;
    LAS float* Vf = Kf + 8192;
    LAS float* Qf = Vf + 8192;
    LAS float* Amat = Qf;
    LAS bf16_t* Pl = (LAS bf16_t*)(Qf + 64 * 68);
    LAS bf16_t* Qb = (LAS bf16_t*)(Qf + 8192);
    LAS bf16_t* Kb = Qb + 64 * 136;
    LAS float* scal = (LAS float*)(Kb + 64 * 136);
    const float* proj = (const float*)(c.ws + WS_PROJ);
    const long rowb = (long)b * SEQ + 64 * ci; const int tg0 = 64 * ci;
    {
        const float* cw = inp(a, I_BCW) + (size_t)l * 4 * 3072;
        const int idx = tid & 127, tq = tid >> 7;
        float x[3][19], w[3][4];
#pragma unroll
        for (int p = 0; p < 3; ++p) { const int ch = p * 1024 + h * 128 + idx;
#pragma unroll
            for (int j = 0; j < 4; ++j) w[p][j] = cw[j * 3072 + ch];
#pragma unroll
            for (int j = 0; j < 19; ++j) { const int t = 16 * tq - 3 + j; x[p][j] = (tg0 + t >= 0) ? proj[(rowb + t) * NINP + C_BQ + ch] : 0.f; } }
#pragma unroll
        for (int p = 0; p < 3; ++p) { LAS float* dst = (p == 0 ? Qf : (p == 1 ? Kf : Vf)) + idx;
#pragma unroll
            for (int i = 0; i < 16; ++i) dst[(16 * tq + i) * 128] = silu(w[p][0] * x[p][i] + w[p][1] * x[p][i + 1] + w[p][2] * x[p][i + 2] + w[p][3] * x[p][i + 3]); }
    }
    __syncthreads();
    for (int i = 0; i < 8; ++i) { const int t = wave * 8 + i; const float q0 = Qf[t * 128 + lane], q1 = Qf[t * 128 + 64 + lane], k0 = Kf[t * 128 + lane], k1 = Kf[t * 128 + 64 + lane];
        const float sq = wave_sum(q0 * q0 + q1 * q1), sk = wave_sum(k0 * k0 + k1 * k1);
        if (lane == 0) { scal[t * 8 + 3] = rsqrtf(sq + L2_EPS) * 0.08838834764831845f; scal[t * 8 + 4] = rsqrtf(sk + L2_EPS); } }
    if (wave == 0) { const int t = lane; const float bb = proj[(rowb + t) * NINP + C_BB + h], ba = proj[(rowb + t) * NINP + C_BA + h];
        const float gt = -__expf(inp(a, I_BALOG)[l * 8 + h]) * softplus(ba + inp(a, I_BDT)[l * 8 + h]);
        float x = gt;
#pragma unroll
        for (int o = 1; o < 64; o <<= 1) { const float y = __shfl_up(x, o); if (lane >= o) x += y; }
        const float bC = __shfl(x, 63);
        scal[t * 8 + 0] = sigm(bb); scal[t * 8 + 1] = x; scal[t * 8 + 2] = __expf(x); scal[t * 8 + 5] = __expf(bC - x);
        if (lane == 63) ((float*)(c.ws + IB_DEC))[u] = __expf(x); }
    __syncthreads();
    {
        const int t = tid >> 3, d0 = (tid & 7) * 16; const float sq = scal[t * 8 + 3], sk = scal[t * 8 + 4], s2 = sq * scal[t * 8 + 2];
        bf16_t* gq = (bf16_t*)(c.ws + IB_Q) + ((size_t)u * 64 + t) * 128;
#pragma unroll
        for (int m = 0; m < 4; ++m) { const int d = d0 + 4 * m; const f32x4 q = *(const LAS f32x4*)(Qf + t * 128 + d), k = *(const LAS f32x4*)(Kf + t * 128 + d);
            *(LAS u32x2*)(Qb + t * 136 + d) = (u32x2){pk2(q.x * sq, q.y * sq), pk2(q.z * sq, q.w * sq)};
            *(LAS u32x2*)(Kb + t * 136 + d) = (u32x2){pk2(k.x * sk, k.y * sk), pk2(k.z * sk, k.w * sk)};
            *(u32x2*)(gq + kpos(d)) = (u32x2){pk2(q.x * s2, q.y * s2), pk2(q.z * s2, q.w * s2)}; }
    }
    __syncthreads();
    {
        const int i = lane & 15, g = lane >> 4;
#pragma unroll
        for (int q2 = 0; q2 < 2; ++q2) { const int idx = 2 * wave + q2, tt = idx >> 2, st = idx & 3; const int s = 16 * st + i;
            if (st <= tt) {
                f32x4 akk = {0.f, 0.f, 0.f, 0.f}, aqk = {0.f, 0.f, 0.f, 0.f};
#pragma unroll
                for (int ks = 0; ks < 4; ++ks) { const bf16x8 bk = *(const LAS bf16x8*)(Kb + (16 * st + i) * 136 + 32 * ks + 8 * g);
                    const bf16x8 ak = *(const LAS bf16x8*)(Kb + (16 * tt + i) * 136 + 32 * ks + 8 * g), aq = *(const LAS bf16x8*)(Qb + (16 * tt + i) * 136 + 32 * ks + 8 * g);
                    akk = MFMA16(ak, bk, akk); aqk = MFMA16(aq, bk, aqk); }
                const float bs = scal[s * 8 + 1];
#pragma unroll
                for (int r = 0; r < 4; ++r) { const int t = 16 * tt + 4 * g + r; const float gam = __expf(fminf(scal[t * 8 + 1] - bs, 0.f));
                    Amat[t * 68 + s] = (s < t) ? scal[t * 8 + 0] * akk[r] * gam : 0.f;
                    Pl[t * 72 + kpos(s)] = bf1((s <= t) ? aqk[r] * gam : 0.f); }
            } else {
#pragma unroll
                for (int r = 0; r < 4; ++r) Pl[(16 * tt + 4 * g + r) * 72 + kpos(s)] = 0;
            }
        }
    }
    __syncthreads();
    if (tid < 256) {
        float R[64];
        int zoff = 0; asm volatile("" : "+v"(zoff));
        const LAS float* Am = Amat + zoff; const LAS float* sc = scal + zoff;
        if (tid < 128) {
#pragma unroll
            for (int t = 0; t < 64; ++t) R[t] = sc[t * 8 + 0] * Vf[t * 128 + tid];
        } else {
#pragma unroll
            for (int t = 0; t < 64; ++t) R[t] = sc[t * 8 + 0] * sc[t * 8 + 2] * sc[t * 8 + 4] * Kf[t * 128 + tid - 128];
        }
#pragma unroll
        for (int t = 1; t < 64; ++t) { float acc = R[t];
#pragma unroll
            for (int s4 = 0; s4 < (t + 3) / 4; ++s4) { const f32x4 a4 = *(const LAS f32x4*)(Am + t * 68 + 4 * s4);
                acc -= a4.x * R[4 * s4];
                if (4 * s4 + 1 < t) acc -= a4.y * R[4 * s4 + 1];
                if (4 * s4 + 2 < t) acc -= a4.z * R[4 * s4 + 2];
                if (4 * s4 + 3 < t) acc -= a4.w * R[4 * s4 + 3]; }
            R[t] = acc; }
        if (tid < 128) { const int w = tid >> 4, i = tid & 15; float* g0 = (float*)(c.ws + IB_U0) + (size_t)u * 8192;
#pragma unroll
            for (int st = 0; st < 4; ++st)
#pragma unroll
                for (int g = 0; g < 4; ++g) *(f32x4*)(g0 + ((st * 8 + w) * 64 + i + 16 * g) * 4) = (f32x4){R[16 * st + 4 * g], R[16 * st + 4 * g + 1], R[16 * st + 4 * g + 2], R[16 * st + 4 * g + 3]};
        } else { bf16_t* gw = (bf16_t*)(c.ws + IB_W) + (size_t)u * 8192 + kpos(tid - 128);
#pragma unroll
            for (int t = 0; t < 64; ++t) gw[t * 128] = bf1(R[t]); }
    } else {
#pragma unroll
        for (int k = 0; k < 2; ++k) { const int p = (tid - 256) + 256 * k, row = p >> 3, c16 = p & 7;
            *(u32x4*)((bf16_t*)(c.ws + IB_P) + (size_t)u * 4096 + row * 64 + c16 * 8) = *(const LAS u32x4*)(Pl + row * 72 + c16 * 8); }
        LAS bf16_t* KTs = Qb; const int d = tid & 127, s0 = ((tid >> 7) & 1) * 32;
#pragma unroll
        for (int m = 0; m < 8; ++m) { float v[4];
#pragma unroll
            for (int j = 0; j < 4; ++j) { const int s = s0 + 4 * m + j; v[j] = Kf[s * 128 + d] * scal[s * 8 + 4] * scal[s * 8 + 5]; }
            *(LAS u32x2*)(KTs + d * 72 + kpos(s0 + 4 * m)) = (u32x2){pk2(v[0], v[1]), pk2(v[2], v[3])}; }
    }
    __syncthreads();
#pragma unroll
    for (int k = 0; k < 2; ++k) { const int p = tid + 512 * k, row = p >> 3, c16 = p & 7;
        *(u32x4*)((bf16_t*)(c.ws + IB_KT) + (size_t)u * 8192 + row * 64 + c16 * 8) = *(const LAS u32x4*)(Qb + row * 72 + c16 * 8); }
    __syncthreads();
}

DI void m1_unit_a(const Ctx& c0, int l, int u) {
    const Ctx c = fresh(c0); const Args& a = *c.a; const int tid = c.tid, lane = c.lane, wave = c.wave;
    const int b = u >> 7, h = (u >> 5) & 3, ci = u & 31;
    LAS float* Bf = (LAS float*)c.lds;
    LAS float* Qf = Bf + 8192;
    LAS float* Kf = Qf + 8192;
    LAS bf16_t* Pl = (LAS bf16_t*)Qf;
    LAS bf16_t* Qh = (LAS bf16_t*)(Kf + 8192);
    LAS bf16_t* Kd = Qh + 64 * 136;
    LAS bf16_t* Ko = Kd + 64 * 136;
    LAS float* tot = (LAS float*)(Ko + 32 * 136);
    const float* proj = (const float*)(c.ws + WS_PROJ);
    const long rowb = (long)b * SEQ + 64 * ci;
    {
        float* gv = (float*)(c.ws + IA_V) + (size_t)u * 8192;
        const int idx = tid & 127, tq = tid >> 7;
        float x[3][16];
#pragma unroll
        for (int i = 0; i < 16; ++i) { const float* pr = proj + (rowb + 16 * tq + i) * NINP + h * 128 + idx; x[0][i] = pr[C_AF]; x[1][i] = pr[C_AQ]; x[2][i] = pr[C_AI]; }
        const float lb = lb_of(a, l, h * 128 + idx);
#pragma unroll
        for (int i = 0; i < 16; ++i) { const int t = 16 * tq + i; const float f = lb + (1.f - lb) * sigm(x[0][i]);
            Bf[t * 128 + idx] = fmaxf(__logf(f), -80.f); Kf[t * 128 + idx] = 1.f - f; Qf[t * 128 + idx] = silu(x[1][i]);
            gv[(((t >> 4) * 8 + (idx >> 4)) * 64 + (idx & 15) + 16 * ((t >> 2) & 3)) * 4 + (t & 3)] = x[2][i]; }
    }
    __syncthreads();
    {
        const int d = tid & 127, q4 = tid >> 7; float run = 0.f;
#pragma unroll
        for (int i = 0; i < 16; ++i) { run += Bf[(16 * q4 + i) * 128 + d]; Bf[(16 * q4 + i) * 128 + d] = run; }
        tot[q4 * 128 + d] = run;
        __syncthreads();
        float off = 0.f;
        for (int q = 0; q < q4; ++q) off += tot[q * 128 + d];
        if (q4 > 0) {
#pragma unroll
            for (int i = 0; i < 16; ++i) Bf[(16 * q4 + i) * 128 + d] += off; }
    }
    __syncthreads();
    {
        const int t = tid >> 3, d0 = (tid & 7) * 16; bf16_t* gq = (bf16_t*)(c.ws + IA_Q) + ((size_t)u * 64 + t) * 128;
#pragma unroll
        for (int m = 0; m < 4; ++m) { const int d = d0 + 4 * m; const f32x4 bb = *(const LAS f32x4*)(Bf + t * 128 + d), q = *(const LAS f32x4*)(Qf + t * 128 + d), k = *(const LAS f32x4*)(Kf + t * 128 + d);
            const f32x4 b31 = *(const LAS f32x4*)(Bf + 31 * 128 + d); const f32x4 rr = (t >= 32) ? b31 : (f32x4){0.f, 0.f, 0.f, 0.f};
            *(u32x2*)(gq + kpos(d)) = (u32x2){pk2(q.x * __expf(bb.x), q.y * __expf(bb.y)), pk2(q.z * __expf(bb.z), q.w * __expf(bb.w))};
            *(LAS u32x2*)(Qh + t * 136 + d) = (u32x2){pk2(q.x * __expf(bb.x - rr.x), q.y * __expf(bb.y - rr.y)), pk2(q.z * __expf(bb.z - rr.z), q.w * __expf(bb.w - rr.w))};
            *(LAS u32x2*)(Kd + t * 136 + d) = (u32x2){pk2(k.x * __expf(fminf(rr.x - bb.x, 80.f)), k.y * __expf(fminf(rr.y - bb.y, 80.f))), pk2(k.z * __expf(fminf(rr.z - bb.z, 80.f)), k.w * __expf(fminf(rr.w - bb.w, 80.f)))};
            if (t < 32) *(LAS u32x2*)(Ko + t * 136 + d) = (u32x2){pk2(k.x * __expf(b31.x - bb.x), k.y * __expf(b31.y - bb.y)), pk2(k.z * __expf(b31.z - bb.z), k.w * __expf(b31.w - bb.w))}; }
        const int d = tid & 127, s0 = (tid >> 7) * 16; bf16_t* gk = (bf16_t*)(c.ws + IA_KT) + ((size_t)u * 128 + d) * 64; const float bC = Bf[63 * 128 + d];
#pragma unroll
        for (int m = 0; m < 4; ++m) { float v[4];
#pragma unroll
            for (int j = 0; j < 4; ++j) { const int s = s0 + 4 * m + j; v[j] = Kf[s * 128 + d] * __expf(bC - Bf[s * 128 + d]); }
            *(u32x2*)(gk + kpos(s0 + 4 * m)) = (u32x2){pk2(v[0], v[1]), pk2(v[2], v[3])}; }
        if (tid < 128) ((float*)(c.ws + IA_DEC))[(size_t)u * 128 + tid] = __expf(bC);
    }
    __syncthreads();
    {
        const int i = lane & 15, g = lane >> 4;
#pragma unroll
        for (int q2 = 0; q2 < 2; ++q2) { const int idx = 2 * wave + q2, tt = idx >> 2, st = idx & 3, I = tt >> 1, J = st >> 1; const int s = 16 * st + i;
            if (J <= I) {
                const LAS bf16_t* bsrc = (I == J ? Kd : Ko) + (16 * st + i) * 136;
                f32x4 acc = {0.f, 0.f, 0.f, 0.f};
#pragma unroll
                for (int ks = 0; ks < 4; ++ks) acc = MFMA16(*(const LAS bf16x8*)(Qh + (16 * tt + i) * 136 + 32 * ks + 8 * g), *(const LAS bf16x8*)(bsrc + 32 * ks + 8 * g), acc);
#pragma unroll
                for (int r = 0; r < 4; ++r) { const int t = 16 * tt + 4 * g + r; Pl[t * 72 + kpos(s)] = bf1((s <= t) ? acc[r] : 0.f); }
            } else {
#pragma unroll
                for (int r = 0; r < 4; ++r) Pl[(16 * tt + 4 * g + r) * 72 + kpos(s)] = 0;
            }
        }
    }
    __syncthreads();
    { const int row = tid >> 3, c16 = tid & 7; *(u32x4*)((bf16_t*)(c.ws + IA_P) + (size_t)u * 4096 + row * 64 + c16 * 8) = *(const LAS u32x4*)(Pl + row * 72 + c16 * 8); }
    __syncthreads();
}

DI void m1_unit_c(const Ctx& c0, int l, int u) {
    const Ctx c = fresh(c0); const Args& a = *c.a; const int tid = c.tid;
    const int b = u >> 7, n = (u >> 4) & 7, ti = u & 15;
    constexpr int TT = 128;
    LAS float* xcv = (LAS float*)c.lds;
    LAS float* ra = xcv + TT * 64;
    LAS float* ia = ra + TT * 64;
    LAS float* segA = ia + TT * 64;
    LAS float* segB = segA + 512;
    const float* proj = (const float*)(c.ws + WS_PROJ);
    const long rowb = (long)b * SEQ + TT * ti; const int tg0 = TT * ti;
    const int j = tid & 63, g = (tid >> 6) & 1, tg = tid >> 7;
    const float* wsrc = (g ? inp(a, I_CWX) : inp(a, I_CWA)) + ((size_t)l * 8 + n) * 4096 + j;
    float wreg[64];
#pragma unroll
    for (int i = 0; i < 64; ++i) wreg[i] = wsrc[i * 64];
    const float gbias = (g ? inp(a, I_CBX) : inp(a, I_CBA))[l * 512 + n * 64 + j];
    const int cch = tid & 63, seg = tid >> 6, chg = n * 64 + cch;
    {
        const float* ccw = inp(a, I_CCW) + (size_t)l * 4 * 512;
        const float w0 = ccw[chg], w1 = ccw[512 + chg], w2 = ccw[1024 + chg], w3 = ccw[1536 + chg], cb = inp(a, I_CCB)[l * 512 + chg];
        const int ts = seg * 16; const int col = C_CX + chg;
        float x[19];
#pragma unroll
        for (int jx = 0; jx < 19; ++jx) { const int t = ts - 3 + jx; x[jx] = (tg0 + t >= 0) ? proj[(rowb + t) * NINP + col] : 0.f; }
#pragma unroll
        for (int i = 0; i < 16; ++i) xcv[(ts + i) * 64 + cch] = w0 * x[i] + w1 * x[i + 1] + w2 * x[i + 2] + w3 * x[i + 3] + cb;
    }
    __syncthreads();
    for (int tt = tg * 32; tt < tg * 32 + 32; ++tt) {
        float acc0 = 0.f, acc1 = 0.f;
#pragma unroll
        for (int i = 0; i < 64; i += 4) { const f32x4 x = *(const LAS f32x4*)(xcv + tt * 64 + i); acc0 += x.x * wreg[i] + x.z * wreg[i + 2]; acc1 += x.y * wreg[i + 1] + x.w * wreg[i + 3]; }
        (g ? ia : ra)[tt * 64 + j] = sigm(acc0 + acc1 + gbias);
    }
    __syncthreads();
    const float spl = softplus(-inp(a, I_CLAM)[l * 512 + chg]);
    {
        float A = 1.f, B = 0.f;
        for (int i = 0; i < 16; ++i) { const int tt = seg * 16 + i; const float r = ra[tt * 64 + cch], ig = ia[tt * 64 + cch], x = xcv[tt * 64 + cch];
            const float la = -8.f * r * spl; const float at = __expf(la); float mult = sqrtf(fmaxf(0.f, -expm1f(2.f * la)));
            if (tg0 + tt == 0) mult = 1.f;
            const float bt = mult * (ig * x); ra[tt * 64 + cch] = at; ia[tt * 64 + cch] = bt; A *= at; B = at * B + bt; }
        segA[seg * 64 + cch] = A; segB[seg * 64 + cch] = B;
    }
    __syncthreads();
    {
        float Ac = 1.f, Bc = 0.f;
        for (int s = 0; s < seg; ++s) { const float sa = segA[s * 64 + cch], sb = segB[s * 64 + cch]; Bc = sa * Bc + sb; Ac *= sa; }
        float* ga = (float*)(c.ws + IC_A); float* gb = (float*)(c.ws + IC_B);
        for (int i = 0; i < 16; ++i) { const int tt = seg * 16 + i; const float at = ra[tt * 64 + cch], bt = ia[tt * 64 + cch]; Ac *= at; Bc = at * Bc + bt;
            ga[(rowb + tt) * 512 + chg] = Ac; gb[(rowb + tt) * 512 + chg] = Bc; }
        if (seg == 7) { float* gt = (float*)(c.ws + IC_TOT) + (((size_t)b * 16 + ti) * 2) * 512; gt[chg] = Ac; gt[512 + chg] = Bc; }
    }
    __syncthreads();
}

DI void phase_m1(const Ctx& c, int l) {
    int w = blockIdx.x; asm volatile("" : "+s"(w));
    for (int rep = 0; rep < (PROBE_SUB == 1 ? 2 : 1); ++rep) for (int u = w; u < 1024; u += c.G) m1_unit_b(c, l, u);
    for (int rep = 0; rep < (PROBE_SUB == 2 ? 2 : 1); ++rep) for (int u = w; u < 512; u += c.G) m1_unit_a(c, l, u);
    for (int rep = 0; rep < (PROBE_SUB == 3 ? 2 : 1); ++rep) for (int u = w; u < 512; u += c.G) m1_unit_c(c, l, u);
}

DI void m2_unit_head(const Ctx& c0, int l, int isB, int b, int h) {
    const Ctx c = fresh(c0); const Args& a = *c.a; const int tid = c.tid, lane = c.lane, wave = c.wave;
    LAS unsigned char* Wl = c.lds;
    LAS unsigned char* Ql = Wl + 64 * 272;
    LAS unsigned char* KTl = Ql + 64 * 272;
    LAS unsigned char* Pl = KTl + 128 * 144;
    LAS float* ob = (LAS float*)(Pl + 64 * 144);
    LAS float* decl = ob + 64 * 132;
    const int i = lane & 15, g = lane >> 4, e0 = 16 * wave;
    const int ubase = isB ? ((b * 8 + h) * 32) : ((b * 4 + h) * 32);
    const unsigned char* gW = c.ws + IB_W; const unsigned char* gQ = c.ws + (isB ? IB_Q : IA_Q); const unsigned char* gKT = c.ws + (isB ? IB_KT : IA_KT);
    const unsigned char* gP = c.ws + (isB ? IB_P : IA_P); const float* gU = (const float*)(c.ws + (isB ? IB_U0 : IA_V));
    const float* proj = (const float*)(c.ws + WS_PROJ); bf16_t* mixo = (bf16_t*)(c.ws + WS_MIXO);
    const float* nw = (isB ? inp(a, I_BNORM) : inp(a, I_ANORM)) + l * 128;
    const int gcol = isB ? (C_BZ + h * 128) : (C_AG + h * 128), ocol = isB ? (512 + h * 128) : (h * 128);
    const float nw0 = nw[2 * lane], nw1 = nw[2 * lane + 1];
    f32x4 S[8];
#pragma unroll
    for (int dt = 0; dt < 8; ++dt) S[dt] = (f32x4){0.f, 0.f, 0.f, 0.f};
    u32x4 pw[2], pq[2], pk[2], pp, pd = {0u, 0u, 0u, 0u};
    const int r16 = tid >> 4, c16 = tid & 15, r8 = tid >> 3, c8 = tid & 7;
#define M2_LOAD(ch) do { const size_t uu = (size_t)(ubase + (ch)); \
        if (isB) { pw[0] = *(const u32x4*)(gW + uu * 16384 + tid * 16); pw[1] = *(const u32x4*)(gW + uu * 16384 + (tid + 512) * 16); } \
        pq[0] = *(const u32x4*)(gQ + uu * 16384 + tid * 16); pq[1] = *(const u32x4*)(gQ + uu * 16384 + (tid + 512) * 16); \
        pk[0] = *(const u32x4*)(gKT + uu * 16384 + tid * 16); pk[1] = *(const u32x4*)(gKT + uu * 16384 + (tid + 512) * 16); \
        pp = *(const u32x4*)(gP + uu * 8192 + tid * 16); \
        if (!isB && tid < 32) pd = *(const u32x4*)(c.ws + IA_DEC + uu * 512 + tid * 16); } while (0)
#define M2_STORE() do { \
        if (isB) { *(LAS u32x4*)(Wl + r16 * 272 + c16 * 16) = pw[0]; *(LAS u32x4*)(Wl + (r16 + 32) * 272 + c16 * 16) = pw[1]; } \
        *(LAS u32x4*)(Ql + r16 * 272 + c16 * 16) = pq[0]; *(LAS u32x4*)(Ql + (r16 + 32) * 272 + c16 * 16) = pq[1]; \
        *(LAS u32x4*)(KTl + r8 * 144 + c8 * 16) = pk[0]; *(LAS u32x4*)(KTl + (r8 + 64) * 144 + c8 * 16) = pk[1]; \
        *(LAS u32x4*)(Pl + r8 * 144 + c8 * 16) = pp; \
        if (!isB && tid < 32) *(LAS u32x4*)((LAS unsigned char*)decl + tid * 16) = pd; } while (0)
    M2_LOAD(0);
    M2_STORE();
    f32x4 U[4], Un[4]; f32x2 gt[8], gtn[8]; float dec = 0.f, decn = 0.f;
#define M2_LOADR(ch, UU, GT, DEC) do { const size_t uu_ = (size_t)(ubase + (ch)); const long row_ = (long)b * SEQ + 64 * (ch); \
        _Pragma("unroll") for (int tt = 0; tt < 4; ++tt) UU[tt] = *(const f32x4*)(gU + uu_ * 8192 + ((tt * 8 + wave) * 64 + lane) * 4); \
        _Pragma("unroll") for (int k = 0; k < 8; ++k) GT[k] = *(const f32x2*)(proj + (row_ + 8 * wave + k) * NINP + gcol + 2 * lane); \
        if (isB) DEC = ((const float*)(c.ws + IB_DEC))[uu_]; } while (0)
    M2_LOADR(0, U, gt, dec);
    __syncthreads();
    for (int ci = 0; ci < 32; ++ci) {
        const long row0 = (long)b * SEQ + 64 * ci;
        asm volatile("" : "+v"(U[0]), "+v"(U[1]), "+v"(U[2]), "+v"(U[3]), "+v"(dec));
        asm volatile("" : "+v"(gt[0]), "+v"(gt[1]), "+v"(gt[2]), "+v"(gt[3]), "+v"(gt[4]), "+v"(gt[5]), "+v"(gt[6]), "+v"(gt[7]));
        if (ci + 1 < 32) { M2_LOAD(ci + 1); M2_LOADR(ci + 1, Un, gtn, decn); }
        bf16x8 Sb[4];
#pragma unroll
        for (int ks = 0; ks < 4; ++ks) { u32x4 p; p.x = pk2(S[2 * ks][0], S[2 * ks][1]); p.y = pk2(S[2 * ks][2], S[2 * ks][3]); p.z = pk2(S[2 * ks + 1][0], S[2 * ks + 1][1]); p.w = pk2(S[2 * ks + 1][2], S[2 * ks + 1][3]); Sb[ks] = __builtin_bit_cast(bf16x8, p); }
        if (isB) {
#pragma unroll
            for (int tt = 0; tt < 4; ++tt) { f32x4 acc = {0.f, 0.f, 0.f, 0.f};
#pragma unroll
                for (int ks = 0; ks < 4; ++ks) acc = MFMA16(*(const LAS bf16x8*)(Wl + (16 * tt + i) * 272 + (32 * ks + 8 * g) * 2), Sb[ks], acc);
                U[tt] = U[tt] - acc; }
        }
        bf16x8 Ub[2];
#pragma unroll
        for (int k = 0; k < 2; ++k) { u32x4 p; p.x = pk2(U[2 * k][0], U[2 * k][1]); p.y = pk2(U[2 * k][2], U[2 * k][3]); p.z = pk2(U[2 * k + 1][0], U[2 * k + 1][1]); p.w = pk2(U[2 * k + 1][2], U[2 * k + 1][3]); Ub[k] = __builtin_bit_cast(bf16x8, p); }
#pragma unroll
        for (int tt = 0; tt < 4; ++tt) { f32x4 acc = {0.f, 0.f, 0.f, 0.f};
#pragma unroll
            for (int ks = 0; ks < 4; ++ks) acc = MFMA16(*(const LAS bf16x8*)(Ql + (16 * tt + i) * 272 + (32 * ks + 8 * g) * 2), Sb[ks], acc);
#pragma unroll
            for (int k = 0; k < 2; ++k) acc = MFMA16(*(const LAS bf16x8*)(Pl + (16 * tt + i) * 144 + (32 * k + 8 * g) * 2), Ub[k], acc);
#pragma unroll
            for (int r = 0; r < 4; ++r) ob[(16 * tt + 4 * g + r) * 132 + e0 + i] = acc[r]; }
        if (isB) {
#pragma unroll
            for (int dt = 0; dt < 8; ++dt) S[dt] = S[dt] * dec;
        } else {
#pragma unroll
            for (int dt = 0; dt < 8; ++dt) S[dt] = S[dt] * *(const LAS f32x4*)(decl + 16 * dt + 4 * g); }
#pragma unroll
        for (int dt = 0; dt < 8; ++dt) {
#pragma unroll
            for (int k = 0; k < 2; ++k) S[dt] = MFMA16(*(const LAS bf16x8*)(KTl + (16 * dt + i) * 144 + (32 * k + 8 * g) * 2), Ub[k], S[dt]); }
        __syncthreads();
        { f32x2 vv[8]; float ss[8];
#pragma unroll
          for (int k = 0; k < 8; ++k) vv[k] = *(const LAS f32x2*)(ob + (8 * wave + k) * 132 + 2 * lane);
#pragma unroll
          for (int k = 0; k < 8; ++k) ss[k] = row16_sum(vv[k].x * vv[k].x + vv[k].y * vv[k].y);
#pragma unroll
          for (int k = 0; k < 8; ++k) ss[k] = __int_as_float(__builtin_amdgcn_readlane(__float_as_int(ss[k]), 0)) + __int_as_float(__builtin_amdgcn_readlane(__float_as_int(ss[k]), 16)) +
              __int_as_float(__builtin_amdgcn_readlane(__float_as_int(ss[k]), 32)) + __int_as_float(__builtin_amdgcn_readlane(__float_as_int(ss[k]), 48));
#pragma unroll
          for (int k = 0; k < 8; ++k) { const float r = rsqrtf(ss[k] * (1.f / 128.f) + NORM_EPS);
            *(unsigned*)(mixo + (row0 + 8 * wave + k) * D + ocol + 2 * lane) = pk2(vv[k].x * r * nw0 * silu(gt[k].x), vv[k].y * r * nw1 * silu(gt[k].y)); } }
        if (ci + 1 < 32) { M2_STORE();
#pragma unroll
            for (int tt = 0; tt < 4; ++tt) U[tt] = Un[tt];
#pragma unroll
            for (int k = 0; k < 8; ++k) gt[k] = gtn[k];
            dec = decn; }
        __syncthreads();
    }
#undef M2_LOADR
#undef M2_LOAD
#undef M2_STORE
    float* so = c.out + (isB ? O_GDP + (((size_t)l * BATCH + b) * 8 + h) * 16384 : O_HGP + (((size_t)l * BATCH + b) * 4 + h) * 16384);
#pragma unroll
    for (int dt = 0; dt < 8; ++dt)
#pragma unroll
        for (int r = 0; r < 4; ++r) so[(size_t)(16 * dt + 4 * g + r) * 128 + e0 + i] = S[dt][r];
}

DI void m2_unit_cfin(const Ctx& c0, int l, int u) {
    const Ctx c = fresh(c0); const int tid = c.tid;
    const int b = u >> 7, n = (u >> 4) & 7, ti = u & 15;
    const int cch = tid & 63, seg = tid >> 6, chg = n * 64 + cch;
    const float* proj = (const float*)(c.ws + WS_PROJ); bf16_t* mixo = (bf16_t*)(c.ws + WS_MIXO);
    const float* ga = (const float*)(c.ws + IC_A); const float* gb = (const float*)(c.ws + IC_B);
    const float* gt = (const float*)(c.ws + IC_TOT) + ((size_t)b * 16 * 2) * 512;
    float hs = 0.f;
    for (int k = 0; k < ti; ++k) hs = gt[(k * 2) * 512 + chg] * hs + gt[(k * 2 + 1) * 512 + chg];
    const long rowb = (long)b * SEQ + 128 * ti;
    float hh = 0.f;
#pragma unroll 4
    for (int i = 0; i < 16; ++i) { const long row = rowb + seg * 16 + i; hh = gb[row * 512 + chg] + ga[row * 512 + chg] * hs;
        mixo[row * D + 1536 + chg] = bf1(hh * gelu_tanh(proj[row * NINP + C_CG + chg])); }
    if (ti == 15 && seg == 7) c.out[O_RHP + ((size_t)l * BATCH + b) * 512 + chg] = hh;
}

DI void block_reduce_cols(LAS float* red, LAS float* full, const float (&p)[4], int tid, float scale) {
    const int e4 = (tid & 31) * 4, dgp = tid >> 5;
    *(LAS f32x4*)(red + dgp * 128 + e4) = (f32x4){p[0], p[1], p[2], p[3]};
    __syncthreads();
    if (tid < 128) { float s = 0.f;
#pragma unroll
        for (int k = 0; k < 16; ++k) s += red[k * 128 + tid];
        full[tid] = s * scale; }
    __syncthreads();
}
DI void unit_b_sample(const Ctx& c0, int l, int b, int h) {
    const Ctx c = fresh(c0);
    const Args& a = *c.a; const int tid = c.tid, lane = c.lane, wave = c.wave;
    LAS float* qkv = (LAS float*)c.lds;
    LAS float* scl = qkv + 384;
    LAS float* red = scl + 8;
    LAS float* full = red + 2048;
    LAS float* uu = full + 128;
    const float* proj = (const float*)(c.ws + WS_PROJ) + (size_t)(NP + b) * NINP;
    if (tid < 384) { const int part = tid >> 7, idx = tid & 127, cc = part * 1024 + h * 128 + idx;
        const float* cw = inp(a, I_BCW) + (size_t)l * 4 * 3072; const float* st = inp(a, I_SGC) + (((size_t)l * NS + b) * 3) * 3072;
        const float x0 = st[cc], x1 = st[3072 + cc], x2 = st[2 * 3072 + cc], x3 = proj[C_BQ + cc];
        qkv[tid] = silu(cw[cc] * x0 + cw[3072 + cc] * x1 + cw[2 * 3072 + cc] * x2 + cw[3 * 3072 + cc] * x3);
        float* so = c.out + O_GCS + (((size_t)l * NS + b) * 3) * 3072; so[cc] = x1; so[3072 + cc] = x2; so[2 * 3072 + cc] = x3; }
    if (tid == 384) { const float bb = proj[C_BB + h], ba = proj[C_BA + h]; scl[0] = sigm(bb); scl[1] = __expf(-__expf(inp(a, I_BALOG)[l * 8 + h]) * softplus(ba + inp(a, I_BDT)[l * 8 + h])); }
    __syncthreads();
    if (wave < 2) { const float x0 = qkv[wave * 128 + lane], x1 = qkv[wave * 128 + 64 + lane]; const float ss = wave_sum(x0 * x0 + x1 * x1);
        if (lane == 0) scl[2 + wave] = rsqrtf(ss + L2_EPS) * (wave == 0 ? 0.08838834764831845f : 1.f); }
    __syncthreads();
    const float beta = scl[0], eg = scl[1], sq = scl[2], sk = scl[3];
    const int e4 = (tid & 31) * 4, d0 = (tid >> 5) * 8;
    const size_t sidx = (((size_t)l * NS + b) * 8 + h) * 16384;
    const float* Sin = inp(a, I_SGD) + sidx; float* Sout = c.out + O_GDS + sidx;
    f32x4 S[8]; float p[4] = {0.f, 0.f, 0.f, 0.f};
#pragma unroll
    for (int i = 0; i < 8; ++i) { S[i] = *(const f32x4*)(Sin + (size_t)(d0 + i) * 128 + e4); const float k = qkv[128 + d0 + i]; p[0] += k * S[i].x; p[1] += k * S[i].y; p[2] += k * S[i].z; p[3] += k * S[i].w; }
    block_reduce_cols(red, full, p, tid, sk);
    if (tid < 128) uu[tid] = beta * (qkv[256 + tid] - eg * full[tid]) * sk;
    __syncthreads();
    const f32x4 u4 = *(const LAS f32x4*)(uu + e4);
    float po[4] = {0.f, 0.f, 0.f, 0.f};
#pragma unroll
    for (int i = 0; i < 8; ++i) { const float k = qkv[128 + d0 + i], q = qkv[d0 + i]; S[i] = S[i] * eg + u4 * k; *(f32x4*)(Sout + (size_t)(d0 + i) * 128 + e4) = S[i];
        po[0] += q * S[i].x; po[1] += q * S[i].y; po[2] += q * S[i].z; po[3] += q * S[i].w; }
    block_reduce_cols(red, full, po, tid, sq);
    if (wave < 2) { const float o = full[wave * 64 + lane]; const float ss = wave_sum(o * o); if (lane == 0) scl[4 + wave] = ss; }
    __syncthreads();
    if (tid < 128) { const float rms = rsqrtf((scl[4] + scl[5]) * (1.f / 128.f) + NORM_EPS);
        const float o = full[tid] * rms * inp(a, I_BNORM)[l * 128 + tid] * silu(proj[C_BZ + h * 128 + tid]);
        ((bf16_t*)(c.ws + WS_MIXO))[(size_t)(NP + b) * D + 512 + h * 128 + tid] = (bf16_t)(pk2(o, 0.f) & 0xffffu); }
    __syncthreads();
}
DI void unit_a_sample(const Ctx& c0, int l, int b, int h) {
    const Ctx c = fresh(c0);
    const Args& a = *c.a; const int tid = c.tid, lane = c.lane, wave = c.wave;
    LAS float* fqv = (LAS float*)c.lds;
    LAS float* scl = fqv + 384;
    LAS float* red = scl + 8;
    LAS float* full = red + 2048;
    const float* proj = (const float*)(c.ws + WS_PROJ) + (size_t)(NP + b) * NINP;
    if (tid < 384) { const int part = tid >> 7, idx = tid & 127;
        if (part == 0) { const float lb = lb_of(a, l, h * 128 + idx); fqv[tid] = lb + (1.f - lb) * sigm(proj[C_AF + h * 128 + idx]); }
        else if (part == 1) fqv[tid] = silu(proj[C_AQ + h * 128 + idx]);
        else fqv[tid] = proj[C_AI + h * 128 + idx]; }
    __syncthreads();
    const int e4 = (tid & 31) * 4, d0 = (tid >> 5) * 8;
    const size_t sidx = (((size_t)l * NS + b) * 4 + h) * 16384;
    const float* Sin = inp(a, I_SHG) + sidx; float* Sout = c.out + O_HGS + sidx;
    const f32x4 v4 = *(const LAS f32x4*)(fqv + 256 + e4);
    float po[4] = {0.f, 0.f, 0.f, 0.f};
#pragma unroll
    for (int i = 0; i < 8; ++i) { const float f = fqv[d0 + i], q = fqv[128 + d0 + i]; f32x4 S = *(const f32x4*)(Sin + (size_t)(d0 + i) * 128 + e4);
        S = S * f + v4 * (1.f - f); *(f32x4*)(Sout + (size_t)(d0 + i) * 128 + e4) = S;
        po[0] += q * S.x; po[1] += q * S.y; po[2] += q * S.z; po[3] += q * S.w; }
    block_reduce_cols(red, full, po, tid, 1.f);
    if (wave < 2) { const float o = full[wave * 64 + lane]; const float ss = wave_sum(o * o); if (lane == 0) scl[4 + wave] = ss; }
    __syncthreads();
    if (tid < 128) { const float rms = rsqrtf((scl[4] + scl[5]) * (1.f / 128.f) + NORM_EPS);
        const float o = full[tid] * rms * inp(a, I_ANORM)[l * 128 + tid] * silu(proj[C_AG + h * 128 + tid]);
        ((bf16_t*)(c.ws + WS_MIXO))[(size_t)(NP + b) * D + h * 128 + tid] = (bf16_t)(pk2(o, 0.f) & 0xffffu); }
    __syncthreads();
}
DI void unit_c_sample(const Ctx& c0, int l, int b) {
    const Ctx c = fresh(c0);
    const Args& a = *c.a; const int tid = c.tid;
    LAS float* xc = (LAS float*)c.lds;
    const float* proj = (const float*)(c.ws + WS_PROJ) + (size_t)(NP + b) * NINP;
    const float* ccw = inp(a, I_CCW) + (size_t)l * 4 * 512; const float* st = inp(a, I_SRC) + (((size_t)l * NS + b) * 3) * 512;
    const float x0 = st[tid], x1 = st[512 + tid], x2 = st[1024 + tid], x3 = proj[C_CX + tid];
    const float xv = ccw[tid] * x0 + ccw[512 + tid] * x1 + ccw[1024 + tid] * x2 + ccw[1536 + tid] * x3 + inp(a, I_CCB)[l * 512 + tid];
    xc[tid] = xv;
    { float* so = c.out + O_RCS + (((size_t)l * NS + b) * 3) * 512; so[tid] = x1; so[512 + tid] = x2; so[1024 + tid] = x3; }
    __syncthreads();
    const int n = tid >> 6, j = tid & 63;
    const float* wa = inp(a, I_CWA) + ((size_t)l * 8 + n) * 4096 + j; const float* wx = inp(a, I_CWX) + ((size_t)l * 8 + n) * 4096 + j;
    float sa = 0.f, sx = 0.f;
#pragma unroll 8
    for (int i = 0; i < 64; ++i) { const float x = xc[n * 64 + i]; sa += x * wa[i * 64]; sx += x * wx[i * 64]; }
    const float r = sigm(sa + inp(a, I_CBA)[l * 512 + tid]), ig = sigm(sx + inp(a, I_CBX)[l * 512 + tid]);
    const float la = -8.f * r * softplus(-inp(a, I_CLAM)[l * 512 + tid]); const float at = __expf(la); const float mult = sqrtf(fmaxf(0.f, -expm1f(2.f * la)));
    const float h0 = inp(a, I_SRH)[((size_t)l * NS + b) * 512 + tid];
    const float hh = at * h0 + mult * (ig * xv);
    c.out[O_RHS + ((size_t)l * NS + b) * 512 + tid] = hh;
    ((bf16_t*)(c.ws + WS_MIXO))[(size_t)(NP + b) * D + 1536 + tid] = (bf16_t)(pk2(hh * gelu_tanh(proj[C_CG + tid]), 0.f) & 0xffffu);
    __syncthreads();
}


DI void phase_m2(const Ctx& c, int l) {
    int w = blockIdx.x; asm volatile("" : "+s"(w));
    if (w < 48) {
        const int isB = w < 32; const int u = isB ? w : w - 32;
        for (int rep = 0; rep < (PROBE_SUB == 4 ? 2 : 1); ++rep) m2_unit_head(c, l, isB, isB ? (u >> 3) : (u >> 2), isB ? (u & 7) : (u & 3));
    } else {
        const int nw = c.G - 48;
        for (int rep = 0; rep < (PROBE_SUB == 5 ? 2 : 1); ++rep)
        for (int u = w - 48; u < 512 + 1664; u += nw) {
            if (u < 512) m2_unit_cfin(c, l, u);
            else { const int v = u - 512;
                if (v < 1024) unit_b_sample(c, l, v >> 3, v & 7);
                else if (v < 1536) { const int x = v - 1024; unit_a_sample(c, l, x >> 2, x & 3); }
                else unit_c_sample(c, l, v - 1536); }
        }
        { const Ctx cv = fresh(c); __syncthreads();
          convert_range(cv, l == 0 ? CV_IN : CV_LAYER + CV_IN, l == 0 ? CV_LAYER + CV_IN : 2 * CV_LAYER, (w - 48) * 8 + cv.wave, nw * 8); }
        const Ctx cc = fresh(c); const float* proj = (const float*)(cc.ws + WS_PROJ);
        const int gt_ = (w - 48) * 512 + cc.tid, NT = nw * 512;
        for (int i = gt_; i < BATCH * 3 * 3072; i += NT) { const int b = i / (3 * 3072), r = i - b * 3 * 3072, j = r / 3072, ch = r - j * 3072;
            cc.out[O_GCP + (size_t)l * BATCH * 3 * 3072 + i] = proj[((size_t)b * SEQ + SEQ - 3 + j) * NINP + C_BQ + ch]; }
        for (int i = gt_; i < BATCH * 3 * 512; i += NT) { const int b = i / (3 * 512), r = i - b * 3 * 512, j = r / 512, ch = r - j * 512;
            cc.out[O_RCP + (size_t)l * BATCH * 3 * 512 + i] = proj[((size_t)b * SEQ + SEQ - 3 + j) * NINP + C_CX + ch]; }
    }
}


#define XB_TMO      128
#define XB_XCNT(j)  (256  + 64 * (j))
#define XB_XSUB(j)  (1280 + 64 * (j))
#define XB_XGEN(j)  (2304 + 64 * (j))
#define XB_TOP      3328
#define XB_TOPGEN   3392
#define XCD_BAR_WORDS 3456
#define XB_SPIN_CAP (1u << 20)
DI unsigned xb_ld(unsigned* p)              { return __hip_atomic_load(p, __ATOMIC_RELAXED, __HIP_MEMORY_SCOPE_AGENT); }
DI unsigned xb_add(unsigned* p, unsigned v) { return __hip_atomic_fetch_add(p, v, __ATOMIC_RELAXED, __HIP_MEMORY_SCOPE_AGENT); }
DI unsigned xb_xcc_id() { return (unsigned)__builtin_amdgcn_s_getreg((3 << 11) | 20) & 0xFu; }
#define XB_SPIN(cond, bar) do { unsigned _sp = 0; while (cond) { __builtin_amdgcn_s_sleep(1); \
    if ((++_sp & 255u) == 0u) { if (xb_ld(&(bar)[XB_TMO])) break; if (_sp > XB_SPIN_CAP) { atomicAdd(&(bar)[XB_TMO], 1u); break; } } } } while (0)
DI void xcd_barrier_post(unsigned* bar) { if (threadIdx.x == 0) (void)xb_add(&bar[XB_XCNT(xb_xcc_id())], 1u); }
DI void xcd_barrier_complete(unsigned* bar, unsigned x, unsigned& nloc, unsigned& nx) {
    const unsigned G = gridDim.x * gridDim.y * gridDim.z;
    unsigned sum, cnt, mine, sp = 0u;
    for (;;) {
        sum = 0u; cnt = 0u; mine = 0u;
#pragma unroll
        for (unsigned j = 0; j < 16; ++j) { const unsigned c = xb_ld(&bar[XB_XCNT(j)]); sum += c; cnt += (c > 0u) ? 1u : 0u; mine = (j == x) ? c : mine; }
        if (sum == G) break;
        __builtin_amdgcn_s_sleep(1);
        if ((++sp & 255u) == 0u) { if (xb_ld(&bar[XB_TMO])) break; if (sp > XB_SPIN_CAP) { atomicAdd(&bar[XB_TMO], 1u); break; } }
    }
    nloc = mine > 0u ? mine : 1u; nx = cnt > 0u ? cnt : 1u;
}
DI void xcd_barrier(unsigned* bar, volatile LAS unsigned* st) {
    asm volatile("s_waitcnt vmcnt(0)" ::: "memory");
    __syncthreads();
    if (threadIdx.x == 0) {
        const unsigned x = xb_xcc_id();
        __builtin_amdgcn_s_waitcnt(0);
        unsigned nloc = st[0], nx = st[1];
        if (nloc == 0u) { xcd_barrier_complete(bar, x, nloc, nx); st[0] = nloc; st[1] = nx; }
        const unsigned old = xb_add(&bar[XB_XSUB(x)], 1u);
        const unsigned gen = old / nloc;
        if (old + 1u == (gen + 1u) * nloc) {
            __builtin_amdgcn_fence(__ATOMIC_RELEASE, "agent");
            asm volatile("s_waitcnt vmcnt(0)" ::: "memory");
            const unsigned og = xb_add(&bar[XB_TOP], 1u);
            const unsigned tg = og / nx;
            if (og + 1u == (tg + 1u) * nx) xb_add(&bar[XB_TOPGEN], 1u);
            else XB_SPIN(xb_ld(&bar[XB_TOPGEN]) == tg, bar);
            __builtin_amdgcn_fence(__ATOMIC_ACQUIRE, "agent");
            xb_add(&bar[XB_XGEN(x)], 1u);
            asm volatile("s_waitcnt vmcnt(0)" ::: "memory");
        } else {
            XB_SPIN(xb_ld(&bar[XB_XGEN(x)]) == gen, bar);
            __builtin_amdgcn_fence(__ATOMIC_ACQUIRE, "agent");
            asm volatile("s_waitcnt vmcnt(0)" ::: "memory");
        }
    }
    __syncthreads();
}

__global__ void __launch_bounds__(512, 2) fwd_megakernel(Args args) {
    extern __shared__ __attribute__((aligned(16))) unsigned char lds_raw[];
    Ctx c0; c0.a = &args; c0.ws = nullptr; c0.out = nullptr; c0.lds = (LAS unsigned char*)lds_raw; c0.tid = 0; c0.lane = 0; c0.wave = 0; c0.G = gridDim.x; c0.bid = 0;
    const int lo = args.ph_lo, hi = args.ph_hi;
    volatile LAS unsigned* bst = (volatile LAS unsigned*)((LAS unsigned char*)lds_raw + LDS_BYTES - 16);
    if (threadIdx.x == 0) { bst[0] = 0u; bst[1] = 0u; }
    __syncthreads();
    xcd_barrier_post((unsigned*)(args.ws + WS_CTL) + 1024);
#pragma unroll 1
    for (int ph2 = 2 * lo; ph2 < 2 * hi; ++ph2) {
        const int ph = ph2 >> 1;
        const int l = (ph - 1) >> 3, k = (ph == 0) ? -1 : ((ph - 1) & 7);
        if ((ph2 & 1) && k != PROBE_REP) continue;
        if (k == -1) phase_p0(c0);
        else if (k == 0 || k == 3 || k == 5 || k == 6) {
            const Ctx c = fresh(c0); unsigned char* ws = c.ws;
            pg8::Gemm g; pg8::EpiAny E; E.mode = 0; E.C = (float*)(ws + WS_MIXF); E.O = nullptr; E.ldc = D;
            if (k == 0)      { g.A = (const bf16_t*)(ws + WS_HBUF); g.Bt = (const bf16_t*)(ws + WS_WIN + l * SZ_WIN);   g.N = NINP; g.K = D;   E.C = (float*)(ws + WS_PROJ); E.ldc = NINP; }
            else if (k == 3) { g.A = (const bf16_t*)(ws + WS_MIXO); g.Bt = (const bf16_t*)(ws + WS_WOUT + l * SZ_WOUT); g.N = D;    g.K = D; }
            else if (k == 5) { g.A = (const bf16_t*)(ws + WS_HBUF); g.Bt = (const bf16_t*)(ws + WS_WGU + l * SZ_WGU);   g.N = NGU;  g.K = D;   E.mode = 1; E.O = (bf16_t*)(ws + WS_PROJ); E.ldc = DFF; }
            else             { g.A = (const bf16_t*)(ws + WS_PROJ); g.Bt = (const bf16_t*)(ws + WS_WDN + l * SZ_WDN);   g.N = D;    g.K = DFF; }
            g.M = (k == 3 || k == 6) ? NP : MPAD;
            pg8::StaticOrder S; S.init(g.M, g.N, c.G, c.bid);
            pg8::gemm_phase<pg8::EpiAny, pg8::StaticOrder, true, true>(c.lds, g, S, E);
            if (k == 3 || k == 6) sample_pieces(c0, g.A + (size_t)NP * g.K, g.Bt, g.K, (float*)(ws + WS_SLAB));
        }
        else if (k == 1) phase_m1(c0, l);
        else if (k == 2) phase_m2(c0, l);
        else {
            const Ctx c = fresh(c0); unsigned char* ws = c.ws;
            float* mixf = (float*)(ws + WS_MIXF); float* x1 = (float*)(ws + WS_X1); bf16_t* hb = (bf16_t*)(ws + WS_HBUF);
            if (k == 4) {
                const float* xa = (l == 0) ? inp(args, I_XP) : c.out; const float* xb = (l == 0) ? inp(args, I_XS) : c.out + (size_t)NP * D;
                row_phase(c0, mixf, (const float*)(ws + WS_SLAB), xa, xb, x1, inp(args, I_LN2) + l * D, inp(args, I_LN3) + l * D, hb);
            } else {
                row_phase(c0, mixf, (const float*)(ws + WS_SLAB), x1, x1 + (size_t)NP * D, c.out, inp(args, I_LN4) + l * D, l == 0 ? inp(args, I_LN1) + D : nullptr, hb);
            }
        }
        if (ph2 + 1 < 2 * hi) {
            if (ph2 == 2 * lo) cg::this_grid().sync();
            else xcd_barrier((unsigned*)(args.ws + WS_CTL) + 1024, bst);
        }
    }
}

extern "C" void kernel_launch(void* const* d_in, const int* in_sizes, int n_in, void* d_out, int out_size, void* d_ws, size_t ws_size, hipStream_t stream) {
    static int grid = 0;
    if (grid == 0) {
        if (n_in != 29 || (size_t)out_size != O_END || ws_size < WS_END) { fprintf(stderr, "kernel_launch: unexpected shapes: n_in %d out %d ws %zu (need %zu)\n", n_in, out_size, ws_size, (size_t)WS_END); grid = -1; return; }
        int dev = 0, cus = 0, per_cu = 0;
        hipGetDevice(&dev); hipDeviceGetAttribute(&cus, hipDeviceAttributeMultiprocessorCount, dev);
        if (hipFuncSetAttribute((const void*)fwd_megakernel, hipFuncAttributeMaxDynamicSharedMemorySize, LDS_BYTES) != hipSuccess) { fprintf(stderr, "kernel_launch: hipFuncSetAttribute failed\n"); grid = -1; return; }
        if (hipOccupancyMaxActiveBlocksPerMultiprocessor(&per_cu, (const void*)fwd_megakernel, 512, LDS_BYTES) != hipSuccess || per_cu < 1) { fprintf(stderr, "kernel_launch: occupancy query says %d\n", per_cu); grid = -1; return; }
        grid = cus;
        if (grid < 224) { fprintf(stderr, "kernel_launch: needs >= 224 CUs, got %d\n", grid); grid = -1; return; }
    }
    if (grid < 0) return;
    hipMemsetAsync((char*)d_ws + WS_CTL, 0, CTL_BYTES, stream);
    Args a{};
    for (int i = 0; i < 29; ++i) a.in[i] = (const float*)d_in[i];
    a.out = (float*)d_out; a.ws = (unsigned char*)d_ws;
#if MK_MULTI
    for (int ph = 0; ph < NPHASE; ++ph) { a.ph_lo = ph; a.ph_hi = ph + 1; hipLaunchKernelGGL(fwd_megakernel, dim3(grid), dim3(512), LDS_BYTES, stream, a); }
#else
    a.ph_lo = 0; a.ph_hi = NPHASE;
    void* kargs[] = {&a};
    hipError_t e = hipLaunchCooperativeKernel((const void*)fwd_megakernel, dim3(grid), dim3(512), kargs, LDS_BYTES, stream);
    if (e != hipSuccess) fprintf(stderr, "cooperative launch failed: %s (grid %d)\n", hipGetErrorString(e), grid);
#endif
}
```

```cpp
#include <hip/hip_runtime.h>
#include <hip/hip_cooperative_groups.h>
#include <cstdio>
#include <cstdint>
namespace cg = cooperative_groups;

#ifndef MK_MULTI
#define MK_MULTI 0
#endif

#ifndef PROBE_REP
#define PROBE_REP (-2)
#endif
#ifndef PROBE_SUB
#define PROBE_SUB 0
#endif
#define DI __device__ __forceinline__
#define LAS __attribute__((address_space(3)))
#define GAS __attribute__((address_space(1)))
typedef unsigned short bf16_t;
typedef float f32x4 __attribute__((ext_vector_type(4)));
typedef float f32x2 __attribute__((ext_vector_type(2)));
typedef unsigned u32x4 __attribute__((ext_vector_type(4)));
typedef unsigned u32x2 __attribute__((ext_vector_type(2)));
typedef short bf16x8 __attribute__((ext_vector_type(8)));
typedef __bf16 bf16v2 __attribute__((ext_vector_type(2)));

constexpr int D = 2048, SEQ = 2048, BATCH = 4, NP = BATCH * SEQ, NS = 128, MT = NP + NS, MPAD = 8448;
constexpr int NIN = 7184, NINP = 7424, DFF = 5632, NGU = 2 * DFF;
constexpr int C_AQ = 0, C_AF = 512, C_AI = 1024, C_AG = 1536, C_BQ = 2048, C_BK = 3072, C_BV = 4096, C_BZ = 5120, C_BB = 6144, C_BA = 6152, C_CX = 6160, C_CG = 6672;
constexpr float NORM_EPS = 1e-6f, L2_EPS = 1e-6f;
constexpr int NPHASE = 17;

constexpr size_t O_YP = 0, O_YS = O_YP + (size_t)NP * D, O_HGP = O_YS + (size_t)NS * D, O_HGS = O_HGP + 2ull * 4 * 4 * 16384,
                 O_GDP = O_HGS + 2ull * 128 * 4 * 16384, O_GDS = O_GDP + 2ull * 4 * 8 * 16384, O_GCP = O_GDS + 2ull * 128 * 8 * 16384,
                 O_GCS = O_GCP + 2ull * 4 * 3 * 3072, O_RHP = O_GCS + 2ull * 128 * 3 * 3072, O_RHS = O_RHP + 2ull * 4 * 512,
                 O_RCP = O_RHS + 2ull * 128 * 512, O_RCS = O_RCP + 2ull * 4 * 3 * 512, O_END = O_RCS + 2ull * 128 * 3 * 512;

constexpr size_t MiB = 1ull << 20;
constexpr size_t WS_CTL = 0, CTL_BYTES = 1 * MiB;
constexpr size_t WS_WIN = 1 * MiB, SZ_WIN = 29 * MiB, WS_WOUT = WS_WIN + 2 * SZ_WIN, SZ_WOUT = 8 * MiB, WS_WGU = WS_WOUT + 2 * SZ_WOUT, SZ_WGU = 44 * MiB,
                 WS_WDN = WS_WGU + 2 * SZ_WGU, SZ_WDN = 22 * MiB;
constexpr size_t WS_PROJ = WS_WDN + 2 * SZ_WDN, SZ_PROJ = 240 * MiB;
constexpr size_t WS_HBUF = WS_PROJ + SZ_PROJ, SZ_HBUF = 33 * MiB;
constexpr size_t WS_MIXO = WS_HBUF + SZ_HBUF;
constexpr size_t WS_MIXF = WS_MIXO + SZ_HBUF, SZ_MIXF = 66 * MiB;
constexpr size_t WS_X1 = WS_MIXF + SZ_MIXF, WS_END = WS_X1 + SZ_MIXF + 25 * MiB;
static_assert((size_t)NINP * D * 2 == SZ_WIN && (size_t)NGU * D * 2 == SZ_WGU && (size_t)D * DFF * 2 == SZ_WDN && (size_t)D * D * 2 == SZ_WOUT, "weight sizes");
static_assert((size_t)MPAD * NINP * 4 <= SZ_PROJ && (size_t)MPAD * D * 2 <= SZ_HBUF && (size_t)MPAD * D * 4 <= SZ_MIXF, "ws map");

constexpr int LDS_BYTES = 147456;

DI unsigned pk2(float lo, float hi) { f32x2 x = {lo, hi}; bf16v2 y = __builtin_convertvector(x, bf16v2); return __builtin_bit_cast(unsigned, y); }
DI float wave_sum(float v) {
#pragma unroll
    for (int o = 1; o < 64; o <<= 1) v += __shfl_xor(v, o);
    return v;
}
template <int CTRL> DI float dpp_mov(float v) { return __int_as_float(__builtin_amdgcn_update_dpp(0, __float_as_int(v), CTRL, 0xF, 0xF, true)); }
DI float row16_sum(float v) {
    v += dpp_mov<0xB1>(v); v += dpp_mov<0x4E>(v); v += dpp_mov<0x124>(v); v += dpp_mov<0x128>(v); return v;
}
DI float sigm(float x) { return 1.f / (1.f + __expf(-x)); }
DI float silu(float x) { return x / (1.f + __expf(-x)); }
DI float softplus(float x) { return x > 20.f ? x : log1pf(__expf(x)); }
DI float gelu_tanh(float x) { const float y = 0.7978845608028654f * (x + 0.044715f * x * x * x); return 0.5f * x * (1.f + tanhf(y)); }
#define LDS_WAIT() asm volatile("s_waitcnt lgkmcnt(0)" ::: "memory")
#define MFMA16(a, b, c) __builtin_amdgcn_mfma_f32_16x16x32_bf16((a), (b), (c), 0, 0, 0)

namespace pg8 {
#define PG8_LAS __attribute__((address_space(3)))
constexpr int BM = 256, BK = 64, HALF = 128, HTB = HALF * BK * 2, STAGE_BYTES = 8 * HTB, NXCD = 8, WGM = 8;
__host__ __device__ __forceinline__ int lds_byte(int r, int c) { const int st = (r >> 4) * 2 + (c >> 5), rr = r & 15, cc = c & 31, ob = rr * 64 + cc * 2; return st * 1024 + (ob ^ (((ob >> 9) & 1) << 5)); }
__host__ __device__ __forceinline__ void stage_rc(int b, int& R, int& C) { const int st = b / 1024, sb = b % 1024, swz = sb ^ (((sb >> 9) & 1) << 5); R = (st >> 1) * 16 + swz / 64; C = (st & 1) * 32 + (swz % 64) / 2; }
struct Unit { int pm, pn; };
struct Gemm { const bf16_t* A; const bf16_t* Bt; int M, N, K; };
struct StaticOrder {
    int nM, nN, nwg, G, c;
    __host__ __device__ void init(int M, int N, int G_, int c_) { nM = M / BM; nN = N / BM; nwg = nM * nN; G = G_; c = c_; }
    __host__ __device__ bool next(int i, Unit& u) const {
        const long L = (long)i * G + c; if (L >= nwg) return false;
        int wgid = (int)L; { const int q = nwg / NXCD, r = nwg % NXCD, xcd = wgid % NXCD, off = wgid / NXCD; wgid = (xcd < r ? xcd * (q + 1) : r * (q + 1) + (xcd - r) * q) + off; }
        const int nig = WGM * nN, gid = wgid / nig, fm = gid * WGM, gsz = (nM - fm) < WGM ? (nM - fm) : WGM;
        u.pm = fm + ((wgid % nig) % gsz); u.pn = (wgid % nig) / gsz; return true;
    }
    __device__ __forceinline__ void a_ready(const Unit&) const {}
    __device__ __forceinline__ void done(const Unit&) const {}
};
struct EpiAny {
    static constexpr bool PERM = false, AFTER_DRAIN = false;
    int mode; float* C; bf16_t* O; int ldc;
    __device__ __forceinline__ void operator()(const f32x4 (&acc)[2][2][4][2], const Unit& u, int wr, int wc, int fr, int fq) const {
        const int row0 = u.pm * BM + wr * 64 + fr;
        if (mode == 0) {
            const int col0 = u.pn * BM + wc * 32 + 4 * fq;
#pragma unroll
            for (int ai = 0; ai < 2; ++ai)
#pragma unroll
                for (int m = 0; m < 4; ++m) { float* rowp = C + (size_t)(row0 + ai * HALF + m * 16) * ldc + col0;
#pragma unroll
                    for (int bj = 0; bj < 2; ++bj)
#pragma unroll
                        for (int n = 0; n < 2; ++n) *(f32x4*)(rowp + bj * HALF + n * 16) = acc[ai][bj][m][n]; }
        } else {
#pragma unroll
            for (int ai = 0; ai < 2; ++ai)
#pragma unroll
                for (int m = 0; m < 4; ++m) { bf16_t* rowp = O + (size_t)(row0 + ai * HALF + m * 16) * ldc;
#pragma unroll
                    for (int bj = 0; bj < 2; ++bj) { const int G = 8 * u.pn + 4 * bj + wc; const f32x4 g = acc[ai][bj][m][0], up = acc[ai][bj][m][1];
                        u32x2 w; w.x = pk2(silu(g[0]) * up[0], silu(g[1]) * up[1]); w.y = pk2(silu(g[2]) * up[2], silu(g[3]) * up[3]);
                        *(u32x2*)(rowp + 16 * G + 4 * fq) = w; } }
        }
    }
};

template <class Epi, class Sched, bool ALIGN_EPI = false, bool SP2 = false>
__device__ __forceinline__ void gemm_phase(PG8_LAS unsigned char* lds, const Gemm g, const Sched& S, const Epi& E) {
    int tid_ = threadIdx.x; asm volatile("" : "+v"(tid_));
    const int tid = tid_, wid = __builtin_amdgcn_readfirstlane(tid >> 6), lane = tid & 63, wr = wid >> 2, wc = wid & 3, fr = lane & 15, fq = lane >> 4;
    const int K = g.K, nt = K / BK;
    unsigned voffA[2], voffB[2];
#pragma unroll
    for (int i = 0; i < 2; ++i) { int R, C; stage_rc(tid * 16 + i * 8192, R, C); voffA[i] = (unsigned)(R * K + C) * 2u; voffB[i] = (unsigned)(R * K + C) * 2u; }
    const size_t kstep = (size_t)(BK * 2);
    const size_t hstep = (size_t)HALF * K * 2;
    const size_t tstep = 2 * hstep;
    const unsigned ldsw = (unsigned)wid * 1024u;
    const int aoff = lds_byte(wr * 64 + fr, fq * 8), boff = lds_byte(wc * 32 + fr, fq * 8);
#define PG8_SA(b, h) (((b) * 2 + (h)) * HTB)
#define PG8_SB(b, h) ((4 + (b) * 2 + (h)) * HTB)
#define PG8_STAGE(bufoff, gbase, voff) do { _Pragma("unroll") for (int _i = 0; _i < 2; ++_i) \
        __builtin_amdgcn_global_load_lds((const unsigned*)((const char*)(gbase) + (voff)[_i]), (PG8_LAS unsigned*)(lds + (bufoff) + ldsw + _i * 8192), 16, 0, 0); } while (0)
#define PG8_LDA(dst, b, h) do { _Pragma("unroll") for (int m = 0; m < 4; ++m) _Pragma("unroll") for (int k = 0; k < 2; ++k) dst[m][k] = *(const PG8_LAS bf16x8*)(lds + PG8_SA(b, h) + aoff + m * 2048 + k * 1024); } while (0)
#define PG8_LDB(dst, b, h) do { _Pragma("unroll") for (int n = 0; n < 2; ++n) _Pragma("unroll") for (int k = 0; k < 2; ++k) dst[n][k] = *(const PG8_LAS bf16x8*)(lds + PG8_SB(b, h) + boff + n * 2048 + k * 1024); } while (0)
#define PG8_MMA(ai, bj, At, Bt) do { __builtin_amdgcn_s_setprio(1); _Pragma("unroll") for (int m = 0; m < 4; ++m) _Pragma("unroll") for (int n = 0; n < 2; ++n) _Pragma("unroll") for (int k = 0; k < 2; ++k) \
        acc[ai][bj][m][n] = __builtin_amdgcn_mfma_f32_16x16x32_bf16(Bt[n][k], At[m][k], acc[ai][bj][m][n], 0, 0, 0); __builtin_amdgcn_s_setprio(0); } while (0)
#define PG8_WAIT_V(n) asm volatile("s_waitcnt vmcnt(" #n ")" ::: "memory")
#define PG8_WAIT_L(n) asm volatile("s_waitcnt lgkmcnt(" #n ")" ::: "memory")
#define PG8_BAR __builtin_amdgcn_s_barrier()
#define PG8_SCHED __builtin_amdgcn_sched_barrier(0)
    Unit cur, nxt; int ui = 0;
    if (!S.next(0, cur)) return;
    f32x4 acc[2][2][4][2];
#pragma unroll
    for (int a = 0; a < 2; ++a)
#pragma unroll
        for (int b = 0; b < 2; ++b)
#pragma unroll
            for (int m = 0; m < 4; ++m)
#pragma unroll
                for (int n = 0; n < 2; ++n) acc[a][b][m][n] = (f32x4){0.f, 0.f, 0.f, 0.f};
    bf16x8 At[4][2], B0[2][2], B1[2][2];
    const char* cA = (const char*)g.A + (size_t)cur.pm * tstep; const char* cB = (const char*)g.Bt + (size_t)cur.pn * tstep;
    S.a_ready(cur);
    if constexpr (SP2) {
        PG8_STAGE(PG8_SB(0, 0), cB, voffB); PG8_STAGE(PG8_SB(0, 1), cB + hstep, voffB); PG8_STAGE(PG8_SA(0, 0), cA, voffA); PG8_STAGE(PG8_SA(0, 1), cA + hstep, voffA);
        if (wr == 1) PG8_BAR;
        PG8_WAIT_V(2); PG8_BAR;
        PG8_STAGE(PG8_SB(1, 0), cB + kstep, voffB); PG8_STAGE(PG8_SA(1, 0), cA + kstep, voffA); PG8_STAGE(PG8_SB(1, 1), cB + hstep + kstep, voffB);
        PG8_WAIT_V(6); PG8_BAR;
    } else {
        PG8_STAGE(PG8_SB(0, 0), cB, voffB); PG8_STAGE(PG8_SA(0, 0), cA, voffA); PG8_STAGE(PG8_SB(0, 1), cB + hstep, voffB); PG8_STAGE(PG8_SA(0, 1), cA + hstep, voffA);
        if (wr == 1) PG8_BAR;
        PG8_WAIT_V(4); PG8_BAR;
        PG8_STAGE(PG8_SB(1, 0), cB + kstep, voffB); PG8_STAGE(PG8_SA(1, 0), cA + kstep, voffA); PG8_STAGE(PG8_SB(1, 1), cB + hstep + kstep, voffB);
        PG8_WAIT_V(6); PG8_BAR;
    }
    for (;;) {
        const bool has_next = S.next(ui + 1, nxt);
        const char* nA = has_next ? (const char*)g.A + (size_t)nxt.pm * tstep : cA; const char* nB = has_next ? (const char*)g.Bt + (size_t)nxt.pn * tstep : cB;
        for (int t = 0; t < nt; t += 2) {
            const bool last = (t == nt - 2);
            const char* a1 = cA + (size_t)(t + 1) * kstep;
            const char* a2 = last ? nA : cA + (size_t)(t + 2) * kstep; const char* b2 = last ? nB : cB + (size_t)(t + 2) * kstep;
            const char* a3 = a2 + kstep; const char* b3 = b2 + kstep;
            if (last && has_next) S.a_ready(nxt);
            if constexpr (SP2) {
            PG8_LDB(B0, 0, 0); PG8_LDB(B1, 0, 1); PG8_SCHED; PG8_LDA(At, 0, 0); PG8_STAGE(PG8_SA(1, 1), a1 + hstep, voffA);
            PG8_WAIT_V(8); PG8_WAIT_L(0); PG8_BAR; PG8_MMA(0, 0, At, B0); PG8_MMA(0, 1, At, B1); PG8_BAR; PG8_SCHED;
            PG8_LDA(At, 0, 1); PG8_STAGE(PG8_SB(0, 0), b2, voffB); PG8_STAGE(PG8_SB(0, 1), b2 + hstep, voffB); PG8_STAGE(PG8_SA(0, 0), a2, voffA);
            PG8_WAIT_V(8); PG8_WAIT_L(0); PG8_BAR; PG8_MMA(1, 0, At, B0); PG8_MMA(1, 1, At, B1); PG8_BAR; PG8_SCHED;
            PG8_LDB(B0, 1, 0); PG8_LDB(B1, 1, 1); PG8_SCHED; PG8_LDA(At, 1, 0); PG8_STAGE(PG8_SA(0, 1), a2 + hstep, voffA);
            PG8_WAIT_V(8); PG8_WAIT_L(0); PG8_BAR; PG8_MMA(0, 0, At, B0); PG8_MMA(0, 1, At, B1); PG8_BAR; PG8_SCHED;
            PG8_LDA(At, 1, 1); PG8_STAGE(PG8_SB(1, 0), b3, voffB); PG8_STAGE(PG8_SB(1, 1), b3 + hstep, voffB); PG8_STAGE(PG8_SA(1, 0), a3, voffA);
            PG8_WAIT_V(8); PG8_WAIT_L(0); PG8_BAR; PG8_MMA(1, 0, At, B0); PG8_MMA(1, 1, At, B1); PG8_BAR; PG8_SCHED;
            } else {
            PG8_LDB(B0, 0, 0); PG8_SCHED; PG8_LDA(At, 0, 0); PG8_STAGE(PG8_SA(1, 1), a1 + hstep, voffA);
            PG8_WAIT_L(8); PG8_BAR; PG8_WAIT_L(0); PG8_MMA(0, 0, At, B0); PG8_BAR; PG8_SCHED;
            PG8_LDB(B1, 0, 1); PG8_STAGE(PG8_SB(0, 0), b2, voffB);
            PG8_BAR; PG8_WAIT_L(0); PG8_MMA(0, 1, At, B1); PG8_BAR;
            PG8_LDA(At, 0, 1); PG8_STAGE(PG8_SA(0, 0), a2, voffA);
            PG8_BAR; PG8_WAIT_L(0); PG8_MMA(1, 0, At, B0); PG8_BAR; PG8_SCHED;
            PG8_STAGE(PG8_SB(0, 1), b2 + hstep, voffB);
            PG8_WAIT_V(6); PG8_BAR; PG8_MMA(1, 1, At, B1); PG8_BAR;
            PG8_LDB(B0, 1, 0); PG8_SCHED; PG8_LDA(At, 1, 0); PG8_STAGE(PG8_SA(0, 1), a2 + hstep, voffA);
            PG8_WAIT_L(8); PG8_BAR; PG8_WAIT_L(0); PG8_MMA(0, 0, At, B0); PG8_BAR; PG8_SCHED;
            PG8_LDB(B1, 1, 1); PG8_STAGE(PG8_SB(1, 0), b3, voffB);
            PG8_BAR; PG8_WAIT_L(0); PG8_MMA(0, 1, At, B1); PG8_BAR;
            PG8_LDA(At, 1, 1); PG8_STAGE(PG8_SA(1, 0), a3, voffA);
            PG8_BAR; PG8_WAIT_L(0); PG8_MMA(1, 0, At, B0); PG8_BAR; PG8_SCHED;
            PG8_STAGE(PG8_SB(1, 1), b3 + hstep, voffB);
            PG8_WAIT_V(6); PG8_BAR; PG8_MMA(1, 1, At, B1); PG8_BAR;
            }
        }
        if constexpr (ALIGN_EPI) { if (wr == 0) PG8_BAR; }
        if constexpr (!Epi::AFTER_DRAIN) { E(acc, cur, wr, wc, fr, fq); S.done(cur); }
        if (!has_next) break;
#pragma unroll
        for (int a = 0; a < 2; ++a)
#pragma unroll
            for (int b = 0; b < 2; ++b)
#pragma unroll
                for (int m = 0; m < 4; ++m)
#pragma unroll
                    for (int n = 0; n < 2; ++n) acc[a][b][m][n] = (f32x4){0.f, 0.f, 0.f, 0.f};
        cur = nxt; cA = nA; cB = nB; ++ui;
        if constexpr (ALIGN_EPI) { if (wr == 1) PG8_BAR; }
    }
    PG8_WAIT_V(0);
    if constexpr (!ALIGN_EPI) { if (wr == 0) PG8_BAR; }
    PG8_BAR;
#undef PG8_SA
#undef PG8_SB
#undef PG8_STAGE
#undef PG8_LDA
#undef PG8_LDB
#undef PG8_MMA
#undef PG8_WAIT_V
#undef PG8_WAIT_L
#undef PG8_BAR
#undef PG8_SCHED
}
}

struct Args { const float* in[29]; float* out; unsigned char* ws; int ph_lo, ph_hi; };
enum { I_XP = 0, I_XS, I_SHG, I_SGD, I_SGC, I_SRH, I_SRC, I_LN1, I_LN2, I_LN3, I_LN4, I_WIN, I_WOUT, I_LB, I_ANORM, I_BCW, I_BALOG, I_BDT, I_BNORM,
       I_CCW, I_CCB, I_CWA, I_CBA, I_CWX, I_CBX, I_CLAM, I_WG, I_WU, I_WD };

struct Ctx {
    const Args* a; unsigned char* ws; float* out; LAS unsigned char* lds; int tid, lane, wave, G, bid;
};
DI Ctx fresh(const Ctx& o) {
    Ctx c = o; int t = threadIdx.x; asm volatile("" : "+v"(t)); c.tid = t; c.lane = t & 63; c.wave = __builtin_amdgcn_readfirstlane(t >> 6);
    size_t z = 0; asm volatile("" : "+s"(z)); c.ws = o.a->ws + z; c.out = o.a->out + z;
    int b = blockIdx.x; asm volatile("" : "+s"(b)); c.bid = b; return c;
}
DI const float* inp(const Args& a, int idx) { int z = idx; asm volatile("" : "+s"(z)); return (const float*)(const GAS float*)a.in[z]; }

template <int MODE>
DI void transpose_item(const float* W, int K, int Nsrc, int nblk, bf16_t* WT, LAS float* scr, int item, int lane) {
    const int kb = item / nblk, nb = item - kb * nblk, k0 = 64 * kb, n0 = 32 * nb;
    const int nn = n0 + (lane & 31); const bool ok = nn < Nsrc;
    float v[32];
#pragma unroll
    for (int i = 0; i < 32; ++i) { const int kk = 2 * i + (lane >> 5); v[i] = ok ? W[(size_t)(k0 + kk) * Nsrc + nn] : 0.f; }
#pragma unroll
    for (int i = 0; i < 32; ++i) { const int kk = 2 * i + (lane >> 5); scr[kk * 33 + (lane & 31)] = v[i]; }
    LDS_WAIT(); asm volatile("" ::: "memory");
    const int c = lane & 7;
#pragma unroll
    for (int j = 0; j < 4; ++j) { const int nl = (lane >> 3) + 8 * j; const LAS float* s = scr + (8 * c) * 33 + nl;
        u32x4 o; o.x = pk2(s[0 * 33], s[1 * 33]); o.y = pk2(s[2 * 33], s[3 * 33]); o.z = pk2(s[4 * 33], s[5 * 33]); o.w = pk2(s[6 * 33], s[7 * 33]);
        const int n = n0 + nl; const int drow = (MODE == 0) ? n : ((n >> 4) * 32 + (n & 15) + (MODE == 2 ? 16 : 0));
        *(u32x4*)(WT + (size_t)drow * K + k0 + 8 * c) = o; }
    LDS_WAIT(); asm volatile("" ::: "memory");
}
DI void norm_row_to_bf16(const float* xr, const float* g, bf16_t* orow, int lane) {
    f32x4 v[8]; float s = 0.f;
#pragma unroll
    for (int j = 0; j < 8; ++j) { v[j] = ((const f32x4*)xr)[lane + 64 * j]; s += (v[j].x * v[j].x + v[j].y * v[j].y) + (v[j].z * v[j].z + v[j].w * v[j].w); }
    const float r = rsqrtf(wave_sum(s) * (1.f / D) + NORM_EPS);
#pragma unroll
    for (int j = 0; j < 8; ++j) { const f32x4 gg = ((const f32x4*)g)[lane + 64 * j]; u32x2 w; w.x = pk2(v[j].x * r * gg.x, v[j].y * r * gg.y); w.y = pk2(v[j].z * r * gg.z, v[j].w * r * gg.w);
        ((u32x2*)orow)[lane + 64 * j] = w; }
}
constexpr int CV_IN = (D / 64) * (NINP / 32), CV_OUT = (D / 64) * (D / 32), CV_G = (D / 64) * (DFF / 32), CV_D = (DFF / 64) * (D / 32), CV_LAYER = CV_IN + CV_OUT + 2 * CV_G + CV_D;
DI void convert_range(const Ctx& c, int lo, int hi, int gw, int NGW) {
    const Args& a = *c.a;
    LAS float* scr = (LAS float*)(c.lds + c.wave * 16384);
    for (int it = lo + gw; it < hi; it += NGW) {
        const int l = it / CV_LAYER; int r = it - l * CV_LAYER;
        if (r < CV_IN) { transpose_item<0>(inp(a, I_WIN) + (size_t)l * D * NIN, D, NIN, NINP / 32, (bf16_t*)(c.ws + WS_WIN + l * SZ_WIN), scr, r, c.lane); continue; } r -= CV_IN;
        if (r < CV_OUT) { transpose_item<0>(inp(a, I_WOUT) + (size_t)l * D * D, D, D, D / 32, (bf16_t*)(c.ws + WS_WOUT + l * SZ_WOUT), scr, r, c.lane); continue; } r -= CV_OUT;
        if (r < CV_G) { transpose_item<1>(inp(a, I_WG) + (size_t)l * D * DFF, D, DFF, DFF / 32, (bf16_t*)(c.ws + WS_WGU + l * SZ_WGU), scr, r, c.lane); continue; } r -= CV_G;
        if (r < CV_G) { transpose_item<2>(inp(a, I_WU) + (size_t)l * D * DFF, D, DFF, DFF / 32, (bf16_t*)(c.ws + WS_WGU + l * SZ_WGU), scr, r, c.lane); continue; } r -= CV_G;
        transpose_item<0>(inp(a, I_WD) + (size_t)l * DFF * D, DFF, D, D / 32, (bf16_t*)(c.ws + WS_WDN + l * SZ_WDN), scr, r, c.lane);
    }
}
DI void phase_p0(const Ctx& c0) {
    const Ctx c = fresh(c0);
    const Args& a = *c.a;
    const int gw = c.bid * 8 + c.wave, NGW = c.G * 8;
    convert_range(c, 0, CV_IN, gw, NGW);
    bf16_t* hb = (bf16_t*)(c.ws + WS_HBUF);
    { const float* xp = inp(a, I_XP); const float* xs = inp(a, I_XS); const float* g1 = inp(a, I_LN1);
      for (int m = gw; m < MT; m += NGW) norm_row_to_bf16(m < NP ? xp + (size_t)m * D : xs + (size_t)(m - NP) * D, g1, hb + (size_t)m * D, c.lane); }
    unsigned z0 = 0u; asm volatile("" : "+v"(z0)); const u32x4 z4 = {z0, z0, z0, z0};
    for (int i = gw * 64 + c.lane; i < (MPAD - MT) * D / 8; i += NGW * 64) {
        ((u32x4*)(hb + (size_t)MT * D))[i] = z4;
        ((u32x4*)((bf16_t*)(c.ws + WS_MIXO) + (size_t)MT * D))[i] = z4;
    }
}

DI void row_phase(const Ctx& c0, const float* y, const float* slabs, const float* xa, const float* xb, float* xout, const float* g_post, const float* g_next, bf16_t* hb) {
    const Ctx c = fresh(c0);
    const int gw = c.bid * 8 + c.wave, NGW = c.G * 8, lane = c.lane;
    for (int m = gw; m < MT; m += NGW) {
        const float* xr = m < NP ? xa + (size_t)m * D : xb + (size_t)(m - NP) * D;
        f32x4 v[8]; float s = 0.f;
        if (m < NP) { const float* yr = y + (size_t)m * D;
#pragma unroll
            for (int j = 0; j < 8; ++j) v[j] = ((const f32x4*)yr)[lane + 64 * j];
        } else { const float* yr = slabs + (size_t)(m - NP) * D;
#pragma unroll
            for (int j = 0; j < 8; ++j) v[j] = ((const f32x4*)yr)[lane + 64 * j] + ((const f32x4*)(yr + (size_t)NS * D))[lane + 64 * j];
#pragma unroll 1
            for (int ks = 2; ks < 8; ks += 2) {
                f32x4 t0[8], t1[8];
#pragma unroll
                for (int j = 0; j < 8; ++j) { t0[j] = ((const f32x4*)(yr + (size_t)ks * NS * D))[lane + 64 * j]; t1[j] = ((const f32x4*)(yr + (size_t)(ks + 1) * NS * D))[lane + 64 * j]; }
#pragma unroll
                for (int j = 0; j < 8; ++j) v[j] = v[j] + t0[j] + t1[j]; }
        }
#pragma unroll
        for (int j = 0; j < 8; ++j) s += (v[j].x * v[j].x + v[j].y * v[j].y) + (v[j].z * v[j].z + v[j].w * v[j].w);
        const float r = rsqrtf(wave_sum(s) * (1.f / D) + NORM_EPS);
        float s2 = 0.f;
#pragma unroll
        for (int j = 0; j < 8; ++j) { const f32x4 gg = ((const f32x4*)g_post)[lane + 64 * j]; const f32x4 xx = ((const f32x4*)xr)[lane + 64 * j];
            v[j] = xx + v[j] * r * gg; s2 += (v[j].x * v[j].x + v[j].y * v[j].y) + (v[j].z * v[j].z + v[j].w * v[j].w);
            ((f32x4*)(xout + (size_t)m * D))[lane + 64 * j] = v[j]; }
        if (g_next) {
            const float r2 = rsqrtf(wave_sum(s2) * (1.f / D) + NORM_EPS);
#pragma unroll
            for (int j = 0; j < 8; ++j) { const f32x4 gg = ((const f32x4*)g_next)[lane + 64 * j]; u32x2 w; w.x = pk2(v[j].x * r2 * gg.x, v[j].y * r2 * gg.y); w.y = pk2(v[j].z * r2 * gg.z, v[j].w * r2 * gg.w);
                ((u32x2*)(hb + (size_t)m * D))[lane + 64 * j] = w; }
        }
    }
}

DI void sample_pieces(const Ctx& c0, const bf16_t* A  , const bf16_t* Bt  , int K, float* slabs) {
    const Ctx c = fresh(c0); const int tid = c.tid, lane = c.lane, wave = c.wave, i = lane & 15, g = lane >> 4;
    constexpr int KC = 256, PPR = KC / 8, NJ = 192 * PPR / 512, RS = KC * 2 + 16;
    const int klen = K / 8;
    for (int p = c.bid; p < 256; p += c.G) {
        const int jt = p & 31, ks = p >> 5;
        f32x4 acc[4];
#pragma unroll
        for (int q = 0; q < 4; ++q) acc[q] = (f32x4){0.f, 0.f, 0.f, 0.f};
#pragma unroll 1
        for (int kc = 0; kc < klen; kc += KC) {
            const int k0 = ks * klen + kc;
            u32x4 v[NJ];
#pragma unroll
            for (int j = 0; j < NJ; ++j) { const int pc = tid + 512 * j; const int row = pc / PPR, col = pc - row * PPR;
                const bf16_t* src = (row < 128 ? A + (size_t)row * K : Bt + (size_t)(64 * jt + row - 128) * K) + k0 + 8 * col;
                v[j] = *(const u32x4*)src; }
            __syncthreads();
#pragma unroll
            for (int j = 0; j < NJ; ++j) { const int pc = tid + 512 * j; const int row = pc / PPR, col = pc - row * PPR;
                *(LAS u32x4*)(c.lds + row * RS + col * 16) = v[j]; }
            __syncthreads();
            const int nk = (klen - kc) >= KC ? KC / 32 : (klen - kc) / 32;
#pragma unroll 2
            for (int kk = 0; kk < nk; ++kk) {
                const bf16x8 av = *(const LAS bf16x8*)(c.lds + (16 * wave + i) * RS + (32 * kk + 8 * g) * 2);
#pragma unroll
                for (int q = 0; q < 4; ++q) acc[q] = MFMA16(av, *(const LAS bf16x8*)(c.lds + (128 + 16 * q + i) * RS + (32 * kk + 8 * g) * 2), acc[q]);
            }
        }
        float* so = slabs + (size_t)ks * NS * D + (size_t)(16 * wave + 4 * g) * D + 64 * jt + i;
#pragma unroll
        for (int q = 0; q < 4; ++q)
#pragma unroll
            for (int r = 0; r < 4; ++r) so[(size_t)r * D + 16 * q] = acc[q][r];
    }
    __syncthreads();
}

DI int perm32(int x) { return 8 * ((x >> 2) & 3) + 4 * (x >> 4) + (x & 3); }
DI int kpos(int k) { return (k & ~31) + perm32(k & 31); }
DI float lb_of(const Args& a, int l, int c) { if (l == 0) return 0.f; const float l0 = inp(a, I_LB)[c], l1 = inp(a, I_LB)[512 + c]; return 1.f / (1.f + __expf(l0 - l1)); }
DI bf16_t bf1(float x) { return (bf16_t)(pk2(x, 0.f) & 0xffffu); }

constexpr size_t IB_W = WS_MIXF, IB_Q = IB_W + 16 * MiB, IB_KT = IB_Q + 16 * MiB, IB_P = IB_KT + 16 * MiB, IB_U0 = IB_P + 8 * MiB,
                 IA_Q = IB_U0 + 32 * MiB, IA_KT = IA_Q + 8 * MiB, IA_P = IA_KT + 8 * MiB, IA_V = IA_P + 4 * MiB,
                 IC_A = IA_V + 16 * MiB, IC_B = IC_A + 16 * MiB, IMISC = IC_B + 16 * MiB, IB_DEC = IMISC, IA_DEC = IMISC + 65536, IC_TOT = IMISC + 524288, I_END = IMISC + 1 * MiB;
static_assert(I_END <= WS_END, "mixer intermediates must fit");
constexpr size_t WS_SLAB = WS_X1 + SZ_MIXF;
static_assert(WS_SLAB + 8 * MiB <= WS_END, "slabs");

DI void m1_unit_b(const Ctx& c0, int l, int u) {
    const Ctx c = fresh(c0); const Args& a = *c.a; const int tid = c.tid, lane = c.lane, wave = c.wave;
    const int b = u >> 8, h = (u >> 5) & 7, ci = u & 31;
    LAS float* Kf = (LAS float*)c.lds;
    LAS float* Vf = Kf + 8192;
    LAS float* Qf = Vf + 8192;
    LAS float* Amat = Qf;
    LAS bf16_t* Pl = (LAS bf16_t*)(Qf + 64 * 68);
    LAS bf16_t* Qb = (LAS bf16_t*)(Qf + 8192);
    LAS bf16_t* Kb = Qb + 64 * 136;
    LAS float* scal = (LAS float*)(Kb + 64 * 136);
    const float* proj = (const float*)(c.ws + WS_PROJ);
    const long rowb = (long)b * SEQ + 64 * ci; const int tg0 = 64 * ci;
    {
        const float* cw = inp(a, I_BCW) + (size_t)l * 4 * 3072;
        const int idx = tid & 127, tq = tid >> 7;
        float x[3][19], w[3][4];
#pragma unroll
        for (int p = 0; p < 3; ++p) { const int ch = p * 1024 + h * 128 + idx;
#pragma unroll
            for (int j = 0; j < 4; ++j) w[p][j] = cw[j * 3072 + ch];
#pragma unroll
            for (int j = 0; j < 19; ++j) { const int t = 16 * tq - 3 + j; x[p][j] = (tg0 + t >= 0) ? proj[(rowb + t) * NINP + C_BQ + ch] : 0.f; } }
#pragma unroll
        for (int p = 0; p < 3; ++p) { LAS float* dst = (p == 0 ? Qf : (p == 1 ? Kf : Vf)) + idx;
#pragma unroll
            for (int i = 0; i < 16; ++i) dst[(16 * tq + i) * 128] = silu(w[p][0] * x[p][i] + w[p][1] * x[p][i + 1] + w[p][2] * x[p][i + 2] + w[p][3] * x[p][i + 3]); }
    }
    __syncthreads();
    for (int i = 0; i < 8; ++i) { const int t = wave * 8 + i; const float q0 = Qf[t * 128 + lane], q1 = Qf[t * 128 + 64 + lane], k0 = Kf[t * 128 + lane], k1 = Kf[t * 128 + 64 + lane];
        const float sq = wave_sum(q0 * q0 + q1 * q1), sk = wave_sum(k0 * k0 + k1 * k1);
        if (lane == 0) { scal[t * 8 + 3] = rsqrtf(sq + L2_EPS) * 0.08838834764831845f; scal[t * 8 + 4] = rsqrtf(sk + L2_EPS); } }
    if (wave == 0) { const int t = lane; const float bb = proj[(rowb + t) * NINP + C_BB + h], ba = proj[(rowb + t) * NINP + C_BA + h];
        const float gt = -__expf(inp(a, I_BALOG)[l * 8 + h]) * softplus(ba + inp(a, I_BDT)[l * 8 + h]);
        float x = gt;
#pragma unroll
        for (int o = 1; o < 64; o <<= 1) { const float y = __shfl_up(x, o); if (lane >= o) x += y; }
        const float bC = __shfl(x, 63);
        scal[t * 8 + 0] = sigm(bb); scal[t * 8 + 1] = x; scal[t * 8 + 2] = __expf(x); scal[t * 8 + 5] = __expf(bC - x);
        if (lane == 63) ((float*)(c.ws + IB_DEC))[u] = __expf(x); }
    __syncthreads();
    {
        const int t = tid >> 3, d0 = (tid & 7) * 16; const float sq = scal[t * 8 + 3], sk = scal[t * 8 + 4], s2 = sq * scal[t * 8 + 2];
        bf16_t* gq = (bf16_t*)(c.ws + IB_Q) + ((size_t)u * 64 + t) * 128;
#pragma unroll
        for (int m = 0; m < 4; ++m) { const int d = d0 + 4 * m; const f32x4 q = *(const LAS f32x4*)(Qf + t * 128 + d), k = *(const LAS f32x4*)(Kf + t * 128 + d);
            *(LAS u32x2*)(Qb + t * 136 + d) = (u32x2){pk2(q.x * sq, q.y * sq), pk2(q.z * sq, q.w * sq)};
            *(LAS u32x2*)(Kb + t * 136 + d) = (u32x2){pk2(k.x * sk, k.y * sk), pk2(k.z * sk, k.w * sk)};
            *(u32x2*)(gq + kpos(d)) = (u32x2){pk2(q.x * s2, q.y * s2), pk2(q.z * s2, q.w * s2)}; }
    }
    __syncthreads();
    {
        const int i = lane & 15, g = lane >> 4;
#pragma unroll
        for (int q2 = 0; q2 < 2; ++q2) { const int idx = 2 * wave + q2, tt = idx >> 2, st = idx & 3; const int s = 16 * st + i;
            if (st <= tt) {
                f32x4 akk = {0.f, 0.f, 0.f, 0.f}, aqk = {0.f, 0.f, 0.f, 0.f};
#pragma unroll
                for (int ks = 0; ks < 4; ++ks) { const bf16x8 bk = *(const LAS bf16x8*)(Kb + (16 * st + i) * 136 + 32 * ks + 8 * g);
                    const bf16x8 ak = *(const LAS bf16x8*)(Kb + (16 * tt + i) * 136 + 32 * ks + 8 * g), aq = *(const LAS bf16x8*)(Qb + (16 * tt + i) * 136 + 32 * ks + 8 * g);
                    akk = MFMA16(ak, bk, akk); aqk = MFMA16(aq, bk, aqk); }
                const float bs = scal[s * 8 + 1];
#pragma unroll
                for (int r = 0; r < 4; ++r) { const int t = 16 * tt + 4 * g + r; const float gam = __expf(fminf(scal[t * 8 + 1] - bs, 0.f));
                    Amat[t * 68 + s] = (s < t) ? scal[t * 8 + 0] * akk[r] * gam : 0.f;
                    Pl[t * 72 + kpos(s)] = bf1((s <= t) ? aqk[r] * gam : 0.f); }
            } else {
#pragma unroll
                for (int r = 0; r < 4; ++r) Pl[(16 * tt + 4 * g + r) * 72 + kpos(s)] = 0;
            }
        }
    }
    __syncthreads();
    if (tid < 256) {
        float R[64];
        int zoff = 0; asm volatile("" : "+v"(zoff));
        const LAS float* Am = Amat + zoff; const LAS float* sc = scal + zoff;
        if (tid < 128) {
#pragma unroll
            for (int t = 0; t < 64; ++t) R[t] = sc[t * 8 + 0] * Vf[t * 128 + tid];
        } else {
#pragma unroll
            for (int t = 0; t < 64; ++t) R[t] = sc[t * 8 + 0] * sc[t * 8 + 2] * sc[t * 8 + 4] * Kf[t * 128 + tid - 128];
        }
#pragma unroll
        for (int t = 1; t < 64; ++t) { float acc = R[t];
#pragma unroll
            for (int s4 = 0; s4 < (t + 3) / 4; ++s4) { const f32x4 a4 = *(const LAS f32x4*)(Am + t * 68 + 4 * s4);
                acc -= a4.x * R[4 * s4];
                if (4 * s4 + 1 < t) acc -= a4.y * R[4 * s4 + 1];
                if (4 * s4 + 2 < t) acc -= a4.z * R[4 * s4 + 2];
                if (4 * s4 + 3 < t) acc -= a4.w * R[4 * s4 + 3]; }
            R[t] = acc; }
        if (tid < 128) { const int w = tid >> 4, i = tid & 15; float* g0 = (float*)(c.ws + IB_U0) + (size_t)u * 8192;
#pragma unroll
            for (int st = 0; st < 4; ++st)
#pragma unroll
                for (int g = 0; g < 4; ++g) *(f32x4*)(g0 + ((st * 8 + w) * 64 + i + 16 * g) * 4) = (f32x4){R[16 * st + 4 * g], R[16 * st + 4 * g + 1], R[16 * st + 4 * g + 2], R[16 * st + 4 * g + 3]};
        } else { bf16_t* gw = (bf16_t*)(c.ws + IB_W) + (size_t)u * 8192 + kpos(tid - 128);
#pragma unroll
            for (int t = 0; t < 64; ++t) gw[t * 128] = bf1(R[t]); }
    } else {
#pragma unroll
        for (int k = 0; k < 2; ++k) { const int p = (tid - 256) + 256 * k, row = p >> 3, c16 = p & 7;
            *(u32x4*)((bf16_t*)(c.ws + IB_P) + (size_t)u * 4096 + row * 64 + c16 * 8) = *(const LAS u32x4*)(Pl + row * 72 + c16 * 8); }
        LAS bf16_t* KTs = Qb; const int d = tid & 127, s0 = ((tid >> 7) & 1) * 32;
#pragma unroll
        for (int m = 0; m < 8; ++m) { float v[4];
#pragma unroll
            for (int j = 0; j < 4; ++j) { const int s = s0 + 4 * m + j; v[j] = Kf[s * 128 + d] * scal[s * 8 + 4] * scal[s * 8 + 5]; }
            *(LAS u32x2*)(KTs + d * 72 + kpos(s0 + 4 * m)) = (u32x2){pk2(v[0], v[1]), pk2(v[2], v[3])}; }
    }
    __syncthreads();
#pragma unroll
    for (int k = 0; k < 2; ++k) { const int p = tid + 512 * k, row = p >> 3, c16 = p & 7;
        *(u32x4*)((bf16_t*)(c.ws + IB_KT) + (size_t)u * 8192 + row * 64 + c16 * 8) = *(const LAS u32x4*)(Qb + row * 72 + c16 * 8); }
    __syncthreads();
}

DI void m1_unit_a(const Ctx& c0, int l, int u) {
    const Ctx c = fresh(c0); const Args& a = *c.a; const int tid = c.tid, lane = c.lane, wave = c.wave;
    const int b = u >> 7, h = (u >> 5) & 3, ci = u & 31;
    LAS float* Bf = (LAS float*)c.lds;
    LAS float* Qf = Bf + 8192;
    LAS float* Kf = Qf + 8192;
    LAS bf16_t* Pl = (LAS bf16_t*)Qf;
    LAS bf16_t* Qh = (LAS bf16_t*)(Kf + 8192);
    LAS bf16_t* Kd = Qh + 64 * 136;
    LAS bf16_t* Ko = Kd + 64 * 136;
    LAS float* tot = (LAS float*)(Ko + 32 * 136);
    const float* proj = (const float*)(c.ws + WS_PROJ);
    const long rowb = (long)b * SEQ + 64 * ci;
    {
        float* gv = (float*)(c.ws + IA_V) + (size_t)u * 8192;
        const int idx = tid & 127, tq = tid >> 7;
        float x[3][16];
#pragma unroll
        for (int i = 0; i < 16; ++i) { const float* pr = proj + (rowb + 16 * tq + i) * NINP + h * 128 + idx; x[0][i] = pr[C_AF]; x[1][i] = pr[C_AQ]; x[2][i] = pr[C_AI]; }
        const float lb = lb_of(a, l, h * 128 + idx);
#pragma unroll
        for (int i = 0; i < 16; ++i) { const int t = 16 * tq + i; const float f = lb + (1.f - lb) * sigm(x[0][i]);
            Bf[t * 128 + idx] = fmaxf(__logf(f), -80.f); Kf[t * 128 + idx] = 1.f - f; Qf[t * 128 + idx] = silu(x[1][i]);
            gv[(((t >> 4) * 8 + (idx >> 4)) * 64 + (idx & 15) + 16 * ((t >> 2) & 3)) * 4 + (t & 3)] = x[2][i]; }
    }
    __syncthreads();
    {
        const int d = tid & 127, q4 = tid >> 7; float run = 0.f;
#pragma unroll
        for (int i = 0; i < 16; ++i) { run += Bf[(16 * q4 + i) * 128 + d]; Bf[(16 * q4 + i) * 128 + d] = run; }
        tot[q4 * 128 + d] = run;
        __syncthreads();
        float off = 0.f;
        for (int q = 0; q < q4; ++q) off += tot[q * 128 + d];
        if (q4 > 0) {
#pragma unroll
            for (int i = 0; i < 16; ++i) Bf[(16 * q4 + i) * 128 + d] += off; }
    }
    __syncthreads();
    {
        const int t = tid >> 3, d0 = (tid & 7) * 16; bf16_t* gq = (bf16_t*)(c.ws + IA_Q) + ((size_t)u * 64 + t) * 128;
#pragma unroll
        for (int m = 0; m < 4; ++m) { const int d = d0 + 4 * m; const f32x4 bb = *(const LAS f32x4*)(Bf + t * 128 + d), q = *(const LAS f32x4*)(Qf + t * 128 + d), k = *(const LAS f32x4*)(Kf + t * 128 + d);
            const f32x4 b31 = *(const LAS f32x4*)(Bf + 31 * 128 + d); const f32x4 rr = b31 * ((t >= 32) ? 1.f : 0.f);
            *(u32x2*)(gq + kpos(d)) = (u32x2){pk2(q.x * __expf(bb.x), q.y * __expf(bb.y)), pk2(q.z * __expf(bb.z), q.w * __expf(bb.w))};
            *(LAS u32x2*)(Qh + t * 136 + d) = (u32x2){pk2(q.x * __expf(bb.x - rr.x), q.y * __expf(bb.y - rr.y)), pk2(q.z * __expf(bb.z - rr.z), q.w * __expf(bb.w - rr.w))};
            *(LAS u32x2*)(Kd + t * 136 + d) = (u32x2){pk2(k.x * __expf(fminf(rr.x - bb.x, 80.f)), k.y * __expf(fminf(rr.y - bb.y, 80.f))), pk2(k.z * __expf(fminf(rr.z - bb.z, 80.f)), k.w * __expf(fminf(rr.w - bb.w, 80.f)))};
            if (t < 32) *(LAS u32x2*)(Ko + t * 136 + d) = (u32x2){pk2(k.x * __expf(b31.x - bb.x), k.y * __expf(b31.y - bb.y)), pk2(k.z * __expf(b31.z - bb.z), k.w * __expf(b31.w - bb.w))}; }
        const int d = tid & 127, s0 = (tid >> 7) * 16; bf16_t* gk = (bf16_t*)(c.ws + IA_KT) + ((size_t)u * 128 + d) * 64; const float bC = Bf[63 * 128 + d];
#pragma unroll
        for (int m = 0; m < 4; ++m) { float v[4];
#pragma unroll
            for (int j = 0; j < 4; ++j) { const int s = s0 + 4 * m + j; v[j] = Kf[s * 128 + d] * __expf(bC - Bf[s * 128 + d]); }
            *(u32x2*)(gk + kpos(s0 + 4 * m)) = (u32x2){pk2(v[0], v[1]), pk2(v[2], v[3])}; }
        if (tid < 128) ((float*)(c.ws + IA_DEC))[(size_t)u * 128 + tid] = __expf(bC);
    }
    __syncthreads();
    {
        const int i = lane & 15, g = lane >> 4;
#pragma unroll
        for (int q2 = 0; q2 < 2; ++q2) { const int idx = 2 * wave + q2, tt = idx >> 2, st = idx & 3, I = tt >> 1, J = st >> 1; const int s = 16 * st + i;
            if (J <= I) {
                const LAS bf16_t* bsrc = (I == J ? Kd : Ko) + (16 * st + i) * 136;
                f32x4 acc = {0.f, 0.f, 0.f, 0.f};
#pragma unroll
                for (int ks = 0; ks < 4; ++ks) acc = MFMA16(*(const LAS bf16x8*)(Qh + (16 * tt + i) * 136 + 32 * ks + 8 * g), *(const LAS bf16x8*)(bsrc + 32 * ks + 8 * g), acc);
#pragma unroll
                for (int r = 0; r < 4; ++r) { const int t = 16 * tt + 4 * g + r; Pl[t * 72 + kpos(s)] = bf1((s <= t) ? acc[r] : 0.f); }
            } else {
#pragma unroll
                for (int r = 0; r < 4; ++r) Pl[(16 * tt + 4 * g + r) * 72 + kpos(s)] = 0;
            }
        }
    }
    __syncthreads();
    { const int row = tid >> 3, c16 = tid & 7; *(u32x4*)((bf16_t*)(c.ws + IA_P) + (size_t)u * 4096 + row * 64 + c16 * 8) = *(const LAS u32x4*)(Pl + row * 72 + c16 * 8); }
    __syncthreads();
}

DI void m1_unit_c(const Ctx& c0, int l, int u) {
    const Ctx c = fresh(c0); const Args& a = *c.a; const int tid = c.tid;
    const int b = u >> 7, n = (u >> 4) & 7, ti = u & 15;
    constexpr int TT = 128;
    LAS float* xcv = (LAS float*)c.lds;
    LAS float* ra = xcv + TT * 64;
    LAS float* ia = ra + TT * 64;
    LAS float* segA = ia + TT * 64;
    LAS float* segB = segA + 512;
    const float* proj = (const float*)(c.ws + WS_PROJ);
    const long rowb = (long)b * SEQ + TT * ti; const int tg0 = TT * ti;
    const int j = tid & 63, g = (tid >> 6) & 1, tg = tid >> 7;
    const float* wsrc = (g ? inp(a, I_CWX) : inp(a, I_CWA)) + ((size_t)l * 8 + n) * 4096 + j;
    float wreg[64];
#pragma unroll
    for (int i = 0; i < 64; ++i) wreg[i] = wsrc[i * 64];
    const float gbias = (g ? inp(a, I_CBX) : inp(a, I_CBA))[l * 512 + n * 64 + j];
    const int cch = tid & 63, seg = tid >> 6, chg = n * 64 + cch;
    {
        const float* ccw = inp(a, I_CCW) + (size_t)l * 4 * 512;
        const float w0 = ccw[chg], w1 = ccw[512 + chg], w2 = ccw[1024 + chg], w3 = ccw[1536 + chg], cb = inp(a, I_CCB)[l * 512 + chg];
        const int ts = seg * 16; const int col = C_CX + chg;
        float x[19];
#pragma unroll
        for (int jx = 0; jx < 19; ++jx) { const int t = ts - 3 + jx; x[jx] = (tg0 + t >= 0) ? proj[(rowb + t) * NINP + col] : 0.f; }
#pragma unroll
        for (int i = 0; i < 16; ++i) xcv[(ts + i) * 64 + cch] = w0 * x[i] + w1 * x[i + 1] + w2 * x[i + 2] + w3 * x[i + 3] + cb;
    }
    __syncthreads();
    for (int tt = tg * 32; tt < tg * 32 + 32; ++tt) {
        float acc0 = 0.f, acc1 = 0.f;
#pragma unroll
        for (int i = 0; i < 64; i += 4) { const f32x4 x = *(const LAS f32x4*)(xcv + tt * 64 + i); acc0 += x.x * wreg[i] + x.z * wreg[i + 2]; acc1 += x.y * wreg[i + 1] + x.w * wreg[i + 3]; }
        (g ? ia : ra)[tt * 64 + j] = sigm(acc0 + acc1 + gbias);
    }
    __syncthreads();
    const float spl = softplus(-inp(a, I_CLAM)[l * 512 + chg]);
    {
        float A = 1.f, B = 0.f;
        for (int i = 0; i < 16; ++i) { const int tt = seg * 16 + i; const float r = ra[tt * 64 + cch], ig = ia[tt * 64 + cch], x = xcv[tt * 64 + cch];
            const float la = -8.f * r * spl; const float at = __expf(la); float mult = sqrtf(fmaxf(0.f, -expm1f(2.f * la)));
            if (tg0 + tt == 0) mult = 1.f;
            const float bt = mult * (ig * x); ra[tt * 64 + cch] = at; ia[tt * 64 + cch] = bt; A *= at; B = at * B + bt; }
        segA[seg * 64 + cch] = A; segB[seg * 64 + cch] = B;
    }
    __syncthreads();
    {
        float Ac = 1.f, Bc = 0.f;
        for (int s = 0; s < seg; ++s) { const float sa = segA[s * 64 + cch], sb = segB[s * 64 + cch]; Bc = sa * Bc + sb; Ac *= sa; }
        float* ga = (float*)(c.ws + IC_A); float* gb = (float*)(c.ws + IC_B);
        for (int i = 0; i < 16; ++i) { const int tt = seg * 16 + i; const float at = ra[tt * 64 + cch], bt = ia[tt * 64 + cch]; Ac *= at; Bc = at * Bc + bt;
            ga[(rowb + tt) * 512 + chg] = Ac; gb[(rowb + tt) * 512 + chg] = Bc; }
        if (seg == 7) { float* gt = (float*)(c.ws + IC_TOT) + (((size_t)b * 16 + ti) * 2) * 512; gt[chg] = Ac; gt[512 + chg] = Bc; }
    }
    __syncthreads();
}

DI void phase_m1(const Ctx& c, int l) {
    int w = blockIdx.x; asm volatile("" : "+s"(w));
    for (int rep = 0; rep < (PROBE_SUB == 1 ? 2 : 1); ++rep) for (int u = w; u < 1024; u += c.G) m1_unit_b(c, l, u);
    for (int rep = 0; rep < (PROBE_SUB == 2 ? 2 : 1); ++rep) for (int u = w; u < 512; u += c.G) m1_unit_a(c, l, u);
    for (int rep = 0; rep < (PROBE_SUB == 3 ? 2 : 1); ++rep) for (int u = w; u < 512; u += c.G) m1_unit_c(c, l, u);
}

DI void m2_unit_head(const Ctx& c0, int l, int isB, int b, int h) {
    const Ctx c = fresh(c0); const Args& a = *c.a; const int tid = c.tid, lane = c.lane, wave = c.wave;
    LAS unsigned char* Wl = c.lds;
    LAS unsigned char* Ql = Wl + 64 * 272;
    LAS unsigned char* KTl = Ql + 64 * 272;
    LAS unsigned char* Pl = KTl + 128 * 144;
    LAS float* ob = (LAS float*)(Pl + 64 * 144);
    LAS float* decl = ob + 64 * 132;
    const int i = lane & 15, g = lane >> 4, e0 = 16 * wave;
    const int ubase = isB ? ((b * 8 + h) * 32) : ((b * 4 + h) * 32);
    const unsigned char* gW = c.ws + IB_W; const unsigned char* gQ = c.ws + (isB ? IB_Q : IA_Q); const unsigned char* gKT = c.ws + (isB ? IB_KT : IA_KT);
    const unsigned char* gP = c.ws + (isB ? IB_P : IA_P); const float* gU = (const float*)(c.ws + (isB ? IB_U0 : IA_V));
    const float* proj = (const float*)(c.ws + WS_PROJ); bf16_t* mixo = (bf16_t*)(c.ws + WS_MIXO);
    const float* nw = (isB ? inp(a, I_BNORM) : inp(a, I_ANORM)) + l * 128;
    const int gcol = isB ? (C_BZ + h * 128) : (C_AG + h * 128), ocol = isB ? (512 + h * 128) : (h * 128);
    const float nw0 = nw[2 * lane], nw1 = nw[2 * lane + 1];
    f32x4 S[8];
#pragma unroll
    for (int dt = 0; dt < 8; ++dt) S[dt] = (f32x4){0.f, 0.f, 0.f, 0.f};
    u32x4 pw[2], pq[2], pk[2], pp, pd = {0u, 0u, 0u, 0u};
    const int r16 = tid >> 4, c16 = tid & 15, r8 = tid >> 3, c8 = tid & 7;
#define M2_LOAD(ch) do { const size_t uu = (size_t)(ubase + (ch)); \
        if (isB) { pw[0] = *(const u32x4*)(gW + uu * 16384 + tid * 16); pw[1] = *(const u32x4*)(gW + uu * 16384 + (tid + 512) * 16); } \
        pq[0] = *(const u32x4*)(gQ + uu * 16384 + tid * 16); pq[1] = *(const u32x4*)(gQ + uu * 16384 + (tid + 512) * 16); \
        pk[0] = *(const u32x4*)(gKT + uu * 16384 + tid * 16); pk[1] = *(const u32x4*)(gKT + uu * 16384 + (tid + 512) * 16); \
        pp = *(const u32x4*)(gP + uu * 8192 + tid * 16); \
        if (!isB && tid < 32) pd = *(const u32x4*)(c.ws + IA_DEC + uu * 512 + tid * 16); } while (0)
#define M2_STORE() do { \
        if (isB) { *(LAS u32x4*)(Wl + r16 * 272 + c16 * 16) = pw[0]; *(LAS u32x4*)(Wl + (r16 + 32) * 272 + c16 * 16) = pw[1]; } \
        *(LAS u32x4*)(Ql + r16 * 272 + c16 * 16) = pq[0]; *(LAS u32x4*)(Ql + (r16 + 32) * 272 + c16 * 16) = pq[1]; \
        *(LAS u32x4*)(KTl + r8 * 144 + c8 * 16) = pk[0]; *(LAS u32x4*)(KTl + (r8 + 64) * 144 + c8 * 16) = pk[1]; \
        *(LAS u32x4*)(Pl + r8 * 144 + c8 * 16) = pp; \
        if (!isB && tid < 32) *(LAS u32x4*)((LAS unsigned char*)decl + tid * 16) = pd; } while (0)
    M2_LOAD(0);
    M2_STORE();
    f32x4 U[4], Un[4]; f32x2 gt[8], gtn[8]; float dec = 0.f, decn = 0.f;
#define M2_LOADR(ch, UU, GT, DEC) do { const size_t uu_ = (size_t)(ubase + (ch)); const long row_ = (long)b * SEQ + 64 * (ch); \
        _Pragma("unroll") for (int tt = 0; tt < 4; ++tt) UU[tt] = *(const f32x4*)(gU + uu_ * 8192 + ((tt * 8 + wave) * 64 + lane) * 4); \
        _Pragma("unroll") for (int k = 0; k < 8; ++k) GT[k] = *(const f32x2*)(proj + (row_ + 8 * wave + k) * NINP + gcol + 2 * lane); \
        if (isB) DEC = ((const float*)(c.ws + IB_DEC))[uu_]; } while (0)
    M2_LOADR(0, U, gt, dec);
    __syncthreads();
    for (int ci = 0; ci < 32; ++ci) {
        const long row0 = (long)b * SEQ + 64 * ci;
        asm volatile("" : "+v"(U[0]), "+v"(U[1]), "+v"(U[2]), "+v"(U[3]), "+v"(dec));
        asm volatile("" : "+v"(gt[0]), "+v"(gt[1]), "+v"(gt[2]), "+v"(gt[3]), "+v"(gt[4]), "+v"(gt[5]), "+v"(gt[6]), "+v"(gt[7]));
        if (ci + 1 < 32) { M2_LOAD(ci + 1); M2_LOADR(ci + 1, Un, gtn, decn); }
        bf16x8 Sb[4];
#pragma unroll
        for (int ks = 0; ks < 4; ++ks) { u32x4 p; p.x = pk2(S[2 * ks][0], S[2 * ks][1]); p.y = pk2(S[2 * ks][2], S[2 * ks][3]); p.z = pk2(S[2 * ks + 1][0], S[2 * ks + 1][1]); p.w = pk2(S[2 * ks + 1][2], S[2 * ks + 1][3]); Sb[ks] = __builtin_bit_cast(bf16x8, p); }
        if (isB) {
#pragma unroll
            for (int tt = 0; tt < 4; ++tt) { f32x4 acc = {0.f, 0.f, 0.f, 0.f};
#pragma unroll
                for (int ks = 0; ks < 4; ++ks) acc = MFMA16(*(const LAS bf16x8*)(Wl + (16 * tt + i) * 272 + (32 * ks + 8 * g) * 2), Sb[ks], acc);
                U[tt] = U[tt] - acc; }
        }
        bf16x8 Ub[2];
#pragma unroll
        for (int k = 0; k < 2; ++k) { u32x4 p; p.x = pk2(U[2 * k][0], U[2 * k][1]); p.y = pk2(U[2 * k][2], U[2 * k][3]); p.z = pk2(U[2 * k + 1][0], U[2 * k + 1][1]); p.w = pk2(U[2 * k + 1][2], U[2 * k + 1][3]); Ub[k] = __builtin_bit_cast(bf16x8, p); }
#pragma unroll
        for (int tt = 0; tt < 4; ++tt) { f32x4 acc = {0.f, 0.f, 0.f, 0.f};
#pragma unroll
            for (int ks = 0; ks < 4; ++ks) acc = MFMA16(*(const LAS bf16x8*)(Ql + (16 * tt + i) * 272 + (32 * ks + 8 * g) * 2), Sb[ks], acc);
#pragma unroll
            for (int k = 0; k < 2; ++k) acc = MFMA16(*(const LAS bf16x8*)(Pl + (16 * tt + i) * 144 + (32 * k + 8 * g) * 2), Ub[k], acc);
#pragma unroll
            for (int r = 0; r < 4; ++r) ob[(16 * tt + 4 * g + r) * 132 + e0 + i] = acc[r]; }
        if (isB) {
#pragma unroll
            for (int dt = 0; dt < 8; ++dt) S[dt] = S[dt] * dec;
        } else {
#pragma unroll
            for (int dt = 0; dt < 8; ++dt) S[dt] = S[dt] * *(const LAS f32x4*)(decl + 16 * dt + 4 * g); }
#pragma unroll
        for (int dt = 0; dt < 8; ++dt) {
#pragma unroll
            for (int k = 0; k < 2; ++k) S[dt] = MFMA16(*(const LAS bf16x8*)(KTl + (16 * dt + i) * 144 + (32 * k + 8 * g) * 2), Ub[k], S[dt]); }
        __syncthreads();
        { f32x2 vv[8]; float ss[8];
#pragma unroll
          for (int k = 0; k < 8; ++k) vv[k] = *(const LAS f32x2*)(ob + (8 * wave + k) * 132 + 2 * lane);
#pragma unroll
          for (int k = 0; k < 8; ++k) ss[k] = row16_sum(vv[k].x * vv[k].x + vv[k].y * vv[k].y);
#pragma unroll
          for (int k = 0; k < 8; ++k) ss[k] = __int_as_float(__builtin_amdgcn_readlane(__float_as_int(ss[k]), 0)) + __int_as_float(__builtin_amdgcn_readlane(__float_as_int(ss[k]), 16)) +
              __int_as_float(__builtin_amdgcn_readlane(__float_as_int(ss[k]), 32)) + __int_as_float(__builtin_amdgcn_readlane(__float_as_int(ss[k]), 48));
#pragma unroll
          for (int k = 0; k < 8; ++k) { const float r = rsqrtf(ss[k] * (1.f / 128.f) + NORM_EPS);
            *(unsigned*)(mixo + (row0 + 8 * wave + k) * D + ocol + 2 * lane) = pk2(vv[k].x * r * nw0 * silu(gt[k].x), vv[k].y * r * nw1 * silu(gt[k].y)); } }
        if (ci + 1 < 32) { M2_STORE();
#pragma unroll
            for (int tt = 0; tt < 4; ++tt) U[tt] = Un[tt];
#pragma unroll
            for (int k = 0; k < 8; ++k) gt[k] = gtn[k];
            dec = decn; }
        __syncthreads();
    }
#undef M2_LOADR
#undef M2_LOAD
#undef M2_STORE
    float* so = c.out + (isB ? O_GDP + (((size_t)l * BATCH + b) * 8 + h) * 16384 : O_HGP + (((size_t)l * BATCH + b) * 4 + h) * 16384);
#pragma unroll
    for (int dt = 0; dt < 8; ++dt)
#pragma unroll
        for (int r = 0; r < 4; ++r) so[(size_t)(16 * dt + 4 * g + r) * 128 + e0 + i] = S[dt][r];
}

DI void m2_unit_cfin(const Ctx& c0, int l, int u) {
    const Ctx c = fresh(c0); const int tid = c.tid;
    const int b = u >> 7, n = (u >> 4) & 7, ti = u & 15;
    const int cch = tid & 63, seg = tid >> 6, chg = n * 64 + cch;
    const float* proj = (const float*)(c.ws + WS_PROJ); bf16_t* mixo = (bf16_t*)(c.ws + WS_MIXO);
    const float* ga = (const float*)(c.ws + IC_A); const float* gb = (const float*)(c.ws + IC_B);
    const float* gt = (const float*)(c.ws + IC_TOT) + ((size_t)b * 16 * 2) * 512;
    float hs = 0.f;
    for (int k = 0; k < ti; ++k) hs = gt[(k * 2) * 512 + chg] * hs + gt[(k * 2 + 1) * 512 + chg];
    const long rowb = (long)b * SEQ + 128 * ti;
    float hh = 0.f;
#pragma unroll 4
    for (int i = 0; i < 16; ++i) { const long row = rowb + seg * 16 + i; hh = gb[row * 512 + chg] + ga[row * 512 + chg] * hs;
        mixo[row * D + 1536 + chg] = bf1(hh * gelu_tanh(proj[row * NINP + C_CG + chg])); }
    if (ti == 15 && seg == 7) c.out[O_RHP + ((size_t)l * BATCH + b) * 512 + chg] = hh;
}

DI void block_reduce_cols(LAS float* red, LAS float* full, const float (&p)[4], int tid, float scale) {
    const int e4 = (tid & 31) * 4, dgp = tid >> 5;
    *(LAS f32x4*)(red + dgp * 128 + e4) = (f32x4){p[0], p[1], p[2], p[3]};
    __syncthreads();
    if (tid < 128) { float s = 0.f;
#pragma unroll
        for (int k = 0; k < 16; ++k) s += red[k * 128 + tid];
        full[tid] = s * scale; }
    __syncthreads();
}
DI void unit_b_sample(const Ctx& c0, int l, int b, int h) {
    const Ctx c = fresh(c0);
    const Args& a = *c.a; const int tid = c.tid, lane = c.lane, wave = c.wave;
    LAS float* qkv = (LAS float*)c.lds;
    LAS float* scl = qkv + 384;
    LAS float* red = scl + 8;
    LAS float* full = red + 2048;
    LAS float* uu = full + 128;
    const float* proj = (const float*)(c.ws + WS_PROJ) + (size_t)(NP + b) * NINP;
    if (tid < 384) { const int part = tid >> 7, idx = tid & 127, cc = part * 1024 + h * 128 + idx;
        const float* cw = inp(a, I_BCW) + (size_t)l * 4 * 3072; const float* st = inp(a, I_SGC) + (((size_t)l * NS + b) * 3) * 3072;
        const float x0 = st[cc], x1 = st[3072 + cc], x2 = st[2 * 3072 + cc], x3 = proj[C_BQ + cc];
        qkv[tid] = silu(cw[cc] * x0 + cw[3072 + cc] * x1 + cw[2 * 3072 + cc] * x2 + cw[3 * 3072 + cc] * x3);
        float* so = c.out + O_GCS + (((size_t)l * NS + b) * 3) * 3072; so[cc] = x1; so[3072 + cc] = x2; so[2 * 3072 + cc] = x3; }
    if (tid == 384) { const float bb = proj[C_BB + h], ba = proj[C_BA + h]; scl[0] = sigm(bb); scl[1] = __expf(-__expf(inp(a, I_BALOG)[l * 8 + h]) * softplus(ba + inp(a, I_BDT)[l * 8 + h])); }
    __syncthreads();
    if (wave < 2) { const float x0 = qkv[wave * 128 + lane], x1 = qkv[wave * 128 + 64 + lane]; const float ss = wave_sum(x0 * x0 + x1 * x1);
        if (lane == 0) scl[2 + wave] = rsqrtf(ss + L2_EPS) * (wave == 0 ? 0.08838834764831845f : 1.f); }
    __syncthreads();
    const float beta = scl[0], eg = scl[1], sq = scl[2], sk = scl[3];
    const int e4 = (tid & 31) * 4, d0 = (tid >> 5) * 8;
    const size_t sidx = (((size_t)l * NS + b) * 8 + h) * 16384;
    const float* Sin = inp(a, I_SGD) + sidx; float* Sout = c.out + O_GDS + sidx;
    f32x4 S[8]; float p[4] = {0.f, 0.f, 0.f, 0.f};
#pragma unroll
    for (int i = 0; i < 8; ++i) { S[i] = *(const f32x4*)(Sin + (size_t)(d0 + i) * 128 + e4); const float k = qkv[128 + d0 + i]; p[0] += k * S[i].x; p[1] += k * S[i].y; p[2] += k * S[i].z; p[3] += k * S[i].w; }
    block_reduce_cols(red, full, p, tid, sk);
    if (tid < 128) uu[tid] = beta * (qkv[256 + tid] - eg * full[tid]) * sk;
    __syncthreads();
    const f32x4 u4 = *(const LAS f32x4*)(uu + e4);
    float po[4] = {0.f, 0.f, 0.f, 0.f};
#pragma unroll
    for (int i = 0; i < 8; ++i) { const float k = qkv[128 + d0 + i], q = qkv[d0 + i]; S[i] = S[i] * eg + u4 * k; *(f32x4*)(Sout + (size_t)(d0 + i) * 128 + e4) = S[i];
        po[0] += q * S[i].x; po[1] += q * S[i].y; po[2] += q * S[i].z; po[3] += q * S[i].w; }
    block_reduce_cols(red, full, po, tid, sq);
    if (wave < 2) { const float o = full[wave * 64 + lane]; const float ss = wave_sum(o * o); if (lane == 0) scl[4 + wave] = ss; }
    __syncthreads();
    if (tid < 128) { const float rms = rsqrtf((scl[4] + scl[5]) * (1.f / 128.f) + NORM_EPS);
        const float o = full[tid] * rms * inp(a, I_BNORM)[l * 128 + tid] * silu(proj[C_BZ + h * 128 + tid]);
        ((bf16_t*)(c.ws + WS_MIXO))[(size_t)(NP + b) * D + 512 + h * 128 + tid] = (bf16_t)(pk2(o, 0.f) & 0xffffu); }
    __syncthreads();
}
DI void unit_a_sample(const Ctx& c0, int l, int b, int h) {
    const Ctx c = fresh(c0);
    const Args& a = *c.a; const int tid = c.tid, lane = c.lane, wave = c.wave;
    LAS float* fqv = (LAS float*)c.lds;
    LAS float* scl = fqv + 384;
    LAS float* red = scl + 8;
    LAS float* full = red + 2048;
    const float* proj = (const float*)(c.ws + WS_PROJ) + (size_t)(NP + b) * NINP;
    if (tid < 384) { const int part = tid >> 7, idx = tid & 127;
        if (part == 0) { const float lb = lb_of(a, l, h * 128 + idx); fqv[tid] = lb + (1.f - lb) * sigm(proj[C_AF + h * 128 + idx]); }
        else if (part == 1) fqv[tid] = silu(proj[C_AQ + h * 128 + idx]);
        else fqv[tid] = proj[C_AI + h * 128 + idx]; }
    __syncthreads();
    const int e4 = (tid & 31) * 4, d0 = (tid >> 5) * 8;
    const size_t sidx = (((size_t)l * NS + b) * 4 + h) * 16384;
    const float* Sin = inp(a, I_SHG) + sidx; float* Sout = c.out + O_HGS + sidx;
    const f32x4 v4 = *(const LAS f32x4*)(fqv + 256 + e4);
    float po[4] = {0.f, 0.f, 0.f, 0.f};
#pragma unroll
    for (int i = 0; i < 8; ++i) { const float f = fqv[d0 + i], q = fqv[128 + d0 + i]; f32x4 S = *(const f32x4*)(Sin + (size_t)(d0 + i) * 128 + e4);
        S = S * f + v4 * (1.f - f); *(f32x4*)(Sout + (size_t)(d0 + i) * 128 + e4) = S;
        po[0] += q * S.x; po[1] += q * S.y; po[2] += q * S.z; po[3] += q * S.w; }
    block_reduce_cols(red, full, po, tid, 1.f);
    if (wave < 2) { const float o = full[wave * 64 + lane]; const float ss = wave_sum(o * o); if (lane == 0) scl[4 + wave] = ss; }
    __syncthreads();
    if (tid < 128) { const float rms = rsqrtf((scl[4] + scl[5]) * (1.f / 128.f) + NORM_EPS);
        const float o = full[tid] * rms * inp(a, I_ANORM)[l * 128 + tid] * silu(proj[C_AG + h * 128 + tid]);
        ((bf16_t*)(c.ws + WS_MIXO))[(size_t)(NP + b) * D + h * 128 + tid] = (bf16_t)(pk2(o, 0.f) & 0xffffu); }
    __syncthreads();
}
DI void unit_c_sample(const Ctx& c0, int l, int b) {
    const Ctx c = fresh(c0);
    const Args& a = *c.a; const int tid = c.tid;
    LAS float* xc = (LAS float*)c.lds;
    const float* proj = (const float*)(c.ws + WS_PROJ) + (size_t)(NP + b) * NINP;
    const float* ccw = inp(a, I_CCW) + (size_t)l * 4 * 512; const float* st = inp(a, I_SRC) + (((size_t)l * NS + b) * 3) * 512;
    const float x0 = st[tid], x1 = st[512 + tid], x2 = st[1024 + tid], x3 = proj[C_CX + tid];
    const float xv = ccw[tid] * x0 + ccw[512 + tid] * x1 + ccw[1024 + tid] * x2 + ccw[1536 + tid] * x3 + inp(a, I_CCB)[l * 512 + tid];
    xc[tid] = xv;
    { float* so = c.out + O_RCS + (((size_t)l * NS + b) * 3) * 512; so[tid] = x1; so[512 + tid] = x2; so[1024 + tid] = x3; }
    __syncthreads();
    const int n = tid >> 6, j = tid & 63;
    const float* wa = inp(a, I_CWA) + ((size_t)l * 8 + n) * 4096 + j; const float* wx = inp(a, I_CWX) + ((size_t)l * 8 + n) * 4096 + j;
    float sa = 0.f, sx = 0.f;
#pragma unroll 8
    for (int i = 0; i < 64; ++i) { const float x = xc[n * 64 + i]; sa += x * wa[i * 64]; sx += x * wx[i * 64]; }
    const float r = sigm(sa + inp(a, I_CBA)[l * 512 + tid]), ig = sigm(sx + inp(a, I_CBX)[l * 512 + tid]);
    const float la = -8.f * r * softplus(-inp(a, I_CLAM)[l * 512 + tid]); const float at = __expf(la); const float mult = sqrtf(fmaxf(0.f, -expm1f(2.f * la)));
    const float h0 = inp(a, I_SRH)[((size_t)l * NS + b) * 512 + tid];
    const float hh = at * h0 + mult * (ig * xv);
    c.out[O_RHS + ((size_t)l * NS + b) * 512 + tid] = hh;
    ((bf16_t*)(c.ws + WS_MIXO))[(size_t)(NP + b) * D + 1536 + tid] = (bf16_t)(pk2(hh * gelu_tanh(proj[C_CG + tid]), 0.f) & 0xffffu);
    __syncthreads();
}


DI void phase_m2(const Ctx& c, int l) {
    int w = blockIdx.x; asm volatile("" : "+s"(w));
    if (w < 48) {
        const int isB = w < 32; const int u = isB ? w : w - 32;
        for (int rep = 0; rep < (PROBE_SUB == 4 ? 2 : 1); ++rep) m2_unit_head(c, l, isB, isB ? (u >> 3) : (u >> 2), isB ? (u & 7) : (u & 3));
    } else {
        const int nw = c.G - 48;
        for (int rep = 0; rep < (PROBE_SUB == 5 ? 2 : 1); ++rep)
        for (int u = w - 48; u < 512 + 1664; u += nw) {
            if (u < 512) m2_unit_cfin(c, l, u);
            else { const int v = u - 512;
                if (v < 1024) unit_b_sample(c, l, v >> 3, v & 7);
                else if (v < 1536) { const int x = v - 1024; unit_a_sample(c, l, x >> 2, x & 3); }
                else unit_c_sample(c, l, v - 1536); }
        }
        { const Ctx cv = fresh(c); __syncthreads();
          convert_range(cv, l == 0 ? CV_IN : CV_LAYER + CV_IN, l == 0 ? CV_LAYER + CV_IN : 2 * CV_LAYER, (w - 48) * 8 + cv.wave, nw * 8); }
        const Ctx cc = fresh(c); const float* proj = (const float*)(cc.ws + WS_PROJ);
        const int gt_ = (w - 48) * 512 + cc.tid, NT = nw * 512;
        for (int i = gt_; i < BATCH * 3 * 3072; i += NT) { const int b = i / (3 * 3072), r = i - b * 3 * 3072, j = r / 3072, ch = r - j * 3072;
            cc.out[O_GCP + (size_t)l * BATCH * 3 * 3072 + i] = proj[((size_t)b * SEQ + SEQ - 3 + j) * NINP + C_BQ + ch]; }
        for (int i = gt_; i < BATCH * 3 * 512; i += NT) { const int b = i / (3 * 512), r = i - b * 3 * 512, j = r / 512, ch = r - j * 512;
            cc.out[O_RCP + (size_t)l * BATCH * 3 * 512 + i] = proj[((size_t)b * SEQ + SEQ - 3 + j) * NINP + C_CX + ch]; }
    }
}


#define XB_TMO      128
#define XB_XCNT(j)  (256  + 64 * (j))
#define XB_XSUB(j)  (1280 + 64 * (j))
#define XB_XGEN(j)  (2304 + 64 * (j))
#define XB_TOP      3328
#define XB_TOPGEN   3392
#define XCD_BAR_WORDS 3456
#define XB_SPIN_CAP (1u << 20)
DI unsigned xb_ld(unsigned* p)              { return __hip_atomic_load(p, __ATOMIC_RELAXED, __HIP_MEMORY_SCOPE_AGENT); }
DI unsigned xb_add(unsigned* p, unsigned v) { return __hip_atomic_fetch_add(p, v, __ATOMIC_RELAXED, __HIP_MEMORY_SCOPE_AGENT); }
DI unsigned xb_xcc_id() { return (unsigned)__builtin_amdgcn_s_getreg((3 << 11) | 20) & 0xFu; }
#define XB_SPIN(cond, bar) do { unsigned _sp = 0; while (cond) { __builtin_amdgcn_s_sleep(1); \
    if ((++_sp & 255u) == 0u) { if (xb_ld(&(bar)[XB_TMO])) break; if (_sp > XB_SPIN_CAP) { atomicAdd(&(bar)[XB_TMO], 1u); break; } } } } while (0)
DI void xcd_barrier_post(unsigned* bar) { if (threadIdx.x == 0) (void)xb_add(&bar[XB_XCNT(xb_xcc_id())], 1u); }
DI void xcd_barrier_complete(unsigned* bar, unsigned x, unsigned& nloc, unsigned& nx) {
    const unsigned G = gridDim.x * gridDim.y * gridDim.z;
    unsigned sum, cnt, mine, sp = 0u;
    for (;;) {
        sum = 0u; cnt = 0u; mine = 0u;
#pragma unroll
        for (unsigned j = 0; j < 16; ++j) { const unsigned c = xb_ld(&bar[XB_XCNT(j)]); sum += c; cnt += (c > 0u) ? 1u : 0u; mine = (j == x) ? c : mine; }
        if (sum == G) break;
        __builtin_amdgcn_s_sleep(1);
        if ((++sp & 255u) == 0u) { if (xb_ld(&bar[XB_TMO])) break; if (sp > XB_SPIN_CAP) { atomicAdd(&bar[XB_TMO], 1u); break; } }
    }
    nloc = mine > 0u ? mine : 1u; nx = cnt > 0u ? cnt : 1u;
}
DI void xcd_barrier(unsigned* bar, volatile LAS unsigned* st) {
    asm volatile("s_waitcnt vmcnt(0)" ::: "memory");
    __syncthreads();
    if (threadIdx.x == 0) {
        const unsigned x = xb_xcc_id();
        __builtin_amdgcn_s_waitcnt(0);
        unsigned nloc = st[0], nx = st[1];
        if (nloc == 0u) { xcd_barrier_complete(bar, x, nloc, nx); st[0] = nloc; st[1] = nx; }
        const unsigned old = xb_add(&bar[XB_XSUB(x)], 1u);
        const unsigned gen = old / nloc;
        if (old + 1u == (gen + 1u) * nloc) {
            __builtin_amdgcn_fence(__ATOMIC_RELEASE, "agent");
            asm volatile("s_waitcnt vmcnt(0)" ::: "memory");
            const unsigned og = xb_add(&bar[XB_TOP], 1u);
            const unsigned tg = og / nx;
            if (og + 1u == (tg + 1u) * nx) xb_add(&bar[XB_TOPGEN], 1u);
            else XB_SPIN(xb_ld(&bar[XB_TOPGEN]) == tg, bar);
            __builtin_amdgcn_fence(__ATOMIC_ACQUIRE, "agent");
            xb_add(&bar[XB_XGEN(x)], 1u);
            asm volatile("s_waitcnt vmcnt(0)" ::: "memory");
        } else {
            XB_SPIN(xb_ld(&bar[XB_XGEN(x)]) == gen, bar);
            __builtin_amdgcn_fence(__ATOMIC_ACQUIRE, "agent");
            asm volatile("s_waitcnt vmcnt(0)" ::: "memory");
        }
    }
    __syncthreads();
}

__global__ void __launch_bounds__(512, 2) fwd_megakernel(Args args) {
    extern __shared__ __attribute__((aligned(16))) unsigned char lds_raw[];
    Ctx c0; c0.a = &args; c0.ws = nullptr; c0.out = nullptr; c0.lds = (LAS unsigned char*)lds_raw; c0.tid = 0; c0.lane = 0; c0.wave = 0; c0.G = gridDim.x; c0.bid = 0;
    const int lo = args.ph_lo, hi = args.ph_hi;
    volatile LAS unsigned* bst = (volatile LAS unsigned*)((LAS unsigned char*)lds_raw + LDS_BYTES - 16);
    if (threadIdx.x == 0) { bst[0] = 0u; bst[1] = 0u; }
    __syncthreads();
    xcd_barrier_post((unsigned*)(args.ws + WS_CTL) + 1024);
#pragma unroll 1
    for (int ph2 = 2 * lo; ph2 < 2 * hi; ++ph2) {
        const int ph = ph2 >> 1;
        const int l = (ph - 1) >> 3, k = (ph == 0) ? -1 : ((ph - 1) & 7);
        if ((ph2 & 1) && k != PROBE_REP) continue;
        if (k == -1) phase_p0(c0);
        else if (k == 0 || k == 3 || k == 5 || k == 6) {
            const Ctx c = fresh(c0); unsigned char* ws = c.ws;
            pg8::Gemm g; pg8::EpiAny E; E.mode = 0; E.C = (float*)(ws + WS_MIXF); E.O = nullptr; E.ldc = D;
            if (k == 0)      { g.A = (const bf16_t*)(ws + WS_HBUF); g.Bt = (const bf16_t*)(ws + WS_WIN + l * SZ_WIN);   g.N = NINP; g.K = D;   E.C = (float*)(ws + WS_PROJ); E.ldc = NINP; }
            else if (k == 3) { g.A = (const bf16_t*)(ws + WS_MIXO); g.Bt = (const bf16_t*)(ws + WS_WOUT + l * SZ_WOUT); g.N = D;    g.K = D; }
            else if (k == 5) { g.A = (const bf16_t*)(ws + WS_HBUF); g.Bt = (const bf16_t*)(ws + WS_WGU + l * SZ_WGU);   g.N = NGU;  g.K = D;   E.mode = 1; E.O = (bf16_t*)(ws + WS_PROJ); E.ldc = DFF; }
            else             { g.A = (const bf16_t*)(ws + WS_PROJ); g.Bt = (const bf16_t*)(ws + WS_WDN + l * SZ_WDN);   g.N = D;    g.K = DFF; }
            g.M = (k == 3 || k == 6) ? NP : MPAD;
            pg8::StaticOrder S; S.init(g.M, g.N, c.G, c.bid);
            pg8::gemm_phase<pg8::EpiAny, pg8::StaticOrder, true, true>(c.lds, g, S, E);
            if (k == 3 || k == 6) sample_pieces(c0, g.A + (size_t)NP * g.K, g.Bt, g.K, (float*)(ws + WS_SLAB));
        }
        else if (k == 1) phase_m1(c0, l);
        else if (k == 2) phase_m2(c0, l);
        else {
            const Ctx c = fresh(c0); unsigned char* ws = c.ws;
            float* mixf = (float*)(ws + WS_MIXF); float* x1 = (float*)(ws + WS_X1); bf16_t* hb = (bf16_t*)(ws + WS_HBUF);
            if (k == 4) {
                const float* xa = (l == 0) ? inp(args, I_XP) : c.out; const float* xb = (l == 0) ? inp(args, I_XS) : c.out + (size_t)NP * D;
                row_phase(c0, mixf, (const float*)(ws + WS_SLAB), xa, xb, x1, inp(args, I_LN2) + l * D, inp(args, I_LN3) + l * D, hb);
            } else {
                row_phase(c0, mixf, (const float*)(ws + WS_SLAB), x1, x1 + (size_t)NP * D, c.out, inp(args, I_LN4) + l * D, l == 0 ? inp(args, I_LN1) + D : nullptr, hb);
            }
        }
        if (ph2 + 1 < 2 * hi) {
            if (ph2 == 2 * lo) cg::this_grid().sync();
            else xcd_barrier((unsigned*)(args.ws + WS_CTL) + 1024, bst);
        }
    }
}

extern "C" void kernel_launch(void* const* d_in, const int* in_sizes, int n_in, void* d_out, int out_size, void* d_ws, size_t ws_size, hipStream_t stream) {
    static int grid = 0;
    if (grid == 0) {
        if (n_in != 29 || (size_t)out_size != O_END || ws_size < WS_END) { fprintf(stderr, "kernel_launch: unexpected shapes: n_in %d out %d ws %zu (need %zu)\n", n_in, out_size, ws_size, (size_t)WS_END); grid = -1; return; }
        int dev = 0, cus = 0, per_cu = 0;
        hipGetDevice(&dev); hipDeviceGetAttribute(&cus, hipDeviceAttributeMultiprocessorCount, dev);
        if (hipFuncSetAttribute((const void*)fwd_megakernel, hipFuncAttributeMaxDynamicSharedMemorySize, LDS_BYTES) != hipSuccess) { fprintf(stderr, "kernel_launch: hipFuncSetAttribute failed\n"); grid = -1; return; }
        if (hipOccupancyMaxActiveBlocksPerMultiprocessor(&per_cu, (const void*)fwd_megakernel, 512, LDS_BYTES) != hipSuccess || per_cu < 1) { fprintf(stderr, "kernel_launch: occupancy query says %d\n", per_cu); grid = -1; return; }
        grid = cus;
        if (grid < 224) { fprintf(stderr, "kernel_launch: needs >= 224 CUs, got %d\n", grid); grid = -1; return; }
    }
    if (grid < 0) return;
    hipMemsetAsync((char*)d_ws + WS_CTL, 0, CTL_BYTES, stream);
    Args a{};
    for (int i = 0; i < 29; ++i) a.in[i] = (const float*)d_in[i];
    a.out = (float*)d_out; a.ws = (unsigned char*)d_ws;
#if MK_MULTI
    for (int ph = 0; ph < NPHASE; ++ph) { a.ph_lo = ph; a.ph_hi = ph + 1; hipLaunchKernelGGL(fwd_megakernel, dim3(grid), dim3(512), LDS_BYTES, stream, a); }
#else
    a.ph_lo = 0; a.ph_hi = NPHASE;
    void* kargs[] = {&a};
    hipError_t e = hipLaunchCooperativeKernel((const void*)fwd_megakernel, dim3(grid), dim3(512), kargs, LDS_BYTES, stream);
    if (e != hipSuccess) fprintf(stderr, "cooperative launch failed: %s (grid %d)\n", hipGetErrorString(e), grid);
#endif
}
```

```cpp
#include <hip/hip_runtime.h>
#include <hip/hip_cooperative_groups.h>
#include <cstdio>
#include <cstdint>
namespace cg = cooperative_groups;

#ifndef MK_MULTI
#define MK_MULTI 0
#endif

#ifndef PROBE_REP
#define PROBE_REP (-2)
#endif
#ifndef PROBE_SUB
#define PROBE_SUB 0
#endif
#ifndef PROBE_SEG
#define PROBE_SEG 0
#endif
#define SEG_T0(id) unsigned long long seg_t0_##id = 0; if (PROBE_SEG == (id)) seg_t0_##id = __builtin_amdgcn_s_memrealtime();
#define SEG_T1(id) if (PROBE_SEG == (id)) { const unsigned long long t1_ = __builtin_amdgcn_s_memrealtime(); const unsigned long long d_ = (t1_ - seg_t0_##id) * 8ull; \
        while (__builtin_amdgcn_s_memrealtime() - t1_ < d_) __builtin_amdgcn_s_sleep(2); }
#define DI __device__ __forceinline__
#define LAS __attribute__((address_space(3)))
#define GAS __attribute__((address_space(1)))
typedef unsigned short bf16_t;
typedef float f32x4 __attribute__((ext_vector_type(4)));
typedef float f32x2 __attribute__((ext_vector_type(2)));
typedef unsigned u32x4 __attribute__((ext_vector_type(4)));
typedef unsigned u32x2 __attribute__((ext_vector_type(2)));
typedef short bf16x8 __attribute__((ext_vector_type(8)));
typedef __bf16 bf16v2 __attribute__((ext_vector_type(2)));

constexpr int D = 2048, SEQ = 2048, BATCH = 4, NP = BATCH * SEQ, NS = 128, MT = NP + NS, MPAD = 8448;
constexpr int NIN = 7184, NINP = 7424, DFF = 5632, NGU = 2 * DFF;
constexpr int C_AQ = 0, C_AF = 512, C_AI = 1024, C_AG = 1536, C_BQ = 2048, C_BK = 3072, C_BV = 4096, C_BZ = 5120, C_BB = 6144, C_BA = 6152, C_CX = 6160, C_CG = 6672;
constexpr float NORM_EPS = 1e-6f, L2_EPS = 1e-6f;
constexpr int NPHASE = 17;

constexpr size_t O_YP = 0, O_YS = O_YP + (size_t)NP * D, O_HGP = O_YS + (size_t)NS * D, O_HGS = O_HGP + 2ull * 4 * 4 * 16384,
                 O_GDP = O_HGS + 2ull * 128 * 4 * 16384, O_GDS = O_GDP + 2ull * 4 * 8 * 16384, O_GCP = O_GDS + 2ull * 128 * 8 * 16384,
                 O_GCS = O_GCP + 2ull * 4 * 3 * 3072, O_RHP = O_GCS + 2ull * 128 * 3 * 3072, O_RHS = O_RHP + 2ull * 4 * 512,
                 O_RCP = O_RHS + 2ull * 128 * 512, O_RCS = O_RCP + 2ull * 4 * 3 * 512, O_END = O_RCS + 2ull * 128 * 3 * 512;

constexpr size_t MiB = 1ull << 20;
constexpr size_t WS_CTL = 0, CTL_BYTES = 1 * MiB;
constexpr size_t WS_WIN = 1 * MiB, SZ_WIN = 29 * MiB, WS_WOUT = WS_WIN + 2 * SZ_WIN, SZ_WOUT = 8 * MiB, WS_WGU = WS_WOUT + 2 * SZ_WOUT, SZ_WGU = 44 * MiB,
                 WS_WDN = WS_WGU + 2 * SZ_WGU, SZ_WDN = 22 * MiB;
constexpr size_t WS_PROJ = WS_WDN + 2 * SZ_WDN, SZ_PROJ = 240 * MiB;
constexpr size_t WS_HBUF = WS_PROJ + SZ_PROJ, SZ_HBUF = 33 * MiB;
constexpr size_t WS_MIXO = WS_HBUF + SZ_HBUF;
constexpr size_t WS_MIXF = WS_MIXO + SZ_HBUF, SZ_MIXF = 66 * MiB;
constexpr size_t WS_X1 = WS_MIXF + SZ_MIXF, WS_END = WS_X1 + SZ_MIXF + 25 * MiB;
static_assert((size_t)NINP * D * 2 == SZ_WIN && (size_t)NGU * D * 2 == SZ_WGU && (size_t)D * DFF * 2 == SZ_WDN && (size_t)D * D * 2 == SZ_WOUT, "weight sizes");
static_assert((size_t)MPAD * NINP * 4 <= SZ_PROJ && (size_t)MPAD * D * 2 <= SZ_HBUF && (size_t)MPAD * D * 4 <= SZ_MIXF, "ws map");

constexpr int LDS_BYTES = 147456;

DI unsigned pk2(float lo, float hi) { f32x2 x = {lo, hi}; bf16v2 y = __builtin_convertvector(x, bf16v2); return __builtin_bit_cast(unsigned, y); }
DI float wave_sum(float v) {
#pragma unroll
    for (int o = 1; o < 64; o <<= 1) v += __shfl_xor(v, o);
    return v;
}
template <int CTRL> DI float dpp_mov(float v) { return __int_as_float(__builtin_amdgcn_update_dpp(0, __float_as_int(v), CTRL, 0xF, 0xF, true)); }
DI float row16_sum(float v) {
    v += dpp_mov<0xB1>(v); v += dpp_mov<0x4E>(v); v += dpp_mov<0x124>(v); v += dpp_mov<0x128>(v); return v;
}
DI float rl(float v, int l) { return __int_as_float(__builtin_amdgcn_readlane(__float_as_int(v), l)); }
DI float wave_sum_fast(float v) { v = row16_sum(v); return (rl(v, 0) + rl(v, 16)) + (rl(v, 32) + rl(v, 48)); }
DI float sigm(float x) { return __builtin_amdgcn_rcpf(1.f + __expf(-x)); }
DI float silu(float x) { return x * __builtin_amdgcn_rcpf(1.f + __expf(-x)); }
DI float softplus(float x) { return x > 20.f ? x : log1pf(__expf(x)); }
DI float gelu_tanh(float x) { const float y = 0.7978845608028654f * (x + 0.044715f * x * x * x); return 0.5f * x * (1.f + tanhf(y)); }
#define LDS_WAIT() asm volatile("s_waitcnt lgkmcnt(0)" ::: "memory")
#define MFMA16(a, b, c) __builtin_amdgcn_mfma_f32_16x16x32_bf16((a), (b), (c), 0, 0, 0)

namespace pg8 {
#define PG8_LAS __attribute__((address_space(3)))
constexpr int BM = 256, BK = 64, HALF = 128, HTB = HALF * BK * 2, STAGE_BYTES = 8 * HTB, NXCD = 8, WGM = 8;
__host__ __device__ __forceinline__ int lds_byte(int r, int c) { const int st = (r >> 4) * 2 + (c >> 5), rr = r & 15, cc = c & 31, ob = rr * 64 + cc * 2; return st * 1024 + (ob ^ (((ob >> 9) & 1) << 5)); }
__host__ __device__ __forceinline__ void stage_rc(int b, int& R, int& C) { const int st = b / 1024, sb = b % 1024, swz = sb ^ (((sb >> 9) & 1) << 5); R = (st >> 1) * 16 + swz / 64; C = (st & 1) * 32 + (swz % 64) / 2; }
struct Unit { int pm, pn; };
struct Gemm { const bf16_t* A; const bf16_t* Bt; int M, N, K; };
struct StaticOrder {
    int nM, nN, nwg, G, c;
    __host__ __device__ void init(int M, int N, int G_, int c_) { nM = M / BM; nN = N / BM; nwg = nM * nN; G = G_; c = c_; }
    __host__ __device__ bool next(int i, Unit& u) const {
        const long L = (long)i * G + c; if (L >= nwg) return false;
        int wgid = (int)L; { const int q = nwg / NXCD, r = nwg % NXCD, xcd = wgid % NXCD, off = wgid / NXCD; wgid = (xcd < r ? xcd * (q + 1) : r * (q + 1) + (xcd - r) * q) + off; }
        const int nig = WGM * nN, gid = wgid / nig, fm = gid * WGM, gsz = (nM - fm) < WGM ? (nM - fm) : WGM;
        u.pm = fm + ((wgid % nig) % gsz); u.pn = (wgid % nig) / gsz; return true;
    }
    __device__ __forceinline__ void a_ready(const Unit&) const {}
    __device__ __forceinline__ void done(const Unit&) const {}
};
struct EpiAny {
    static constexpr bool PERM = false, AFTER_DRAIN = false;
    int mode; float* C; bf16_t* O; int ldc;
    __device__ __forceinline__ void operator()(const f32x4 (&acc)[2][2][4][2], const Unit& u, int wr, int wc, int fr, int fq) const {
        const int row0 = u.pm * BM + wr * 64 + fr;
        if (mode == 0) {
            const int col0 = u.pn * BM + wc * 32 + 4 * fq;
#pragma unroll
            for (int ai = 0; ai < 2; ++ai)
#pragma unroll
                for (int m = 0; m < 4; ++m) { float* rowp = C + (size_t)(row0 + ai * HALF + m * 16) * ldc + col0;
#pragma unroll
                    for (int bj = 0; bj < 2; ++bj)
#pragma unroll
                        for (int n = 0; n < 2; ++n) *(f32x4*)(rowp + bj * HALF + n * 16) = acc[ai][bj][m][n]; }
        } else {
#pragma unroll
            for (int ai = 0; ai < 2; ++ai)
#pragma unroll
                for (int m = 0; m < 4; ++m) { bf16_t* rowp = O + (size_t)(row0 + ai * HALF + m * 16) * ldc;
#pragma unroll
                    for (int bj = 0; bj < 2; ++bj) { const int G = 8 * u.pn + 4 * bj + wc; const f32x4 g = acc[ai][bj][m][0], up = acc[ai][bj][m][1];
                        u32x2 w; w.x = pk2(silu(g[0]) * up[0], silu(g[1]) * up[1]); w.y = pk2(silu(g[2]) * up[2], silu(g[3]) * up[3]);
                        *(u32x2*)(rowp + 16 * G + 4 * fq) = w; } }
        }
    }
};

template <class Epi, class Sched, bool ALIGN_EPI = false, bool SP2 = false>
__device__ __forceinline__ void gemm_phase(PG8_LAS unsigned char* lds, const Gemm g, const Sched& S, const Epi& E) {
    int tid_ = threadIdx.x; asm volatile("" : "+v"(tid_));
    const int tid = tid_, wid = __builtin_amdgcn_readfirstlane(tid >> 6), lane = tid & 63, wr = wid >> 2, wc = wid & 3, fr = lane & 15, fq = lane >> 4;
    const int K = g.K, nt = K / BK;
    unsigned voffA[2], voffB[2];
#pragma unroll
    for (int i = 0; i < 2; ++i) { int R, C; stage_rc(tid * 16 + i * 8192, R, C); voffA[i] = (unsigned)(R * K + C) * 2u; voffB[i] = (unsigned)(R * K + C) * 2u; }
    const size_t kstep = (size_t)(BK * 2);
    const size_t hstep = (size_t)HALF * K * 2;
    const size_t tstep = 2 * hstep;
    const unsigned ldsw = (unsigned)wid * 1024u;
    const int aoff = lds_byte(wr * 64 + fr, fq * 8), boff = lds_byte(wc * 32 + fr, fq * 8);
#define PG8_SA(b, h) (((b) * 2 + (h)) * HTB)
#define PG8_SB(b, h) ((4 + (b) * 2 + (h)) * HTB)
#define PG8_STAGE(bufoff, gbase, voff) do { _Pragma("unroll") for (int _i = 0; _i < 2; ++_i) \
        __builtin_amdgcn_global_load_lds((const unsigned*)((const char*)(gbase) + (voff)[_i]), (PG8_LAS unsigned*)(lds + (bufoff) + ldsw + _i * 8192), 16, 0, 0); } while (0)
#define PG8_LDA(dst, b, h) do { _Pragma("unroll") for (int m = 0; m < 4; ++m) _Pragma("unroll") for (int k = 0; k < 2; ++k) dst[m][k] = *(const PG8_LAS bf16x8*)(lds + PG8_SA(b, h) + aoff + m * 2048 + k * 1024); } while (0)
#define PG8_LDB(dst, b, h) do { _Pragma("unroll") for (int n = 0; n < 2; ++n) _Pragma("unroll") for (int k = 0; k < 2; ++k) dst[n][k] = *(const PG8_LAS bf16x8*)(lds + PG8_SB(b, h) + boff + n * 2048 + k * 1024); } while (0)
#define PG8_MMA(ai, bj, At, Bt) do { __builtin_amdgcn_s_setprio(1); _Pragma("unroll") for (int m = 0; m < 4; ++m) _Pragma("unroll") for (int n = 0; n < 2; ++n) _Pragma("unroll") for (int k = 0; k < 2; ++k) \
        acc[ai][bj][m][n] = __builtin_amdgcn_mfma_f32_16x16x32_bf16(Bt[n][k], At[m][k], acc[ai][bj][m][n], 0, 0, 0); __builtin_amdgcn_s_setprio(0); } while (0)
#define PG8_WAIT_V(n) asm volatile("s_waitcnt vmcnt(" #n ")" ::: "memory")
#define PG8_WAIT_L(n) asm volatile("s_waitcnt lgkmcnt(" #n ")" ::: "memory")
#define PG8_BAR __builtin_amdgcn_s_barrier()
#define PG8_SCHED __builtin_amdgcn_sched_barrier(0)
    Unit cur, nxt; int ui = 0;
    if (!S.next(0, cur)) return;
    f32x4 acc[2][2][4][2];
#pragma unroll
    for (int a = 0; a < 2; ++a)
#pragma unroll
        for (int b = 0; b < 2; ++b)
#pragma unroll
            for (int m = 0; m < 4; ++m)
#pragma unroll
                for (int n = 0; n < 2; ++n) acc[a][b][m][n] = (f32x4){0.f, 0.f, 0.f, 0.f};
    bf16x8 At[4][2], B0[2][2], B1[2][2];
    const char* cA = (const char*)g.A + (size_t)cur.pm * tstep; const char* cB = (const char*)g.Bt + (size_t)cur.pn * tstep;
    S.a_ready(cur);
    if constexpr (SP2) {
        PG8_STAGE(PG8_SB(0, 0), cB, voffB); PG8_STAGE(PG8_SB(0, 1), cB + hstep, voffB); PG8_STAGE(PG8_SA(0, 0), cA, voffA); PG8_STAGE(PG8_SA(0, 1), cA + hstep, voffA);
        if (wr == 1) PG8_BAR;
        PG8_WAIT_V(2); PG8_BAR;
        PG8_STAGE(PG8_SB(1, 0), cB + kstep, voffB); PG8_STAGE(PG8_SA(1, 0), cA + kstep, voffA); PG8_STAGE(PG8_SB(1, 1), cB + hstep + kstep, voffB);
        PG8_WAIT_V(6); PG8_BAR;
    } else {
        PG8_STAGE(PG8_SB(0, 0), cB, voffB); PG8_STAGE(PG8_SA(0, 0), cA, voffA); PG8_STAGE(PG8_SB(0, 1), cB + hstep, voffB); PG8_STAGE(PG8_SA(0, 1), cA + hstep, voffA);
        if (wr == 1) PG8_BAR;
        PG8_WAIT_V(4); PG8_BAR;
        PG8_STAGE(PG8_SB(1, 0), cB + kstep, voffB); PG8_STAGE(PG8_SA(1, 0), cA + kstep, voffA); PG8_STAGE(PG8_SB(1, 1), cB + hstep + kstep, voffB);
        PG8_WAIT_V(6); PG8_BAR;
    }
    for (;;) {
        const bool has_next = S.next(ui + 1, nxt);
        const char* nA = has_next ? (const char*)g.A + (size_t)nxt.pm * tstep : cA; const char* nB = has_next ? (const char*)g.Bt + (size_t)nxt.pn * tstep : cB;
        for (int t = 0; t < nt; t += 2) {
            const bool last = (t == nt - 2);
            const char* a1 = cA + (size_t)(t + 1) * kstep;
            const char* a2 = last ? nA : cA + (size_t)(t + 2) * kstep; const char* b2 = last ? nB : cB + (size_t)(t + 2) * kstep;
            const char* a3 = a2 + kstep; const char* b3 = b2 + kstep;
            if (last && has_next) S.a_ready(nxt);
            if constexpr (SP2) {
            PG8_LDB(B0, 0, 0); PG8_LDB(B1, 0, 1); PG8_SCHED; PG8_LDA(At, 0, 0); PG8_STAGE(PG8_SA(1, 1), a1 + hstep, voffA);
            PG8_WAIT_V(8); PG8_WAIT_L(0); PG8_BAR; PG8_MMA(0, 0, At, B0); PG8_MMA(0, 1, At, B1); PG8_BAR; PG8_SCHED;
            PG8_LDA(At, 0, 1); PG8_STAGE(PG8_SB(0, 0), b2, voffB); PG8_STAGE(PG8_SB(0, 1), b2 + hstep, voffB); PG8_STAGE(PG8_SA(0, 0), a2, voffA);
            PG8_WAIT_V(8); PG8_WAIT_L(0); PG8_BAR; PG8_MMA(1, 0, At, B0); PG8_MMA(1, 1, At, B1); PG8_BAR; PG8_SCHED;
            PG8_LDB(B0, 1, 0); PG8_LDB(B1, 1, 1); PG8_SCHED; PG8_LDA(At, 1, 0); PG8_STAGE(PG8_SA(0, 1), a2 + hstep, voffA);
            PG8_WAIT_V(8); PG8_WAIT_L(0); PG8_BAR; PG8_MMA(0, 0, At, B0); PG8_MMA(0, 1, At, B1); PG8_BAR; PG8_SCHED;
            PG8_LDA(At, 1, 1); PG8_STAGE(PG8_SB(1, 0), b3, voffB); PG8_STAGE(PG8_SB(1, 1), b3 + hstep, voffB); PG8_STAGE(PG8_SA(1, 0), a3, voffA);
            PG8_WAIT_V(8); PG8_WAIT_L(0); PG8_BAR; PG8_MMA(1, 0, At, B0); PG8_MMA(1, 1, At, B1); PG8_BAR; PG8_SCHED;
            } else {
            PG8_LDB(B0, 0, 0); PG8_SCHED; PG8_LDA(At, 0, 0); PG8_STAGE(PG8_SA(1, 1), a1 + hstep, voffA);
            PG8_WAIT_L(8); PG8_BAR; PG8_WAIT_L(0); PG8_MMA(0, 0, At, B0); PG8_BAR; PG8_SCHED;
            PG8_LDB(B1, 0, 1); PG8_STAGE(PG8_SB(0, 0), b2, voffB);
            PG8_BAR; PG8_WAIT_L(0); PG8_MMA(0, 1, At, B1); PG8_BAR;
            PG8_LDA(At, 0, 1); PG8_STAGE(PG8_SA(0, 0), a2, voffA);
            PG8_BAR; PG8_WAIT_L(0); PG8_MMA(1, 0, At, B0); PG8_BAR; PG8_SCHED;
            PG8_STAGE(PG8_SB(0, 1), b2 + hstep, voffB);
            PG8_WAIT_V(6); PG8_BAR; PG8_MMA(1, 1, At, B1); PG8_BAR;
            PG8_LDB(B0, 1, 0); PG8_SCHED; PG8_LDA(At, 1, 0); PG8_STAGE(PG8_SA(0, 1), a2 + hstep, voffA);
            PG8_WAIT_L(8); PG8_BAR; PG8_WAIT_L(0); PG8_MMA(0, 0, At, B0); PG8_BAR; PG8_SCHED;
            PG8_LDB(B1, 1, 1); PG8_STAGE(PG8_SB(1, 0), b3, voffB);
            PG8_BAR; PG8_WAIT_L(0); PG8_MMA(0, 1, At, B1); PG8_BAR;
            PG8_LDA(At, 1, 1); PG8_STAGE(PG8_SA(1, 0), a3, voffA);
            PG8_BAR; PG8_WAIT_L(0); PG8_MMA(1, 0, At, B0); PG8_BAR; PG8_SCHED;
            PG8_STAGE(PG8_SB(1, 1), b3 + hstep, voffB);
            PG8_WAIT_V(6); PG8_BAR; PG8_MMA(1, 1, At, B1); PG8_BAR;
            }
        }
        if constexpr (ALIGN_EPI) { if (wr == 0) PG8_BAR; }
        if constexpr (!Epi::AFTER_DRAIN) { E(acc, cur, wr, wc, fr, fq); S.done(cur); }
        if (!has_next) break;
#pragma unroll
        for (int a = 0; a < 2; ++a)
#pragma unroll
            for (int b = 0; b < 2; ++b)
#pragma unroll
                for (int m = 0; m < 4; ++m)
#pragma unroll
                    for (int n = 0; n < 2; ++n) acc[a][b][m][n] = (f32x4){0.f, 0.f, 0.f, 0.f};
        cur = nxt; cA = nA; cB = nB; ++ui;
        if constexpr (ALIGN_EPI) { if (wr == 1) PG8_BAR; }
    }
    PG8_WAIT_V(0);
    if constexpr (!ALIGN_EPI) { if (wr == 0) PG8_BAR; }
    PG8_BAR;
#undef PG8_SA
#undef PG8_SB
#undef PG8_STAGE
#undef PG8_LDA
#undef PG8_LDB
#undef PG8_MMA
#undef PG8_WAIT_V
#undef PG8_WAIT_L
#undef PG8_BAR
#undef PG8_SCHED
}
}

struct Args { const float* in[29]; float* out; unsigned char* ws; int ph_lo, ph_hi; };
enum { I_XP = 0, I_XS, I_SHG, I_SGD, I_SGC, I_SRH, I_SRC, I_LN1, I_LN2, I_LN3, I_LN4, I_WIN, I_WOUT, I_LB, I_ANORM, I_BCW, I_BALOG, I_BDT, I_BNORM,
       I_CCW, I_CCB, I_CWA, I_CBA, I_CWX, I_CBX, I_CLAM, I_WG, I_WU, I_WD };

struct Ctx {
    const Args* a; unsigned char* ws; float* out; LAS unsigned char* lds; int tid, lane, wave, G, bid;
};
DI Ctx fresh(const Ctx& o) {
    Ctx c = o; int t = threadIdx.x; asm volatile("" : "+v"(t)); c.tid = t; c.lane = t & 63; c.wave = __builtin_amdgcn_readfirstlane(t >> 6);
    size_t z = 0; asm volatile("" : "+s"(z)); c.ws = o.a->ws + z; c.out = o.a->out + z;
    int b = blockIdx.x; asm volatile("" : "+s"(b)); c.bid = b; return c;
}
DI const float* inp(const Args& a, int idx) { int z = idx; asm volatile("" : "+s"(z)); return (const float*)(const GAS float*)a.in[z]; }

template <int MODE>
DI void transpose_item(const float* W, int K, int Nsrc, int nblk, bf16_t* WT, LAS float* scr, int item, int lane) {
    const int kb = item / nblk, nb = item - kb * nblk, k0 = 64 * kb, n0 = 32 * nb;
    const int nn = n0 + (lane & 31); const bool ok = nn < Nsrc;
    float v[32];
#pragma unroll
    for (int i = 0; i < 32; ++i) { const int kk = 2 * i + (lane >> 5); v[i] = ok ? W[(size_t)(k0 + kk) * Nsrc + nn] : 0.f; }
#pragma unroll
    for (int i = 0; i < 32; ++i) { const int kk = 2 * i + (lane >> 5); scr[kk * 33 + (lane & 31)] = v[i]; }
    LDS_WAIT(); asm volatile("" ::: "memory");
    const int c = lane & 7;
#pragma unroll
    for (int j = 0; j < 4; ++j) { const int nl = (lane >> 3) + 8 * j; const LAS float* s = scr + (8 * c) * 33 + nl;
        u32x4 o; o.x = pk2(s[0 * 33], s[1 * 33]); o.y = pk2(s[2 * 33], s[3 * 33]); o.z = pk2(s[4 * 33], s[5 * 33]); o.w = pk2(s[6 * 33], s[7 * 33]);
        const int n = n0 + nl; const int drow = (MODE == 0) ? n : ((n >> 4) * 32 + (n & 15) + (MODE == 2 ? 16 : 0));
        *(u32x4*)(WT + (size_t)drow * K + k0 + 8 * c) = o; }
    LDS_WAIT(); asm volatile("" ::: "memory");
}
DI void norm_row_to_bf16(const float* xr, const float* g, bf16_t* orow, int lane) {
    f32x4 v[8]; float s = 0.f;
#pragma unroll
    for (int j = 0; j < 8; ++j) { v[j] = ((const f32x4*)xr)[lane + 64 * j]; s += (v[j].x * v[j].x + v[j].y * v[j].y) + (v[j].z * v[j].z + v[j].w * v[j].w); }
    const float r = rsqrtf(wave_sum_fast(s) * (1.f / D) + NORM_EPS);
#pragma unroll
    for (int j = 0; j < 8; ++j) { const f32x4 gg = ((const f32x4*)g)[lane + 64 * j]; u32x2 w; w.x = pk2(v[j].x * r * gg.x, v[j].y * r * gg.y); w.y = pk2(v[j].z * r * gg.z, v[j].w * r * gg.w);
        ((u32x2*)orow)[lane + 64 * j] = w; }
}
constexpr int CV_IN = (D / 64) * (NINP / 32), CV_OUT = (D / 64) * (D / 32), CV_G = (D / 64) * (DFF / 32), CV_D = (DFF / 64) * (D / 32), CV_LAYER = CV_IN + CV_OUT + 2 * CV_G + CV_D;
DI void convert_range(const Ctx& c, int lo, int hi, int gw, int NGW) {
    const Args& a = *c.a;
    LAS float* scr = (LAS float*)(c.lds + c.wave * 16384);
    for (int it = lo + gw; it < hi; it += NGW) {
        const int l = it / CV_LAYER; int r = it - l * CV_LAYER;
        if (r < CV_IN) { transpose_item<0>(inp(a, I_WIN) + (size_t)l * D * NIN, D, NIN, NINP / 32, (bf16_t*)(c.ws + WS_WIN + l * SZ_WIN), scr, r, c.lane); continue; } r -= CV_IN;
        if (r < CV_OUT) { transpose_item<0>(inp(a, I_WOUT) + (size_t)l * D * D, D, D, D / 32, (bf16_t*)(c.ws + WS_WOUT + l * SZ_WOUT), scr, r, c.lane); continue; } r -= CV_OUT;
        if (r < CV_G) { transpose_item<1>(inp(a, I_WG) + (size_t)l * D * DFF, D, DFF, DFF / 32, (bf16_t*)(c.ws + WS_WGU + l * SZ_WGU), scr, r, c.lane); continue; } r -= CV_G;
        if (r < CV_G) { transpose_item<2>(inp(a, I_WU) + (size_t)l * D * DFF, D, DFF, DFF / 32, (bf16_t*)(c.ws + WS_WGU + l * SZ_WGU), scr, r, c.lane); continue; } r -= CV_G;
        transpose_item<0>(inp(a, I_WD) + (size_t)l * DFF * D, DFF, D, D / 32, (bf16_t*)(c.ws + WS_WDN + l * SZ_WDN), scr, r, c.lane);
    }
}
DI void phase_p0(const Ctx& c0) {
    const Ctx c = fresh(c0);
    const Args& a = *c.a;
    const int gw = c.bid * 8 + c.wave, NGW = c.G * 8;
    convert_range(c, 0, CV_IN, gw, NGW);
    bf16_t* hb = (bf16_t*)(c.ws + WS_HBUF);
    { const float* xp = inp(a, I_XP); const float* xs = inp(a, I_XS); const float* g1 = inp(a, I_LN1);
      for (int m = gw; m < MT; m += NGW) norm_row_to_bf16(m < NP ? xp + (size_t)m * D : xs + (size_t)(m - NP) * D, g1, hb + (size_t)m * D, c.lane); }
    unsigned z0 = 0u; asm volatile("" : "+v"(z0)); const u32x4 z4 = {z0, z0, z0, z0};
    for (int i = gw * 64 + c.lane; i < (MPAD - MT) * D / 8; i += NGW * 64) {
        ((u32x4*)(hb + (size_t)MT * D))[i] = z4;
        ((u32x4*)((bf16_t*)(c.ws + WS_MIXO) + (size_t)MT * D))[i] = z4;
    }
}

DI void row_phase(const Ctx& c0, const float* y, const float* slabs, const float* xa, const float* xb, float* xout, const float* g_post, const float* g_next, bf16_t* hb) {
    const Ctx c = fresh(c0);
    const int gw = c.bid * 8 + c.wave, NGW = c.G * 8, lane = c.lane;
    f32x4 v[8], vn[8];
    if (gw < NP) {
#pragma unroll
        for (int j = 0; j < 8; ++j) v[j] = ((const f32x4*)(y + (size_t)gw * D))[lane + 64 * j]; }
    for (int m = gw; m < MT; m += NGW) {
        const float* xr = m < NP ? xa + (size_t)m * D : xb + (size_t)(m - NP) * D;
        const int mn = m + NGW;
        f32x4 xx[8];
#pragma unroll
        for (int j = 0; j < 8; ++j) xx[j] = ((const f32x4*)xr)[lane + 64 * j];
        if (mn < NP) {
#pragma unroll
            for (int j = 0; j < 8; ++j) vn[j] = ((const f32x4*)(y + (size_t)mn * D))[lane + 64 * j]; }
        if (m >= NP) { const float* yr = slabs + (size_t)(m - NP) * D;
#pragma unroll
            for (int j = 0; j < 8; ++j) v[j] = ((const f32x4*)yr)[lane + 64 * j] + ((const f32x4*)(yr + (size_t)NS * D))[lane + 64 * j];
#pragma unroll 1
            for (int ks = 2; ks < 8; ks += 2) {
                f32x4 t0[8], t1[8];
#pragma unroll
                for (int j = 0; j < 8; ++j) { t0[j] = ((const f32x4*)(yr + (size_t)ks * NS * D))[lane + 64 * j]; t1[j] = ((const f32x4*)(yr + (size_t)(ks + 1) * NS * D))[lane + 64 * j]; }
#pragma unroll
                for (int j = 0; j < 8; ++j) v[j] = v[j] + t0[j] + t1[j]; }
        }
        float s = 0.f;
#pragma unroll
        for (int j = 0; j < 8; ++j) s += (v[j].x * v[j].x + v[j].y * v[j].y) + (v[j].z * v[j].z + v[j].w * v[j].w);
        const float r = rsqrtf(wave_sum_fast(s) * (1.f / D) + NORM_EPS);
        float s2 = 0.f;
#pragma unroll
        for (int j = 0; j < 8; ++j) { const f32x4 gg = ((const f32x4*)g_post)[lane + 64 * j];
            v[j] = xx[j] + v[j] * r * gg; s2 += (v[j].x * v[j].x + v[j].y * v[j].y) + (v[j].z * v[j].z + v[j].w * v[j].w);
            ((f32x4*)(xout + (size_t)m * D))[lane + 64 * j] = v[j]; }
        if (g_next) {
            const float r2 = rsqrtf(wave_sum_fast(s2) * (1.f / D) + NORM_EPS);
#pragma unroll
            for (int j = 0; j < 8; ++j) { const f32x4 gg = ((const f32x4*)g_next)[lane + 64 * j]; u32x2 w; w.x = pk2(v[j].x * r2 * gg.x, v[j].y * r2 * gg.y); w.y = pk2(v[j].z * r2 * gg.z, v[j].w * r2 * gg.w);
                ((u32x2*)(hb + (size_t)m * D))[lane + 64 * j] = w; }
        }
#pragma unroll
        for (int j = 0; j < 8; ++j) v[j] = vn[j];
    }
}

DI void sample_pieces(const Ctx& c0, const bf16_t* A  , const bf16_t* Bt  , int K, float* slabs) {
    const Ctx c = fresh(c0); const int tid = c.tid, lane = c.lane, wave = c.wave, i = lane & 15, g = lane >> 4;
    constexpr int KC = 256, PPR = KC / 8, NJ = 192 * PPR / 512, RS = KC * 2 + 16;
    const int klen = K / 8;
    for (int p = c.bid; p < 256; p += c.G) {
        const int jt = p & 31, ks = p >> 5;
        f32x4 acc[4];
#pragma unroll
        for (int q = 0; q < 4; ++q) acc[q] = (f32x4){0.f, 0.f, 0.f, 0.f};
#pragma unroll 1
        for (int kc = 0; kc < klen; kc += KC) {
            const int k0 = ks * klen + kc;
            u32x4 v[NJ];
#pragma unroll
            for (int j = 0; j < NJ; ++j) { const int pc = tid + 512 * j; const int row = pc / PPR, col = pc - row * PPR;
                const bf16_t* src = (row < 128 ? A + (size_t)row * K : Bt + (size_t)(64 * jt + row - 128) * K) + k0 + 8 * col;
                v[j] = *(const u32x4*)src; }
            __syncthreads();
#pragma unroll
            for (int j = 0; j < NJ; ++j) { const int pc = tid + 512 * j; const int row = pc / PPR, col = pc - row * PPR;
                *(LAS u32x4*)(c.lds + row * RS + col * 16) = v[j]; }
            __syncthreads();
            const int nk = (klen - kc) >= KC ? KC / 32 : (klen - kc) / 32;
#pragma unroll 2
            for (int kk = 0; kk < nk; ++kk) {
                const bf16x8 av = *(const LAS bf16x8*)(c.lds + (16 * wave + i) * RS + (32 * kk + 8 * g) * 2);
#pragma unroll
                for (int q = 0; q < 4; ++q) acc[q] = MFMA16(av, *(const LAS bf16x8*)(c.lds + (128 + 16 * q + i) * RS + (32 * kk + 8 * g) * 2), acc[q]);
            }
        }
        float* so = slabs + (size_t)ks * NS * D + (size_t)(16 * wave + 4 * g) * D + 64 * jt + i;
#pragma unroll
        for (int q = 0; q < 4; ++q)
#pragma unroll
            for (int r = 0; r < 4; ++r) so[(size_t)r * D + 16 * q] = acc[q][r];
    }
    __syncthreads();
}

DI int perm32(int x) { return 8 * ((x >> 2) & 3) + 4 * (x >> 4) + (x & 3); }
DI int kpos(int k) { return (k & ~31) + perm32(k & 31); }
DI float lb_of(const Args& a, int l, int c) { if (l == 0) return 0.f; const float l0 = inp(a, I_LB)[c], l1 = inp(a, I_LB)[512 + c]; return 1.f / (1.f + __expf(l0 - l1)); }
DI bf16_t bf1(float x) { return (bf16_t)(pk2(x, 0.f) & 0xffffu); }

constexpr size_t IB_W = WS_MIXF, IB_Q = IB_W + 16 * MiB, IB_KT = IB_Q + 16 * MiB, IB_P = IB_KT + 16 * MiB, IB_U0 = IB_P + 8 * MiB,
                 IA_Q = IB_U0 + 32 * MiB, IA_KT = IA_Q + 8 * MiB, IA_P = IA_KT + 8 * MiB, IA_V = IA_P + 4 * MiB,
                 IC_A = IA_V + 16 * MiB, IC_B = IC_A + 16 * MiB, IMISC = IC_B + 16 * MiB, IB_DEC = IMISC, IA_DEC = IMISC + 65536, IC_TOT = IMISC + 524288, I_END = IMISC + 1 * MiB;
static_assert(I_END <= WS_END, "mixer intermediates must fit");
constexpr size_t WS_SLAB = WS_X1 + SZ_MIXF;
static_assert(WS_SLAB + 8 * MiB <= WS_END, "slabs");

DI void m1_unit_b(const Ctx& c0, int l, int u) {
    const Ctx c = fresh(c0); const Args& a = *c.a; const int tid = c.tid, lane = c.lane, wave = c.wave;
    const int b = u >> 8, h = (u >> 5) & 7, ci = u & 31;
    LAS float* Kf = (LAS float*)c.lds;
    LAS float* Vf = Kf + 8192;
    LAS float* Qf = Vf + 8192;
    LAS float* Amat = Qf;
    LAS bf16_t* Pl = (LAS bf16_t*)(Qf + 64 * 68);
    LAS bf16_t* Qb = (LAS bf16_t*)(Qf + 8192);
    LAS bf16_t* Kb = Qb + 64 * 136;
    LAS float* scal = (LAS float*)(Kb + 64 * 136);
    const float* proj = (const float*)(c.ws + WS_PROJ);
    const long rowb = (long)b * SEQ + 64 * ci; const int tg0 = 64 * ci;
    SEG_T0(10)
    {
        const float* cw = inp(a, I_BCW) + (size_t)l * 4 * 3072;
        const int idx = tid & 127, tq = tid >> 7;
        float x[3][19], w[3][4];
#pragma unroll
        for (int p = 0; p < 3; ++p) { const int ch = p * 1024 + h * 128 + idx;
#pragma unroll
            for (int j = 0; j < 4; ++j) w[p][j] = cw[j * 3072 + ch];
#pragma unroll
            for (int j = 0; j < 19; ++j) { const int t = 16 * tq - 3 + j; x[p][j] = (tg0 + t >= 0) ? proj[(rowb + t) * NINP + C_BQ + ch] : 0.f; } }
#pragma unroll
        for (int p = 0; p < 3; ++p) { LAS float* dst = (p == 0 ? Qf : (p == 1 ? Kf : Vf)) + idx;
#pragma unroll
            for (int i = 0; i < 16; ++i) dst[(16 * tq + i) * 128] = silu(w[p][0] * x[p][i] + w[p][1] * x[p][i + 1] + w[p][2] * x[p][i + 2] + w[p][3] * x[p][i + 3]); }
    }
    SEG_T1(10)
    __syncthreads();
    SEG_T0(11)
    for (int i = 0; i < 8; ++i) { const int t = wave * 8 + i; const float q0 = Qf[t * 128 + lane], q1 = Qf[t * 128 + 64 + lane], k0 = Kf[t * 128 + lane], k1 = Kf[t * 128 + 64 + lane];
        const float sq = wave_sum_fast(q0 * q0 + q1 * q1), sk = wave_sum_fast(k0 * k0 + k1 * k1);
        if (lane == 0) { scal[t * 8 + 3] = rsqrtf(sq + L2_EPS) * 0.08838834764831845f; scal[t * 8 + 4] = rsqrtf(sk + L2_EPS); } }
    if (wave == 0) { const int t = lane; const float bb = proj[(rowb + t) * NINP + C_BB + h], ba = proj[(rowb + t) * NINP + C_BA + h];
        const float gt = -__expf(inp(a, I_BALOG)[l * 8 + h]) * softplus(ba + inp(a, I_BDT)[l * 8 + h]);
        float x = gt;
#pragma unroll
        for (int o = 1; o < 64; o <<= 1) { const float y = __shfl_up(x, o); if (lane >= o) x += y; }
        const float bC = __shfl(x, 63);
        scal[t * 8 + 0] = sigm(bb); scal[t * 8 + 1] = x; scal[t * 8 + 2] = __expf(x); scal[t * 8 + 5] = __expf(bC - x);
        if (lane == 63) ((float*)(c.ws + IB_DEC))[u] = __expf(x); }
    SEG_T1(11)
    __syncthreads();
    SEG_T0(12)
    {
        const int t = tid >> 3, d0 = (tid & 7) * 16; const float sq = scal[t * 8 + 3], sk = scal[t * 8 + 4], s2 = sq * scal[t * 8 + 2];
        bf16_t* gq = (bf16_t*)(c.ws + IB_Q) + ((size_t)u * 64 + t) * 128;
#pragma unroll
        for (int m = 0; m < 4; ++m) { const int d = d0 + 4 * m; const f32x4 q = *(const LAS f32x4*)(Qf + t * 128 + d), k = *(const LAS f32x4*)(Kf + t * 128 + d);
            *(LAS u32x2*)(Qb + t * 136 + d) = (u32x2){pk2(q.x * sq, q.y * sq), pk2(q.z * sq, q.w * sq)};
            *(LAS u32x2*)(Kb + t * 136 + d) = (u32x2){pk2(k.x * sk, k.y * sk), pk2(k.z * sk, k.w * sk)};
            *(u32x2*)(gq + kpos(d)) = (u32x2){pk2(q.x * s2, q.y * s2), pk2(q.z * s2, q.w * s2)}; }
    }
    SEG_T1(12)
    __syncthreads();
    SEG_T0(13)
    {
        const int i = lane & 15, g = lane >> 4;
#pragma unroll
        for (int q2 = 0; q2 < 2; ++q2) { const int idx = 2 * wave + q2, tt = idx >> 2, st = idx & 3; const int s = 16 * st + i;
            if (st <= tt) {
                f32x4 akk = {0.f, 0.f, 0.f, 0.f}, aqk = {0.f, 0.f, 0.f, 0.f};
#pragma unroll
                for (int ks = 0; ks < 4; ++ks) { const bf16x8 bk = *(const LAS bf16x8*)(Kb + (16 * st + i) * 136 + 32 * ks + 8 * g);
                    const bf16x8 ak = *(const LAS bf16x8*)(Kb + (16 * tt + i) * 136 + 32 * ks + 8 * g), aq = *(const LAS bf16x8*)(Qb + (16 * tt + i) * 136 + 32 * ks + 8 * g);
                    akk = MFMA16(ak, bk, akk); aqk = MFMA16(aq, bk, aqk); }
                const float bs = scal[s * 8 + 1];
#pragma unroll
                for (int r = 0; r < 4; ++r) { const int t = 16 * tt + 4 * g + r; const float gam = __expf(fminf(scal[t * 8 + 1] - bs, 0.f));
                    Amat[t * 68 + s] = (s < t) ? scal[t * 8 + 0] * akk[r] * gam : 0.f;
                    Pl[t * 72 + kpos(s)] = bf1((s <= t) ? aqk[r] * gam : 0.f); }
            } else {
#pragma unroll
                for (int r = 0; r < 4; ++r) Pl[(16 * tt + 4 * g + r) * 72 + kpos(s)] = 0;
            }
        }
    }
    SEG_T1(13)
    __syncthreads();
    SEG_T0(14)
    if (tid < 256) {
        float R[64];
        int zoff = 0; asm volatile("" : "+v"(zoff));
        const LAS float* Am = Amat + zoff; const LAS float* sc = scal + zoff;
        if (tid < 128) {
#pragma unroll
            for (int t = 0; t < 64; ++t) R[t] = sc[t * 8 + 0] * Vf[t * 128 + tid];
        } else {
#pragma unroll
            for (int t = 0; t < 64; ++t) R[t] = sc[t * 8 + 0] * sc[t * 8 + 2] * sc[t * 8 + 4] * Kf[t * 128 + tid - 128];
        }
#pragma unroll
        for (int t = 1; t < 64; ++t) { float acc = R[t];
#pragma unroll
            for (int s4 = 0; s4 < (t + 3) / 4; ++s4) { const f32x4 a4 = *(const LAS f32x4*)(Am + t * 68 + 4 * s4);
                acc -= a4.x * R[4 * s4];
                if (4 * s4 + 1 < t) acc -= a4.y * R[4 * s4 + 1];
                if (4 * s4 + 2 < t) acc -= a4.z * R[4 * s4 + 2];
                if (4 * s4 + 3 < t) acc -= a4.w * R[4 * s4 + 3]; }
            R[t] = acc; }
        if (tid < 128) { const int w = tid >> 4, i = tid & 15; float* g0 = (float*)(c.ws + IB_U0) + (size_t)u * 8192;
#pragma unroll
            for (int st = 0; st < 4; ++st)
#pragma unroll
                for (int g = 0; g < 4; ++g) *(f32x4*)(g0 + ((st * 8 + w) * 64 + i + 16 * g) * 4) = (f32x4){R[16 * st + 4 * g], R[16 * st + 4 * g + 1], R[16 * st + 4 * g + 2], R[16 * st + 4 * g + 3]};
        } else { bf16_t* gw = (bf16_t*)(c.ws + IB_W) + (size_t)u * 8192 + kpos(tid - 128);
#pragma unroll
            for (int t = 0; t < 64; ++t) gw[t * 128] = bf1(R[t]); }
    } else {
#pragma unroll
        for (int k = 0; k < 2; ++k) { const int p = (tid - 256) + 256 * k, row = p >> 3, c16 = p & 7;
            *(u32x4*)((bf16_t*)(c.ws + IB_P) + (size_t)u * 4096 + row * 64 + c16 * 8) = *(const LAS u32x4*)(Pl + row * 72 + c16 * 8); }
        LAS bf16_t* KTs = Qb; const int d = tid & 127, s0 = ((tid >> 7) & 1) * 32;
#pragma unroll
        for (int m = 0; m < 8; ++m) { float v[4];
#pragma unroll
            for (int j = 0; j < 4; ++j) { const int s = s0 + 4 * m + j; v[j] = Kf[s * 128 + d] * scal[s * 8 + 4] * scal[s * 8 + 5]; }
            *(LAS u32x2*)(KTs + d * 72 + kpos(s0 + 4 * m)) = (u32x2){pk2(v[0], v[1]), pk2(v[2], v[3])}; }
    }
    SEG_T1(14)
    __syncthreads();
    SEG_T0(15)
#pragma unroll
    for (int k = 0; k < 2; ++k) { const int p = tid + 512 * k, row = p >> 3, c16 = p & 7;
        *(u32x4*)((bf16_t*)(c.ws + IB_KT) + (size_t)u * 8192 + row * 64 + c16 * 8) = *(const LAS u32x4*)(Qb + row * 72 + c16 * 8); }
    SEG_T1(15)
    __syncthreads();
}

DI void m1_unit_a(const Ctx& c0, int l, int u) {
    const Ctx c = fresh(c0); const Args& a = *c.a; const int tid = c.tid, lane = c.lane, wave = c.wave;
    const int b = u >> 7, h = (u >> 5) & 3, ci = u & 31;
    LAS float* Bf = (LAS float*)c.lds;
    LAS float* Qf = Bf + 8192;
    LAS float* Kf = Qf + 8192;
    LAS bf16_t* Pl = (LAS bf16_t*)Qf;
    LAS bf16_t* Qh = (LAS bf16_t*)(Kf + 8192);
    LAS bf16_t* Kd = Qh + 64 * 136;
    LAS bf16_t* Ko = Kd + 64 * 136;
    LAS float* tot = (LAS float*)(Ko + 32 * 136);
    const float* proj = (const float*)(c.ws + WS_PROJ);
    const long rowb = (long)b * SEQ + 64 * ci;
    {
        float* gv = (float*)(c.ws + IA_V) + (size_t)u * 8192;
        const int idx = tid & 127, tq = tid >> 7;
        float x[3][16];
#pragma unroll
        for (int i = 0; i < 16; ++i) { const float* pr = proj + (rowb + 16 * tq + i) * NINP + h * 128 + idx; x[0][i] = pr[C_AF]; x[1][i] = pr[C_AQ]; x[2][i] = pr[C_AI]; }
        const float lb = lb_of(a, l, h * 128 + idx);
#pragma unroll
        for (int i = 0; i < 16; ++i) { const int t = 16 * tq + i; const float f = lb + (1.f - lb) * sigm(x[0][i]);
            Bf[t * 128 + idx] = fmaxf(__logf(f), -80.f); Kf[t * 128 + idx] = 1.f - f; Qf[t * 128 + idx] = silu(x[1][i]);
            gv[(((t >> 4) * 8 + (idx >> 4)) * 64 + (idx & 15) + 16 * ((t >> 2) & 3)) * 4 + (t & 3)] = x[2][i]; }
    }
    __syncthreads();
    {
        const int d = tid & 127, q4 = tid >> 7; float run = 0.f;
#pragma unroll
        for (int i = 0; i < 16; ++i) { run += Bf[(16 * q4 + i) * 128 + d]; Bf[(16 * q4 + i) * 128 + d] = run; }
        tot[q4 * 128 + d] = run;
        __syncthreads();
        float off = 0.f;
        for (int q = 0; q < q4; ++q) off += tot[q * 128 + d];
        if (q4 > 0) {
#pragma unroll
            for (int i = 0; i < 16; ++i) Bf[(16 * q4 + i) * 128 + d] += off; }
    }
    __syncthreads();
    {
        const int t = tid >> 3, d0 = (tid & 7) * 16; bf16_t* gq = (bf16_t*)(c.ws + IA_Q) + ((size_t)u * 64 + t) * 128;
#pragma unroll
        for (int m = 0; m < 4; ++m) { const int d = d0 + 4 * m; const f32x4 bb = *(const LAS f32x4*)(Bf + t * 128 + d), q = *(const LAS f32x4*)(Qf + t * 128 + d), k = *(const LAS f32x4*)(Kf + t * 128 + d);
            const f32x4 b31 = *(const LAS f32x4*)(Bf + 31 * 128 + d); const f32x4 rr = b31 * ((t >= 32) ? 1.f : 0.f);
            *(u32x2*)(gq + kpos(d)) = (u32x2){pk2(q.x * __expf(bb.x), q.y * __expf(bb.y)), pk2(q.z * __expf(bb.z), q.w * __expf(bb.w))};
            *(LAS u32x2*)(Qh + t * 136 + d) = (u32x2){pk2(q.x * __expf(bb.x - rr.x), q.y * __expf(bb.y - rr.y)), pk2(q.z * __expf(bb.z - rr.z), q.w * __expf(bb.w - rr.w))};
            *(LAS u32x2*)(Kd + t * 136 + d) = (u32x2){pk2(k.x * __expf(fminf(rr.x - bb.x, 80.f)), k.y * __expf(fminf(rr.y - bb.y, 80.f))), pk2(k.z * __expf(fminf(rr.z - bb.z, 80.f)), k.w * __expf(fminf(rr.w - bb.w, 80.f)))};
            if (t < 32) *(LAS u32x2*)(Ko + t * 136 + d) = (u32x2){pk2(k.x * __expf(b31.x - bb.x), k.y * __expf(b31.y - bb.y)), pk2(k.z * __expf(b31.z - bb.z), k.w * __expf(b31.w - bb.w))}; }
        const int d = tid & 127, s0 = (tid >> 7) * 16; bf16_t* gk = (bf16_t*)(c.ws + IA_KT) + ((size_t)u * 128 + d) * 64; const float bC = Bf[63 * 128 + d];
#pragma unroll
        for (int m = 0; m < 4; ++m) { float v[4];
#pragma unroll
            for (int j = 0; j < 4; ++j) { const int s = s0 + 4 * m + j; v[j] = Kf[s * 128 + d] * __expf(bC - Bf[s * 128 + d]); }
            *(u32x2*)(gk + kpos(s0 + 4 * m)) = (u32x2){pk2(v[0], v[1]), pk2(v[2], v[3])}; }
        if (tid < 128) ((float*)(c.ws + IA_DEC))[(size_t)u * 128 + tid] = __expf(bC);
    }
    __syncthreads();
    {
        const int i = lane & 15, g = lane >> 4;
#pragma unroll
        for (int q2 = 0; q2 < 2; ++q2) { const int idx = 2 * wave + q2, tt = idx >> 2, st = idx & 3, I = tt >> 1, J = st >> 1; const int s = 16 * st + i;
            if (J <= I) {
                const LAS bf16_t* bsrc = (I == J ? Kd : Ko) + (16 * st + i) * 136;
                f32x4 acc = {0.f, 0.f, 0.f, 0.f};
#pragma unroll
                for (int ks = 0; ks < 4; ++ks) acc = MFMA16(*(const LAS bf16x8*)(Qh + (16 * tt + i) * 136 + 32 * ks + 8 * g), *(const LAS bf16x8*)(bsrc + 32 * ks + 8 * g), acc);
#pragma unroll
                for (int r = 0; r < 4; ++r) { const int t = 16 * tt + 4 * g + r; Pl[t * 72 + kpos(s)] = bf1((s <= t) ? acc[r] : 0.f); }
            } else {
#pragma unroll
                for (int r = 0; r < 4; ++r) Pl[(16 * tt + 4 * g + r) * 72 + kpos(s)] = 0;
            }
        }
    }
    __syncthreads();
    { const int row = tid >> 3, c16 = tid & 7; *(u32x4*)((bf16_t*)(c.ws + IA_P) + (size_t)u * 4096 + row * 64 + c16 * 8) = *(const LAS u32x4*)(Pl + row * 72 + c16 * 8); }
    __syncthreads();
}

DI void m1_unit_c(const Ctx& c0, int l, int u) {
    const Ctx c = fresh(c0); const Args& a = *c.a; const int tid = c.tid, lane = c.lane, wave = c.wave;
    const int b = u >> 7, n = (u >> 4) & 7, ti = u & 15;
    constexpr int TT = 128;
    LAS float* xcv = (LAS float*)c.lds;
    LAS float* ra = xcv + TT * 64;
    LAS float* ia = ra + TT * 64;
    LAS float* segA = ia + TT * 64;
    LAS float* segB = segA + 512;
    LAS bf16_t* xb = (LAS bf16_t*)(segB + 512);
    LAS bf16_t* Wt = xb + TT * 72;
    const float* proj = (const float*)(c.ws + WS_PROJ);
    const long rowb = (long)b * SEQ + TT * ti; const int tg0 = TT * ti;
    const int cch = tid & 63, seg = tid >> 6, chg = n * 64 + cch;
    {
        const float* wa = inp(a, I_CWA) + ((size_t)l * 8 + n) * 4096; const float* wx = inp(a, I_CWX) + ((size_t)l * 8 + n) * 4096;
        float wv[16];
#pragma unroll
        for (int k = 0; k < 16; ++k) { const int e = tid + 512 * k; wv[k] = (e < 4096 ? wa : wx)[e & 4095]; }
        const float* ccw = inp(a, I_CCW) + (size_t)l * 4 * 512;
        const float w0 = ccw[chg], w1 = ccw[512 + chg], w2 = ccw[1024 + chg], w3 = ccw[1536 + chg], cb = inp(a, I_CCB)[l * 512 + chg];
        const int ts = seg * 16; const int col = C_CX + chg;
        float x[19];
#pragma unroll
        for (int jx = 0; jx < 19; ++jx) { const int t = ts - 3 + jx; x[jx] = (tg0 + t >= 0) ? proj[(rowb + t) * NINP + col] : 0.f; }
#pragma unroll
        for (int k = 0; k < 16; ++k) { const int e = tid + 512 * k, gate = e >> 12, i = (e >> 6) & 63, j = e & 63; Wt[(gate * 64 + j) * 72 + i] = bf1(wv[k]); }
#pragma unroll
        for (int i = 0; i < 16; ++i) { const float y = w0 * x[i] + w1 * x[i + 1] + w2 * x[i + 2] + w3 * x[i + 3] + cb; xcv[(ts + i) * 64 + cch] = y; xb[(ts + i) * 72 + cch] = bf1(y); }
    }
    __syncthreads();
    {
        const int i = lane & 15, g = lane >> 4;
        const bf16x8 a0 = *(const LAS bf16x8*)(xb + (16 * wave + i) * 72 + 8 * g), a1 = *(const LAS bf16x8*)(xb + (16 * wave + i) * 72 + 32 + 8 * g);
        const float* bsa = inp(a, I_CBA) + l * 512 + n * 64; const float* bsx = inp(a, I_CBX) + l * 512 + n * 64;
#pragma unroll
        for (int jt = 0; jt < 8; ++jt) { f32x4 acc = {0.f, 0.f, 0.f, 0.f};
            acc = MFMA16(a0, *(const LAS bf16x8*)(Wt + (16 * jt + i) * 72 + 8 * g), acc);
            acc = MFMA16(a1, *(const LAS bf16x8*)(Wt + (16 * jt + i) * 72 + 32 + 8 * g), acc);
            const int jc = 16 * (jt & 3) + i; const float bias = (jt < 4 ? bsa : bsx)[jc]; LAS float* dst = (jt < 4 ? ra : ia);
#pragma unroll
            for (int r = 0; r < 4; ++r) dst[(16 * wave + 4 * g + r) * 64 + jc] = sigm(acc[r] + bias); }
    }
    __syncthreads();
    const float spl = softplus(-inp(a, I_CLAM)[l * 512 + chg]);
    {
        float A = 1.f, B = 0.f;
        for (int i = 0; i < 16; ++i) { const int tt = seg * 16 + i; const float r = ra[tt * 64 + cch], ig = ia[tt * 64 + cch], x = xcv[tt * 64 + cch];
            const float la = -8.f * r * spl; const float at = __expf(la); float mult = sqrtf(fmaxf(0.f, -expm1f(2.f * la)));
            if (tg0 + tt == 0) mult = 1.f;
            const float bt = mult * (ig * x); ra[tt * 64 + cch] = at; ia[tt * 64 + cch] = bt; A *= at; B = at * B + bt; }
        segA[seg * 64 + cch] = A; segB[seg * 64 + cch] = B;
    }
    __syncthreads();
    {
        float Ac = 1.f, Bc = 0.f;
        for (int s = 0; s < seg; ++s) { const float sa = segA[s * 64 + cch], sb = segB[s * 64 + cch]; Bc = sa * Bc + sb; Ac *= sa; }
        float* ga = (float*)(c.ws + IC_A); float* gb = (float*)(c.ws + IC_B);
        for (int i = 0; i < 16; ++i) { const int tt = seg * 16 + i; const float at = ra[tt * 64 + cch], bt = ia[tt * 64 + cch]; Ac *= at; Bc = at * Bc + bt;
            ga[(rowb + tt) * 512 + chg] = Ac; gb[(rowb + tt) * 512 + chg] = Bc; }
        if (seg == 7) { float* gt = (float*)(c.ws + IC_TOT) + (((size_t)b * 16 + ti) * 2) * 512; gt[chg] = Ac; gt[512 + chg] = Bc; }
    }
    __syncthreads();
}

DI void phase_m1(const Ctx& c, int l) {
    int w = blockIdx.x; asm volatile("" : "+s"(w));
    for (int rep = 0; rep < (PROBE_SUB == 1 ? 2 : 1); ++rep) for (int u = w; u < 1024; u += c.G) m1_unit_b(c, l, u);
    for (int rep = 0; rep < (PROBE_SUB == 2 ? 2 : 1); ++rep) for (int u = w; u < 512; u += c.G) m1_unit_a(c, l, u);
    for (int rep = 0; rep < (PROBE_SUB == 3 ? 2 : 1); ++rep) for (int u = w; u < 512; u += c.G) m1_unit_c(c, l, u);
}

DI void m2_unit_head(const Ctx& c0, int l, int isB, int b, int h) {
    const Ctx c = fresh(c0); const Args& a = *c.a; const int tid = c.tid, lane = c.lane, wave = c.wave;
    LAS unsigned char* Wl = c.lds;
    LAS unsigned char* Ql = Wl + 64 * 272;
    LAS unsigned char* KTl = Ql + 64 * 272;
    LAS unsigned char* Pl = KTl + 128 * 144;
    LAS float* ob = (LAS float*)(Pl + 64 * 144);
    LAS float* decl = ob + 64 * 132;
    const int i = lane & 15, g = lane >> 4, e0 = 16 * wave;
    const int ubase = isB ? ((b * 8 + h) * 32) : ((b * 4 + h) * 32);
    const unsigned char* gW = c.ws + IB_W; const unsigned char* gQ = c.ws + (isB ? IB_Q : IA_Q); const unsigned char* gKT = c.ws + (isB ? IB_KT : IA_KT);
    const unsigned char* gP = c.ws + (isB ? IB_P : IA_P); const float* gU = (const float*)(c.ws + (isB ? IB_U0 : IA_V));
    const float* proj = (const float*)(c.ws + WS_PROJ); bf16_t* mixo = (bf16_t*)(c.ws + WS_MIXO);
    const float* nw = (isB ? inp(a, I_BNORM) : inp(a, I_ANORM)) + l * 128;
    const int gcol = isB ? (C_BZ + h * 128) : (C_AG + h * 128), ocol = isB ? (512 + h * 128) : (h * 128);
    const float nw0 = nw[2 * lane], nw1 = nw[2 * lane + 1];
    f32x4 S[8];
#pragma unroll
    for (int dt = 0; dt < 8; ++dt) S[dt] = (f32x4){0.f, 0.f, 0.f, 0.f};
    u32x4 pw[2], pq[2], pk[2], pp, pd = {0u, 0u, 0u, 0u};
    const int r16 = tid >> 4, c16 = tid & 15, r8 = tid >> 3, c8 = tid & 7;
#define M2_LOAD(ch) do { const size_t uu = (size_t)(ubase + (ch)); \
        if (isB) { pw[0] = *(const u32x4*)(gW + uu * 16384 + tid * 16); pw[1] = *(const u32x4*)(gW + uu * 16384 + (tid + 512) * 16); } \
        pq[0] = *(const u32x4*)(gQ + uu * 16384 + tid * 16); pq[1] = *(const u32x4*)(gQ + uu * 16384 + (tid + 512) * 16); \
        pk[0] = *(const u32x4*)(gKT + uu * 16384 + tid * 16); pk[1] = *(const u32x4*)(gKT + uu * 16384 + (tid + 512) * 16); \
        pp = *(const u32x4*)(gP + uu * 8192 + tid * 16); \
        if (!isB && tid < 32) pd = *(const u32x4*)(c.ws + IA_DEC + uu * 512 + tid * 16); } while (0)
#define M2_STORE() do { \
        if (isB) { *(LAS u32x4*)(Wl + r16 * 272 + c16 * 16) = pw[0]; *(LAS u32x4*)(Wl + (r16 + 32) * 272 + c16 * 16) = pw[1]; } \
        *(LAS u32x4*)(Ql + r16 * 272 + c16 * 16) = pq[0]; *(LAS u32x4*)(Ql + (r16 + 32) * 272 + c16 * 16) = pq[1]; \
        *(LAS u32x4*)(KTl + r8 * 144 + c8 * 16) = pk[0]; *(LAS u32x4*)(KTl + (r8 + 64) * 144 + c8 * 16) = pk[1]; \
        *(LAS u32x4*)(Pl + r8 * 144 + c8 * 16) = pp; \
        if (!isB && tid < 32) *(LAS u32x4*)((LAS unsigned char*)decl + tid * 16) = pd; } while (0)
    M2_LOAD(0);
    M2_STORE();
    f32x4 U[4]; f32x2 gt[8], gtn[8]; float dec = 0.f, decn = 0.f;
#define M2_LOADU(ch) do { const size_t uu_ = (size_t)(ubase + (ch)); \
        _Pragma("unroll") for (int tt = 0; tt < 4; ++tt) U[tt] = *(const f32x4*)(gU + uu_ * 8192 + ((tt * 8 + wave) * 64 + lane) * 4); } while (0)
#define M2_LOADR(ch, GT, DEC) do { const size_t uu_ = (size_t)(ubase + (ch)); const long row_ = (long)b * SEQ + 64 * (ch); \
        _Pragma("unroll") for (int k = 0; k < 8; ++k) GT[k] = *(const f32x2*)(proj + (row_ + 8 * wave + k) * NINP + gcol + 2 * lane); \
        if (isB) DEC = ((const float*)(c.ws + IB_DEC))[uu_]; } while (0)
    M2_LOADU(0);
    M2_LOADR(0, gt, dec);
    __syncthreads();
    for (int ci = 0; ci < 32; ++ci) {
        const long row0 = (long)b * SEQ + 64 * ci;
        SEG_T0(20)
        asm volatile("" : "+v"(U[0]), "+v"(U[1]), "+v"(U[2]), "+v"(U[3]), "+v"(dec));
        asm volatile("" : "+v"(gt[0]), "+v"(gt[1]), "+v"(gt[2]), "+v"(gt[3]), "+v"(gt[4]), "+v"(gt[5]), "+v"(gt[6]), "+v"(gt[7]));
        if (ci + 1 < 32) { M2_LOAD(ci + 1); M2_LOADR(ci + 1, gtn, decn); }
        bf16x8 Sb[4];
#pragma unroll
        for (int ks = 0; ks < 4; ++ks) { u32x4 p; p.x = pk2(S[2 * ks][0], S[2 * ks][1]); p.y = pk2(S[2 * ks][2], S[2 * ks][3]); p.z = pk2(S[2 * ks + 1][0], S[2 * ks + 1][1]); p.w = pk2(S[2 * ks + 1][2], S[2 * ks + 1][3]); Sb[ks] = __builtin_bit_cast(bf16x8, p); }
#define M2_SCHED() __builtin_amdgcn_sched_barrier(0)
        if (isB) {
#pragma unroll
            for (int hf = 0; hf < 2; ++hf) { bf16x8 fr[8];
#pragma unroll
                for (int j = 0; j < 8; ++j) fr[j] = *(const LAS bf16x8*)(Wl + (16 * (2 * hf + (j >> 2)) + i) * 272 + (32 * (j & 3) + 8 * g) * 2);
                M2_SCHED();
                f32x4 a0 = {0.f, 0.f, 0.f, 0.f}, a1 = {0.f, 0.f, 0.f, 0.f};
#pragma unroll
                for (int ks = 0; ks < 4; ++ks) { a0 = MFMA16(fr[ks], Sb[ks], a0); a1 = MFMA16(fr[4 + ks], Sb[ks], a1); }
                U[2 * hf] = U[2 * hf] - a0; U[2 * hf + 1] = U[2 * hf + 1] - a1;
                M2_SCHED(); }
        }
        bf16x8 Ub[2];
#pragma unroll
        for (int k = 0; k < 2; ++k) { u32x4 p; p.x = pk2(U[2 * k][0], U[2 * k][1]); p.y = pk2(U[2 * k][2], U[2 * k][3]); p.z = pk2(U[2 * k + 1][0], U[2 * k + 1][1]); p.w = pk2(U[2 * k + 1][2], U[2 * k + 1][3]); Ub[k] = __builtin_bit_cast(bf16x8, p); }
        SEG_T1(20)
        SEG_T0(21)
        asm volatile("" : "+v"(Ub[0]), "+v"(Ub[1]));
        if (ci + 1 < 32) M2_LOADU(ci + 1);
#pragma unroll
        for (int hf = 0; hf < 2; ++hf) { bf16x8 fq[8], fp[4];
#pragma unroll
            for (int j = 0; j < 8; ++j) fq[j] = *(const LAS bf16x8*)(Ql + (16 * (2 * hf + (j >> 2)) + i) * 272 + (32 * (j & 3) + 8 * g) * 2);
            M2_SCHED();
            f32x4 a0 = {0.f, 0.f, 0.f, 0.f}, a1 = {0.f, 0.f, 0.f, 0.f};
#pragma unroll
            for (int ks = 0; ks < 4; ++ks) { a0 = MFMA16(fq[ks], Sb[ks], a0); a1 = MFMA16(fq[4 + ks], Sb[ks], a1); }
            M2_SCHED();
#pragma unroll
            for (int j = 0; j < 4; ++j) fp[j] = *(const LAS bf16x8*)(Pl + (16 * (2 * hf + (j >> 1)) + i) * 144 + (32 * (j & 1) + 8 * g) * 2);
            M2_SCHED();
#pragma unroll
            for (int k = 0; k < 2; ++k) { a0 = MFMA16(fp[k], Ub[k], a0); a1 = MFMA16(fp[2 + k], Ub[k], a1); }
#pragma unroll
            for (int r = 0; r < 4; ++r) { ob[(16 * (2 * hf) + 4 * g + r) * 132 + e0 + i] = a0[r]; ob[(16 * (2 * hf + 1) + 4 * g + r) * 132 + e0 + i] = a1[r]; }
            M2_SCHED(); }
        if (isB) {
#pragma unroll
            for (int dt = 0; dt < 8; ++dt) S[dt] = S[dt] * dec;
        } else {
#pragma unroll
            for (int dt = 0; dt < 8; ++dt) S[dt] = S[dt] * *(const LAS f32x4*)(decl + 16 * dt + 4 * g); }
#pragma unroll
        for (int hf = 0; hf < 2; ++hf) { bf16x8 fk[8];
#pragma unroll
            for (int j = 0; j < 8; ++j) fk[j] = *(const LAS bf16x8*)(KTl + (16 * (4 * hf + (j >> 1)) + i) * 144 + (32 * (j & 1) + 8 * g) * 2);
            M2_SCHED();
#pragma unroll
            for (int j = 0; j < 8; ++j) S[4 * hf + (j >> 1)] = MFMA16(fk[j], Ub[j & 1], S[4 * hf + (j >> 1)]);
            M2_SCHED(); }
#undef M2_SCHED
        SEG_T1(21)
        SEG_T0(22)
        __syncthreads();
        SEG_T1(22)
        SEG_T0(23)
        { f32x2 vv[8]; float ss[8];
#pragma unroll
          for (int k = 0; k < 8; ++k) vv[k] = *(const LAS f32x2*)(ob + (8 * wave + k) * 132 + 2 * lane);
#pragma unroll
          for (int k = 0; k < 8; ++k) ss[k] = row16_sum(vv[k].x * vv[k].x + vv[k].y * vv[k].y);
#pragma unroll
          for (int k = 0; k < 8; ++k) ss[k] = __int_as_float(__builtin_amdgcn_readlane(__float_as_int(ss[k]), 0)) + __int_as_float(__builtin_amdgcn_readlane(__float_as_int(ss[k]), 16)) +
              __int_as_float(__builtin_amdgcn_readlane(__float_as_int(ss[k]), 32)) + __int_as_float(__builtin_amdgcn_readlane(__float_as_int(ss[k]), 48));
#pragma unroll
          for (int k = 0; k < 8; ++k) { const float r = rsqrtf(ss[k] * (1.f / 128.f) + NORM_EPS);
            *(unsigned*)(mixo + (row0 + 8 * wave + k) * D + ocol + 2 * lane) = pk2(vv[k].x * r * nw0 * silu(gt[k].x), vv[k].y * r * nw1 * silu(gt[k].y)); } }
        SEG_T1(23)
        SEG_T0(24)
        if (ci + 1 < 32) { M2_STORE();
#pragma unroll
            for (int k = 0; k < 8; ++k) gt[k] = gtn[k];
            dec = decn; }
        __syncthreads();
        SEG_T1(24)
    }
#undef M2_LOADR
#undef M2_LOADU
#undef M2_LOAD
#undef M2_STORE
    float* so = c.out + (isB ? O_GDP + (((size_t)l * BATCH + b) * 8 + h) * 16384 : O_HGP + (((size_t)l * BATCH + b) * 4 + h) * 16384);
#pragma unroll
    for (int dt = 0; dt < 8; ++dt)
#pragma unroll
        for (int r = 0; r < 4; ++r) so[(size_t)(16 * dt + 4 * g + r) * 128 + e0 + i] = S[dt][r];
}

DI void m2_unit_cfin(const Ctx& c0, int l, int u) {
    const Ctx c = fresh(c0); const int tid = c.tid;
    const int b = u >> 7, n = (u >> 4) & 7, ti = u & 15;
    const int cch = tid & 63, seg = tid >> 6, chg = n * 64 + cch;
    const float* proj = (const float*)(c.ws + WS_PROJ); bf16_t* mixo = (bf16_t*)(c.ws + WS_MIXO);
    const float* ga = (const float*)(c.ws + IC_A); const float* gb = (const float*)(c.ws + IC_B);
    const float* gt = (const float*)(c.ws + IC_TOT) + ((size_t)b * 16 * 2) * 512;
    float hs = 0.f;
    for (int k = 0; k < ti; ++k) hs = gt[(k * 2) * 512 + chg] * hs + gt[(k * 2 + 1) * 512 + chg];
    const long rowb = (long)b * SEQ + 128 * ti;
    float hh = 0.f;
#pragma unroll 4
    for (int i = 0; i < 16; ++i) { const long row = rowb + seg * 16 + i; hh = gb[row * 512 + chg] + ga[row * 512 + chg] * hs;
        mixo[row * D + 1536 + chg] = bf1(hh * gelu_tanh(proj[row * NINP + C_CG + chg])); }
    if (ti == 15 && seg == 7) c.out[O_RHP + ((size_t)l * BATCH + b) * 512 + chg] = hh;
}

DI void block_reduce_cols(LAS float* red, LAS float* full, const float (&p)[4], int tid, float scale) {
    const int e4 = (tid & 31) * 4, dgp = tid >> 5;
    *(LAS f32x4*)(red + dgp * 128 + e4) = (f32x4){p[0], p[1], p[2], p[3]};
    __syncthreads();
    if (tid < 128) { float s = 0.f;
#pragma unroll
        for (int k = 0; k < 16; ++k) s += red[k * 128 + tid];
        full[tid] = s * scale; }
    __syncthreads();
}
DI void unit_b_sample(const Ctx& c0, int l, int b, int h) {
    const Ctx c = fresh(c0);
    const Args& a = *c.a; const int tid = c.tid, lane = c.lane, wave = c.wave;
    LAS float* qkv = (LAS float*)c.lds;
    LAS float* scl = qkv + 384;
    LAS float* red = scl + 8;
    LAS float* full = red + 2048;
    LAS float* uu = full + 128;
    const float* proj = (const float*)(c.ws + WS_PROJ) + (size_t)(NP + b) * NINP;
    if (tid < 384) { const int part = tid >> 7, idx = tid & 127, cc = part * 1024 + h * 128 + idx;
        const float* cw = inp(a, I_BCW) + (size_t)l * 4 * 3072; const float* st = inp(a, I_SGC) + (((size_t)l * NS + b) * 3) * 3072;
        const float x0 = st[cc], x1 = st[3072 + cc], x2 = st[2 * 3072 + cc], x3 = proj[C_BQ + cc];
        qkv[tid] = silu(cw[cc] * x0 + cw[3072 + cc] * x1 + cw[2 * 3072 + cc] * x2 + cw[3 * 3072 + cc] * x3);
        float* so = c.out + O_GCS + (((size_t)l * NS + b) * 3) * 3072; so[cc] = x1; so[3072 + cc] = x2; so[2 * 3072 + cc] = x3; }
    if (tid == 384) { const float bb = proj[C_BB + h], ba = proj[C_BA + h]; scl[0] = sigm(bb); scl[1] = __expf(-__expf(inp(a, I_BALOG)[l * 8 + h]) * softplus(ba + inp(a, I_BDT)[l * 8 + h])); }
    __syncthreads();
    if (wave < 2) { const float x0 = qkv[wave * 128 + lane], x1 = qkv[wave * 128 + 64 + lane]; const float ss = wave_sum_fast(x0 * x0 + x1 * x1);
        if (lane == 0) scl[2 + wave] = rsqrtf(ss + L2_EPS) * (wave == 0 ? 0.08838834764831845f : 1.f); }
    __syncthreads();
    const float beta = scl[0], eg = scl[1], sq = scl[2], sk = scl[3];
    const int e4 = (tid & 31) * 4, d0 = (tid >> 5) * 8;
    const size_t sidx = (((size_t)l * NS + b) * 8 + h) * 16384;
    const float* Sin = inp(a, I_SGD) + sidx; float* Sout = c.out + O_GDS + sidx;
    f32x4 S[8]; float p[4] = {0.f, 0.f, 0.f, 0.f};
#pragma unroll
    for (int i = 0; i < 8; ++i) { S[i] = *(const f32x4*)(Sin + (size_t)(d0 + i) * 128 + e4); const float k = qkv[128 + d0 + i]; p[0] += k * S[i].x; p[1] += k * S[i].y; p[2] += k * S[i].z; p[3] += k * S[i].w; }
    block_reduce_cols(red, full, p, tid, sk);
    if (tid < 128) uu[tid] = beta * (qkv[256 + tid] - eg * full[tid]) * sk;
    __syncthreads();
    const f32x4 u4 = *(const LAS f32x4*)(uu + e4);
    float po[4] = {0.f, 0.f, 0.f, 0.f};
#pragma unroll
    for (int i = 0; i < 8; ++i) { const float k = qkv[128 + d0 + i], q = qkv[d0 + i]; S[i] = S[i] * eg + u4 * k; *(f32x4*)(Sout + (size_t)(d0 + i) * 128 + e4) = S[i];
        po[0] += q * S[i].x; po[1] += q * S[i].y; po[2] += q * S[i].z; po[3] += q * S[i].w; }
    block_reduce_cols(red, full, po, tid, sq);
    if (wave < 2) { const float o = full[wave * 64 + lane]; const float ss = wave_sum_fast(o * o); if (lane == 0) scl[4 + wave] = ss; }
    __syncthreads();
    if (tid < 128) { const float rms = rsqrtf((scl[4] + scl[5]) * (1.f / 128.f) + NORM_EPS);
        const float o = full[tid] * rms * inp(a, I_BNORM)[l * 128 + tid] * silu(proj[C_BZ + h * 128 + tid]);
        ((bf16_t*)(c.ws + WS_MIXO))[(size_t)(NP + b) * D + 512 + h * 128 + tid] = (bf16_t)(pk2(o, 0.f) & 0xffffu); }
    __syncthreads();
}
DI void unit_a_sample(const Ctx& c0, int l, int b, int h) {
    const Ctx c = fresh(c0);
    const Args& a = *c.a; const int tid = c.tid, lane = c.lane, wave = c.wave;
    LAS float* fqv = (LAS float*)c.lds;
    LAS float* scl = fqv + 384;
    LAS float* red = scl + 8;
    LAS float* full = red + 2048;
    const float* proj = (const float*)(c.ws + WS_PROJ) + (size_t)(NP + b) * NINP;
    if (tid < 384) { const int part = tid >> 7, idx = tid & 127;
        if (part == 0) { const float lb = lb_of(a, l, h * 128 + idx); fqv[tid] = lb + (1.f - lb) * sigm(proj[C_AF + h * 128 + idx]); }
        else if (part == 1) fqv[tid] = silu(proj[C_AQ + h * 128 + idx]);
        else fqv[tid] = proj[C_AI + h * 128 + idx]; }
    __syncthreads();
    const int e4 = (tid & 31) * 4, d0 = (tid >> 5) * 8;
    const size_t sidx = (((size_t)l * NS + b) * 4 + h) * 16384;
    const float* Sin = inp(a, I_SHG) + sidx; float* Sout = c.out + O_HGS + sidx;
    const f32x4 v4 = *(const LAS f32x4*)(fqv + 256 + e4);
    float po[4] = {0.f, 0.f, 0.f, 0.f};
#pragma unroll
    for (int i = 0; i < 8; ++i) { const float f = fqv[d0 + i], q = fqv[128 + d0 + i]; f32x4 S = *(const f32x4*)(Sin + (size_t)(d0 + i) * 128 + e4);
        S = S * f + v4 * (1.f - f); *(f32x4*)(Sout + (size_t)(d0 + i) * 128 + e4) = S;
        po[0] += q * S.x; po[1] += q * S.y; po[2] += q * S.z; po[3] += q * S.w; }
    block_reduce_cols(red, full, po, tid, 1.f);
    if (wave < 2) { const float o = full[wave * 64 + lane]; const float ss = wave_sum_fast(o * o); if (lane == 0) scl[4 + wave] = ss; }
    __syncthreads();
    if (tid < 128) { const float rms = rsqrtf((scl[4] + scl[5]) * (1.f / 128.f) + NORM_EPS);
        const float o = full[tid] * rms * inp(a, I_ANORM)[l * 128 + tid] * silu(proj[C_AG + h * 128 + tid]);
        ((bf16_t*)(c.ws + WS_MIXO))[(size_t)(NP + b) * D + h * 128 + tid] = (bf16_t)(pk2(o, 0.f) & 0xffffu); }
    __syncthreads();
}
DI void unit_c_sample(const Ctx& c0, int l, int b) {
    const Ctx c = fresh(c0);
    const Args& a = *c.a; const int tid = c.tid;
    LAS float* xc = (LAS float*)c.lds;
    const float* proj = (const float*)(c.ws + WS_PROJ) + (size_t)(NP + b) * NINP;
    const float* ccw = inp(a, I_CCW) + (size_t)l * 4 * 512; const float* st = inp(a, I_SRC) + (((size_t)l * NS + b) * 3) * 512;
    const float x0 = st[tid], x1 = st[512 + tid], x2 = st[1024 + tid], x3 = proj[C_CX + tid];
    const float xv = ccw[tid] * x0 + ccw[512 + tid] * x1 + ccw[1024 + tid] * x2 + ccw[1536 + tid] * x3 + inp(a, I_CCB)[l * 512 + tid];
    xc[tid] = xv;
    { float* so = c.out + O_RCS + (((size_t)l * NS + b) * 3) * 512; so[tid] = x1; so[512 + tid] = x2; so[1024 + tid] = x3; }
    __syncthreads();
    const int n = tid >> 6, j = tid & 63;
    const float* wa = inp(a, I_CWA) + ((size_t)l * 8 + n) * 4096 + j; const float* wx = inp(a, I_CWX) + ((size_t)l * 8 + n) * 4096 + j;
    float sa = 0.f, sx = 0.f;
#pragma unroll 8
    for (int i = 0; i < 64; ++i) { const float x = xc[n * 64 + i]; sa += x * wa[i * 64]; sx += x * wx[i * 64]; }
    const float r = sigm(sa + inp(a, I_CBA)[l * 512 + tid]), ig = sigm(sx + inp(a, I_CBX)[l * 512 + tid]);
    const float la = -8.f * r * softplus(-inp(a, I_CLAM)[l * 512 + tid]); const float at = __expf(la); const float mult = sqrtf(fmaxf(0.f, -expm1f(2.f * la)));
    const float h0 = inp(a, I_SRH)[((size_t)l * NS + b) * 512 + tid];
    const float hh = at * h0 + mult * (ig * xv);
    c.out[O_RHS + ((size_t)l * NS + b) * 512 + tid] = hh;
    ((bf16_t*)(c.ws + WS_MIXO))[(size_t)(NP + b) * D + 1536 + tid] = (bf16_t)(pk2(hh * gelu_tanh(proj[C_CG + tid]), 0.f) & 0xffffu);
    __syncthreads();
}


DI void phase_m2(const Ctx& c, int l) {
    int w = blockIdx.x; asm volatile("" : "+s"(w));
    if (w < 48) {
        const int isB = w < 32; const int u = isB ? w : w - 32;
        for (int rep = 0; rep < (PROBE_SUB == 4 ? 2 : 1); ++rep) m2_unit_head(c, l, isB, isB ? (u >> 3) : (u >> 2), isB ? (u & 7) : (u & 3));
    } else {
        const int nw = c.G - 48;
        for (int rep = 0; rep < (PROBE_SUB == 5 ? 2 : 1); ++rep)
        for (int u = w - 48; u < 512 + 1664; u += nw) {
            if (u < 512) m2_unit_cfin(c, l, u);
            else { const int v = u - 512;
                if (v < 1024) unit_b_sample(c, l, v >> 3, v & 7);
                else if (v < 1536) { const int x = v - 1024; unit_a_sample(c, l, x >> 2, x & 3); }
                else unit_c_sample(c, l, v - 1536); }
        }
        { const Ctx cv = fresh(c); __syncthreads();
          convert_range(cv, l == 0 ? CV_IN : CV_LAYER + CV_IN, l == 0 ? CV_LAYER + CV_IN : 2 * CV_LAYER, (w - 48) * 8 + cv.wave, nw * 8); }
        const Ctx cc = fresh(c); const float* proj = (const float*)(cc.ws + WS_PROJ);
        const int gt_ = (w - 48) * 512 + cc.tid, NT = nw * 512;
        for (int i = gt_; i < BATCH * 3 * 3072; i += NT) { const int b = i / (3 * 3072), r = i - b * 3 * 3072, j = r / 3072, ch = r - j * 3072;
            cc.out[O_GCP + (size_t)l * BATCH * 3 * 3072 + i] = proj[((size_t)b * SEQ + SEQ - 3 + j) * NINP + C_BQ + ch]; }
        for (int i = gt_; i < BATCH * 3 * 512; i += NT) { const int b = i / (3 * 512), r = i - b * 3 * 512, j = r / 512, ch = r - j * 512;
            cc.out[O_RCP + (size_t)l * BATCH * 3 * 512 + i] = proj[((size_t)b * SEQ + SEQ - 3 + j) * NINP + C_CX + ch]; }
    }
}


#define XB_TMO      128
#define XB_XCNT(j)  (256  + 64 * (j))
#define XB_XSUB(j)  (1280 + 64 * (j))
#define XB_XGEN(j)  (2304 + 64 * (j))
#define XB_TOP      3328
#define XB_TOPGEN   3392
#define XCD_BAR_WORDS 3456
#define XB_SPIN_CAP (1u << 20)
DI unsigned xb_ld(unsigned* p)              { return __hip_atomic_load(p, __ATOMIC_RELAXED, __HIP_MEMORY_SCOPE_AGENT); }
DI unsigned xb_add(unsigned* p, unsigned v) { return __hip_atomic_fetch_add(p, v, __ATOMIC_RELAXED, __HIP_MEMORY_SCOPE_AGENT); }
DI unsigned xb_xcc_id() { return (unsigned)__builtin_amdgcn_s_getreg((3 << 11) | 20) & 0xFu; }
#define XB_SPIN(cond, bar) do { unsigned _sp = 0; while (cond) { __builtin_amdgcn_s_sleep(1); \
    if ((++_sp & 255u) == 0u) { if (xb_ld(&(bar)[XB_TMO])) break; if (_sp > XB_SPIN_CAP) { atomicAdd(&(bar)[XB_TMO], 1u); break; } } } } while (0)
DI void xcd_barrier_post(unsigned* bar) { if (threadIdx.x == 0) (void)xb_add(&bar[XB_XCNT(xb_xcc_id())], 1u); }
DI void xcd_barrier_complete(unsigned* bar, unsigned x, unsigned& nloc, unsigned& nx) {
    const unsigned G = gridDim.x * gridDim.y * gridDim.z;
    unsigned sum, cnt, mine, sp = 0u;
    for (;;) {
        sum = 0u; cnt = 0u; mine = 0u;
#pragma unroll
        for (unsigned j = 0; j < 16; ++j) { const unsigned c = xb_ld(&bar[XB_XCNT(j)]); sum += c; cnt += (c > 0u) ? 1u : 0u; mine = (j == x) ? c : mine; }
        if (sum == G) break;
        __builtin_amdgcn_s_sleep(1);
        if ((++sp & 255u) == 0u) { if (xb_ld(&bar[XB_TMO])) break; if (sp > XB_SPIN_CAP) { atomicAdd(&bar[XB_TMO], 1u); break; } }
    }
    nloc = mine > 0u ? mine : 1u; nx = cnt > 0u ? cnt : 1u;
}
DI void xcd_barrier(unsigned* bar, volatile LAS unsigned* st) {
    asm volatile("s_waitcnt vmcnt(0)" ::: "memory");
    __syncthreads();
    if (threadIdx.x == 0) {
        const unsigned x = xb_xcc_id();
        __builtin_amdgcn_s_waitcnt(0);
        unsigned nloc = st[0], nx = st[1];
        if (nloc == 0u) { xcd_barrier_complete(bar, x, nloc, nx); st[0] = nloc; st[1] = nx; }
        const unsigned old = xb_add(&bar[XB_XSUB(x)], 1u);
        const unsigned gen = old / nloc;
        if (old + 1u == (gen + 1u) * nloc) {
            __builtin_amdgcn_fence(__ATOMIC_RELEASE, "agent");
            asm volatile("s_waitcnt vmcnt(0)" ::: "memory");
            const unsigned og = xb_add(&bar[XB_TOP], 1u);
            const unsigned tg = og / nx;
            if (og + 1u == (tg + 1u) * nx) xb_add(&bar[XB_TOPGEN], 1u);
            else XB_SPIN(xb_ld(&bar[XB_TOPGEN]) == tg, bar);
            __builtin_amdgcn_fence(__ATOMIC_ACQUIRE, "agent");
            xb_add(&bar[XB_XGEN(x)], 1u);
            asm volatile("s_waitcnt vmcnt(0)" ::: "memory");
        } else {
            XB_SPIN(xb_ld(&bar[XB_XGEN(x)]) == gen, bar);
            __builtin_amdgcn_fence(__ATOMIC_ACQUIRE, "agent");
            asm volatile("s_waitcnt vmcnt(0)" ::: "memory");
        }
    }
    __syncthreads();
}

__global__ void __launch_bounds__(512, 2) fwd_megakernel(Args args) {
    extern __shared__ __attribute__((aligned(16))) unsigned char lds_raw[];
    Ctx c0; c0.a = &args; c0.ws = nullptr; c0.out = nullptr; c0.lds = (LAS unsigned char*)lds_raw; c0.tid = 0; c0.lane = 0; c0.wave = 0; c0.G = gridDim.x; c0.bid = 0;
    const int lo = args.ph_lo, hi = args.ph_hi;
    volatile LAS unsigned* bst = (volatile LAS unsigned*)((LAS unsigned char*)lds_raw + LDS_BYTES - 16);
    if (threadIdx.x == 0) { bst[0] = 0u; bst[1] = 0u; }
    __syncthreads();
    xcd_barrier_post((unsigned*)(args.ws + WS_CTL) + 1024);
#pragma unroll 1
    for (int ph2 = 2 * lo; ph2 < 2 * hi; ++ph2) {
        const int ph = ph2 >> 1;
        const int l = (ph - 1) >> 3, k = (ph == 0) ? -1 : ((ph - 1) & 7);
        if ((ph2 & 1) && k != PROBE_REP) continue;
        if (k == -1) phase_p0(c0);
        else if (k == 0 || k == 3 || k == 5 || k == 6) {
            const Ctx c = fresh(c0); unsigned char* ws = c.ws;
            pg8::Gemm g; pg8::EpiAny E; E.mode = 0; E.C = (float*)(ws + WS_MIXF); E.O = nullptr; E.ldc = D;
            if (k == 0)      { g.A = (const bf16_t*)(ws + WS_HBUF); g.Bt = (const bf16_t*)(ws + WS_WIN + l * SZ_WIN);   g.N = NINP; g.K = D;   E.C = (float*)(ws + WS_PROJ); E.ldc = NINP; }
            else if (k == 3) { g.A = (const bf16_t*)(ws + WS_MIXO); g.Bt = (const bf16_t*)(ws + WS_WOUT + l * SZ_WOUT); g.N = D;    g.K = D; }
            else if (k == 5) { g.A = (const bf16_t*)(ws + WS_HBUF); g.Bt = (const bf16_t*)(ws + WS_WGU + l * SZ_WGU);   g.N = NGU;  g.K = D;   E.mode = 1; E.O = (bf16_t*)(ws + WS_PROJ); E.ldc = DFF; }
            else             { g.A = (const bf16_t*)(ws + WS_PROJ); g.Bt = (const bf16_t*)(ws + WS_WDN + l * SZ_WDN);   g.N = D;    g.K = DFF; }
            g.M = (k == 3 || k == 6) ? NP : MPAD;
            pg8::StaticOrder S; S.init(g.M, g.N, c.G, c.bid);
            pg8::gemm_phase<pg8::EpiAny, pg8::StaticOrder, true, true>(c.lds, g, S, E);
            if (k == 3 || k == 6) sample_pieces(c0, g.A + (size_t)NP * g.K, g.Bt, g.K, (float*)(ws + WS_SLAB));
        }
        else if (k == 1) phase_m1(c0, l);
        else if (k == 2) phase_m2(c0, l);
        else {
            const Ctx c = fresh(c0); unsigned char* ws = c.ws;
            float* mixf = (float*)(ws + WS_MIXF); float* x1 = (float*)(ws + WS_X1); bf16_t* hb = (bf16_t*)(ws + WS_HBUF);
            if (k == 4) {
                const float* xa = (l == 0) ? inp(args, I_XP) : c.out; const float* xb = (l == 0) ? inp(args, I_XS) : c.out + (size_t)NP * D;
                row_phase(c0, mixf, (const float*)(ws + WS_SLAB), xa, xb, x1, inp(args, I_LN2) + l * D, inp(args, I_LN3) + l * D, hb);
            } else {
                row_phase(c0, mixf, (const float*)(ws + WS_SLAB), x1, x1 + (size_t)NP * D, c.out, inp(args, I_LN4) + l * D, l == 0 ? inp(args, I_LN1) + D : nullptr, hb);
            }
        }
        if (ph2 + 1 < 2 * hi) {
            if (ph2 == 2 * lo) cg::this_grid().sync();
            else xcd_barrier((unsigned*)(args.ws + WS_CTL) + 1024, bst);
        }
    }
}

extern "C" void kernel_launch(void* const* d_in, const int* in_sizes, int n_in, void* d_out, int out_size, void* d_ws, size_t ws_size, hipStream_t stream) {
    static int grid = 0;
    if (grid == 0) {
        if (n_in != 29 || (size_t)out_size != O_END || ws_size < WS_END) { fprintf(stderr, "kernel_launch: unexpected shapes: n_in %d out %d ws %zu (need %zu)\n", n_in, out_size, ws_size, (size_t)WS_END); grid = -1; return; }
        int dev = 0, cus = 0, per_cu = 0;
        hipGetDevice(&dev); hipDeviceGetAttribute(&cus, hipDeviceAttributeMultiprocessorCount, dev);
        if (hipFuncSetAttribute((const void*)fwd_megakernel, hipFuncAttributeMaxDynamicSharedMemorySize, LDS_BYTES) != hipSuccess) { fprintf(stderr, "kernel_launch: hipFuncSetAttribute failed\n"); grid = -1; return; }
        if (hipOccupancyMaxActiveBlocksPerMultiprocessor(&per_cu, (const void*)fwd_megakernel, 512, LDS_BYTES) != hipSuccess || per_cu < 1) { fprintf(stderr, "kernel_launch: occupancy query says %d\n", per_cu); grid = -1; return; }
        grid = cus;
        if (grid < 224) { fprintf(stderr, "kernel_launch: needs >= 224 CUs, got %d\n", grid); grid = -1; return; }
    }
    if (grid < 0) return;
    hipMemsetAsync((char*)d_ws + WS_CTL, 0, CTL_BYTES, stream);
    Args a{};
    for (int i = 0; i < 29; ++i) a.in[i] = (const float*)d_in[i];
    a.out = (float*)d_out; a.ws = (unsigned char*)d_ws;
#if MK_MULTI
    for (int ph = 0; ph < NPHASE; ++ph) { a.ph_lo = ph; a.ph_hi = ph + 1; hipLaunchKernelGGL(fwd_megakernel, dim3(grid), dim3(512), LDS_BYTES, stream, a); }
#else
    a.ph_lo = 0; a.ph_hi = NPHASE;
    void* kargs[] = {&a};
    hipError_t e = hipLaunchCooperativeKernel((const void*)fwd_megakernel, dim3(grid), dim3(512), kargs, LDS_BYTES, stream);
    if (e != hipSuccess) fprintf(stderr, "cooperative launch failed: %s (grid %d)\n", hipGetErrorString(e), grid);
#endif
}
```

```cpp
#include <hip/hip_runtime.h>
#include <hip/hip_cooperative_groups.h>
#include <cstdio>
#include <cstdint>
namespace cg = cooperative_groups;

#ifndef MK_MULTI
#define MK_MULTI 0
#endif

#ifndef PROBE_REP
#define PROBE_REP (-2)
#endif
#ifndef PROBE_SUB
#define PROBE_SUB 0
#endif
#ifndef PROBE_SEG
#define PROBE_SEG 0
#endif
#define SEG_T0(id) unsigned long long seg_t0_##id = 0; if (PROBE_SEG == (id)) seg_t0_##id = __builtin_amdgcn_s_memrealtime();
#define SEG_T1(id) if (PROBE_SEG == (id)) { const unsigned long long t1_ = __builtin_amdgcn_s_memrealtime(); const unsigned long long d_ = (t1_ - seg_t0_##id) * 8ull; \
        while (__builtin_amdgcn_s_memrealtime() - t1_ < d_) __builtin_amdgcn_s_sleep(2); }
#define DI __device__ __forceinline__
#define LAS __attribute__((address_space(3)))
#define GAS __attribute__((address_space(1)))
typedef unsigned short bf16_t;
typedef float f32x4 __attribute__((ext_vector_type(4)));
typedef float f32x2 __attribute__((ext_vector_type(2)));
typedef unsigned u32x4 __attribute__((ext_vector_type(4)));
typedef unsigned u32x2 __attribute__((ext_vector_type(2)));
typedef short bf16x8 __attribute__((ext_vector_type(8)));
typedef __bf16 bf16v2 __attribute__((ext_vector_type(2)));

constexpr int D = 2048, SEQ = 2048, BATCH = 4, NP = BATCH * SEQ, NS = 128, MT = NP + NS, MPAD = 8448;
constexpr int NIN = 7184, NINP = 7424, DFF = 5632, NGU = 2 * DFF;
constexpr int C_AQ = 0, C_AF = 512, C_AI = 1024, C_AG = 1536, C_BQ = 2048, C_BK = 3072, C_BV = 4096, C_BZ = 5120, C_BB = 6144, C_BA = 6152, C_CX = 6160, C_CG = 6672;
constexpr float NORM_EPS = 1e-6f, L2_EPS = 1e-6f;
constexpr int NPHASE = 17;

constexpr size_t O_YP = 0, O_YS = O_YP + (size_t)NP * D, O_HGP = O_YS + (size_t)NS * D, O_HGS = O_HGP + 2ull * 4 * 4 * 16384,
                 O_GDP = O_HGS + 2ull * 128 * 4 * 16384, O_GDS = O_GDP + 2ull * 4 * 8 * 16384, O_GCP = O_GDS + 2ull * 128 * 8 * 16384,
                 O_GCS = O_GCP + 2ull * 4 * 3 * 3072, O_RHP = O_GCS + 2ull * 128 * 3 * 3072, O_RHS = O_RHP + 2ull * 4 * 512,
                 O_RCP = O_RHS + 2ull * 128 * 512, O_RCS = O_RCP + 2ull * 4 * 3 * 512, O_END = O_RCS + 2ull * 128 * 3 * 512;

constexpr size_t MiB = 1ull << 20;
constexpr size_t WS_CTL = 0, CTL_BYTES = 1 * MiB;
constexpr size_t WS_WIN = 1 * MiB, SZ_WIN = 29 * MiB, WS_WOUT = WS_WIN + 2 * SZ_WIN, SZ_WOUT = 8 * MiB, WS_WGU = WS_WOUT + 2 * SZ_WOUT, SZ_WGU = 44 * MiB,
                 WS_WDN = WS_WGU + 2 * SZ_WGU, SZ_WDN = 22 * MiB;
constexpr size_t WS_PROJ = WS_WDN + 2 * SZ_WDN, SZ_PROJ = 240 * MiB;
constexpr size_t WS_HBUF = WS_PROJ + SZ_PROJ, SZ_HBUF = 33 * MiB;
constexpr size_t WS_MIXO = WS_HBUF + SZ_HBUF;
constexpr size_t WS_MIXF = WS_MIXO + SZ_HBUF, SZ_MIXF = 66 * MiB;
constexpr size_t WS_X1 = WS_MIXF + SZ_MIXF, WS_END = WS_X1 + SZ_MIXF + 25 * MiB;
static_assert((size_t)NINP * D * 2 == SZ_WIN && (size_t)NGU * D * 2 == SZ_WGU && (size_t)D * DFF * 2 == SZ_WDN && (size_t)D * D * 2 == SZ_WOUT, "weight sizes");
static_assert((size_t)MPAD * NINP * 4 <= SZ_PROJ && (size_t)MPAD * D * 2 <= SZ_HBUF && (size_t)MPAD * D * 4 <= SZ_MIXF, "ws map");

constexpr int LDS_BYTES = 147456;

DI unsigned pk2(float lo, float hi) { f32x2 x = {lo, hi}; bf16v2 y = __builtin_convertvector(x, bf16v2); return __builtin_bit_cast(unsigned, y); }
DI float wave_sum(float v) {
#pragma unroll
    for (int o = 1; o < 64; o <<= 1) v += __shfl_xor(v, o);
    return v;
}
template <int CTRL> DI float dpp_mov(float v) { return __int_as_float(__builtin_amdgcn_update_dpp(0, __float_as_int(v), CTRL, 0xF, 0xF, true)); }
DI float row16_sum(float v) {
    v += dpp_mov<0xB1>(v); v += dpp_mov<0x4E>(v); v += dpp_mov<0x124>(v); v += dpp_mov<0x128>(v); return v;
}
DI float rl(float v, int l) { return __int_as_float(__builtin_amdgcn_readlane(__float_as_int(v), l)); }
DI float wave_sum_fast(float v) { v = row16_sum(v); return (rl(v, 0) + rl(v, 16)) + (rl(v, 32) + rl(v, 48)); }
DI float sigm(float x) { return __builtin_amdgcn_rcpf(1.f + __expf(-x)); }
DI float silu(float x) { return x * __builtin_amdgcn_rcpf(1.f + __expf(-x)); }
DI float softplus(float x) { return x > 20.f ? x : log1pf(__expf(x)); }
DI float gelu_tanh(float x) { const float y = 0.7978845608028654f * (x + 0.044715f * x * x * x); return 0.5f * x * (1.f + tanhf(y)); }
#define LDS_WAIT() asm volatile("s_waitcnt lgkmcnt(0)" ::: "memory")
#define MFMA16(a, b, c) __builtin_amdgcn_mfma_f32_16x16x32_bf16((a), (b), (c), 0, 0, 0)

namespace pg8 {
#define PG8_LAS __attribute__((address_space(3)))
constexpr int BM = 256, BK = 64, HALF = 128, HTB = HALF * BK * 2, STAGE_BYTES = 8 * HTB, NXCD = 8, WGM = 8;
__host__ __device__ __forceinline__ int lds_byte(int r, int c) { const int st = (r >> 4) * 2 + (c >> 5), rr = r & 15, cc = c & 31, ob = rr * 64 + cc * 2; return st * 1024 + (ob ^ (((ob >> 9) & 1) << 5)); }
__host__ __device__ __forceinline__ void stage_rc(int b, int& R, int& C) { const int st = b / 1024, sb = b % 1024, swz = sb ^ (((sb >> 9) & 1) << 5); R = (st >> 1) * 16 + swz / 64; C = (st & 1) * 32 + (swz % 64) / 2; }
struct Unit { int pm, pn; };
struct Gemm { const bf16_t* A; const bf16_t* Bt; int M, N, K; };
struct StaticOrder {
    int nM, nN, nwg, G, c;
    __host__ __device__ void init(int M, int N, int G_, int c_) { nM = M / BM; nN = N / BM; nwg = nM * nN; G = G_; c = c_; }
    __host__ __device__ bool next(int i, Unit& u) const {
        const long L = (long)i * G + c; if (L >= nwg) return false;
        int wgid = (int)L; { const int q = nwg / NXCD, r = nwg % NXCD, xcd = wgid % NXCD, off = wgid / NXCD; wgid = (xcd < r ? xcd * (q + 1) : r * (q + 1) + (xcd - r) * q) + off; }
        const int nig = WGM * nN, gid = wgid / nig, fm = gid * WGM, gsz = (nM - fm) < WGM ? (nM - fm) : WGM;
        u.pm = fm + ((wgid % nig) % gsz); u.pn = (wgid % nig) / gsz; return true;
    }
    __device__ __forceinline__ void a_ready(const Unit&) const {}
    __device__ __forceinline__ void done(const Unit&) const {}
};
struct EpiAny {
    static constexpr bool PERM = false, AFTER_DRAIN = false;
    int mode; float* C; bf16_t* O; int ldc;
    __device__ __forceinline__ void operator()(const f32x4 (&acc)[2][2][4][2], const Unit& u, int wr, int wc, int fr, int fq) const {
        const int row0 = u.pm * BM + wr * 64 + fr;
        if (mode == 0) {
            const int col0 = u.pn * BM + wc * 32 + 4 * fq;
#pragma unroll
            for (int ai = 0; ai < 2; ++ai)
#pragma unroll
                for (int m = 0; m < 4; ++m) { float* rowp = C + (size_t)(row0 + ai * HALF + m * 16) * ldc + col0;
#pragma unroll
                    for (int bj = 0; bj < 2; ++bj)
#pragma unroll
                        for (int n = 0; n < 2; ++n) *(f32x4*)(rowp + bj * HALF + n * 16) = acc[ai][bj][m][n]; }
        } else {
#pragma unroll
            for (int ai = 0; ai < 2; ++ai)
#pragma unroll
                for (int m = 0; m < 4; ++m) { bf16_t* rowp = O + (size_t)(row0 + ai * HALF + m * 16) * ldc;
#pragma unroll
                    for (int bj = 0; bj < 2; ++bj) { const int G = 8 * u.pn + 4 * bj + wc; const f32x4 g = acc[ai][bj][m][0], up = acc[ai][bj][m][1];
                        u32x2 w; w.x = pk2(silu(g[0]) * up[0], silu(g[1]) * up[1]); w.y = pk2(silu(g[2]) * up[2], silu(g[3]) * up[3]);
                        *(u32x2*)(rowp + 16 * G + 4 * fq) = w; } }
        }
    }
};

template <class Epi, class Sched, bool ALIGN_EPI = false, bool SP2 = false>
__device__ __forceinline__ void gemm_phase(PG8_LAS unsigned char* lds, const Gemm g, const Sched& S, const Epi& E) {
    int tid_ = threadIdx.x; asm volatile("" : "+v"(tid_));
    const int tid = tid_, wid = __builtin_amdgcn_readfirstlane(tid >> 6), lane = tid & 63, wr = wid >> 2, wc = wid & 3, fr = lane & 15, fq = lane >> 4;
    const int K = g.K, nt = K / BK;
    unsigned voffA[2], voffB[2];
#pragma unroll
    for (int i = 0; i < 2; ++i) { int R, C; stage_rc(tid * 16 + i * 8192, R, C); voffA[i] = (unsigned)(R * K + C) * 2u; voffB[i] = (unsigned)(R * K + C) * 2u; }
    const size_t kstep = (size_t)(BK * 2);
    const size_t hstep = (size_t)HALF * K * 2;
    const size_t tstep = 2 * hstep;
    const unsigned ldsw = (unsigned)wid * 1024u;
    const int aoff = lds_byte(wr * 64 + fr, fq * 8), boff = lds_byte(wc * 32 + fr, fq * 8);
#define PG8_SA(b, h) (((b) * 2 + (h)) * HTB)
#define PG8_SB(b, h) ((4 + (b) * 2 + (h)) * HTB)
#define PG8_STAGE(bufoff, gbase, voff) do { _Pragma("unroll") for (int _i = 0; _i < 2; ++_i) \
        __builtin_amdgcn_global_load_lds((const unsigned*)((const char*)(gbase) + (voff)[_i]), (PG8_LAS unsigned*)(lds + (bufoff) + ldsw + _i * 8192), 16, 0, 0); } while (0)
#define PG8_LDA(dst, b, h) do { _Pragma("unroll") for (int m = 0; m < 4; ++m) _Pragma("unroll") for (int k = 0; k < 2; ++k) dst[m][k] = *(const PG8_LAS bf16x8*)(lds + PG8_SA(b, h) + aoff + m * 2048 + k * 1024); } while (0)
#define PG8_LDB(dst, b, h) do { _Pragma("unroll") for (int n = 0; n < 2; ++n) _Pragma("unroll") for (int k = 0; k < 2; ++k) dst[n][k] = *(const PG8_LAS bf16x8*)(lds + PG8_SB(b, h) + boff + n * 2048 + k * 1024); } while (0)
#define PG8_MMA(ai, bj, At, Bt) do { __builtin_amdgcn_s_setprio(1); _Pragma("unroll") for (int m = 0; m < 4; ++m) _Pragma("unroll") for (int n = 0; n < 2; ++n) _Pragma("unroll") for (int k = 0; k < 2; ++k) \
        acc[ai][bj][m][n] = __builtin_amdgcn_mfma_f32_16x16x32_bf16(Bt[n][k], At[m][k], acc[ai][bj][m][n], 0, 0, 0); __builtin_amdgcn_s_setprio(0); } while (0)
#define PG8_WAIT_V(n) asm volatile("s_waitcnt vmcnt(" #n ")" ::: "memory")
#define PG8_WAIT_L(n) asm volatile("s_waitcnt lgkmcnt(" #n ")" ::: "memory")
#define PG8_BAR __builtin_amdgcn_s_barrier()
#define PG8_SCHED __builtin_amdgcn_sched_barrier(0)
    Unit cur, nxt; int ui = 0;
    if (!S.next(0, cur)) return;
    f32x4 acc[2][2][4][2];
#pragma unroll
    for (int a = 0; a < 2; ++a)
#pragma unroll
        for (int b = 0; b < 2; ++b)
#pragma unroll
            for (int m = 0; m < 4; ++m)
#pragma unroll
                for (int n = 0; n < 2; ++n) acc[a][b][m][n] = (f32x4){0.f, 0.f, 0.f, 0.f};
    bf16x8 At[4][2], B0[2][2], B1[2][2];
    const char* cA = (const char*)g.A + (size_t)cur.pm * tstep; const char* cB = (const char*)g.Bt + (size_t)cur.pn * tstep;
    S.a_ready(cur);
    if constexpr (SP2) {
        PG8_STAGE(PG8_SB(0, 0), cB, voffB); PG8_STAGE(PG8_SB(0, 1), cB + hstep, voffB); PG8_STAGE(PG8_SA(0, 0), cA, voffA); PG8_STAGE(PG8_SA(0, 1), cA + hstep, voffA);
        if (wr == 1) PG8_BAR;
        PG8_WAIT_V(2); PG8_BAR;
        PG8_STAGE(PG8_SB(1, 0), cB + kstep, voffB); PG8_STAGE(PG8_SA(1, 0), cA + kstep, voffA); PG8_STAGE(PG8_SB(1, 1), cB + hstep + kstep, voffB);
        PG8_WAIT_V(6); PG8_BAR;
    } else {
        PG8_STAGE(PG8_SB(0, 0), cB, voffB); PG8_STAGE(PG8_SA(0, 0), cA, voffA); PG8_STAGE(PG8_SB(0, 1), cB + hstep, voffB); PG8_STAGE(PG8_SA(0, 1), cA + hstep, voffA);
        if (wr == 1) PG8_BAR;
        PG8_WAIT_V(4); PG8_BAR;
        PG8_STAGE(PG8_SB(1, 0), cB + kstep, voffB); PG8_STAGE(PG8_SA(1, 0), cA + kstep, voffA); PG8_STAGE(PG8_SB(1, 1), cB + hstep + kstep, voffB);
        PG8_WAIT_V(6); PG8_BAR;
    }
    for (;;) {
        const bool has_next = S.next(ui + 1, nxt);
        const char* nA = has_next ? (const char*)g.A + (size_t)nxt.pm * tstep : cA; const char* nB = has_next ? (const char*)g.Bt + (size_t)nxt.pn * tstep : cB;
        for (int t = 0; t < nt; t += 2) {
            const bool last = (t == nt - 2);
            const char* a1 = cA + (size_t)(t + 1) * kstep;
            const char* a2 = last ? nA : cA + (size_t)(t + 2) * kstep; const char* b2 = last ? nB : cB + (size_t)(t + 2) * kstep;
            const char* a3 = a2 + kstep; const char* b3 = b2 + kstep;
            if (last && has_next) S.a_ready(nxt);
            if constexpr (SP2) {
            PG8_LDB(B0, 0, 0); PG8_LDB(B1, 0, 1); PG8_SCHED; PG8_LDA(At, 0, 0); PG8_STAGE(PG8_SA(1, 1), a1 + hstep, voffA);
            PG8_WAIT_V(8); PG8_WAIT_L(0); PG8_BAR; PG8_MMA(0, 0, At, B0); PG8_MMA(0, 1, At, B1); PG8_BAR; PG8_SCHED;
            PG8_LDA(At, 0, 1); PG8_STAGE(PG8_SB(0, 0), b2, voffB); PG8_STAGE(PG8_SB(0, 1), b2 + hstep, voffB); PG8_STAGE(PG8_SA(0, 0), a2, voffA);
            PG8_WAIT_V(8); PG8_WAIT_L(0); PG8_BAR; PG8_MMA(1, 0, At, B0); PG8_MMA(1, 1, At, B1); PG8_BAR; PG8_SCHED;
            PG8_LDB(B0, 1, 0); PG8_LDB(B1, 1, 1); PG8_SCHED; PG8_LDA(At, 1, 0); PG8_STAGE(PG8_SA(0, 1), a2 + hstep, voffA);
            PG8_WAIT_V(8); PG8_WAIT_L(0); PG8_BAR; PG8_MMA(0, 0, At, B0); PG8_MMA(0, 1, At, B1); PG8_BAR; PG8_SCHED;
            PG8_LDA(At, 1, 1); PG8_STAGE(PG8_SB(1, 0), b3, voffB); PG8_STAGE(PG8_SB(1, 1), b3 + hstep, voffB); PG8_STAGE(PG8_SA(1, 0), a3, voffA);
            PG8_WAIT_V(8); PG8_WAIT_L(0); PG8_BAR; PG8_MMA(1, 0, At, B0); PG8_MMA(1, 1, At, B1); PG8_BAR; PG8_SCHED;
            } else {
            PG8_LDB(B0, 0, 0); PG8_SCHED; PG8_LDA(At, 0, 0); PG8_STAGE(PG8_SA(1, 1), a1 + hstep, voffA);
            PG8_WAIT_L(8); PG8_BAR; PG8_WAIT_L(0); PG8_MMA(0, 0, At, B0); PG8_BAR; PG8_SCHED;
            PG8_LDB(B1, 0, 1); PG8_STAGE(PG8_SB(0, 0), b2, voffB);
            PG8_BAR; PG8_WAIT_L(0); PG8_MMA(0, 1, At, B1); PG8_BAR;
            PG8_LDA(At, 0, 1); PG8_STAGE(PG8_SA(0, 0), a2, voffA);
            PG8_BAR; PG8_WAIT_L(0); PG8_MMA(1, 0, At, B0); PG8_BAR; PG8_SCHED;
            PG8_STAGE(PG8_SB(0, 1), b2 + hstep, voffB);
            PG8_WAIT_V(6); PG8_BAR; PG8_MMA(1, 1, At, B1); PG8_BAR;
            PG8_LDB(B0, 1, 0); PG8_SCHED; PG8_LDA(At, 1, 0); PG8_STAGE(PG8_SA(0, 1), a2 + hstep, voffA);
            PG8_WAIT_L(8); PG8_BAR; PG8_WAIT_L(0); PG8_MMA(0, 0, At, B0); PG8_BAR; PG8_SCHED;
            PG8_LDB(B1, 1, 1); PG8_STAGE(PG8_SB(1, 0), b3, voffB);
            PG8_BAR; PG8_WAIT_L(0); PG8_MMA(0, 1, At, B1); PG8_BAR;
            PG8_LDA(At, 1, 1); PG8_STAGE(PG8_SA(1, 0), a3, voffA);
            PG8_BAR; PG8_WAIT_L(0); PG8_MMA(1, 0, At, B0); PG8_BAR; PG8_SCHED;
            PG8_STAGE(PG8_SB(1, 1), b3 + hstep, voffB);
            PG8_WAIT_V(6); PG8_BAR; PG8_MMA(1, 1, At, B1); PG8_BAR;
            }
        }
        if constexpr (ALIGN_EPI) { if (wr == 0) PG8_BAR; }
        if constexpr (!Epi::AFTER_DRAIN) { E(acc, cur, wr, wc, fr, fq); S.done(cur); }
        if (!has_next) break;
#pragma unroll
        for (int a = 0; a < 2; ++a)
#pragma unroll
            for (int b = 0; b < 2; ++b)
#pragma unroll
                for (int m = 0; m < 4; ++m)
#pragma unroll
                    for (int n = 0; n < 2; ++n) acc[a][b][m][n] = (f32x4){0.f, 0.f, 0.f, 0.f};
        cur = nxt; cA = nA; cB = nB; ++ui;
        if constexpr (ALIGN_EPI) { if (wr == 1) PG8_BAR; }
    }
    PG8_WAIT_V(0);
    if constexpr (!ALIGN_EPI) { if (wr == 0) PG8_BAR; }
    PG8_BAR;
#undef PG8_SA
#undef PG8_SB
#undef PG8_STAGE
#undef PG8_LDA
#undef PG8_LDB
#undef PG8_MMA
#undef PG8_WAIT_V
#undef PG8_WAIT_L
#undef PG8_BAR
#undef PG8_SCHED
}
}

struct Args { const float* in[29]; float* out; unsigned char* ws; int ph_lo, ph_hi; };
enum { I_XP = 0, I_XS, I_SHG, I_SGD, I_SGC, I_SRH, I_SRC, I_LN1, I_LN2, I_LN3, I_LN4, I_WIN, I_WOUT, I_LB, I_ANORM, I_BCW, I_BALOG, I_BDT, I_BNORM,
       I_CCW, I_CCB, I_CWA, I_CBA, I_CWX, I_CBX, I_CLAM, I_WG, I_WU, I_WD };

struct Ctx {
    const Args* a; unsigned char* ws; float* out; LAS unsigned char* lds; int tid, lane, wave, G, bid;
};
DI Ctx fresh(const Ctx& o) {
    Ctx c = o; int t = threadIdx.x; asm volatile("" : "+v"(t)); c.tid = t; c.lane = t & 63; c.wave = __builtin_amdgcn_readfirstlane(t >> 6);
    size_t z = 0; asm volatile("" : "+s"(z)); c.ws = o.a->ws + z; c.out = o.a->out + z;
    int b = blockIdx.x; asm volatile("" : "+s"(b)); c.bid = b; return c;
}
DI const float* inp(const Args& a, int idx) { int z = idx; asm volatile("" : "+s"(z)); return (const float*)(const GAS float*)a.in[z]; }

template <int MODE>
DI void transpose_item(const float* W, int K, int Nsrc, int nblk, bf16_t* WT, LAS float* scr, int item, int lane) {
    const int kb = item / nblk, nb = item - kb * nblk, k0 = 64 * kb, n0 = 32 * nb;
    const int nn = n0 + (lane & 31); const bool ok = nn < Nsrc;
    float v[32];
#pragma unroll
    for (int i = 0; i < 32; ++i) { const int kk = 2 * i + (lane >> 5); v[i] = ok ? W[(size_t)(k0 + kk) * Nsrc + nn] : 0.f; }
#pragma unroll
    for (int i = 0; i < 32; ++i) { const int kk = 2 * i + (lane >> 5); scr[kk * 33 + (lane & 31)] = v[i]; }
    LDS_WAIT(); asm volatile("" ::: "memory");
    const int c = lane & 7;
#pragma unroll
    for (int j = 0; j < 4; ++j) { const int nl = (lane >> 3) + 8 * j; const LAS float* s = scr + (8 * c) * 33 + nl;
        u32x4 o; o.x = pk2(s[0 * 33], s[1 * 33]); o.y = pk2(s[2 * 33], s[3 * 33]); o.z = pk2(s[4 * 33], s[5 * 33]); o.w = pk2(s[6 * 33], s[7 * 33]);
        const int n = n0 + nl; const int drow = (MODE == 0) ? n : ((n >> 4) * 32 + (n & 15) + (MODE == 2 ? 16 : 0));
        *(u32x4*)(WT + (size_t)drow * K + k0 + 8 * c) = o; }
    LDS_WAIT(); asm volatile("" ::: "memory");
}
DI void norm_row_to_bf16(const float* xr, const float* g, bf16_t* orow, int lane) {
    f32x4 v[8]; float s = 0.f;
#pragma unroll
    for (int j = 0; j < 8; ++j) { v[j] = ((const f32x4*)xr)[lane + 64 * j]; s += (v[j].x * v[j].x + v[j].y * v[j].y) + (v[j].z * v[j].z + v[j].w * v[j].w); }
    const float r = rsqrtf(wave_sum_fast(s) * (1.f / D) + NORM_EPS);
#pragma unroll
    for (int j = 0; j < 8; ++j) { const f32x4 gg = ((const f32x4*)g)[lane + 64 * j]; u32x2 w; w.x = pk2(v[j].x * r * gg.x, v[j].y * r * gg.y); w.y = pk2(v[j].z * r * gg.z, v[j].w * r * gg.w);
        ((u32x2*)orow)[lane + 64 * j] = w; }
}
constexpr int CV_IN = (D / 64) * (NINP / 32), CV_OUT = (D / 64) * (D / 32), CV_G = (D / 64) * (DFF / 32), CV_D = (DFF / 64) * (D / 32), CV_LAYER = CV_IN + CV_OUT + 2 * CV_G + CV_D;
DI void convert_range(const Ctx& c, int lo, int hi, int gw, int NGW) {
    const Args& a = *c.a;
    LAS float* scr = (LAS float*)(c.lds + c.wave * 16384);
    for (int it = lo + gw; it < hi; it += NGW) {
        const int l = it / CV_LAYER; int r = it - l * CV_LAYER;
        if (r < CV_IN) { transpose_item<0>(inp(a, I_WIN) + (size_t)l * D * NIN, D, NIN, NINP / 32, (bf16_t*)(c.ws + WS_WIN + l * SZ_WIN), scr, r, c.lane); continue; } r -= CV_IN;
        if (r < CV_OUT) { transpose_item<0>(inp(a, I_WOUT) + (size_t)l * D * D, D, D, D / 32, (bf16_t*)(c.ws + WS_WOUT + l * SZ_WOUT), scr, r, c.lane); continue; } r -= CV_OUT;
        if (r < CV_G) { transpose_item<1>(inp(a, I_WG) + (size_t)l * D * DFF, D, DFF, DFF / 32, (bf16_t*)(c.ws + WS_WGU + l * SZ_WGU), scr, r, c.lane); continue; } r -= CV_G;
        if (r < CV_G) { transpose_item<2>(inp(a, I_WU) + (size_t)l * D * DFF, D, DFF, DFF / 32, (bf16_t*)(c.ws + WS_WGU + l * SZ_WGU), scr, r, c.lane); continue; } r -= CV_G;
        transpose_item<0>(inp(a, I_WD) + (size_t)l * DFF * D, DFF, D, D / 32, (bf16_t*)(c.ws + WS_WDN + l * SZ_WDN), scr, r, c.lane);
    }
}
DI void phase_p0(const Ctx& c0) {
    const Ctx c = fresh(c0);
    const Args& a = *c.a;
    const int gw = c.bid * 8 + c.wave, NGW = c.G * 8;
    convert_range(c, 0, CV_IN, gw, NGW);
    bf16_t* hb = (bf16_t*)(c.ws + WS_HBUF);
    { const float* xp = inp(a, I_XP); const float* xs = inp(a, I_XS); const float* g1 = inp(a, I_LN1);
      for (int m = gw; m < MT; m += NGW) norm_row_to_bf16(m < NP ? xp + (size_t)m * D : xs + (size_t)(m - NP) * D, g1, hb + (size_t)m * D, c.lane); }
    unsigned z0 = 0u; asm volatile("" : "+v"(z0)); const u32x4 z4 = {z0, z0, z0, z0};
    for (int i = gw * 64 + c.lane; i < (MPAD - MT) * D / 8; i += NGW * 64) {
        ((u32x4*)(hb + (size_t)MT * D))[i] = z4;
        ((u32x4*)((bf16_t*)(c.ws + WS_MIXO) + (size_t)MT * D))[i] = z4;
    }
}

DI void row_phase(const Ctx& c0, const float* y, const float* slabs, const float* xa, const float* xb, float* xout, const float* g_post, const float* g_next, bf16_t* hb) {
    const Ctx c = fresh(c0);
    const int gw = c.bid * 8 + c.wave, NGW = c.G * 8, lane = c.lane;
    f32x4 v[8], vn[8];
    if (gw < NP) {
#pragma unroll
        for (int j = 0; j < 8; ++j) v[j] = ((const f32x4*)(y + (size_t)gw * D))[lane + 64 * j]; }
    for (int m = gw; m < MT; m += NGW) {
        const float* xr = m < NP ? xa + (size_t)m * D : xb + (size_t)(m - NP) * D;
        const int mn = m + NGW;
        f32x4 xx[8];
#pragma unroll
        for (int j = 0; j < 8; ++j) xx[j] = ((const f32x4*)xr)[lane + 64 * j];
        if (mn < NP) {
#pragma unroll
            for (int j = 0; j < 8; ++j) vn[j] = ((const f32x4*)(y + (size_t)mn * D))[lane + 64 * j]; }
        if (m >= NP) { const float* yr = slabs + (size_t)(m - NP) * D;
#pragma unroll
            for (int j = 0; j < 8; ++j) v[j] = ((const f32x4*)yr)[lane + 64 * j] + ((const f32x4*)(yr + (size_t)NS * D))[lane + 64 * j];
#pragma unroll 1
            for (int ks = 2; ks < 8; ks += 2) {
                f32x4 t0[8], t1[8];
#pragma unroll
                for (int j = 0; j < 8; ++j) { t0[j] = ((const f32x4*)(yr + (size_t)ks * NS * D))[lane + 64 * j]; t1[j] = ((const f32x4*)(yr + (size_t)(ks + 1) * NS * D))[lane + 64 * j]; }
#pragma unroll
                for (int j = 0; j < 8; ++j) v[j] = v[j] + t0[j] + t1[j]; }
        }
        float s = 0.f;
#pragma unroll
        for (int j = 0; j < 8; ++j) s += (v[j].x * v[j].x + v[j].y * v[j].y) + (v[j].z * v[j].z + v[j].w * v[j].w);
        const float r = rsqrtf(wave_sum_fast(s) * (1.f / D) + NORM_EPS);
        float s2 = 0.f;
#pragma unroll
        for (int j = 0; j < 8; ++j) { const f32x4 gg = ((const f32x4*)g_post)[lane + 64 * j];
            v[j] = xx[j] + v[j] * r * gg; s2 += (v[j].x * v[j].x + v[j].y * v[j].y) + (v[j].z * v[j].z + v[j].w * v[j].w);
            ((f32x4*)(xout + (size_t)m * D))[lane + 64 * j] = v[j]; }
        if (g_next) {
            const float r2 = rsqrtf(wave_sum_fast(s2) * (1.f / D) + NORM_EPS);
#pragma unroll
            for (int j = 0; j < 8; ++j) { const f32x4 gg = ((const f32x4*)g_next)[lane + 64 * j]; u32x2 w; w.x = pk2(v[j].x * r2 * gg.x, v[j].y * r2 * gg.y); w.y = pk2(v[j].z * r2 * gg.z, v[j].w * r2 * gg.w);
                ((u32x2*)(hb + (size_t)m * D))[lane + 64 * j] = w; }
        }
#pragma unroll
        for (int j = 0; j < 8; ++j) v[j] = vn[j];
    }
}

DI void sample_pieces(const Ctx& c0, const bf16_t* A  , const bf16_t* Bt  , int K, float* slabs) {
    const Ctx c = fresh(c0); const int tid = c.tid, lane = c.lane, wave = c.wave, i = lane & 15, g = lane >> 4;
    constexpr int KC = 256, PPR = KC / 8, NJ = 192 * PPR / 512, RS = KC * 2 + 16;
    const int klen = K / 8;
    for (int p = c.bid; p < 256; p += c.G) {
        const int jt = p & 31, ks = p >> 5;
        f32x4 acc[4];
#pragma unroll
        for (int q = 0; q < 4; ++q) acc[q] = (f32x4){0.f, 0.f, 0.f, 0.f};
#pragma unroll 1
        for (int kc = 0; kc < klen; kc += KC) {
            const int k0 = ks * klen + kc;
            u32x4 v[NJ];
#pragma unroll
            for (int j = 0; j < NJ; ++j) { const int pc = tid + 512 * j; const int row = pc / PPR, col = pc - row * PPR;
                const bf16_t* src = (row < 128 ? A + (size_t)row * K : Bt + (size_t)(64 * jt + row - 128) * K) + k0 + 8 * col;
                v[j] = *(const u32x4*)src; }
            __syncthreads();
#pragma unroll
            for (int j = 0; j < NJ; ++j) { const int pc = tid + 512 * j; const int row = pc / PPR, col = pc - row * PPR;
                *(LAS u32x4*)(c.lds + row * RS + col * 16) = v[j]; }
            __syncthreads();
            const int nk = (klen - kc) >= KC ? KC / 32 : (klen - kc) / 32;
#pragma unroll 2
            for (int kk = 0; kk < nk; ++kk) {
                const bf16x8 av = *(const LAS bf16x8*)(c.lds + (16 * wave + i) * RS + (32 * kk + 8 * g) * 2);
#pragma unroll
                for (int q = 0; q < 4; ++q) acc[q] = MFMA16(av, *(const LAS bf16x8*)(c.lds + (128 + 16 * q + i) * RS + (32 * kk + 8 * g) * 2), acc[q]);
            }
        }
        float* so = slabs + (size_t)ks * NS * D + (size_t)(16 * wave + 4 * g) * D + 64 * jt + i;
#pragma unroll
        for (int q = 0; q < 4; ++q)
#pragma unroll
            for (int r = 0; r < 4; ++r) so[(size_t)r * D + 16 * q] = acc[q][r];
    }
    __syncthreads();
}

DI int perm32(int x) { return 8 * ((x >> 2) & 3) + 4 * (x >> 4) + (x & 3); }
DI int kpos(int k) { return (k & ~31) + perm32(k & 31); }
DI float lb_of(const Args& a, int l, int c) { if (l == 0) return 0.f; const float l0 = inp(a, I_LB)[c], l1 = inp(a, I_LB)[512 + c]; return 1.f / (1.f + __expf(l0 - l1)); }
DI bf16_t bf1(float x) { return (bf16_t)(pk2(x, 0.f) & 0xffffu); }

constexpr size_t IB_W = WS_MIXF, IB_Q = IB_W + 16 * MiB, IB_KT = IB_Q + 16 * MiB, IB_P = IB_KT + 16 * MiB, IB_U0 = IB_P + 8 * MiB,
                 IA_Q = IB_U0 + 32 * MiB, IA_KT = IA_Q + 8 * MiB, IA_P = IA_KT + 8 * MiB, IA_V = IA_P + 4 * MiB,
                 IC_A = IA_V + 16 * MiB, IC_B = IC_A + 16 * MiB, IMISC = IC_B + 16 * MiB, IB_DEC = IMISC, IA_DEC = IMISC + 65536, IC_TOT = IMISC + 524288, I_END = IMISC + 1 * MiB;
static_assert(I_END <= WS_END, "mixer intermediates must fit");
constexpr size_t IG_B = WS_HBUF, IG_A = WS_HBUF + 16 * MiB;
static_assert(IG_A + 8 * MiB <= WS_HBUF + SZ_HBUF, "gate buffers");
constexpr size_t WS_SLAB = WS_X1 + SZ_MIXF;
static_assert(WS_SLAB + 8 * MiB <= WS_END, "slabs");

DI void m1_unit_b(const Ctx& c0, int l, int u) {
    const Ctx c = fresh(c0); const Args& a = *c.a; const int tid = c.tid, lane = c.lane, wave = c.wave;
    const int b = u >> 8, h = (u >> 5) & 7, ci = u & 31;
    LAS float* Kf = (LAS float*)c.lds;
    LAS float* Vf = Kf + 8192;
    LAS float* Qf = Vf + 8192;
    LAS float* Amat = Qf;
    LAS bf16_t* Pl = (LAS bf16_t*)(Qf + 64 * 68);
    LAS bf16_t* Qb = (LAS bf16_t*)(Qf + 8192);
    LAS bf16_t* Kb = Qb + 64 * 136;
    LAS float* scal = (LAS float*)(Kb + 64 * 136);
    const float* proj = (const float*)(c.ws + WS_PROJ);
    const long rowb = (long)b * SEQ + 64 * ci; const int tg0 = 64 * ci;
    SEG_T0(10)
    {
        const float* cw = inp(a, I_BCW) + (size_t)l * 4 * 3072;
        const int idx = tid & 127, tq = tid >> 7;
        float x[3][19], w[3][4], gz[16];
#pragma unroll
        for (int i = 0; i < 16; ++i) gz[i] = proj[(rowb + 16 * tq + i) * NINP + C_BZ + h * 128 + idx];
        const float nwt = inp(a, I_BNORM)[l * 128 + idx];
#pragma unroll
        for (int p = 0; p < 3; ++p) { const int ch = p * 1024 + h * 128 + idx;
#pragma unroll
            for (int j = 0; j < 4; ++j) w[p][j] = cw[j * 3072 + ch];
#pragma unroll
            for (int j = 0; j < 19; ++j) { const int t = 16 * tq - 3 + j; x[p][j] = (tg0 + t >= 0) ? proj[(rowb + t) * NINP + C_BQ + ch] : 0.f; } }
#pragma unroll
        for (int p = 0; p < 3; ++p) { LAS float* dst = (p == 0 ? Qf : (p == 1 ? Kf : Vf)) + idx;
#pragma unroll
            for (int i = 0; i < 16; ++i) dst[(16 * tq + i) * 128] = silu(w[p][0] * x[p][i] + w[p][1] * x[p][i + 1] + w[p][2] * x[p][i + 2] + w[p][3] * x[p][i + 3]); }
        bf16_t* gg = (bf16_t*)(c.ws + IG_B) + ((size_t)u * 64 + 16 * tq) * 128 + idx;
#pragma unroll
        for (int i = 0; i < 16; ++i) gg[i * 128] = bf1(silu(gz[i]) * nwt);
    }
    SEG_T1(10)
    __syncthreads();
    SEG_T0(11)
    for (int i = 0; i < 8; ++i) { const int t = wave * 8 + i; const float q0 = Qf[t * 128 + lane], q1 = Qf[t * 128 + 64 + lane], k0 = Kf[t * 128 + lane], k1 = Kf[t * 128 + 64 + lane];
        const float sq = wave_sum_fast(q0 * q0 + q1 * q1), sk = wave_sum_fast(k0 * k0 + k1 * k1);
        if (lane == 0) { scal[t * 8 + 3] = rsqrtf(sq + L2_EPS) * 0.08838834764831845f; scal[t * 8 + 4] = rsqrtf(sk + L2_EPS); } }
    if (wave == 0) { const int t = lane; const float bb = proj[(rowb + t) * NINP + C_BB + h], ba = proj[(rowb + t) * NINP + C_BA + h];
        const float gt = -__expf(inp(a, I_BALOG)[l * 8 + h]) * softplus(ba + inp(a, I_BDT)[l * 8 + h]);
        float x = gt;
#pragma unroll
        for (int o = 1; o < 64; o <<= 1) { const float y = __shfl_up(x, o); if (lane >= o) x += y; }
        const float bC = __shfl(x, 63);
        scal[t * 8 + 0] = sigm(bb); scal[t * 8 + 1] = x; scal[t * 8 + 2] = __expf(x); scal[t * 8 + 5] = __expf(bC - x);
        if (lane == 63) ((float*)(c.ws + IB_DEC))[u] = __expf(x); }
    SEG_T1(11)
    __syncthreads();
    SEG_T0(12)
    {
        const int t = tid >> 3, d0 = (tid & 7) * 16; const float sq = scal[t * 8 + 3], sk = scal[t * 8 + 4], s2 = sq * scal[t * 8 + 2];
        bf16_t* gq = (bf16_t*)(c.ws + IB_Q) + ((size_t)u * 64 + t) * 128;
#pragma unroll
        for (int m = 0; m < 4; ++m) { const int d = d0 + 4 * m; const f32x4 q = *(const LAS f32x4*)(Qf + t * 128 + d), k = *(const LAS f32x4*)(Kf + t * 128 + d);
            *(LAS u32x2*)(Qb + t * 136 + d) = (u32x2){pk2(q.x * sq, q.y * sq), pk2(q.z * sq, q.w * sq)};
            *(LAS u32x2*)(Kb + t * 136 + d) = (u32x2){pk2(k.x * sk, k.y * sk), pk2(k.z * sk, k.w * sk)};
            *(u32x2*)(gq + kpos(d)) = (u32x2){pk2(q.x * s2, q.y * s2), pk2(q.z * s2, q.w * s2)}; }
    }
    SEG_T1(12)
    __syncthreads();
    SEG_T0(13)
    {
        const int i = lane & 15, g = lane >> 4;
#pragma unroll
        for (int q2 = 0; q2 < 2; ++q2) { const int idx = 2 * wave + q2, tt = idx >> 2, st = idx & 3; const int s = 16 * st + i;
            if (st <= tt) {
                f32x4 akk = {0.f, 0.f, 0.f, 0.f}, aqk = {0.f, 0.f, 0.f, 0.f};
#pragma unroll
                for (int ks = 0; ks < 4; ++ks) { const bf16x8 bk = *(const LAS bf16x8*)(Kb + (16 * st + i) * 136 + 32 * ks + 8 * g);
                    const bf16x8 ak = *(const LAS bf16x8*)(Kb + (16 * tt + i) * 136 + 32 * ks + 8 * g), aq = *(const LAS bf16x8*)(Qb + (16 * tt + i) * 136 + 32 * ks + 8 * g);
                    akk = MFMA16(ak, bk, akk); aqk = MFMA16(aq, bk, aqk); }
                const float bs = scal[s * 8 + 1];
#pragma unroll
                for (int r = 0; r < 4; ++r) { const int t = 16 * tt + 4 * g + r; const float gam = __expf(fminf(scal[t * 8 + 1] - bs, 0.f));
                    Amat[t * 68 + s] = (s < t) ? scal[t * 8 + 0] * akk[r] * gam : 0.f;
                    Pl[t * 72 + kpos(s)] = bf1((s <= t) ? aqk[r] * gam : 0.f); }
            } else {
#pragma unroll
                for (int r = 0; r < 4; ++r) Pl[(16 * tt + 4 * g + r) * 72 + kpos(s)] = 0;
            }
        }
    }
    SEG_T1(13)
    __syncthreads();
    SEG_T0(14)
    LAS float* Tm = scal + 512;
    LAS bf16_t* KTs = Qb;
    LAS bf16_t* Wst = Qb + 128 * 72;
    {
#pragma unroll
        for (int k = 0; k < 1; ++k) { const int p = tid, row = p >> 3, c16 = p & 7;
            *(u32x4*)((bf16_t*)(c.ws + IB_P) + (size_t)u * 4096 + row * 64 + c16 * 8) = *(const LAS u32x4*)(Pl + row * 72 + c16 * 8); }
        const int d = tid & 127, s0 = (tid >> 7) * 16;
#pragma unroll
        for (int m = 0; m < 4; ++m) { float v[4];
#pragma unroll
            for (int j = 0; j < 4; ++j) { const int s_ = s0 + 4 * m + j; v[j] = Kf[s_ * 128 + d] * scal[s_ * 8 + 4] * scal[s_ * 8 + 5]; }
            *(LAS u32x2*)(KTs + d * 72 + kpos(s0 + 4 * m)) = (u32x2){pk2(v[0], v[1]), pk2(v[2], v[3])}; }
        if (wave < 4 && lane < 16) {
            const LAS float* Ab = Amat + (16 * wave) * 68 + 16 * wave; float xk[16];
#pragma unroll
            for (int r = 0; r < 16; ++r) { float acc = (r == lane) ? 1.f : 0.f;
#pragma unroll
                for (int q = 0; q < r; ++q) acc -= Ab[r * 68 + q] * xk[q];
                xk[r] = acc; Tm[(wave * 16 + r) * 20 + lane] = acc; }
        }
    }
    __syncthreads();
    {
        const int i = lane & 15, g = lane >> 4;
#pragma unroll
        for (int q2 = 0; q2 < 2; ++q2) { const int ct = 2 * wave + q2;
            f32x4 X[4];
#pragma unroll
            for (int I = 0; I < 4; ++I) {
                f32x4 acc;
#pragma unroll
                for (int r = 0; r < 4; ++r) { const int t = 16 * I + 4 * g + r;
                    acc[r] = (ct < 8) ? scal[t * 8 + 0] * Vf[t * 128 + 16 * ct + i] : scal[t * 8 + 0] * scal[t * 8 + 2] * scal[t * 8 + 4] * Kf[t * 128 + 16 * (ct - 8) + i]; }
#pragma unroll
                for (int J = 0; J < I; ++J) { const f32x4 a4 = *(const LAS f32x4*)(Amat + (16 * I + i) * 68 + 16 * J + 4 * g);
#pragma unroll
                    for (int kk = 0; kk < 4; ++kk) acc = __builtin_amdgcn_mfma_f32_16x16x4f32(-a4[kk], X[J][kk], acc, 0, 0, 0); }
                const f32x4 t4 = *(const LAS f32x4*)(Tm + (16 * I + i) * 20 + 4 * g);
                f32x4 xi = {0.f, 0.f, 0.f, 0.f};
#pragma unroll
                for (int kk = 0; kk < 4; ++kk) xi = __builtin_amdgcn_mfma_f32_16x16x4f32(t4[kk], acc[kk], xi, 0, 0, 0);
                X[I] = xi;
            }
            if (ct < 8) { float* g0 = (float*)(c.ws + IB_U0) + (size_t)u * 8192;
#pragma unroll
                for (int I = 0; I < 4; ++I) *(f32x4*)(g0 + ((I * 8 + ct) * 64 + lane) * 4) = X[I];
            } else { const int dp = kpos(16 * (ct - 8) + i);
#pragma unroll
                for (int I = 0; I < 4; ++I)
#pragma unroll
                    for (int r = 0; r < 4; ++r) Wst[(16 * I + 4 * g + r) * 128 + dp] = bf1(X[I][r]); }
        }
    }
    SEG_T1(14)
    __syncthreads();
    SEG_T0(15)
#pragma unroll
    for (int k = 0; k < 2; ++k) { const int p = tid + 512 * k, row = p >> 3, c16 = p & 7;
        *(u32x4*)((bf16_t*)(c.ws + IB_KT) + (size_t)u * 8192 + row * 64 + c16 * 8) = *(const LAS u32x4*)(KTs + row * 72 + c16 * 8);
        *(u32x4*)((bf16_t*)(c.ws + IB_W) + (size_t)u * 8192 + p * 8) = *(const LAS u32x4*)(Wst + p * 8); }
    SEG_T1(15)
    __syncthreads();
}

DI void m1_unit_a(const Ctx& c0, int l, int u) {
    const Ctx c = fresh(c0); const Args& a = *c.a; const int tid = c.tid, lane = c.lane, wave = c.wave;
    const int b = u >> 7, h = (u >> 5) & 3, ci = u & 31;
    LAS float* Bf = (LAS float*)c.lds;
    LAS float* Qf = Bf + 8192;
    LAS float* Kf = Qf + 8192;
    LAS bf16_t* Pl = (LAS bf16_t*)Qf;
    LAS bf16_t* Qh = (LAS bf16_t*)(Kf + 8192);
    LAS bf16_t* Kd = Qh + 64 * 136;
    LAS bf16_t* Ko = Kd + 64 * 136;
    LAS float* tot = (LAS float*)(Ko + 32 * 136);
    const float* proj = (const float*)(c.ws + WS_PROJ);
    const long rowb = (long)b * SEQ + 64 * ci;
    {
        float* gv = (float*)(c.ws + IA_V) + (size_t)u * 8192;
        const int idx = tid & 127, tq = tid >> 7;
        float x[4][16];
#pragma unroll
        for (int i = 0; i < 16; ++i) { const float* pr = proj + (rowb + 16 * tq + i) * NINP + h * 128 + idx; x[0][i] = pr[C_AF]; x[1][i] = pr[C_AQ]; x[2][i] = pr[C_AI]; x[3][i] = pr[C_AG]; }
        const float nwt = inp(a, I_ANORM)[l * 128 + idx]; bf16_t* gg = (bf16_t*)(c.ws + IG_A) + ((size_t)u * 64 + 16 * tq) * 128 + idx;
        const float lb = lb_of(a, l, h * 128 + idx);
#pragma unroll
        for (int i = 0; i < 16; ++i) { const int t = 16 * tq + i; const float f = lb + (1.f - lb) * sigm(x[0][i]);
            Bf[t * 128 + idx] = fmaxf(__logf(f), -80.f); Kf[t * 128 + idx] = 1.f - f; Qf[t * 128 + idx] = silu(x[1][i]);
            gv[(((t >> 4) * 8 + (idx >> 4)) * 64 + (idx & 15) + 16 * ((t >> 2) & 3)) * 4 + (t & 3)] = x[2][i];
            gg[i * 128] = bf1(silu(x[3][i]) * nwt); }
    }
    __syncthreads();
    {
        const int d = tid & 127, q4 = tid >> 7; float run = 0.f;
#pragma unroll
        for (int i = 0; i < 16; ++i) { run += Bf[(16 * q4 + i) * 128 + d]; Bf[(16 * q4 + i) * 128 + d] = run; }
        tot[q4 * 128 + d] = run;
        __syncthreads();
        float off = 0.f;
        for (int q = 0; q < q4; ++q) off += tot[q * 128 + d];
        if (q4 > 0) {
#pragma unroll
            for (int i = 0; i < 16; ++i) Bf[(16 * q4 + i) * 128 + d] += off; }
    }
    __syncthreads();
    {
        const int t = tid >> 3, d0 = (tid & 7) * 16; bf16_t* gq = (bf16_t*)(c.ws + IA_Q) + ((size_t)u * 64 + t) * 128;
#pragma unroll
        for (int m = 0; m < 4; ++m) { const int d = d0 + 4 * m; const f32x4 bb = *(const LAS f32x4*)(Bf + t * 128 + d), q = *(const LAS f32x4*)(Qf + t * 128 + d), k = *(const LAS f32x4*)(Kf + t * 128 + d);
            const f32x4 b31 = *(const LAS f32x4*)(Bf + 31 * 128 + d); const f32x4 rr = b31 * ((t >= 32) ? 1.f : 0.f);
            *(u32x2*)(gq + kpos(d)) = (u32x2){pk2(q.x * __expf(bb.x), q.y * __expf(bb.y)), pk2(q.z * __expf(bb.z), q.w * __expf(bb.w))};
            *(LAS u32x2*)(Qh + t * 136 + d) = (u32x2){pk2(q.x * __expf(bb.x - rr.x), q.y * __expf(bb.y - rr.y)), pk2(q.z * __expf(bb.z - rr.z), q.w * __expf(bb.w - rr.w))};
            *(LAS u32x2*)(Kd + t * 136 + d) = (u32x2){pk2(k.x * __expf(fminf(rr.x - bb.x, 80.f)), k.y * __expf(fminf(rr.y - bb.y, 80.f))), pk2(k.z * __expf(fminf(rr.z - bb.z, 80.f)), k.w * __expf(fminf(rr.w - bb.w, 80.f)))};
            if (t < 32) *(LAS u32x2*)(Ko + t * 136 + d) = (u32x2){pk2(k.x * __expf(b31.x - bb.x), k.y * __expf(b31.y - bb.y)), pk2(k.z * __expf(b31.z - bb.z), k.w * __expf(b31.w - bb.w))}; }
        const int d = tid & 127, s0 = (tid >> 7) * 16; bf16_t* gk = (bf16_t*)(c.ws + IA_KT) + ((size_t)u * 128 + d) * 64; const float bC = Bf[63 * 128 + d];
#pragma unroll
        for (int m = 0; m < 4; ++m) { float v[4];
#pragma unroll
            for (int j = 0; j < 4; ++j) { const int s = s0 + 4 * m + j; v[j] = Kf[s * 128 + d] * __expf(bC - Bf[s * 128 + d]); }
            *(u32x2*)(gk + kpos(s0 + 4 * m)) = (u32x2){pk2(v[0], v[1]), pk2(v[2], v[3])}; }
        if (tid < 128) ((float*)(c.ws + IA_DEC))[(size_t)u * 128 + tid] = __expf(bC);
    }
    __syncthreads();
    {
        const int i = lane & 15, g = lane >> 4;
#pragma unroll
        for (int q2 = 0; q2 < 2; ++q2) { const int idx = 2 * wave + q2, tt = idx >> 2, st = idx & 3, I = tt >> 1, J = st >> 1; const int s = 16 * st + i;
            if (J <= I) {
                const LAS bf16_t* bsrc = (I == J ? Kd : Ko) + (16 * st + i) * 136;
                f32x4 acc = {0.f, 0.f, 0.f, 0.f};
#pragma unroll
                for (int ks = 0; ks < 4; ++ks) acc = MFMA16(*(const LAS bf16x8*)(Qh + (16 * tt + i) * 136 + 32 * ks + 8 * g), *(const LAS bf16x8*)(bsrc + 32 * ks + 8 * g), acc);
#pragma unroll
                for (int r = 0; r < 4; ++r) { const int t = 16 * tt + 4 * g + r; Pl[t * 72 + kpos(s)] = bf1((s <= t) ? acc[r] : 0.f); }
            } else {
#pragma unroll
                for (int r = 0; r < 4; ++r) Pl[(16 * tt + 4 * g + r) * 72 + kpos(s)] = 0;
            }
        }
    }
    __syncthreads();
    { const int row = tid >> 3, c16 = tid & 7; *(u32x4*)((bf16_t*)(c.ws + IA_P) + (size_t)u * 4096 + row * 64 + c16 * 8) = *(const LAS u32x4*)(Pl + row * 72 + c16 * 8); }
    __syncthreads();
}

DI void m1_unit_c(const Ctx& c0, int l, int u) {
    const Ctx c = fresh(c0); const Args& a = *c.a; const int tid = c.tid, lane = c.lane, wave = c.wave;
    const int b = u >> 7, n = (u >> 4) & 7, ti = u & 15;
    constexpr int TT = 128;
    LAS float* xcv = (LAS float*)c.lds;
    LAS float* ra = xcv + TT * 64;
    LAS float* ia = ra + TT * 64;
    LAS float* segA = ia + TT * 64;
    LAS float* segB = segA + 512;
    LAS bf16_t* xb = (LAS bf16_t*)(segB + 512);
    LAS bf16_t* Wt = xb + TT * 72;
    const float* proj = (const float*)(c.ws + WS_PROJ);
    const long rowb = (long)b * SEQ + TT * ti; const int tg0 = TT * ti;
    const int cch = tid & 63, seg = tid >> 6, chg = n * 64 + cch;
    {
        const float* wa = inp(a, I_CWA) + ((size_t)l * 8 + n) * 4096; const float* wx = inp(a, I_CWX) + ((size_t)l * 8 + n) * 4096;
        float wv[16];
#pragma unroll
        for (int k = 0; k < 16; ++k) { const int e = tid + 512 * k; wv[k] = (e < 4096 ? wa : wx)[e & 4095]; }
        const float* ccw = inp(a, I_CCW) + (size_t)l * 4 * 512;
        const float w0 = ccw[chg], w1 = ccw[512 + chg], w2 = ccw[1024 + chg], w3 = ccw[1536 + chg], cb = inp(a, I_CCB)[l * 512 + chg];
        const int ts = seg * 16; const int col = C_CX + chg;
        float x[19];
#pragma unroll
        for (int jx = 0; jx < 19; ++jx) { const int t = ts - 3 + jx; x[jx] = (tg0 + t >= 0) ? proj[(rowb + t) * NINP + col] : 0.f; }
#pragma unroll
        for (int k = 0; k < 16; ++k) { const int e = tid + 512 * k, gate = e >> 12, i = (e >> 6) & 63, j = e & 63; Wt[(gate * 64 + j) * 72 + i] = bf1(wv[k]); }
#pragma unroll
        for (int i = 0; i < 16; ++i) { const float y = w0 * x[i] + w1 * x[i + 1] + w2 * x[i + 2] + w3 * x[i + 3] + cb; xcv[(ts + i) * 64 + cch] = y; xb[(ts + i) * 72 + cch] = bf1(y); }
    }
    __syncthreads();
    {
        const int i = lane & 15, g = lane >> 4;
        const bf16x8 a0 = *(const LAS bf16x8*)(xb + (16 * wave + i) * 72 + 8 * g), a1 = *(const LAS bf16x8*)(xb + (16 * wave + i) * 72 + 32 + 8 * g);
        const float* bsa = inp(a, I_CBA) + l * 512 + n * 64; const float* bsx = inp(a, I_CBX) + l * 512 + n * 64;
#pragma unroll
        for (int jt = 0; jt < 8; ++jt) { f32x4 acc = {0.f, 0.f, 0.f, 0.f};
            acc = MFMA16(a0, *(const LAS bf16x8*)(Wt + (16 * jt + i) * 72 + 8 * g), acc);
            acc = MFMA16(a1, *(const LAS bf16x8*)(Wt + (16 * jt + i) * 72 + 32 + 8 * g), acc);
            const int jc = 16 * (jt & 3) + i; const float bias = (jt < 4 ? bsa : bsx)[jc]; LAS float* dst = (jt < 4 ? ra : ia);
#pragma unroll
            for (int r = 0; r < 4; ++r) dst[(16 * wave + 4 * g + r) * 64 + jc] = sigm(acc[r] + bias); }
    }
    __syncthreads();
    const float spl = softplus(-inp(a, I_CLAM)[l * 512 + chg]);
    {
        float A = 1.f, B = 0.f;
        for (int i = 0; i < 16; ++i) { const int tt = seg * 16 + i; const float r = ra[tt * 64 + cch], ig = ia[tt * 64 + cch], x = xcv[tt * 64 + cch];
            const float la = -8.f * r * spl; const float at = __expf(la); float mult = sqrtf(fmaxf(0.f, -expm1f(2.f * la)));
            if (tg0 + tt == 0) mult = 1.f;
            const float bt = mult * (ig * x); ra[tt * 64 + cch] = at; ia[tt * 64 + cch] = bt; A *= at; B = at * B + bt; }
        segA[seg * 64 + cch] = A; segB[seg * 64 + cch] = B;
    }
    __syncthreads();
    {
        float Ac = 1.f, Bc = 0.f;
        for (int s = 0; s < seg; ++s) { const float sa = segA[s * 64 + cch], sb = segB[s * 64 + cch]; Bc = sa * Bc + sb; Ac *= sa; }
        float* ga = (float*)(c.ws + IC_A); float* gb = (float*)(c.ws + IC_B);
        for (int i = 0; i < 16; ++i) { const int tt = seg * 16 + i; const float at = ra[tt * 64 + cch], bt = ia[tt * 64 + cch]; Ac *= at; Bc = at * Bc + bt;
            ga[(rowb + tt) * 512 + chg] = Ac; gb[(rowb + tt) * 512 + chg] = Bc; }
        if (seg == 7) { float* gt = (float*)(c.ws + IC_TOT) + (((size_t)b * 16 + ti) * 2) * 512; gt[chg] = Ac; gt[512 + chg] = Bc; }
    }
    __syncthreads();
}

DI void phase_m1(const Ctx& c, int l) {
    int w = blockIdx.x; asm volatile("" : "+s"(w));
    for (int rep = 0; rep < (PROBE_SUB == 1 ? 2 : 1); ++rep) for (int u = w; u < 1024; u += c.G) m1_unit_b(c, l, u);
    for (int rep = 0; rep < (PROBE_SUB == 2 ? 2 : 1); ++rep) for (int u = w; u < 512; u += c.G) m1_unit_a(c, l, u);
    for (int rep = 0; rep < (PROBE_SUB == 3 ? 2 : 1); ++rep) for (int u = w; u < 512; u += c.G) m1_unit_c(c, l, u);
}

DI void m2_unit_head(const Ctx& c0, int l, int isB, int b, int h) {
    const Ctx c = fresh(c0); const Args& a = *c.a; const int tid = c.tid, lane = c.lane, wave = c.wave;
    LAS unsigned char* Wl = c.lds;
    LAS unsigned char* Ql = Wl + 64 * 272;
    LAS unsigned char* KTl = Ql + 64 * 272;
    LAS unsigned char* Pl = KTl + 128 * 144;
    LAS float* ob = (LAS float*)(Pl + 64 * 144);
    LAS float* decl = ob + 64 * 132;
    const int i = lane & 15, g = lane >> 4, e0 = 16 * wave;
    const int ubase = isB ? ((b * 8 + h) * 32) : ((b * 4 + h) * 32);
    const unsigned char* gW = c.ws + IB_W; const unsigned char* gQ = c.ws + (isB ? IB_Q : IA_Q); const unsigned char* gKT = c.ws + (isB ? IB_KT : IA_KT);
    const unsigned char* gP = c.ws + (isB ? IB_P : IA_P); const float* gU = (const float*)(c.ws + (isB ? IB_U0 : IA_V));
    const float* proj = (const float*)(c.ws + WS_PROJ); bf16_t* mixo = (bf16_t*)(c.ws + WS_MIXO);
    const bf16_t* gG = (const bf16_t*)(c.ws + (isB ? IG_B : IG_A));
    const int ocol = isB ? (512 + h * 128) : (h * 128);
    f32x4 S[8];
#pragma unroll
    for (int dt = 0; dt < 8; ++dt) S[dt] = (f32x4){0.f, 0.f, 0.f, 0.f};
    u32x4 pw[2], pq[2], pk[2], pp, pd = {0u, 0u, 0u, 0u};
    const int r16 = tid >> 4, c16 = tid & 15, r8 = tid >> 3, c8 = tid & 7;
#define M2_LOAD(ch) do { const size_t uu = (size_t)(ubase + (ch)); \
        if (isB) { pw[0] = *(const u32x4*)(gW + uu * 16384 + tid * 16); pw[1] = *(const u32x4*)(gW + uu * 16384 + (tid + 512) * 16); } \
        pq[0] = *(const u32x4*)(gQ + uu * 16384 + tid * 16); pq[1] = *(const u32x4*)(gQ + uu * 16384 + (tid + 512) * 16); \
        pk[0] = *(const u32x4*)(gKT + uu * 16384 + tid * 16); pk[1] = *(const u32x4*)(gKT + uu * 16384 + (tid + 512) * 16); \
        pp = *(const u32x4*)(gP + uu * 8192 + tid * 16); \
        if (!isB && tid < 32) pd = *(const u32x4*)(c.ws + IA_DEC + uu * 512 + tid * 16); } while (0)
#define M2_STORE() do { \
        if (isB) { *(LAS u32x4*)(Wl + r16 * 272 + c16 * 16) = pw[0]; *(LAS u32x4*)(Wl + (r16 + 32) * 272 + c16 * 16) = pw[1]; } \
        *(LAS u32x4*)(Ql + r16 * 272 + c16 * 16) = pq[0]; *(LAS u32x4*)(Ql + (r16 + 32) * 272 + c16 * 16) = pq[1]; \
        *(LAS u32x4*)(KTl + r8 * 144 + c8 * 16) = pk[0]; *(LAS u32x4*)(KTl + (r8 + 64) * 144 + c8 * 16) = pk[1]; \
        *(LAS u32x4*)(Pl + r8 * 144 + c8 * 16) = pp; \
        if (!isB && tid < 32) *(LAS u32x4*)((LAS unsigned char*)decl + tid * 16) = pd; } while (0)
    M2_LOAD(0);
    M2_STORE();
    f32x4 U[4]; unsigned gt[8], gtn[8], outp[8]; float dec = 0.f, decn = 0.f;
#define M2_LOADU(ch) do { const size_t uu_ = (size_t)(ubase + (ch)); \
        _Pragma("unroll") for (int tt = 0; tt < 4; ++tt) U[tt] = *(const f32x4*)(gU + uu_ * 8192 + ((tt * 8 + wave) * 64 + lane) * 4); } while (0)
#define M2_LOADR(ch, GT, DEC) do { const size_t uu_ = (size_t)(ubase + (ch)); \
        _Pragma("unroll") for (int k = 0; k < 8; ++k) GT[k] = *(const unsigned*)(gG + (uu_ * 64 + 8 * wave + k) * 128 + 2 * lane); \
        if (isB) DEC = ((const float*)(c.ws + IB_DEC))[uu_]; } while (0)
    M2_LOADU(0);
    M2_LOADR(0, gt, dec);
    __syncthreads();
    for (int ci = 0; ci < 32; ++ci) {
        const long row0 = (long)b * SEQ + 64 * ci;
        SEG_T0(20)
        asm volatile("" : "+v"(U[0]), "+v"(U[1]), "+v"(U[2]), "+v"(U[3]), "+v"(dec));
        asm volatile("" : "+v"(gt[0]), "+v"(gt[1]), "+v"(gt[2]), "+v"(gt[3]), "+v"(gt[4]), "+v"(gt[5]), "+v"(gt[6]), "+v"(gt[7]));
        if (ci > 0) {
#pragma unroll
            for (int k = 0; k < 8; ++k) *(unsigned*)(mixo + (row0 - 64 + 8 * wave + k) * D + ocol + 2 * lane) = outp[k]; }
        if (ci + 1 < 32) { M2_LOAD(ci + 1); M2_LOADR(ci + 1, gtn, decn); }
        bf16x8 Sb[4];
#pragma unroll
        for (int ks = 0; ks < 4; ++ks) { u32x4 p; p.x = pk2(S[2 * ks][0], S[2 * ks][1]); p.y = pk2(S[2 * ks][2], S[2 * ks][3]); p.z = pk2(S[2 * ks + 1][0], S[2 * ks + 1][1]); p.w = pk2(S[2 * ks + 1][2], S[2 * ks + 1][3]); Sb[ks] = __builtin_bit_cast(bf16x8, p); }
#define M2_SCHED() __builtin_amdgcn_sched_barrier(0)
        if (isB) {
#pragma unroll
            for (int hf = 0; hf < 2; ++hf) { bf16x8 fr[8];
#pragma unroll
                for (int j = 0; j < 8; ++j) fr[j] = *(const LAS bf16x8*)(Wl + (16 * (2 * hf + (j >> 2)) + i) * 272 + (32 * (j & 3) + 8 * g) * 2);
                M2_SCHED();
                f32x4 a0 = {0.f, 0.f, 0.f, 0.f}, a1 = {0.f, 0.f, 0.f, 0.f};
#pragma unroll
                for (int ks = 0; ks < 4; ++ks) { a0 = MFMA16(fr[ks], Sb[ks], a0); a1 = MFMA16(fr[4 + ks], Sb[ks], a1); }
                U[2 * hf] = U[2 * hf] - a0; U[2 * hf + 1] = U[2 * hf + 1] - a1;
                M2_SCHED(); }
        }
        bf16x8 Ub[2];
#pragma unroll
        for (int k = 0; k < 2; ++k) { u32x4 p; p.x = pk2(U[2 * k][0], U[2 * k][1]); p.y = pk2(U[2 * k][2], U[2 * k][3]); p.z = pk2(U[2 * k + 1][0], U[2 * k + 1][1]); p.w = pk2(U[2 * k + 1][2], U[2 * k + 1][3]); Ub[k] = __builtin_bit_cast(bf16x8, p); }
        SEG_T1(20)
        SEG_T0(21)
        asm volatile("" : "+v"(Ub[0]), "+v"(Ub[1]));
        if (ci + 1 < 32) M2_LOADU(ci + 1);
#pragma unroll
        for (int hf = 0; hf < 2; ++hf) { bf16x8 fq[8], fp[4];
#pragma unroll
            for (int j = 0; j < 8; ++j) fq[j] = *(const LAS bf16x8*)(Ql + (16 * (2 * hf + (j >> 2)) + i) * 272 + (32 * (j & 3) + 8 * g) * 2);
            M2_SCHED();
            f32x4 a0 = {0.f, 0.f, 0.f, 0.f}, a1 = {0.f, 0.f, 0.f, 0.f};
#pragma unroll
            for (int ks = 0; ks < 4; ++ks) { a0 = MFMA16(fq[ks], Sb[ks], a0); a1 = MFMA16(fq[4 + ks], Sb[ks], a1); }
            M2_SCHED();
#pragma unroll
            for (int j = 0; j < 4; ++j) fp[j] = *(const LAS bf16x8*)(Pl + (16 * (2 * hf + (j >> 1)) + i) * 144 + (32 * (j & 1) + 8 * g) * 2);
            M2_SCHED();
#pragma unroll
            for (int k = 0; k < 2; ++k) { a0 = MFMA16(fp[k], Ub[k], a0); a1 = MFMA16(fp[2 + k], Ub[k], a1); }
#pragma unroll
            for (int r = 0; r < 4; ++r) { ob[(16 * (2 * hf) + 4 * g + r) * 132 + e0 + i] = a0[r]; ob[(16 * (2 * hf + 1) + 4 * g + r) * 132 + e0 + i] = a1[r]; }
            M2_SCHED(); }
        if (isB) {
#pragma unroll
            for (int dt = 0; dt < 8; ++dt) S[dt] = S[dt] * dec;
        } else {
#pragma unroll
            for (int dt = 0; dt < 8; ++dt) S[dt] = S[dt] * *(const LAS f32x4*)(decl + 16 * dt + 4 * g); }
#pragma unroll
        for (int hf = 0; hf < 2; ++hf) { bf16x8 fk[8];
#pragma unroll
            for (int j = 0; j < 8; ++j) fk[j] = *(const LAS bf16x8*)(KTl + (16 * (4 * hf + (j >> 1)) + i) * 144 + (32 * (j & 1) + 8 * g) * 2);
            M2_SCHED();
#pragma unroll
            for (int j = 0; j < 8; ++j) S[4 * hf + (j >> 1)] = MFMA16(fk[j], Ub[j & 1], S[4 * hf + (j >> 1)]);
            M2_SCHED(); }
#undef M2_SCHED
        SEG_T1(21)
        SEG_T0(22)
        __syncthreads();
        SEG_T1(22)
        SEG_T0(23)
        { f32x2 vv[8]; float ss[8];
#pragma unroll
          for (int k = 0; k < 8; ++k) vv[k] = *(const LAS f32x2*)(ob + (8 * wave + k) * 132 + 2 * lane);
#pragma unroll
          for (int k = 0; k < 8; ++k) ss[k] = row16_sum(vv[k].x * vv[k].x + vv[k].y * vv[k].y);
#pragma unroll
          for (int k = 0; k < 8; ++k) ss[k] = __int_as_float(__builtin_amdgcn_readlane(__float_as_int(ss[k]), 0)) + __int_as_float(__builtin_amdgcn_readlane(__float_as_int(ss[k]), 16)) +
              __int_as_float(__builtin_amdgcn_readlane(__float_as_int(ss[k]), 32)) + __int_as_float(__builtin_amdgcn_readlane(__float_as_int(ss[k]), 48));
#pragma unroll
          for (int k = 0; k < 8; ++k) { const float r = rsqrtf(ss[k] * (1.f / 128.f) + NORM_EPS);
            outp[k] = pk2(vv[k].x * r * __uint_as_float(gt[k] << 16), vv[k].y * r * __uint_as_float(gt[k] & 0xffff0000u)); } }
        SEG_T1(23)
        SEG_T0(24)
        if (ci + 1 < 32) { M2_STORE();
#pragma unroll
            for (int k = 0; k < 8; ++k) gt[k] = gtn[k];
            dec = decn; }
        __syncthreads();
        SEG_T1(24)
    }
#pragma unroll
    for (int k = 0; k < 8; ++k) *(unsigned*)(mixo + ((long)b * SEQ + 64 * 31 + 8 * wave + k) * D + ocol + 2 * lane) = outp[k];
#undef M2_LOADR
#undef M2_LOADU
#undef M2_LOAD
#undef M2_STORE
    float* so = c.out + (isB ? O_GDP + (((size_t)l * BATCH + b) * 8 + h) * 16384 : O_HGP + (((size_t)l * BATCH + b) * 4 + h) * 16384);
#pragma unroll
    for (int dt = 0; dt < 8; ++dt)
#pragma unroll
        for (int r = 0; r < 4; ++r) so[(size_t)(16 * dt + 4 * g + r) * 128 + e0 + i] = S[dt][r];
}

DI void m2_unit_cfin(const Ctx& c0, int l, int u) {
    const Ctx c = fresh(c0); const int tid = c.tid;
    const int b = u >> 7, n = (u >> 4) & 7, ti = u & 15;
    const int cch = tid & 63, seg = tid >> 6, chg = n * 64 + cch;
    const float* proj = (const float*)(c.ws + WS_PROJ); bf16_t* mixo = (bf16_t*)(c.ws + WS_MIXO);
    const float* ga = (const float*)(c.ws + IC_A); const float* gb = (const float*)(c.ws + IC_B);
    const float* gt = (const float*)(c.ws + IC_TOT) + ((size_t)b * 16 * 2) * 512;
    float hs = 0.f;
    { float ta[15], tb[15];
#pragma unroll
      for (int k = 0; k < 15; ++k) { ta[k] = gt[(k * 2) * 512 + chg]; tb[k] = gt[(k * 2 + 1) * 512 + chg]; }
#pragma unroll
      for (int k = 0; k < 15; ++k) if (k < ti) hs = ta[k] * hs + tb[k]; }
    const long rowb = (long)b * SEQ + 128 * ti;
    float hh = 0.f;
    { float va[16], vb[16], vg[16];
#pragma unroll
      for (int i = 0; i < 16; ++i) { const long row = rowb + seg * 16 + i; va[i] = ga[row * 512 + chg]; vb[i] = gb[row * 512 + chg]; vg[i] = proj[row * NINP + C_CG + chg]; }
#pragma unroll
      for (int i = 0; i < 16; ++i) { const long row = rowb + seg * 16 + i; hh = vb[i] + va[i] * hs; mixo[row * D + 1536 + chg] = bf1(hh * gelu_tanh(vg[i])); } }
    if (ti == 15 && seg == 7) c.out[O_RHP + ((size_t)l * BATCH + b) * 512 + chg] = hh;
}

DI void block_reduce_cols(LAS float* red, LAS float* full, const float (&p)[4], int tid, float scale) {
    const int e4 = (tid & 31) * 4, dgp = tid >> 5;
    *(LAS f32x4*)(red + dgp * 128 + e4) = (f32x4){p[0], p[1], p[2], p[3]};
    __syncthreads();
    if (tid < 128) { float s = 0.f;
#pragma unroll
        for (int k = 0; k < 16; ++k) s += red[k * 128 + tid];
        full[tid] = s * scale; }
    __syncthreads();
}
DI void unit_b_sample(const Ctx& c0, int l, int b, int h) {
    const Ctx c = fresh(c0);
    const Args& a = *c.a; const int tid = c.tid, lane = c.lane, wave = c.wave;
    LAS float* qkv = (LAS float*)c.lds;
    LAS float* scl = qkv + 384;
    LAS float* red = scl + 8;
    LAS float* full = red + 2048;
    LAS float* uu = full + 128;
    const float* proj = (const float*)(c.ws + WS_PROJ) + (size_t)(NP + b) * NINP;
    const int e4 = (tid & 31) * 4, d0 = (tid >> 5) * 8;
    const size_t sidx = (((size_t)l * NS + b) * 8 + h) * 16384;
    const float* Sin = inp(a, I_SGD) + sidx; float* Sout = c.out + O_GDS + sidx;
    f32x4 S[8];
#pragma unroll
    for (int i = 0; i < 8; ++i) S[i] = *(const f32x4*)(Sin + (size_t)(d0 + i) * 128 + e4);
    float gz = 0.f, nwt = 0.f;
    if (tid < 128) { gz = proj[C_BZ + h * 128 + tid]; nwt = inp(a, I_BNORM)[l * 128 + tid]; }
    if (tid < 384) { const int part = tid >> 7, idx = tid & 127, cc = part * 1024 + h * 128 + idx;
        const float* cw = inp(a, I_BCW) + (size_t)l * 4 * 3072; const float* st = inp(a, I_SGC) + (((size_t)l * NS + b) * 3) * 3072;
        const float x0 = st[cc], x1 = st[3072 + cc], x2 = st[2 * 3072 + cc], x3 = proj[C_BQ + cc];
        qkv[tid] = silu(cw[cc] * x0 + cw[3072 + cc] * x1 + cw[2 * 3072 + cc] * x2 + cw[3 * 3072 + cc] * x3);
        float* so = c.out + O_GCS + (((size_t)l * NS + b) * 3) * 3072; so[cc] = x1; so[3072 + cc] = x2; so[2 * 3072 + cc] = x3; }
    if (tid == 384) { const float bb = proj[C_BB + h], ba = proj[C_BA + h]; scl[0] = sigm(bb); scl[1] = __expf(-__expf(inp(a, I_BALOG)[l * 8 + h]) * softplus(ba + inp(a, I_BDT)[l * 8 + h])); }
    __syncthreads();
    if (wave < 2) { const float x0 = qkv[wave * 128 + lane], x1 = qkv[wave * 128 + 64 + lane]; const float ss = wave_sum_fast(x0 * x0 + x1 * x1);
        if (lane == 0) scl[2 + wave] = rsqrtf(ss + L2_EPS) * (wave == 0 ? 0.08838834764831845f : 1.f); }
    __syncthreads();
    const float beta = scl[0], eg = scl[1], sq = scl[2], sk = scl[3];
    float p[4] = {0.f, 0.f, 0.f, 0.f};
#pragma unroll
    for (int i = 0; i < 8; ++i) { const float k = qkv[128 + d0 + i]; p[0] += k * S[i].x; p[1] += k * S[i].y; p[2] += k * S[i].z; p[3] += k * S[i].w; }
    block_reduce_cols(red, full, p, tid, sk);
    if (tid < 128) uu[tid] = beta * (qkv[256 + tid] - eg * full[tid]) * sk;
    __syncthreads();
    const f32x4 u4 = *(const LAS f32x4*)(uu + e4);
    float po[4] = {0.f, 0.f, 0.f, 0.f};
#pragma unroll
    for (int i = 0; i < 8; ++i) { const float k = qkv[128 + d0 + i], q = qkv[d0 + i]; S[i] = S[i] * eg + u4 * k; *(f32x4*)(Sout + (size_t)(d0 + i) * 128 + e4) = S[i];
        po[0] += q * S[i].x; po[1] += q * S[i].y; po[2] += q * S[i].z; po[3] += q * S[i].w; }
    block_reduce_cols(red, full, po, tid, sq);
    if (wave < 2) { const float o = full[wave * 64 + lane]; const float ss = wave_sum_fast(o * o); if (lane == 0) scl[4 + wave] = ss; }
    __syncthreads();
    if (tid < 128) { const float rms = rsqrtf((scl[4] + scl[5]) * (1.f / 128.f) + NORM_EPS);
        const float o = full[tid] * rms * nwt * silu(gz);
        ((bf16_t*)(c.ws + WS_MIXO))[(size_t)(NP + b) * D + 512 + h * 128 + tid] = (bf16_t)(pk2(o, 0.f) & 0xffffu); }
    __syncthreads();
}
DI void unit_a_sample(const Ctx& c0, int l, int b, int h) {
    const Ctx c = fresh(c0);
    const Args& a = *c.a; const int tid = c.tid, lane = c.lane, wave = c.wave;
    LAS float* fqv = (LAS float*)c.lds;
    LAS float* scl = fqv + 384;
    LAS float* red = scl + 8;
    LAS float* full = red + 2048;
    const float* proj = (const float*)(c.ws + WS_PROJ) + (size_t)(NP + b) * NINP;
    const int e4 = (tid & 31) * 4, d0 = (tid >> 5) * 8;
    const size_t sidx = (((size_t)l * NS + b) * 4 + h) * 16384;
    const float* Sin = inp(a, I_SHG) + sidx; float* Sout = c.out + O_HGS + sidx;
    f32x4 S8[8];
#pragma unroll
    for (int i = 0; i < 8; ++i) S8[i] = *(const f32x4*)(Sin + (size_t)(d0 + i) * 128 + e4);
    float gz = 0.f, nwt = 0.f;
    if (tid < 128) { gz = proj[C_AG + h * 128 + tid]; nwt = inp(a, I_ANORM)[l * 128 + tid]; }
    if (tid < 384) { const int part = tid >> 7, idx = tid & 127;
        if (part == 0) { const float lb = lb_of(a, l, h * 128 + idx); fqv[tid] = lb + (1.f - lb) * sigm(proj[C_AF + h * 128 + idx]); }
        else if (part == 1) fqv[tid] = silu(proj[C_AQ + h * 128 + idx]);
        else fqv[tid] = proj[C_AI + h * 128 + idx]; }
    __syncthreads();
    const f32x4 v4 = *(const LAS f32x4*)(fqv + 256 + e4);
    float po[4] = {0.f, 0.f, 0.f, 0.f};
#pragma unroll
    for (int i = 0; i < 8; ++i) { const float f = fqv[d0 + i], q = fqv[128 + d0 + i]; f32x4 S = S8[i];
        S = S * f + v4 * (1.f - f); *(f32x4*)(Sout + (size_t)(d0 + i) * 128 + e4) = S;
        po[0] += q * S.x; po[1] += q * S.y; po[2] += q * S.z; po[3] += q * S.w; }
    block_reduce_cols(red, full, po, tid, 1.f);
    if (wave < 2) { const float o = full[wave * 64 + lane]; const float ss = wave_sum_fast(o * o); if (lane == 0) scl[4 + wave] = ss; }
    __syncthreads();
    if (tid < 128) { const float rms = rsqrtf((scl[4] + scl[5]) * (1.f / 128.f) + NORM_EPS);
        const float o = full[tid] * rms * nwt * silu(gz);
        ((bf16_t*)(c.ws + WS_MIXO))[(size_t)(NP + b) * D + h * 128 + tid] = (bf16_t)(pk2(o, 0.f) & 0xffffu); }
    __syncthreads();
}
DI void unit_c_sample(const Ctx& c0, int l, int b) {
    const Ctx c = fresh(c0);
    const Args& a = *c.a; const int tid = c.tid;
    LAS float* xc = (LAS float*)c.lds;
    const float* proj = (const float*)(c.ws + WS_PROJ) + (size_t)(NP + b) * NINP;
    const float* ccw = inp(a, I_CCW) + (size_t)l * 4 * 512; const float* st = inp(a, I_SRC) + (((size_t)l * NS + b) * 3) * 512;
    const float x0 = st[tid], x1 = st[512 + tid], x2 = st[1024 + tid], x3 = proj[C_CX + tid];
    const float xv = ccw[tid] * x0 + ccw[512 + tid] * x1 + ccw[1024 + tid] * x2 + ccw[1536 + tid] * x3 + inp(a, I_CCB)[l * 512 + tid];
    xc[tid] = xv;
    { float* so = c.out + O_RCS + (((size_t)l * NS + b) * 3) * 512; so[tid] = x1; so[512 + tid] = x2; so[1024 + tid] = x3; }
    __syncthreads();
    const int n = tid >> 6, j = tid & 63;
    const float* wa = inp(a, I_CWA) + ((size_t)l * 8 + n) * 4096 + j; const float* wx = inp(a, I_CWX) + ((size_t)l * 8 + n) * 4096 + j;
    float sa = 0.f, sx = 0.f;
#pragma unroll 8
    for (int i = 0; i < 64; ++i) { const float x = xc[n * 64 + i]; sa += x * wa[i * 64]; sx += x * wx[i * 64]; }
    const float r = sigm(sa + inp(a, I_CBA)[l * 512 + tid]), ig = sigm(sx + inp(a, I_CBX)[l * 512 + tid]);
    const float la = -8.f * r * softplus(-inp(a, I_CLAM)[l * 512 + tid]); const float at = __expf(la); const float mult = sqrtf(fmaxf(0.f, -expm1f(2.f * la)));
    const float h0 = inp(a, I_SRH)[((size_t)l * NS + b) * 512 + tid];
    const float hh = at * h0 + mult * (ig * xv);
    c.out[O_RHS + ((size_t)l * NS + b) * 512 + tid] = hh;
    ((bf16_t*)(c.ws + WS_MIXO))[(size_t)(NP + b) * D + 1536 + tid] = (bf16_t)(pk2(hh * gelu_tanh(proj[C_CG + tid]), 0.f) & 0xffffu);
    __syncthreads();
}


DI void phase_m2(const Ctx& c, int l) {
    int w = blockIdx.x; asm volatile("" : "+s"(w));
    if (w < 48) {
        const int isB = w < 32; const int u = isB ? w : w - 32;
        for (int rep = 0; rep < (PROBE_SUB == 4 ? 2 : 1); ++rep) m2_unit_head(c, l, isB, isB ? (u >> 3) : (u >> 2), isB ? (u & 7) : (u & 3));
    } else {
        const int nw = c.G - 48;
        for (int rep = 0; rep < (PROBE_SUB == 5 ? 2 : 1); ++rep)
        for (int u = w - 48; u < 512 + 1664; u += nw) {
            if (u < 512) m2_unit_cfin(c, l, u);
            else { const int v = u - 512;
                if (v < 1024) unit_b_sample(c, l, v >> 3, v & 7);
                else if (v < 1536) { const int x = v - 1024; unit_a_sample(c, l, x >> 2, x & 3); }
                else unit_c_sample(c, l, v - 1536); }
        }
        { const Ctx cv = fresh(c); __syncthreads();
          convert_range(cv, l == 0 ? CV_IN : CV_LAYER + CV_IN, l == 0 ? CV_LAYER + CV_IN : 2 * CV_LAYER, (w - 48) * 8 + cv.wave, nw * 8); }
        const Ctx cc = fresh(c); const float* proj = (const float*)(cc.ws + WS_PROJ);
        const int gt_ = (w - 48) * 512 + cc.tid, NT = nw * 512;
        for (int i = gt_; i < BATCH * 3 * 3072; i += NT) { const int b = i / (3 * 3072), r = i - b * 3 * 3072, j = r / 3072, ch = r - j * 3072;
            cc.out[O_GCP + (size_t)l * BATCH * 3 * 3072 + i] = proj[((size_t)b * SEQ + SEQ - 3 + j) * NINP + C_BQ + ch]; }
        for (int i = gt_; i < BATCH * 3 * 512; i += NT) { const int b = i / (3 * 512), r = i - b * 3 * 512, j = r / 512, ch = r - j * 512;
            cc.out[O_RCP + (size_t)l * BATCH * 3 * 512 + i] = proj[((size_t)b * SEQ + SEQ - 3 + j) * NINP + C_CX + ch]; }
    }
}


#define XB_TMO      128
#define XB_XCNT(j)  (256  + 64 * (j))
#define XB_XSUB(j)  (1280 + 64 * (j))
#define XB_XGEN(j)  (2304 + 64 * (j))
#define XB_TOP      3328
#define XB_TOPGEN   3392
#define XCD_BAR_WORDS 3456
#define XB_SPIN_CAP (1u << 20)
DI unsigned xb_ld(unsigned* p)              { return __hip_atomic_load(p, __ATOMIC_RELAXED, __HIP_MEMORY_SCOPE_AGENT); }
DI unsigned xb_add(unsigned* p, unsigned v) { return __hip_atomic_fetch_add(p, v, __ATOMIC_RELAXED, __HIP_MEMORY_SCOPE_AGENT); }
DI unsigned xb_xcc_id() { return (unsigned)__builtin_amdgcn_s_getreg((3 << 11) | 20) & 0xFu; }
#define XB_SPIN(cond, bar) do { unsigned _sp = 0; while (cond) { __builtin_amdgcn_s_sleep(1); \
    if ((++_sp & 255u) == 0u) { if (xb_ld(&(bar)[XB_TMO])) break; if (_sp > XB_SPIN_CAP) { atomicAdd(&(bar)[XB_TMO], 1u); break; } } } } while (0)
DI void xcd_barrier_post(unsigned* bar) { if (threadIdx.x == 0) (void)xb_add(&bar[XB_XCNT(xb_xcc_id())], 1u); }
DI void xcd_barrier_complete(unsigned* bar, unsigned x, unsigned& nloc, unsigned& nx) {
    const unsigned G = gridDim.x * gridDim.y * gridDim.z;
    unsigned sum, cnt, mine, sp = 0u;
    for (;;) {
        sum = 0u; cnt = 0u; mine = 0u;
#pragma unroll
        for (unsigned j = 0; j < 16; ++j) { const unsigned c = xb_ld(&bar[XB_XCNT(j)]); sum += c; cnt += (c > 0u) ? 1u : 0u; mine = (j == x) ? c : mine; }
        if (sum == G) break;
        __builtin_amdgcn_s_sleep(1);
        if ((++sp & 255u) == 0u) { if (xb_ld(&bar[XB_TMO])) break; if (sp > XB_SPIN_CAP) { atomicAdd(&bar[XB_TMO], 1u); break; } }
    }
    nloc = mine > 0u ? mine : 1u; nx = cnt > 0u ? cnt : 1u;
}
DI void xcd_barrier(unsigned* bar, volatile LAS unsigned* st) {
    asm volatile("s_waitcnt vmcnt(0)" ::: "memory");
    __syncthreads();
    if (threadIdx.x == 0) {
        const unsigned x = xb_xcc_id();
        __builtin_amdgcn_s_waitcnt(0);
        unsigned nloc = st[0], nx = st[1];
        if (nloc == 0u) { xcd_barrier_complete(bar, x, nloc, nx); st[0] = nloc; st[1] = nx; }
        const unsigned old = xb_add(&bar[XB_XSUB(x)], 1u);
        const unsigned gen = old / nloc;
        if (old + 1u == (gen + 1u) * nloc) {
            __builtin_amdgcn_fence(__ATOMIC_RELEASE, "agent");
            asm volatile("s_waitcnt vmcnt(0)" ::: "memory");
            const unsigned og = xb_add(&bar[XB_TOP], 1u);
            const unsigned tg = og / nx;
            if (og + 1u == (tg + 1u) * nx) xb_add(&bar[XB_TOPGEN], 1u);
            else XB_SPIN(xb_ld(&bar[XB_TOPGEN]) == tg, bar);
            __builtin_amdgcn_fence(__ATOMIC_ACQUIRE, "agent");
            xb_add(&bar[XB_XGEN(x)], 1u);
            asm volatile("s_waitcnt vmcnt(0)" ::: "memory");
        } else {
            XB_SPIN(xb_ld(&bar[XB_XGEN(x)]) == gen, bar);
            __builtin_amdgcn_fence(__ATOMIC_ACQUIRE, "agent");
            asm volatile("s_waitcnt vmcnt(0)" ::: "memory");
        }
    }
    __syncthreads();
}

__global__ void __launch_bounds__(512, 2) fwd_megakernel(Args args) {
    extern __shared__ __attribute__((aligned(16))) unsigned char lds_raw[];
    Ctx c0; c0.a = &args; c0.ws = nullptr; c0.out = nullptr; c0.lds = (LAS unsigned char*)lds_raw; c0.tid = 0; c0.lane = 0; c0.wave = 0; c0.G = gridDim.x; c0.bid = 0;
    const int lo = args.ph_lo, hi = args.ph_hi;
    volatile LAS unsigned* bst = (volatile LAS unsigned*)((LAS unsigned char*)lds_raw + LDS_BYTES - 16);
    if (threadIdx.x == 0) { bst[0] = 0u; bst[1] = 0u; }
    __syncthreads();
    xcd_barrier_post((unsigned*)(args.ws + WS_CTL) + 1024);
#pragma unroll 1
    for (int ph2 = 2 * lo; ph2 < 2 * hi; ++ph2) {
        const int ph = ph2 >> 1;
        const int l = (ph - 1) >> 3, k = (ph == 0) ? -1 : ((ph - 1) & 7);
        if ((ph2 & 1) && k != PROBE_REP) continue;
        if (k == -1) phase_p0(c0);
        else if (k == 0 || k == 3 || k == 5 || k == 6) {
            const Ctx c = fresh(c0); unsigned char* ws = c.ws;
            pg8::Gemm g; pg8::EpiAny E; E.mode = 0; E.C = (float*)(ws + WS_MIXF); E.O = nullptr; E.ldc = D;
            if (k == 0)      { g.A = (const bf16_t*)(ws + WS_HBUF); g.Bt = (const bf16_t*)(ws + WS_WIN + l * SZ_WIN);   g.N = NINP; g.K = D;   E.C = (float*)(ws + WS_PROJ); E.ldc = NINP; }
            else if (k == 3) { g.A = (const bf16_t*)(ws + WS_MIXO); g.Bt = (const bf16_t*)(ws + WS_WOUT + l * SZ_WOUT); g.N = D;    g.K = D; }
            else if (k == 5) { g.A = (const bf16_t*)(ws + WS_HBUF); g.Bt = (const bf16_t*)(ws + WS_WGU + l * SZ_WGU);   g.N = NGU;  g.K = D;   E.mode = 1; E.O = (bf16_t*)(ws + WS_PROJ); E.ldc = DFF; }
            else             { g.A = (const bf16_t*)(ws + WS_PROJ); g.Bt = (const bf16_t*)(ws + WS_WDN + l * SZ_WDN);   g.N = D;    g.K = DFF; }
            g.M = (k == 3 || k == 6) ? NP : MPAD;
            pg8::StaticOrder S; S.init(g.M, g.N, c.G, c.bid);
            pg8::gemm_phase<pg8::EpiAny, pg8::StaticOrder, true, true>(c.lds, g, S, E);
            if (k == 3 || k == 6) sample_pieces(c0, g.A + (size_t)NP * g.K, g.Bt, g.K, (float*)(ws + WS_SLAB));
        }
        else if (k == 1) phase_m1(c0, l);
        else if (k == 2) phase_m2(c0, l);
        else {
            const Ctx c = fresh(c0); unsigned char* ws = c.ws;
            float* mixf = (float*)(ws + WS_MIXF); float* x1 = (float*)(ws + WS_X1); bf16_t* hb = (bf16_t*)(ws + WS_HBUF);
            if (k == 4) {
                const float* xa = (l == 0) ? inp(args, I_XP) : c.out; const float* xb = (l == 0) ? inp(args, I_XS) : c.out + (size_t)NP * D;
                row_phase(c0, mixf, (const float*)(ws + WS_SLAB), xa, xb, x1, inp(args, I_LN2) + l * D, inp(args, I_LN3) + l * D, hb);
            } else {
                row_phase(c0, mixf, (const float*)(ws + WS_SLAB), x1, x1 + (size_t)NP * D, c.out, inp(args, I_LN4) + l * D, l == 0 ? inp(args, I_LN1) + D : nullptr, hb);
            }
        }
        if (ph2 + 1 < 2 * hi) {
            if (ph2 == 2 * lo) cg::this_grid().sync();
            else xcd_barrier((unsigned*)(args.ws + WS_CTL) + 1024, bst);
        }
    }
}

extern "C" void kernel_launch(void* const* d_in, const int* in_sizes, int n_in, void* d_out, int out_size, void* d_ws, size_t ws_size, hipStream_t stream) {
    static int grid = 0;
    if (grid == 0) {
        if (n_in != 29 || (size_t)out_size != O_END || ws_size < WS_END) { fprintf(stderr, "kernel_launch: unexpected shapes: n_in %d out %d ws %zu (need %zu)\n", n_in, out_size, ws_size, (size_t)WS_END); grid = -1; return; }
        int dev = 0, cus = 0, per_cu = 0;
        hipGetDevice(&dev); hipDeviceGetAttribute(&cus, hipDeviceAttributeMultiprocessorCount, dev);
        if (hipFuncSetAttribute((const void*)fwd_megakernel, hipFuncAttributeMaxDynamicSharedMemorySize, LDS_BYTES) != hipSuccess) { fprintf(stderr, "kernel_launch: hipFuncSetAttribute failed\n"); grid = -1; return; }
        if (hipOccupancyMaxActiveBlocksPerMultiprocessor(&per_cu, (const void*)fwd_megakernel, 512, LDS_BYTES) != hipSuccess || per_cu < 1) { fprintf(stderr, "kernel_launch: occupancy query says %d\n", per_cu); grid = -1; return; }
        grid = cus;
        if (grid < 224) { fprintf(stderr, "kernel_launch: needs >= 224 CUs, got %d\n", grid); grid = -1; return; }
    }
    if (grid < 0) return;
    hipMemsetAsync((char*)d_ws + WS_CTL, 0, CTL_BYTES, stream);
    Args a{};
    for (int i = 0; i < 29; ++i) a.in[i] = (const float*)d_in[i];
    a.out = (float*)d_out; a.ws = (unsigned char*)d_ws;
#if MK_MULTI
    for (int ph = 0; ph < NPHASE; ++ph) { a.ph_lo = ph; a.ph_hi = ph + 1; hipLaunchKernelGGL(fwd_megakernel, dim3(grid), dim3(512), LDS_BYTES, stream, a); }
#else
    a.ph_lo = 0; a.ph_hi = NPHASE;
    void* kargs[] = {&a};
    hipError_t e = hipLaunchCooperativeKernel((const void*)fwd_megakernel, dim3(grid), dim3(512), kargs, LDS_BYTES, stream);
    if (e != hipSuccess) fprintf(stderr, "cooperative launch failed: %s (grid %d)\n", hipGetErrorString(e), grid);
#endif
}
```

```cpp
#include <hip/hip_runtime.h>
#include <hip/hip_cooperative_groups.h>
#include <cstdio>
#include <cstdint>
namespace cg = cooperative_groups;

#ifndef MK_MULTI
#define MK_MULTI 0
#endif

#ifndef PROBE_REP
#define PROBE_REP (-2)
#endif
#ifndef PROBE_SUB
#define PROBE_SUB 0
#endif
#ifndef PROBE_SEG
#define PROBE_SEG 0
#endif
#define SEG_T0(id) unsigned long long seg_t0_##id = 0; if (PROBE_SEG == (id)) seg_t0_##id = __builtin_amdgcn_s_memrealtime();
#define SEG_T1(id) if (PROBE_SEG == (id)) { const unsigned long long t1_ = __builtin_amdgcn_s_memrealtime(); const unsigned long long d_ = (t1_ - seg_t0_##id) * 8ull; \
        while (__builtin_amdgcn_s_memrealtime() - t1_ < d_) __builtin_amdgcn_s_sleep(2); }
#define DI __device__ __forceinline__
#define LAS __attribute__((address_space(3)))
#define GAS __attribute__((address_space(1)))
typedef unsigned short bf16_t;
typedef float f32x4 __attribute__((ext_vector_type(4)));
typedef float f32x2 __attribute__((ext_vector_type(2)));
typedef unsigned u32x4 __attribute__((ext_vector_type(4)));
typedef unsigned u32x2 __attribute__((ext_vector_type(2)));
typedef short bf16x8 __attribute__((ext_vector_type(8)));
typedef __bf16 bf16v2 __attribute__((ext_vector_type(2)));

constexpr int D = 2048, SEQ = 2048, BATCH = 4, NP = BATCH * SEQ, NS = 128, MT = NP + NS, MPAD = 8448;
constexpr int NIN = 7184, NINP = 7424, DFF = 5632, NGU = 2 * DFF;
constexpr int C_AQ = 0, C_AF = 512, C_AI = 1024, C_AG = 1536, C_BQ = 2048, C_BK = 3072, C_BV = 4096, C_BZ = 5120, C_BB = 6144, C_BA = 6152, C_CX = 6160, C_CG = 6672;
constexpr float NORM_EPS = 1e-6f, L2_EPS = 1e-6f;
constexpr int NPHASE = 17;
constexpr int GRID = 256;

constexpr size_t O_YP = 0, O_YS = O_YP + (size_t)NP * D, O_HGP = O_YS + (size_t)NS * D, O_HGS = O_HGP + 2ull * 4 * 4 * 16384,
                 O_GDP = O_HGS + 2ull * 128 * 4 * 16384, O_GDS = O_GDP + 2ull * 4 * 8 * 16384, O_GCP = O_GDS + 2ull * 128 * 8 * 16384,
                 O_GCS = O_GCP + 2ull * 4 * 3 * 3072, O_RHP = O_GCS + 2ull * 128 * 3 * 3072, O_RHS = O_RHP + 2ull * 4 * 512,
                 O_RCP = O_RHS + 2ull * 128 * 512, O_RCS = O_RCP + 2ull * 4 * 3 * 512, O_END = O_RCS + 2ull * 128 * 3 * 512;

constexpr size_t MiB = 1ull << 20;
constexpr size_t WS_CTL = 0, CTL_BYTES = 1 * MiB;
constexpr size_t WS_WIN = 1 * MiB, SZ_WIN = 29 * MiB, WS_WOUT = WS_WIN + 2 * SZ_WIN, SZ_WOUT = 8 * MiB, WS_WGU = WS_WOUT + 2 * SZ_WOUT, SZ_WGU = 44 * MiB,
                 WS_WDN = WS_WGU + 2 * SZ_WGU, SZ_WDN = 22 * MiB;
constexpr size_t WS_PROJ = WS_WDN + 2 * SZ_WDN, SZ_PROJ = 240 * MiB;
constexpr size_t WS_HBUF = WS_PROJ + SZ_PROJ, SZ_HBUF = 33 * MiB;
constexpr size_t WS_MIXO = WS_HBUF + SZ_HBUF;
constexpr size_t WS_MIXF = WS_MIXO + SZ_HBUF, SZ_MIXF = 66 * MiB;
constexpr size_t WS_X1 = WS_MIXF + SZ_MIXF, WS_END = WS_X1 + SZ_MIXF + 25 * MiB;
static_assert((size_t)NINP * D * 2 == SZ_WIN && (size_t)NGU * D * 2 == SZ_WGU && (size_t)D * DFF * 2 == SZ_WDN && (size_t)D * D * 2 == SZ_WOUT, "weight sizes");
static_assert((size_t)MPAD * NINP * 4 <= SZ_PROJ && (size_t)MPAD * D * 2 <= SZ_HBUF && (size_t)MPAD * D * 4 <= SZ_MIXF, "ws map");

constexpr int LDS_BYTES = 147456;

DI unsigned pk2(float lo, float hi) { f32x2 x = {lo, hi}; bf16v2 y = __builtin_convertvector(x, bf16v2); return __builtin_bit_cast(unsigned, y); }
struct ProjPtr { const float* p;
    DI float operator[](long i) const { return p[i]; }
    DI ProjPtr operator+(long o) const { return ProjPtr{p + o}; } };
DI float wave_sum(float v) {
#pragma unroll
    for (int o = 1; o < 64; o <<= 1) v += __shfl_xor(v, o);
    return v;
}
template <int CTRL> DI float dpp_mov(float v) { return __int_as_float(__builtin_amdgcn_update_dpp(0, __float_as_int(v), CTRL, 0xF, 0xF, true)); }
DI float row16_sum(float v) {
    v += dpp_mov<0xB1>(v); v += dpp_mov<0x4E>(v); v += dpp_mov<0x124>(v); v += dpp_mov<0x128>(v); return v;
}
DI float rl(float v, int l) { return __int_as_float(__builtin_amdgcn_readlane(__float_as_int(v), l)); }
DI float wave_sum_fast(float v) { v = row16_sum(v); return (rl(v, 0) + rl(v, 16)) + (rl(v, 32) + rl(v, 48)); }
DI float sigm(float x) { return __builtin_amdgcn_rcpf(1.f + __expf(-x)); }
DI float silu(float x) { return x * __builtin_amdgcn_rcpf(1.f + __expf(-x)); }
DI float softplus(float x) { return x > 20.f ? x : log1pf(__expf(x)); }
DI float gelu_tanh(float x) { const float y = 0.7978845608028654f * (x + 0.044715f * x * x * x); return 0.5f * x * (1.f + tanhf(y)); }
#define LDS_WAIT() asm volatile("s_waitcnt lgkmcnt(0)" ::: "memory")
#define MFMA16(a, b, c) __builtin_amdgcn_mfma_f32_16x16x32_bf16((a), (b), (c), 0, 0, 0)

namespace pg8 {
#define PG8_LAS __attribute__((address_space(3)))
constexpr int BM = 256, BK = 64, HALF = 128, HTB = HALF * BK * 2, STAGE_BYTES = 8 * HTB, NXCD = 8, WGM = 8;
__host__ __device__ __forceinline__ int lds_byte(int r, int c) { const int st = (r >> 4) * 2 + (c >> 5), rr = r & 15, cc = c & 31, ob = rr * 64 + cc * 2; return st * 1024 + (ob ^ (((ob >> 9) & 1) << 5)); }
__host__ __device__ __forceinline__ void stage_rc(int b, int& R, int& C) { const int st = b / 1024, sb = b % 1024, swz = sb ^ (((sb >> 9) & 1) << 5); R = (st >> 1) * 16 + swz / 64; C = (st & 1) * 32 + (swz % 64) / 2; }
struct Unit { int pm, pn; };
struct Gemm { const bf16_t* A; const bf16_t* Bt; int M, N, K; };
struct StaticOrder {
    int nM, nN, nwg, G, c;
    __host__ __device__ void init(int M, int N, int G_, int c_) { nM = M / BM; nN = N / BM; nwg = nM * nN; G = G_; c = c_; }
    __host__ __device__ bool next(int i, Unit& u) const {
        const long L = (long)i * G + c; if (L >= nwg) return false;
        int wgid = (int)L; { const int q = nwg / NXCD, r = nwg % NXCD, xcd = wgid % NXCD, off = wgid / NXCD; wgid = (xcd < r ? xcd * (q + 1) : r * (q + 1) + (xcd - r) * q) + off; }
        const int nig = WGM * nN, gid = wgid / nig, fm = gid * WGM, gsz = (nM - fm) < WGM ? (nM - fm) : WGM;
        u.pm = fm + ((wgid % nig) % gsz); u.pn = (wgid % nig) / gsz; return true;
    }
    __device__ __forceinline__ void a_ready(const Unit&) const {}
    __device__ __forceinline__ void done(const Unit&) const {}
};
struct EpiAny {
    static constexpr bool PERM = false, AFTER_DRAIN = false;
    int mode; float* C; bf16_t* O; int ldc;
    __device__ __forceinline__ void operator()(const f32x4 (&acc)[2][2][4][2], const Unit& u, int wr, int wc, int fr, int fq) const {
        const int row0 = u.pm * BM + wr * 64 + fr;
        if (mode == 0) {
            const int col0 = u.pn * BM + wc * 32 + 4 * fq;
#pragma unroll
            for (int ai = 0; ai < 2; ++ai)
#pragma unroll
                for (int m = 0; m < 4; ++m) { float* rowp = C + (size_t)(row0 + ai * HALF + m * 16) * ldc + col0;
#pragma unroll
                    for (int bj = 0; bj < 2; ++bj)
#pragma unroll
                        for (int n = 0; n < 2; ++n) *(f32x4*)(rowp + bj * HALF + n * 16) = acc[ai][bj][m][n]; }
        } else if (mode == 2) {
            const int col0 = u.pn * BM + wc * 32 + 4 * fq;
#pragma unroll
            for (int ai = 0; ai < 2; ++ai)
#pragma unroll
                for (int m = 0; m < 4; ++m) { bf16_t* rowp = O + (size_t)(row0 + ai * HALF + m * 16) * ldc + col0;
#pragma unroll
                    for (int bj = 0; bj < 2; ++bj)
#pragma unroll
                        for (int n = 0; n < 2; ++n) { const f32x4 v = acc[ai][bj][m][n]; *(u32x2*)(rowp + bj * HALF + n * 16) = (u32x2){pk2(v[0], v[1]), pk2(v[2], v[3])}; } }
        } else {
#pragma unroll
            for (int ai = 0; ai < 2; ++ai)
#pragma unroll
                for (int m = 0; m < 4; ++m) { bf16_t* rowp = O + (size_t)(row0 + ai * HALF + m * 16) * ldc;
#pragma unroll
                    for (int bj = 0; bj < 2; ++bj) { const int G = 8 * u.pn + 4 * bj + wc; const f32x4 g = acc[ai][bj][m][0], up = acc[ai][bj][m][1];
                        u32x2 w; w.x = pk2(silu(g[0]) * up[0], silu(g[1]) * up[1]); w.y = pk2(silu(g[2]) * up[2], silu(g[3]) * up[3]);
                        *(u32x2*)(rowp + 16 * G + 4 * fq) = w; } }
        }
    }
};

template <class Epi, class Sched, bool ALIGN_EPI = false, bool SP2 = false>
__device__ __forceinline__ void gemm_phase(PG8_LAS unsigned char* lds, const Gemm g, const Sched& S, const Epi& E) {
    int tid_ = threadIdx.x; asm volatile("" : "+v"(tid_));
    const int tid = tid_, wid = __builtin_amdgcn_readfirstlane(tid >> 6), lane = tid & 63, wr = wid >> 2, wc = wid & 3, fr = lane & 15, fq = lane >> 4;
    const int K = g.K, nt = K / BK;
    unsigned voffA[2], voffB[2];
#pragma unroll
    for (int i = 0; i < 2; ++i) { int R, C; stage_rc(tid * 16 + i * 8192, R, C); voffA[i] = (unsigned)(R * K + C) * 2u; voffB[i] = (unsigned)(R * K + C) * 2u; }
    const size_t kstep = (size_t)(BK * 2);
    const size_t hstep = (size_t)HALF * K * 2;
    const size_t tstep = 2 * hstep;
    const unsigned ldsw = (unsigned)wid * 1024u;
    const int aoff = lds_byte(wr * 64 + fr, fq * 8), boff = lds_byte(wc * 32 + fr, fq * 8);
#define PG8_SA(b, h) (((b) * 2 + (h)) * HTB)
#define PG8_SB(b, h) ((4 + (b) * 2 + (h)) * HTB)
#define PG8_STAGE(bufoff, gbase, voff) do { _Pragma("unroll") for (int _i = 0; _i < 2; ++_i) \
        __builtin_amdgcn_global_load_lds((const unsigned*)((const char*)(gbase) + (voff)[_i]), (PG8_LAS unsigned*)(lds + (bufoff) + ldsw + _i * 8192), 16, 0, 0); } while (0)
#define PG8_LDA(dst, b, h) do { _Pragma("unroll") for (int m = 0; m < 4; ++m) _Pragma("unroll") for (int k = 0; k < 2; ++k) dst[m][k] = *(const PG8_LAS bf16x8*)(lds + PG8_SA(b, h) + aoff + m * 2048 + k * 1024); } while (0)
#define PG8_LDB(dst, b, h) do { _Pragma("unroll") for (int n = 0; n < 2; ++n) _Pragma("unroll") for (int k = 0; k < 2; ++k) dst[n][k] = *(const PG8_LAS bf16x8*)(lds + PG8_SB(b, h) + boff + n * 2048 + k * 1024); } while (0)
#define PG8_MMA(ai, bj, At, Bt) do { __builtin_amdgcn_s_setprio(1); _Pragma("unroll") for (int m = 0; m < 4; ++m) _Pragma("unroll") for (int n = 0; n < 2; ++n) _Pragma("unroll") for (int k = 0; k < 2; ++k) \
        acc[ai][bj][m][n] = __builtin_amdgcn_mfma_f32_16x16x32_bf16(Bt[n][k], At[m][k], acc[ai][bj][m][n], 0, 0, 0); __builtin_amdgcn_s_setprio(0); } while (0)
#define PG8_WAIT_V(n) asm volatile("s_waitcnt vmcnt(" #n ")" ::: "memory")
#define PG8_WAIT_L(n) asm volatile("s_waitcnt lgkmcnt(" #n ")" ::: "memory")
#define PG8_BAR __builtin_amdgcn_s_barrier()
#define PG8_SCHED __builtin_amdgcn_sched_barrier(0)
    Unit cur, nxt; int ui = 0;
    if (!S.next(0, cur)) return;
    f32x4 acc[2][2][4][2];
#pragma unroll
    for (int a = 0; a < 2; ++a)
#pragma unroll
        for (int b = 0; b < 2; ++b)
#pragma unroll
            for (int m = 0; m < 4; ++m)
#pragma unroll
                for (int n = 0; n < 2; ++n) acc[a][b][m][n] = (f32x4){0.f, 0.f, 0.f, 0.f};
    bf16x8 At[4][2], B0[2][2], B1[2][2];
    const char* cA = (const char*)g.A + (size_t)cur.pm * tstep; const char* cB = (const char*)g.Bt + (size_t)cur.pn * tstep;
    S.a_ready(cur);
    if constexpr (SP2) {
        PG8_STAGE(PG8_SB(0, 0), cB, voffB); PG8_STAGE(PG8_SB(0, 1), cB + hstep, voffB); PG8_STAGE(PG8_SA(0, 0), cA, voffA); PG8_STAGE(PG8_SA(0, 1), cA + hstep, voffA);
        if (wr == 1) PG8_BAR;
        PG8_WAIT_V(2); PG8_BAR;
        PG8_STAGE(PG8_SB(1, 0), cB + kstep, voffB); PG8_STAGE(PG8_SA(1, 0), cA + kstep, voffA); PG8_STAGE(PG8_SB(1, 1), cB + hstep + kstep, voffB);
        PG8_WAIT_V(6); PG8_BAR;
    } else {
        PG8_STAGE(PG8_SB(0, 0), cB, voffB); PG8_STAGE(PG8_SA(0, 0), cA, voffA); PG8_STAGE(PG8_SB(0, 1), cB + hstep, voffB); PG8_STAGE(PG8_SA(0, 1), cA + hstep, voffA);
        if (wr == 1) PG8_BAR;
        PG8_WAIT_V(4); PG8_BAR;
        PG8_STAGE(PG8_SB(1, 0), cB + kstep, voffB); PG8_STAGE(PG8_SA(1, 0), cA + kstep, voffA); PG8_STAGE(PG8_SB(1, 1), cB + hstep + kstep, voffB);
        PG8_WAIT_V(6); PG8_BAR;
    }
    for (;;) {
        const bool has_next = S.next(ui + 1, nxt);
        const char* nA = has_next ? (const char*)g.A + (size_t)nxt.pm * tstep : cA; const char* nB = has_next ? (const char*)g.Bt + (size_t)nxt.pn * tstep : cB;
        for (int t = 0; t < nt; t += 2) {
            const bool last = (t == nt - 2);
            const char* a1 = cA + (size_t)(t + 1) * kstep;
            const char* a2 = last ? nA : cA + (size_t)(t + 2) * kstep; const char* b2 = last ? nB : cB + (size_t)(t + 2) * kstep;
            const char* a3 = a2 + kstep; const char* b3 = b2 + kstep;
            if (last && has_next) S.a_ready(nxt);
            if constexpr (SP2) {
            PG8_LDB(B0, 0, 0); PG8_LDB(B1, 0, 1); PG8_SCHED; PG8_LDA(At, 0, 0); PG8_STAGE(PG8_SA(1, 1), a1 + hstep, voffA);
            PG8_WAIT_V(8); PG8_WAIT_L(0); PG8_BAR; PG8_MMA(0, 0, At, B0); PG8_MMA(0, 1, At, B1); PG8_BAR; PG8_SCHED;
            PG8_LDA(At, 0, 1); PG8_STAGE(PG8_SB(0, 0), b2, voffB); PG8_STAGE(PG8_SB(0, 1), b2 + hstep, voffB); PG8_STAGE(PG8_SA(0, 0), a2, voffA);
            PG8_WAIT_V(8); PG8_WAIT_L(0); PG8_BAR; PG8_MMA(1, 0, At, B0); PG8_MMA(1, 1, At, B1); PG8_BAR; PG8_SCHED;
            PG8_LDB(B0, 1, 0); PG8_LDB(B1, 1, 1); PG8_SCHED; PG8_LDA(At, 1, 0); PG8_STAGE(PG8_SA(0, 1), a2 + hstep, voffA);
            PG8_WAIT_V(8); PG8_WAIT_L(0); PG8_BAR; PG8_MMA(0, 0, At, B0); PG8_MMA(0, 1, At, B1); PG8_BAR; PG8_SCHED;
            PG8_LDA(At, 1, 1); PG8_STAGE(PG8_SB(1, 0), b3, voffB); PG8_STAGE(PG8_SB(1, 1), b3 + hstep, voffB); PG8_STAGE(PG8_SA(1, 0), a3, voffA);
            PG8_WAIT_V(8); PG8_WAIT_L(0); PG8_BAR; PG8_MMA(1, 0, At, B0); PG8_MMA(1, 1, At, B1); PG8_BAR; PG8_SCHED;
            } else {
            PG8_LDB(B0, 0, 0); PG8_SCHED; PG8_LDA(At, 0, 0); PG8_STAGE(PG8_SA(1, 1), a1 + hstep, voffA);
            PG8_WAIT_L(8); PG8_BAR; PG8_WAIT_L(0); PG8_MMA(0, 0, At, B0); PG8_BAR; PG8_SCHED;
            PG8_LDB(B1, 0, 1); PG8_STAGE(PG8_SB(0, 0), b2, voffB);
            PG8_BAR; PG8_WAIT_L(0); PG8_MMA(0, 1, At, B1); PG8_BAR;
            PG8_LDA(At, 0, 1); PG8_STAGE(PG8_SA(0, 0), a2, voffA);
            PG8_BAR; PG8_WAIT_L(0); PG8_MMA(1, 0, At, B0); PG8_BAR; PG8_SCHED;
            PG8_STAGE(PG8_SB(0, 1), b2 + hstep, voffB);
            PG8_WAIT_V(6); PG8_BAR; PG8_MMA(1, 1, At, B1); PG8_BAR;
            PG8_LDB(B0, 1, 0); PG8_SCHED; PG8_LDA(At, 1, 0); PG8_STAGE(PG8_SA(0, 1), a2 + hstep, voffA);
            PG8_WAIT_L(8); PG8_BAR; PG8_WAIT_L(0); PG8_MMA(0, 0, At, B0); PG8_BAR; PG8_SCHED;
            PG8_LDB(B1, 1, 1); PG8_STAGE(PG8_SB(1, 0), b3, voffB);
            PG8_BAR; PG8_WAIT_L(0); PG8_MMA(0, 1, At, B1); PG8_BAR;
            PG8_LDA(At, 1, 1); PG8_STAGE(PG8_SA(1, 0), a3, voffA);
            PG8_BAR; PG8_WAIT_L(0); PG8_MMA(1, 0, At, B0); PG8_BAR; PG8_SCHED;
            PG8_STAGE(PG8_SB(1, 1), b3 + hstep, voffB);
            PG8_WAIT_V(6); PG8_BAR; PG8_MMA(1, 1, At, B1); PG8_BAR;
            }
        }
        if constexpr (ALIGN_EPI) { if (wr == 0) PG8_BAR; }
        if constexpr (!Epi::AFTER_DRAIN) { E(acc, cur, wr, wc, fr, fq); S.done(cur); }
        if (!has_next) break;
#pragma unroll
        for (int a = 0; a < 2; ++a)
#pragma unroll
            for (int b = 0; b < 2; ++b)
#pragma unroll
                for (int m = 0; m < 4; ++m)
#pragma unroll
                    for (int n = 0; n < 2; ++n) acc[a][b][m][n] = (f32x4){0.f, 0.f, 0.f, 0.f};
        cur = nxt; cA = nA; cB = nB; ++ui;
        if constexpr (ALIGN_EPI) { if (wr == 1) PG8_BAR; }
    }
    PG8_WAIT_V(0);
    if constexpr (!ALIGN_EPI) { if (wr == 0) PG8_BAR; }
    PG8_BAR;
#undef PG8_SA
#undef PG8_SB
#undef PG8_STAGE
#undef PG8_LDA
#undef PG8_LDB
#undef PG8_MMA
#undef PG8_WAIT_V
#undef PG8_WAIT_L
#undef PG8_BAR
#undef PG8_SCHED
}
}

struct Args { const float* in[29]; float* out; unsigned char* ws; int ph_lo, ph_hi; };
enum { I_XP = 0, I_XS, I_SHG, I_SGD, I_SGC, I_SRH, I_SRC, I_LN1, I_LN2, I_LN3, I_LN4, I_WIN, I_WOUT, I_LB, I_ANORM, I_BCW, I_BALOG, I_BDT, I_BNORM,
       I_CCW, I_CCB, I_CWA, I_CBA, I_CWX, I_CBX, I_CLAM, I_WG, I_WU, I_WD };

struct Ctx {
    const Args* a; unsigned char* ws; float* out; LAS unsigned char* lds; int tid, lane, wave, G, bid;
};
DI Ctx fresh(const Ctx& o) {
    Ctx c = o; int t = threadIdx.x; asm volatile("" : "+v"(t)); c.tid = t; c.lane = t & 63; c.wave = __builtin_amdgcn_readfirstlane(t >> 6);
    size_t z = 0; asm volatile("" : "+s"(z)); c.ws = o.a->ws + z; c.out = o.a->out + z;
    int b = blockIdx.x; asm volatile("" : "+s"(b)); c.bid = b; return c;
}
DI const float* inp(const Args& a, int idx) { int z = idx; asm volatile("" : "+s"(z)); return (const float*)(const GAS float*)a.in[z]; }

template <int MODE>
DI void transpose_item(const float* W, int K, int Nsrc, int nblk, bf16_t* WT, LAS float* scr, int item, int lane) {
    const int kb = item / nblk, nb = item - kb * nblk, k0 = 64 * kb, n0 = 32 * nb;
    const int nn = n0 + (lane & 31); const bool ok = nn < Nsrc;
    float v[32];
#pragma unroll
    for (int i = 0; i < 32; ++i) { const int kk = 2 * i + (lane >> 5); v[i] = ok ? W[(size_t)(k0 + kk) * Nsrc + nn] : 0.f; }
#pragma unroll
    for (int i = 0; i < 32; ++i) { const int kk = 2 * i + (lane >> 5); scr[kk * 33 + (lane & 31)] = v[i]; }
    LDS_WAIT(); asm volatile("" ::: "memory");
    const int c = lane & 7;
#pragma unroll
    for (int j = 0; j < 4; ++j) { const int nl = (lane >> 3) + 8 * j; const LAS float* s = scr + (8 * c) * 33 + nl;
        u32x4 o; o.x = pk2(s[0 * 33], s[1 * 33]); o.y = pk2(s[2 * 33], s[3 * 33]); o.z = pk2(s[4 * 33], s[5 * 33]); o.w = pk2(s[6 * 33], s[7 * 33]);
        const int n = n0 + nl; const int drow = (MODE == 0) ? n : ((n >> 4) * 32 + (n & 15) + (MODE == 2 ? 16 : 0));
        *(u32x4*)(WT + (size_t)drow * K + k0 + 8 * c) = o; }
    LDS_WAIT(); asm volatile("" ::: "memory");
}
DI void norm_row_to_bf16(const float* xr, const float* g, bf16_t* orow, int lane) {
    f32x4 v[8]; float s = 0.f;
#pragma unroll
    for (int j = 0; j < 8; ++j) { v[j] = ((const f32x4*)xr)[lane + 64 * j]; s += (v[j].x * v[j].x + v[j].y * v[j].y) + (v[j].z * v[j].z + v[j].w * v[j].w); }
    const float r = rsqrtf(wave_sum_fast(s) * (1.f / D) + NORM_EPS);
#pragma unroll
    for (int j = 0; j < 8; ++j) { const f32x4 gg = ((const f32x4*)g)[lane + 64 * j]; u32x2 w; w.x = pk2(v[j].x * r * gg.x, v[j].y * r * gg.y); w.y = pk2(v[j].z * r * gg.z, v[j].w * r * gg.w);
        ((u32x2*)orow)[lane + 64 * j] = w; }
}
constexpr int CV_IN = (D / 64) * (NINP / 32), CV_OUT = (D / 64) * (D / 32), CV_G = (D / 64) * (DFF / 32), CV_D = (DFF / 64) * (D / 32), CV_LAYER = CV_IN + CV_OUT + 2 * CV_G + CV_D;
DI void convert_range(const Ctx& c, int lo, int hi, int gw, int NGW) {
    const Args& a = *c.a;
    LAS float* scr = (LAS float*)(c.lds + c.wave * 16384);
    for (int it = lo + gw; it < hi; it += NGW) {
        const int l = it / CV_LAYER; int r = it - l * CV_LAYER;
        if (r < CV_IN) { transpose_item<0>(inp(a, I_WIN) + (size_t)l * D * NIN, D, NIN, NINP / 32, (bf16_t*)(c.ws + WS_WIN + l * SZ_WIN), scr, r, c.lane); continue; } r -= CV_IN;
        if (r < CV_OUT) { transpose_item<0>(inp(a, I_WOUT) + (size_t)l * D * D, D, D, D / 32, (bf16_t*)(c.ws + WS_WOUT + l * SZ_WOUT), scr, r, c.lane); continue; } r -= CV_OUT;
        if (r < CV_G) { transpose_item<1>(inp(a, I_WG) + (size_t)l * D * DFF, D, DFF, DFF / 32, (bf16_t*)(c.ws + WS_WGU + l * SZ_WGU), scr, r, c.lane); continue; } r -= CV_G;
        if (r < CV_G) { transpose_item<2>(inp(a, I_WU) + (size_t)l * D * DFF, D, DFF, DFF / 32, (bf16_t*)(c.ws + WS_WGU + l * SZ_WGU), scr, r, c.lane); continue; } r -= CV_G;
        transpose_item<0>(inp(a, I_WD) + (size_t)l * DFF * D, DFF, D, D / 32, (bf16_t*)(c.ws + WS_WDN + l * SZ_WDN), scr, r, c.lane);
    }
}
DI void phase_p0(const Ctx& c0) {
    const Ctx c = fresh(c0);
    const Args& a = *c.a;
    const int gw = c.bid * 8 + c.wave, NGW = GRID * 8;
    convert_range(c, 0, CV_IN, gw, NGW);
    bf16_t* hb = (bf16_t*)(c.ws + WS_HBUF);
    { const float* xp = inp(a, I_XP); const float* xs = inp(a, I_XS); const float* g1 = inp(a, I_LN1);
      for (int m = gw; m < MT; m += NGW) norm_row_to_bf16(m < NP ? xp + (size_t)m * D : xs + (size_t)(m - NP) * D, g1, hb + (size_t)m * D, c.lane); }
    unsigned z0 = 0u; asm volatile("" : "+v"(z0)); const u32x4 z4 = {z0, z0, z0, z0};
    for (int i = gw * 64 + c.lane; i < (MPAD - MT) * D / 8; i += NGW * 64) {
        ((u32x4*)(hb + (size_t)MT * D))[i] = z4;
        ((u32x4*)((bf16_t*)(c.ws + WS_MIXO) + (size_t)MT * D))[i] = z4;
    }
}

DI void row_phase(const Ctx& c0, const bf16_t* y, const float* slabs, const float* xa, const float* xb, float* xout, const float* g_post, const float* g_next, bf16_t* hb) {
    const Ctx c = fresh(c0);
    const int gw = c.bid * 8 + c.wave, NGW = GRID * 8, lane = c.lane;
    f32x4 v[8], vn[8];
#define Y_LOAD(dst, row) do { _Pragma("unroll") for (int j = 0; j < 8; ++j) { const u32x2 w_ = ((const u32x2*)(y + (size_t)(row) * D))[lane + 64 * j]; \
        dst[j] = (f32x4){__uint_as_float(w_.x << 16), __uint_as_float(w_.x & 0xffff0000u), __uint_as_float(w_.y << 16), __uint_as_float(w_.y & 0xffff0000u)}; } } while (0)
    if (gw < NP) Y_LOAD(v, gw);
    for (int m = gw; m < MT; m += NGW) {
        const float* xr = m < NP ? xa + (size_t)m * D : xb + (size_t)(m - NP) * D;
        const int mn = m + NGW;
        f32x4 xx[8];
#pragma unroll
        for (int j = 0; j < 8; ++j) xx[j] = ((const f32x4*)xr)[lane + 64 * j];
        if (mn < NP) Y_LOAD(vn, mn);
        if (m >= NP) { const float* yr = slabs + (size_t)(m - NP) * D;
#pragma unroll
            for (int j = 0; j < 8; ++j) v[j] = ((const f32x4*)yr)[lane + 64 * j] + ((const f32x4*)(yr + (size_t)NS * D))[lane + 64 * j];
#pragma unroll 1
            for (int ks = 2; ks < 8; ks += 2) {
                f32x4 t0[8], t1[8];
#pragma unroll
                for (int j = 0; j < 8; ++j) { t0[j] = ((const f32x4*)(yr + (size_t)ks * NS * D))[lane + 64 * j]; t1[j] = ((const f32x4*)(yr + (size_t)(ks + 1) * NS * D))[lane + 64 * j]; }
#pragma unroll
                for (int j = 0; j < 8; ++j) v[j] = v[j] + t0[j] + t1[j]; }
        }
        float s = 0.f;
#pragma unroll
        for (int j = 0; j < 8; ++j) s += (v[j].x * v[j].x + v[j].y * v[j].y) + (v[j].z * v[j].z + v[j].w * v[j].w);
        const float r = rsqrtf(wave_sum_fast(s) * (1.f / D) + NORM_EPS);
        float s2 = 0.f;
#pragma unroll
        for (int j = 0; j < 8; ++j) { const f32x4 gg = ((const f32x4*)g_post)[lane + 64 * j];
            v[j] = xx[j] + v[j] * r * gg; s2 += (v[j].x * v[j].x + v[j].y * v[j].y) + (v[j].z * v[j].z + v[j].w * v[j].w);
            ((f32x4*)(xout + (size_t)m * D))[lane + 64 * j] = v[j]; }
        if (g_next) {
            const float r2 = rsqrtf(wave_sum_fast(s2) * (1.f / D) + NORM_EPS);
#pragma unroll
            for (int j = 0; j < 8; ++j) { const f32x4 gg = ((const f32x4*)g_next)[lane + 64 * j]; u32x2 w; w.x = pk2(v[j].x * r2 * gg.x, v[j].y * r2 * gg.y); w.y = pk2(v[j].z * r2 * gg.z, v[j].w * r2 * gg.w);
                ((u32x2*)(hb + (size_t)m * D))[lane + 64 * j] = w; }
        }
#pragma unroll
        for (int j = 0; j < 8; ++j) v[j] = vn[j];
    }
}

DI void sample_pieces(const Ctx& c0, const bf16_t* A  , const bf16_t* Bt  , int K, float* slabs) {
    const Ctx c = fresh(c0); const int tid = c.tid, lane = c.lane, wave = c.wave, i = lane & 15, g = lane >> 4;
    constexpr int KC = 256, PPR = KC / 8, NJ = 192 * PPR / 512, RS = KC * 2 + 16;
    const int klen = K / 8;
    for (int p = c.bid; p < 256; p += GRID) {
        const int jt = p & 31, ks = p >> 5;
        f32x4 acc[4];
#pragma unroll
        for (int q = 0; q < 4; ++q) acc[q] = (f32x4){0.f, 0.f, 0.f, 0.f};
#pragma unroll 1
        for (int kc = 0; kc < klen; kc += KC) {
            const int k0 = ks * klen + kc;
            u32x4 v[NJ];
#pragma unroll
            for (int j = 0; j < NJ; ++j) { const int pc = tid + 512 * j; const int row = pc / PPR, col = pc - row * PPR;
                const bf16_t* src = (row < 128 ? A + (size_t)row * K : Bt + (size_t)(64 * jt + row - 128) * K) + k0 + 8 * col;
                v[j] = *(const u32x4*)src; }
            __syncthreads();
#pragma unroll
            for (int j = 0; j < NJ; ++j) { const int pc = tid + 512 * j; const int row = pc / PPR, col = pc - row * PPR;
                *(LAS u32x4*)(c.lds + row * RS + col * 16) = v[j]; }
            __syncthreads();
            const int nk = (klen - kc) >= KC ? KC / 32 : (klen - kc) / 32;
#pragma unroll 2
            for (int kk = 0; kk < nk; ++kk) {
                const bf16x8 av = *(const LAS bf16x8*)(c.lds + (16 * wave + i) * RS + (32 * kk + 8 * g) * 2);
#pragma unroll
                for (int q = 0; q < 4; ++q) acc[q] = MFMA16(av, *(const LAS bf16x8*)(c.lds + (128 + 16 * q + i) * RS + (32 * kk + 8 * g) * 2), acc[q]);
            }
        }
        float* so = slabs + (size_t)ks * NS * D + (size_t)(16 * wave + 4 * g) * D + 64 * jt + i;
#pragma unroll
        for (int q = 0; q < 4; ++q)
#pragma unroll
            for (int r = 0; r < 4; ++r) so[(size_t)r * D + 16 * q] = acc[q][r];
    }
    __syncthreads();
}

DI int perm32(int x) { return 8 * ((x >> 2) & 3) + 4 * (x >> 4) + (x & 3); }
DI int kpos(int k) { return (k & ~31) + perm32(k & 31); }
DI float lb_of(const Args& a, int l, int c) { if (l == 0) return 0.f; const float l0 = inp(a, I_LB)[c], l1 = inp(a, I_LB)[512 + c]; return 1.f / (1.f + __expf(l0 - l1)); }
DI bf16_t bf1(float x) { return (bf16_t)(pk2(x, 0.f) & 0xffffu); }

constexpr size_t IB_W = WS_MIXF, IB_Q = IB_W + 16 * MiB, IB_KT = IB_Q + 16 * MiB, IB_P = IB_KT + 16 * MiB, IB_U0 = IB_P + 8 * MiB,
                 IA_Q = IB_U0 + 32 * MiB, IA_KT = IA_Q + 8 * MiB, IA_P = IA_KT + 8 * MiB, IA_V = IA_P + 4 * MiB,
                 IC_A = IA_V + 16 * MiB, IC_B = IC_A + 16 * MiB, IMISC = IC_B + 16 * MiB, IB_DEC = IMISC, IA_DEC = IMISC + 65536, IC_TOT = IMISC + 524288, I_END = IMISC + 1 * MiB;
static_assert(I_END <= WS_END, "mixer intermediates must fit");
constexpr size_t IG_B = WS_HBUF, IG_A = WS_HBUF + 16 * MiB;
static_assert(IG_A + 8 * MiB <= WS_HBUF + SZ_HBUF, "gate buffers");
constexpr size_t WS_SLAB = WS_X1 + SZ_MIXF;
static_assert(WS_SLAB + 8 * MiB <= WS_END, "slabs");

struct M1BRegs { float x[3][19], w[3][4], gz[16], nwt, bb, ba; };
DI void m1b_load(const Ctx& c, int l, int u, M1BRegs& R) {
    const Args& a = *c.a; const int tid = c.tid;
    const int b = u >> 8, h = (u >> 5) & 7, ci = u & 31;
    const ProjPtr proj{(const float*)(c.ws + WS_PROJ)};
    const long rowb = (long)b * SEQ + 64 * ci; const int tg0 = 64 * ci;
    const float* cw = inp(a, I_BCW) + (size_t)l * 4 * 3072;
    const int idx = tid & 127, tq = tid >> 7;
#pragma unroll
    for (int i = 0; i < 16; ++i) R.gz[i] = proj[(rowb + 16 * tq + i) * NINP + C_BZ + h * 128 + idx];
    R.nwt = inp(a, I_BNORM)[l * 128 + idx];
    R.bb = proj[(rowb + (tid & 63)) * NINP + C_BB + h]; R.ba = proj[(rowb + (tid & 63)) * NINP + C_BA + h];
#pragma unroll
    for (int p = 0; p < 3; ++p) { const int ch = p * 1024 + h * 128 + idx;
#pragma unroll
        for (int j = 0; j < 4; ++j) R.w[p][j] = cw[j * 3072 + ch];
#pragma unroll
        for (int j = 0; j < 19; ++j) { const int t = 16 * tq - 3 + j; R.x[p][j] = (tg0 + t >= 0) ? proj[(rowb + t) * NINP + C_BQ + ch] : 0.f; } }
}
DI void m1_unit_b(const Ctx& c0, int l, int u, int unext, M1BRegs& R) {
    const Ctx c = fresh(c0); const Args& a = *c.a; const int tid = c.tid, lane = c.lane, wave = c.wave;
    const int b = u >> 8, h = (u >> 5) & 7, ci = u & 31;
    LAS float* Kf = (LAS float*)c.lds;
    LAS float* Vf = Kf + 8192;
    LAS float* Qf = Vf + 8192;
    LAS float* Amat = Qf;
    LAS bf16_t* Pl = (LAS bf16_t*)(Qf + 64 * 68);
    LAS bf16_t* Qb = (LAS bf16_t*)(Qf + 8192);
    LAS bf16_t* Kb = Qb + 64 * 136;
    LAS float* scal = (LAS float*)(Kb + 64 * 136);
    const ProjPtr proj{(const float*)(c.ws + WS_PROJ)};
    const long rowb = (long)b * SEQ + 64 * ci; const int tg0 = 64 * ci;
    SEG_T0(10)
    {
        const int idx = tid & 127, tq = tid >> 7;
#pragma unroll
        for (int p = 0; p < 3; ++p) { LAS float* dst = (p == 0 ? Qf : (p == 1 ? Kf : Vf)) + idx;
#pragma unroll
            for (int i = 0; i < 16; ++i) dst[(16 * tq + i) * 128] = silu(R.w[p][0] * R.x[p][i] + R.w[p][1] * R.x[p][i + 1] + R.w[p][2] * R.x[p][i + 2] + R.w[p][3] * R.x[p][i + 3]); }
        bf16_t* gg = (bf16_t*)(c.ws + IG_B) + ((size_t)u * 64 + 16 * tq) * 128 + idx;
#pragma unroll
        for (int i = 0; i < 16; ++i) gg[i * 128] = bf1(silu(R.gz[i]) * R.nwt);
    }
    SEG_T1(10)
    __syncthreads();
    SEG_T0(11)
    for (int i = 0; i < 8; ++i) { const int t = wave * 8 + i; const float q0 = Qf[t * 128 + lane], q1 = Qf[t * 128 + 64 + lane], k0 = Kf[t * 128 + lane], k1 = Kf[t * 128 + 64 + lane];
        const float sq = wave_sum_fast(q0 * q0 + q1 * q1), sk = wave_sum_fast(k0 * k0 + k1 * k1);
        if (lane == 0) { scal[t * 8 + 3] = rsqrtf(sq + L2_EPS) * 0.08838834764831845f; scal[t * 8 + 4] = rsqrtf(sk + L2_EPS); } }
    if (wave == 0) { const int t = lane; const float bb = R.bb, ba = R.ba;
        const float gt = -__expf(inp(a, I_BALOG)[l * 8 + h]) * softplus(ba + inp(a, I_BDT)[l * 8 + h]);
        float x = gt;
#pragma unroll
        for (int o = 1; o < 64; o <<= 1) { const float y = __shfl_up(x, o); if (lane >= o) x += y; }
        const float bC = __shfl(x, 63);
        scal[t * 8 + 0] = sigm(bb); scal[t * 8 + 1] = x; scal[t * 8 + 2] = __expf(x); scal[t * 8 + 5] = __expf(bC - x);
        if (lane == 63) ((float*)(c.ws + IB_DEC))[u] = __expf(x); }
    SEG_T1(11)
    __syncthreads();
    SEG_T0(12)
    {
        const int t = tid >> 3, d0 = (tid & 7) * 16; const float sq = scal[t * 8 + 3], sk = scal[t * 8 + 4], s2 = sq * scal[t * 8 + 2];
        bf16_t* gq = (bf16_t*)(c.ws + IB_Q) + ((size_t)u * 64 + t) * 128;
#pragma unroll
        for (int m = 0; m < 4; ++m) { const int d = d0 + 4 * m; const f32x4 q = *(const LAS f32x4*)(Qf + t * 128 + d), k = *(const LAS f32x4*)(Kf + t * 128 + d);
            *(LAS u32x2*)(Qb + t * 136 + d) = (u32x2){pk2(q.x * sq, q.y * sq), pk2(q.z * sq, q.w * sq)};
            *(LAS u32x2*)(Kb + t * 136 + d) = (u32x2){pk2(k.x * sk, k.y * sk), pk2(k.z * sk, k.w * sk)};
            *(u32x2*)(gq + kpos(d)) = (u32x2){pk2(q.x * s2, q.y * s2), pk2(q.z * s2, q.w * s2)}; }
    }
    SEG_T1(12)
    __syncthreads();
    SEG_T0(13)
    {
        const int i = lane & 15, g = lane >> 4;
#pragma unroll
        for (int q2 = 0; q2 < 2; ++q2) { const int idx = 2 * wave + q2, tt = idx >> 2, st = idx & 3; const int s = 16 * st + i;
            if (st <= tt) {
                f32x4 akk = {0.f, 0.f, 0.f, 0.f}, aqk = {0.f, 0.f, 0.f, 0.f};
#pragma unroll
                for (int ks = 0; ks < 4; ++ks) { const bf16x8 bk = *(const LAS bf16x8*)(Kb + (16 * st + i) * 136 + 32 * ks + 8 * g);
                    const bf16x8 ak = *(const LAS bf16x8*)(Kb + (16 * tt + i) * 136 + 32 * ks + 8 * g), aq = *(const LAS bf16x8*)(Qb + (16 * tt + i) * 136 + 32 * ks + 8 * g);
                    akk = MFMA16(ak, bk, akk); aqk = MFMA16(aq, bk, aqk); }
                const float bs = scal[s * 8 + 1];
#pragma unroll
                for (int r = 0; r < 4; ++r) { const int t = 16 * tt + 4 * g + r; const float gam = __expf(fminf(scal[t * 8 + 1] - bs, 0.f));
                    Amat[t * 68 + s] = (s < t) ? scal[t * 8 + 0] * akk[r] * gam : 0.f;
                    Pl[t * 72 + kpos(s)] = bf1((s <= t) ? aqk[r] * gam : 0.f); }
            } else {
#pragma unroll
                for (int r = 0; r < 4; ++r) Pl[(16 * tt + 4 * g + r) * 72 + kpos(s)] = 0;
            }
        }
    }
    SEG_T1(13)
    __syncthreads();
    SEG_T0(14)
    LAS float* Tm = scal + 512;
    LAS bf16_t* KTs = Qb;
    LAS bf16_t* Wst = Qb + 128 * 72;
    if (unext < 1024) m1b_load(c, l, unext, R);
    if (wave >= 4) {
#pragma unroll
        for (int k = 0; k < 2; ++k) { const int p = (tid - 256) + 256 * k, row = p >> 3, c16 = p & 7;
            *(u32x4*)((bf16_t*)(c.ws + IB_P) + (size_t)u * 4096 + row * 64 + c16 * 8) = *(const LAS u32x4*)(Pl + row * 72 + c16 * 8); }
        const int d = tid & 127, s0 = ((tid >> 7) & 1) * 32;
#pragma unroll
        for (int m = 0; m < 8; ++m) { float v[4];
#pragma unroll
            for (int j = 0; j < 4; ++j) { const int s_ = s0 + 4 * m + j; v[j] = Kf[s_ * 128 + d] * scal[s_ * 8 + 4] * scal[s_ * 8 + 5]; }
            *(LAS u32x2*)(KTs + d * 72 + kpos(s0 + 4 * m)) = (u32x2){pk2(v[0], v[1]), pk2(v[2], v[3])}; }
    } else if (lane < 16) {
        const LAS float* Ab = Amat + (16 * wave) * 68 + 16 * wave;
        f32x4 ar[16][4];
#pragma unroll
        for (int r = 1; r < 16; ++r)
#pragma unroll
            for (int q4 = 0; q4 < (r + 3) / 4; ++q4) ar[r][q4] = *(const LAS f32x4*)(Ab + r * 68 + 4 * q4);
        float xk[16];
#pragma unroll
        for (int r = 0; r < 16; ++r) { float acc = (r == lane) ? 1.f : 0.f;
#pragma unroll
            for (int q = 0; q < r; ++q) acc -= ar[r][q >> 2][q & 3] * xk[q];
            xk[r] = acc; Tm[(wave * 16 + r) * 20 + lane] = acc; }
    }
    __syncthreads();
    {
        const int i = lane & 15, g = lane >> 4;
#pragma unroll
        for (int q2 = 0; q2 < 2; ++q2) { const int ct = 2 * wave + q2;
            f32x4 X[4];
#pragma unroll
            for (int I = 0; I < 4; ++I) {
                f32x4 acc;
#pragma unroll
                for (int r = 0; r < 4; ++r) { const int t = 16 * I + 4 * g + r;
                    acc[r] = (ct < 8) ? scal[t * 8 + 0] * Vf[t * 128 + 16 * ct + i] : scal[t * 8 + 0] * scal[t * 8 + 2] * scal[t * 8 + 4] * Kf[t * 128 + 16 * (ct - 8) + i]; }
#pragma unroll
                for (int J = 0; J < I; ++J) { const f32x4 a4 = *(const LAS f32x4*)(Amat + (16 * I + i) * 68 + 16 * J + 4 * g);
#pragma unroll
                    for (int kk = 0; kk < 4; ++kk) acc = __builtin_amdgcn_mfma_f32_16x16x4f32(-a4[kk], X[J][kk], acc, 0, 0, 0); }
                const f32x4 t4 = *(const LAS f32x4*)(Tm + (16 * I + i) * 20 + 4 * g);
                f32x4 xi = {0.f, 0.f, 0.f, 0.f};
#pragma unroll
                for (int kk = 0; kk < 4; ++kk) xi = __builtin_amdgcn_mfma_f32_16x16x4f32(t4[kk], acc[kk], xi, 0, 0, 0);
                X[I] = xi;
            }
            if (ct < 8) { float* g0 = (float*)(c.ws + IB_U0) + (size_t)u * 8192;
#pragma unroll
                for (int I = 0; I < 4; ++I) *(f32x4*)(g0 + ((I * 8 + ct) * 64 + lane) * 4) = X[I];
            } else { const int dp = kpos(16 * (ct - 8) + i);
#pragma unroll
                for (int I = 0; I < 4; ++I)
#pragma unroll
                    for (int r = 0; r < 4; ++r) Wst[(16 * I + 4 * g + r) * 128 + dp] = bf1(X[I][r]); }
        }
    }
    SEG_T1(14)
    __syncthreads();
    SEG_T0(15)
#pragma unroll
    for (int k = 0; k < 2; ++k) { const int p = tid + 512 * k, row = p >> 3, c16 = p & 7;
        *(u32x4*)((bf16_t*)(c.ws + IB_KT) + (size_t)u * 8192 + row * 64 + c16 * 8) = *(const LAS u32x4*)(KTs + row * 72 + c16 * 8);
        *(u32x4*)((bf16_t*)(c.ws + IB_W) + (size_t)u * 8192 + p * 8) = *(const LAS u32x4*)(Wst + p * 8); }
    SEG_T1(15)
    __syncthreads();
}

DI void m1_unit_a(const Ctx& c0, int l, int u) {
    const Ctx c = fresh(c0); const Args& a = *c.a; const int tid = c.tid, lane = c.lane, wave = c.wave;
    const int b = u >> 7, h = (u >> 5) & 3, ci = u & 31;
    LAS float* Bf = (LAS float*)c.lds;
    LAS float* Qf = Bf + 8192;
    LAS float* Kf = Qf + 8192;
    LAS bf16_t* Pl = (LAS bf16_t*)Qf;
    LAS bf16_t* Qh = (LAS bf16_t*)(Kf + 8192);
    LAS bf16_t* Kd = Qh + 64 * 136;
    LAS bf16_t* Ko = Kd + 64 * 136;
    LAS float* tot = (LAS float*)(Ko + 32 * 136);
    const ProjPtr proj{(const float*)(c.ws + WS_PROJ)};
    const long rowb = (long)b * SEQ + 64 * ci;
    {
        float* gv = (float*)(c.ws + IA_V) + (size_t)u * 8192;
        const int idx = tid & 127, tq = tid >> 7;
        float x[4][16];
#pragma unroll
        for (int i = 0; i < 16; ++i) { const ProjPtr pr = proj + ((rowb + 16 * tq + i) * NINP + h * 128 + idx); x[0][i] = pr[C_AF]; x[1][i] = pr[C_AQ]; x[2][i] = pr[C_AI]; x[3][i] = pr[C_AG]; }
        const float nwt = inp(a, I_ANORM)[l * 128 + idx]; bf16_t* gg = (bf16_t*)(c.ws + IG_A) + ((size_t)u * 64 + 16 * tq) * 128 + idx;
        const float lb = lb_of(a, l, h * 128 + idx);
#pragma unroll
        for (int i = 0; i < 16; ++i) { const int t = 16 * tq + i; const float f = lb + (1.f - lb) * sigm(x[0][i]);
            Bf[t * 128 + idx] = fmaxf(__logf(f), -80.f); Kf[t * 128 + idx] = 1.f - f; Qf[t * 128 + idx] = silu(x[1][i]);
            gv[(((t >> 4) * 8 + (idx >> 4)) * 64 + (idx & 15) + 16 * ((t >> 2) & 3)) * 4 + (t & 3)] = x[2][i];
            gg[i * 128] = bf1(silu(x[3][i]) * nwt); }
    }
    __syncthreads();
    {
        const int d = tid & 127, q4 = tid >> 7; float run = 0.f;
#pragma unroll
        for (int i = 0; i < 16; ++i) { run += Bf[(16 * q4 + i) * 128 + d]; Bf[(16 * q4 + i) * 128 + d] = run; }
        tot[q4 * 128 + d] = run;
        __syncthreads();
        float off = 0.f;
        for (int q = 0; q < q4; ++q) off += tot[q * 128 + d];
        if (q4 > 0) {
#pragma unroll
            for (int i = 0; i < 16; ++i) Bf[(16 * q4 + i) * 128 + d] += off; }
    }
    __syncthreads();
    {
        const int t = tid >> 3, d0 = (tid & 7) * 16; bf16_t* gq = (bf16_t*)(c.ws + IA_Q) + ((size_t)u * 64 + t) * 128;
#pragma unroll
        for (int m = 0; m < 4; ++m) { const int d = d0 + 4 * m; const f32x4 bb = *(const LAS f32x4*)(Bf + t * 128 + d), q = *(const LAS f32x4*)(Qf + t * 128 + d), k = *(const LAS f32x4*)(Kf + t * 128 + d);
            const f32x4 b31 = *(const LAS f32x4*)(Bf + 31 * 128 + d); const f32x4 rr = b31 * ((t >= 32) ? 1.f : 0.f);
            *(u32x2*)(gq + kpos(d)) = (u32x2){pk2(q.x * __expf(bb.x), q.y * __expf(bb.y)), pk2(q.z * __expf(bb.z), q.w * __expf(bb.w))};
            *(LAS u32x2*)(Qh + t * 136 + d) = (u32x2){pk2(q.x * __expf(bb.x - rr.x), q.y * __expf(bb.y - rr.y)), pk2(q.z * __expf(bb.z - rr.z), q.w * __expf(bb.w - rr.w))};
            *(LAS u32x2*)(Kd + t * 136 + d) = (u32x2){pk2(k.x * __expf(fminf(rr.x - bb.x, 80.f)), k.y * __expf(fminf(rr.y - bb.y, 80.f))), pk2(k.z * __expf(fminf(rr.z - bb.z, 80.f)), k.w * __expf(fminf(rr.w - bb.w, 80.f)))};
            if (t < 32) *(LAS u32x2*)(Ko + t * 136 + d) = (u32x2){pk2(k.x * __expf(b31.x - bb.x), k.y * __expf(b31.y - bb.y)), pk2(k.z * __expf(b31.z - bb.z), k.w * __expf(b31.w - bb.w))}; }
        const int d = tid & 127, s0 = (tid >> 7) * 16; bf16_t* gk = (bf16_t*)(c.ws + IA_KT) + ((size_t)u * 128 + d) * 64; const float bC = Bf[63 * 128 + d];
#pragma unroll
        for (int m = 0; m < 4; ++m) { float v[4];
#pragma unroll
            for (int j = 0; j < 4; ++j) { const int s = s0 + 4 * m + j; v[j] = Kf[s * 128 + d] * __expf(bC - Bf[s * 128 + d]); }
            *(u32x2*)(gk + kpos(s0 + 4 * m)) = (u32x2){pk2(v[0], v[1]), pk2(v[2], v[3])}; }
        if (tid < 128) ((float*)(c.ws + IA_DEC))[(size_t)u * 128 + tid] = __expf(bC);
    }
    __syncthreads();
    {
        const int i = lane & 15, g = lane >> 4;
#pragma unroll
        for (int q2 = 0; q2 < 2; ++q2) { const int idx = 2 * wave + q2, tt = idx >> 2, st = idx & 3, I = tt >> 1, J = st >> 1; const int s = 16 * st + i;
            if (J <= I) {
                const LAS bf16_t* bsrc = (I == J ? Kd : Ko) + (16 * st + i) * 136;
                f32x4 acc = {0.f, 0.f, 0.f, 0.f};
#pragma unroll
                for (int ks = 0; ks < 4; ++ks) acc = MFMA16(*(const LAS bf16x8*)(Qh + (16 * tt + i) * 136 + 32 * ks + 8 * g), *(const LAS bf16x8*)(bsrc + 32 * ks + 8 * g), acc);
#pragma unroll
                for (int r = 0; r < 4; ++r) { const int t = 16 * tt + 4 * g + r; Pl[t * 72 + kpos(s)] = bf1((s <= t) ? acc[r] : 0.f); }
            } else {
#pragma unroll
                for (int r = 0; r < 4; ++r) Pl[(16 * tt + 4 * g + r) * 72 + kpos(s)] = 0;
            }
        }
    }
    __syncthreads();
    { const int row = tid >> 3, c16 = tid & 7; *(u32x4*)((bf16_t*)(c.ws + IA_P) + (size_t)u * 4096 + row * 64 + c16 * 8) = *(const LAS u32x4*)(Pl + row * 72 + c16 * 8); }
    __syncthreads();
}

DI void m1_unit_c(const Ctx& c0, int l, int u) {
    const Ctx c = fresh(c0); const Args& a = *c.a; const int tid = c.tid, lane = c.lane, wave = c.wave;
    const int b = u >> 7, n = (u >> 4) & 7, ti = u & 15;
    constexpr int TT = 128;
    LAS float* xcv = (LAS float*)c.lds;
    LAS float* ra = xcv + TT * 64;
    LAS float* ia = ra + TT * 64;
    LAS float* segA = ia + TT * 64;
    LAS float* segB = segA + 512;
    LAS bf16_t* xb = (LAS bf16_t*)(segB + 512);
    LAS bf16_t* Wt = xb + TT * 72;
    const ProjPtr proj{(const float*)(c.ws + WS_PROJ)};
    const long rowb = (long)b * SEQ + TT * ti; const int tg0 = TT * ti;
    const int cch = tid & 63, seg = tid >> 6, chg = n * 64 + cch;
    {
        const float* wa = inp(a, I_CWA) + ((size_t)l * 8 + n) * 4096; const float* wx = inp(a, I_CWX) + ((size_t)l * 8 + n) * 4096;
        float wv[16];
#pragma unroll
        for (int k = 0; k < 16; ++k) { const int e = tid + 512 * k; wv[k] = (e < 4096 ? wa : wx)[e & 4095]; }
        const float* ccw = inp(a, I_CCW) + (size_t)l * 4 * 512;
        const float w0 = ccw[chg], w1 = ccw[512 + chg], w2 = ccw[1024 + chg], w3 = ccw[1536 + chg], cb = inp(a, I_CCB)[l * 512 + chg];
        const int ts = seg * 16; const int col = C_CX + chg;
        float x[19];
#pragma unroll
        for (int jx = 0; jx < 19; ++jx) { const int t = ts - 3 + jx; x[jx] = (tg0 + t >= 0) ? proj[(rowb + t) * NINP + col] : 0.f; }
#pragma unroll
        for (int k = 0; k < 16; ++k) { const int e = tid + 512 * k, gate = e >> 12, i = (e >> 6) & 63, j = e & 63; Wt[(gate * 64 + j) * 72 + i] = bf1(wv[k]); }
#pragma unroll
        for (int i = 0; i < 16; ++i) { const float y = w0 * x[i] + w1 * x[i + 1] + w2 * x[i + 2] + w3 * x[i + 3] + cb; xcv[(ts + i) * 64 + cch] = y; xb[(ts + i) * 72 + cch] = bf1(y); }
    }
    __syncthreads();
    {
        const int i = lane & 15, g = lane >> 4;
        const bf16x8 a0 = *(const LAS bf16x8*)(xb + (16 * wave + i) * 72 + 8 * g), a1 = *(const LAS bf16x8*)(xb + (16 * wave + i) * 72 + 32 + 8 * g);
        const float* bsa = inp(a, I_CBA) + l * 512 + n * 64; const float* bsx = inp(a, I_CBX) + l * 512 + n * 64;
#pragma unroll
        for (int jt = 0; jt < 8; ++jt) { f32x4 acc = {0.f, 0.f, 0.f, 0.f};
            acc = MFMA16(a0, *(const LAS bf16x8*)(Wt + (16 * jt + i) * 72 + 8 * g), acc);
            acc = MFMA16(a1, *(const LAS bf16x8*)(Wt + (16 * jt + i) * 72 + 32 + 8 * g), acc);
            const int jc = 16 * (jt & 3) + i; const float bias = (jt < 4 ? bsa : bsx)[jc]; LAS float* dst = (jt < 4 ? ra : ia);
#pragma unroll
            for (int r = 0; r < 4; ++r) dst[(16 * wave + 4 * g + r) * 64 + jc] = sigm(acc[r] + bias); }
    }
    __syncthreads();
    const float spl = softplus(-inp(a, I_CLAM)[l * 512 + chg]);
    {
        float A = 1.f, B = 0.f;
        for (int i = 0; i < 16; ++i) { const int tt = seg * 16 + i; const float r = ra[tt * 64 + cch], ig = ia[tt * 64 + cch], x = xcv[tt * 64 + cch];
            const float la = -8.f * r * spl; const float at = __expf(la); float mult = sqrtf(fmaxf(0.f, -expm1f(2.f * la)));
            if (tg0 + tt == 0) mult = 1.f;
            const float bt = mult * (ig * x); ra[tt * 64 + cch] = at; ia[tt * 64 + cch] = bt; A *= at; B = at * B + bt; }
        segA[seg * 64 + cch] = A; segB[seg * 64 + cch] = B;
    }
    __syncthreads();
    {
        float Ac = 1.f, Bc = 0.f;
        for (int s = 0; s < seg; ++s) { const float sa = segA[s * 64 + cch], sb = segB[s * 64 + cch]; Bc = sa * Bc + sb; Ac *= sa; }
        float* ga = (float*)(c.ws + IC_A); float* gb = (float*)(c.ws + IC_B);
        for (int i = 0; i < 16; ++i) { const int tt = seg * 16 + i; const float at = ra[tt * 64 + cch], bt = ia[tt * 64 + cch]; Ac *= at; Bc = at * Bc + bt;
            ga[(rowb + tt) * 512 + chg] = Ac; gb[(rowb + tt) * 512 + chg] = Bc; }
        if (seg == 7) { float* gt = (float*)(c.ws + IC_TOT) + (((size_t)b * 16 + ti) * 2) * 512; gt[chg] = Ac; gt[512 + chg] = Bc; }
    }
    __syncthreads();
}

DI void phase_m1(const Ctx& c, int l) {
    int w = blockIdx.x; asm volatile("" : "+s"(w));
    for (int rep = 0; rep < (PROBE_SUB == 1 ? 2 : 1); ++rep) {
        M1BRegs R; { const Ctx cl = fresh(c); if (w < 1024) m1b_load(cl, l, w, R); }
        for (int u = w; u < 1024; u += GRID) m1_unit_b(c, l, u, u + GRID, R); }
    for (int rep = 0; rep < (PROBE_SUB == 2 ? 2 : 1); ++rep) for (int u = w; u < 512; u += GRID) m1_unit_a(c, l, u);
    for (int rep = 0; rep < (PROBE_SUB == 3 ? 2 : 1); ++rep) for (int u = w; u < 512; u += GRID) m1_unit_c(c, l, u);
}

DI void m2_unit_head(const Ctx& c0, int l, int isB, int b, int h) {
    const Ctx c = fresh(c0); const Args& a = *c.a; const int tid = c.tid, lane = c.lane, wave = c.wave;
    LAS unsigned char* Wl = c.lds;
    LAS unsigned char* Ql = Wl + 64 * 272;
    LAS unsigned char* KTl = Ql + 64 * 272;
    LAS unsigned char* Pl = KTl + 128 * 144;
    LAS float* ob = (LAS float*)(Pl + 64 * 144);
    LAS float* decl = ob + 64 * 132;
    const int i = lane & 15, g = lane >> 4, e0 = 16 * wave;
    const int ubase = isB ? ((b * 8 + h) * 32) : ((b * 4 + h) * 32);
    const unsigned char* gW = c.ws + IB_W; const unsigned char* gQ = c.ws + (isB ? IB_Q : IA_Q); const unsigned char* gKT = c.ws + (isB ? IB_KT : IA_KT);
    const unsigned char* gP = c.ws + (isB ? IB_P : IA_P); const float* gU = (const float*)(c.ws + (isB ? IB_U0 : IA_V));
    const ProjPtr proj{(const float*)(c.ws + WS_PROJ)}; bf16_t* mixo = (bf16_t*)(c.ws + WS_MIXO);
    const bf16_t* gG = (const bf16_t*)(c.ws + (isB ? IG_B : IG_A));
    const int ocol = isB ? (512 + h * 128) : (h * 128);
    f32x4 S[8];
#pragma unroll
    for (int dt = 0; dt < 8; ++dt) S[dt] = (f32x4){0.f, 0.f, 0.f, 0.f};
    u32x4 pw[2], pq[2], pk[2], pp, pd = {0u, 0u, 0u, 0u};
    const int r16 = tid >> 4, c16 = tid & 15, r8 = tid >> 3, c8 = tid & 7;
#define M2_LOAD(ch) do { const size_t uu = (size_t)(ubase + (ch)); \
        if (isB) { pw[0] = *(const u32x4*)(gW + uu * 16384 + tid * 16); pw[1] = *(const u32x4*)(gW + uu * 16384 + (tid + 512) * 16); } \
        pq[0] = *(const u32x4*)(gQ + uu * 16384 + tid * 16); pq[1] = *(const u32x4*)(gQ + uu * 16384 + (tid + 512) * 16); \
        pk[0] = *(const u32x4*)(gKT + uu * 16384 + tid * 16); pk[1] = *(const u32x4*)(gKT + uu * 16384 + (tid + 512) * 16); \
        pp = *(const u32x4*)(gP + uu * 8192 + tid * 16); \
        if (!isB && tid < 32) pd = *(const u32x4*)(c.ws + IA_DEC + uu * 512 + tid * 16); } while (0)
#define M2_STORE() do { \
        if (isB) { *(LAS u32x4*)(Wl + r16 * 272 + c16 * 16) = pw[0]; *(LAS u32x4*)(Wl + (r16 + 32) * 272 + c16 * 16) = pw[1]; } \
        *(LAS u32x4*)(Ql + r16 * 272 + c16 * 16) = pq[0]; *(LAS u32x4*)(Ql + (r16 + 32) * 272 + c16 * 16) = pq[1]; \
        *(LAS u32x4*)(KTl + r8 * 144 + c8 * 16) = pk[0]; *(LAS u32x4*)(KTl + (r8 + 64) * 144 + c8 * 16) = pk[1]; \
        *(LAS u32x4*)(Pl + r8 * 144 + c8 * 16) = pp; \
        if (!isB && tid < 32) *(LAS u32x4*)((LAS unsigned char*)decl + tid * 16) = pd; } while (0)
    M2_LOAD(0);
    M2_STORE();
    f32x4 U[4]; unsigned gt[8], gtn[8], outp[8]; float dec = 0.f, decn = 0.f;
#define M2_LOADU(ch) do { const size_t uu_ = (size_t)(ubase + (ch)); \
        _Pragma("unroll") for (int tt = 0; tt < 4; ++tt) U[tt] = *(const f32x4*)(gU + uu_ * 8192 + ((tt * 8 + wave) * 64 + lane) * 4); } while (0)
#define M2_LOADR(ch, GT, DEC) do { const size_t uu_ = (size_t)(ubase + (ch)); \
        _Pragma("unroll") for (int k = 0; k < 8; ++k) GT[k] = *(const unsigned*)(gG + (uu_ * 64 + 8 * wave + k) * 128 + 2 * lane); \
        if (isB) DEC = ((const float*)(c.ws + IB_DEC))[uu_]; } while (0)
    M2_LOADU(0);
    M2_LOADR(0, gt, dec);
    __syncthreads();
    for (int ci = 0; ci < 32; ++ci) {
        const long row0 = (long)b * SEQ + 64 * ci;
        SEG_T0(20)
        asm volatile("" : "+v"(U[0]), "+v"(U[1]), "+v"(U[2]), "+v"(U[3]), "+v"(dec));
        asm volatile("" : "+v"(gt[0]), "+v"(gt[1]), "+v"(gt[2]), "+v"(gt[3]), "+v"(gt[4]), "+v"(gt[5]), "+v"(gt[6]), "+v"(gt[7]));
        if (ci > 0) {
#pragma unroll
            for (int k = 0; k < 8; ++k) *(unsigned*)(mixo + (row0 - 64 + 8 * wave + k) * D + ocol + 2 * lane) = outp[k]; }
        if (ci + 1 < 32) { M2_LOAD(ci + 1); M2_LOADR(ci + 1, gtn, decn); }
        bf16x8 Sb[4];
#pragma unroll
        for (int ks = 0; ks < 4; ++ks) { u32x4 p; p.x = pk2(S[2 * ks][0], S[2 * ks][1]); p.y = pk2(S[2 * ks][2], S[2 * ks][3]); p.z = pk2(S[2 * ks + 1][0], S[2 * ks + 1][1]); p.w = pk2(S[2 * ks + 1][2], S[2 * ks + 1][3]); Sb[ks] = __builtin_bit_cast(bf16x8, p); }
#define M2_SCHED() __builtin_amdgcn_sched_barrier(0)
        if (isB) {
#pragma unroll
            for (int hf = 0; hf < 2; ++hf) { bf16x8 fr[8];
#pragma unroll
                for (int j = 0; j < 8; ++j) fr[j] = *(const LAS bf16x8*)(Wl + (16 * (2 * hf + (j >> 2)) + i) * 272 + (32 * (j & 3) + 8 * g) * 2);
                M2_SCHED();
                f32x4 a0 = {0.f, 0.f, 0.f, 0.f}, a1 = {0.f, 0.f, 0.f, 0.f};
#pragma unroll
                for (int ks = 0; ks < 4; ++ks) { a0 = MFMA16(fr[ks], Sb[ks], a0); a1 = MFMA16(fr[4 + ks], Sb[ks], a1); }
                U[2 * hf] = U[2 * hf] - a0; U[2 * hf + 1] = U[2 * hf + 1] - a1;
                M2_SCHED(); }
        }
        bf16x8 Ub[2];
#pragma unroll
        for (int k = 0; k < 2; ++k) { u32x4 p; p.x = pk2(U[2 * k][0], U[2 * k][1]); p.y = pk2(U[2 * k][2], U[2 * k][3]); p.z = pk2(U[2 * k + 1][0], U[2 * k + 1][1]); p.w = pk2(U[2 * k + 1][2], U[2 * k + 1][3]); Ub[k] = __builtin_bit_cast(bf16x8, p); }
        SEG_T1(20)
        SEG_T0(21)
        asm volatile("" : "+v"(Ub[0]), "+v"(Ub[1]));
        if (ci + 1 < 32) M2_LOADU(ci + 1);
#pragma unroll
        for (int hf = 0; hf < 2; ++hf) { bf16x8 fq[8], fp[4];
#pragma unroll
            for (int j = 0; j < 8; ++j) fq[j] = *(const LAS bf16x8*)(Ql + (16 * (2 * hf + (j >> 2)) + i) * 272 + (32 * (j & 3) + 8 * g) * 2);
            M2_SCHED();
            f32x4 a0 = {0.f, 0.f, 0.f, 0.f}, a1 = {0.f, 0.f, 0.f, 0.f};
#pragma unroll
            for (int ks = 0; ks < 4; ++ks) { a0 = MFMA16(fq[ks], Sb[ks], a0); a1 = MFMA16(fq[4 + ks], Sb[ks], a1); }
            M2_SCHED();
#pragma unroll
            for (int j = 0; j < 4; ++j) fp[j] = *(const LAS bf16x8*)(Pl + (16 * (2 * hf + (j >> 1)) + i) * 144 + (32 * (j & 1) + 8 * g) * 2);
            M2_SCHED();
#pragma unroll
            for (int k = 0; k < 2; ++k) { a0 = MFMA16(fp[k], Ub[k], a0); a1 = MFMA16(fp[2 + k], Ub[k], a1); }
#pragma unroll
            for (int r = 0; r < 4; ++r) { ob[(16 * (2 * hf) + 4 * g + r) * 132 + e0 + i] = a0[r]; ob[(16 * (2 * hf + 1) + 4 * g + r) * 132 + e0 + i] = a1[r]; }
            M2_SCHED(); }
        if (isB) {
#pragma unroll
            for (int dt = 0; dt < 8; ++dt) S[dt] = S[dt] * dec;
        } else {
#pragma unroll
            for (int dt = 0; dt < 8; ++dt) S[dt] = S[dt] * *(const LAS f32x4*)(decl + 16 * dt + 4 * g); }
#pragma unroll
        for (int hf = 0; hf < 2; ++hf) { bf16x8 fk[8];
#pragma unroll
            for (int j = 0; j < 8; ++j) fk[j] = *(const LAS bf16x8*)(KTl + (16 * (4 * hf + (j >> 1)) + i) * 144 + (32 * (j & 1) + 8 * g) * 2);
            M2_SCHED();
#pragma unroll
            for (int j = 0; j < 8; ++j) S[4 * hf + (j >> 1)] = MFMA16(fk[j], Ub[j & 1], S[4 * hf + (j >> 1)]);
            M2_SCHED(); }
#undef M2_SCHED
        SEG_T1(21)
        SEG_T0(22)
        __syncthreads();
        SEG_T1(22)
        SEG_T0(23)
        { f32x2 vv[8]; float ss[8];
#pragma unroll
          for (int k = 0; k < 8; ++k) vv[k] = *(const LAS f32x2*)(ob + (8 * wave + k) * 132 + 2 * lane);
#pragma unroll
          for (int k = 0; k < 8; ++k) ss[k] = row16_sum(vv[k].x * vv[k].x + vv[k].y * vv[k].y);
#pragma unroll
          for (int k = 0; k < 8; ++k) ss[k] = __int_as_float(__builtin_amdgcn_readlane(__float_as_int(ss[k]), 0)) + __int_as_float(__builtin_amdgcn_readlane(__float_as_int(ss[k]), 16)) +
              __int_as_float(__builtin_amdgcn_readlane(__float_as_int(ss[k]), 32)) + __int_as_float(__builtin_amdgcn_readlane(__float_as_int(ss[k]), 48));
#pragma unroll
          for (int k = 0; k < 8; ++k) { const float r = rsqrtf(ss[k] * (1.f / 128.f) + NORM_EPS);
            outp[k] = pk2(vv[k].x * r * __uint_as_float(gt[k] << 16), vv[k].y * r * __uint_as_float(gt[k] & 0xffff0000u)); } }
        SEG_T1(23)
        SEG_T0(24)
        if (ci + 1 < 32) { M2_STORE();
#pragma unroll
            for (int k = 0; k < 8; ++k) gt[k] = gtn[k];
            dec = decn; }
        __syncthreads();
        SEG_T1(24)
    }
#pragma unroll
    for (int k = 0; k < 8; ++k) *(unsigned*)(mixo + ((long)b * SEQ + 64 * 31 + 8 * wave + k) * D + ocol + 2 * lane) = outp[k];
#undef M2_LOADR
#undef M2_LOADU
#undef M2_LOAD
#undef M2_STORE
    float* so = c.out + (isB ? O_GDP + (((size_t)l * BATCH + b) * 8 + h) * 16384 : O_HGP + (((size_t)l * BATCH + b) * 4 + h) * 16384);
#pragma unroll
    for (int dt = 0; dt < 8; ++dt)
#pragma unroll
        for (int r = 0; r < 4; ++r) so[(size_t)(16 * dt + 4 * g + r) * 128 + e0 + i] = S[dt][r];
}

DI void m2_unit_cfin(const Ctx& c0, int l, int u) {
    const Ctx c = fresh(c0); const int tid = c.tid;
    const int b = u >> 7, n = (u >> 4) & 7, ti = u & 15;
    const int cch = tid & 63, seg = tid >> 6, chg = n * 64 + cch;
    const ProjPtr proj{(const float*)(c.ws + WS_PROJ)}; bf16_t* mixo = (bf16_t*)(c.ws + WS_MIXO);
    const float* ga = (const float*)(c.ws + IC_A); const float* gb = (const float*)(c.ws + IC_B);
    const float* gt = (const float*)(c.ws + IC_TOT) + ((size_t)b * 16 * 2) * 512;
    float hs = 0.f;
    { float ta[15], tb[15];
#pragma unroll
      for (int k = 0; k < 15; ++k) { ta[k] = gt[(k * 2) * 512 + chg]; tb[k] = gt[(k * 2 + 1) * 512 + chg]; }
#pragma unroll
      for (int k = 0; k < 15; ++k) if (k < ti) hs = ta[k] * hs + tb[k]; }
    const long rowb = (long)b * SEQ + 128 * ti;
    float hh = 0.f;
    { float va[16], vb[16], vg[16];
#pragma unroll
      for (int i = 0; i < 16; ++i) { const long row = rowb + seg * 16 + i; va[i] = ga[row * 512 + chg]; vb[i] = gb[row * 512 + chg]; vg[i] = proj[row * NINP + C_CG + chg]; }
#pragma unroll
      for (int i = 0; i < 16; ++i) { const long row = rowb + seg * 16 + i; hh = vb[i] + va[i] * hs; mixo[row * D + 1536 + chg] = bf1(hh * gelu_tanh(vg[i])); } }
    if (ti == 15 && seg == 7) c.out[O_RHP + ((size_t)l * BATCH + b) * 512 + chg] = hh;
}

DI void block_reduce_cols(LAS float* red, LAS float* full, const float (&p)[4], int tid, float scale) {
    const int e4 = (tid & 31) * 4, dgp = tid >> 5;
    *(LAS f32x4*)(red + dgp * 128 + e4) = (f32x4){p[0], p[1], p[2], p[3]};
    __syncthreads();
    if (tid < 128) { float s = 0.f;
#pragma unroll
        for (int k = 0; k < 16; ++k) s += red[k * 128 + tid];
        full[tid] = s * scale; }
    __syncthreads();
}
DI void unit_b_sample(const Ctx& c0, int l, int b, int h) {
    const Ctx c = fresh(c0);
    const Args& a = *c.a; const int tid = c.tid, lane = c.lane, wave = c.wave;
    LAS float* qkv = (LAS float*)c.lds;
    LAS float* scl = qkv + 384;
    LAS float* red = scl + 8;
    LAS float* full = red + 2048;
    LAS float* uu = full + 128;
    const ProjPtr proj = ProjPtr{(const float*)(c.ws + WS_PROJ)} + (long)(NP + b) * NINP;
    const int e4 = (tid & 31) * 4, d0 = (tid >> 5) * 8;
    const size_t sidx = (((size_t)l * NS + b) * 8 + h) * 16384;
    const float* Sin = inp(a, I_SGD) + sidx; float* Sout = c.out + O_GDS + sidx;
    f32x4 S[8];
#pragma unroll
    for (int i = 0; i < 8; ++i) S[i] = *(const f32x4*)(Sin + (size_t)(d0 + i) * 128 + e4);
    float gz = 0.f, nwt = 0.f;
    if (tid < 128) { gz = proj[C_BZ + h * 128 + tid]; nwt = inp(a, I_BNORM)[l * 128 + tid]; }
    if (tid < 384) { const int part = tid >> 7, idx = tid & 127, cc = part * 1024 + h * 128 + idx;
        const float* cw = inp(a, I_BCW) + (size_t)l * 4 * 3072; const float* st = inp(a, I_SGC) + (((size_t)l * NS + b) * 3) * 3072;
        const float x0 = st[cc], x1 = st[3072 + cc], x2 = st[2 * 3072 + cc], x3 = proj[C_BQ + cc];
        qkv[tid] = silu(cw[cc] * x0 + cw[3072 + cc] * x1 + cw[2 * 3072 + cc] * x2 + cw[3 * 3072 + cc] * x3);
        float* so = c.out + O_GCS + (((size_t)l * NS + b) * 3) * 3072; so[cc] = x1; so[3072 + cc] = x2; so[2 * 3072 + cc] = x3; }
    if (tid == 384) { const float bb = proj[C_BB + h], ba = proj[C_BA + h]; scl[0] = sigm(bb); scl[1] = __expf(-__expf(inp(a, I_BALOG)[l * 8 + h]) * softplus(ba + inp(a, I_BDT)[l * 8 + h])); }
    __syncthreads();
    if (wave < 2) { const float x0 = qkv[wave * 128 + lane], x1 = qkv[wave * 128 + 64 + lane]; const float ss = wave_sum_fast(x0 * x0 + x1 * x1);
        if (lane == 0) scl[2 + wave] = rsqrtf(ss + L2_EPS) * (wave == 0 ? 0.08838834764831845f : 1.f); }
    __syncthreads();
    const float beta = scl[0], eg = scl[1], sq = scl[2], sk = scl[3];
    float p[4] = {0.f, 0.f, 0.f, 0.f};
#pragma unroll
    for (int i = 0; i < 8; ++i) { const float k = qkv[128 + d0 + i]; p[0] += k * S[i].x; p[1] += k * S[i].y; p[2] += k * S[i].z; p[3] += k * S[i].w; }
    block_reduce_cols(red, full, p, tid, sk);
    if (tid < 128) uu[tid] = beta * (qkv[256 + tid] - eg * full[tid]) * sk;
    __syncthreads();
    const f32x4 u4 = *(const LAS f32x4*)(uu + e4);
    float po[4] = {0.f, 0.f, 0.f, 0.f};
#pragma unroll
    for (int i = 0; i < 8; ++i) { const float k = qkv[128 + d0 + i], q = qkv[d0 + i]; S[i] = S[i] * eg + u4 * k; *(f32x4*)(Sout + (size_t)(d0 + i) * 128 + e4) = S[i];
        po[0] += q * S[i].x; po[1] += q * S[i].y; po[2] += q * S[i].z; po[3] += q * S[i].w; }
    block_reduce_cols(red, full, po, tid, sq);
    if (wave < 2) { const float o = full[wave * 64 + lane]; const float ss = wave_sum_fast(o * o); if (lane == 0) scl[4 + wave] = ss; }
    __syncthreads();
    if (tid < 128) { const float rms = rsqrtf((scl[4] + scl[5]) * (1.f / 128.f) + NORM_EPS);
        const float o = full[tid] * rms * nwt * silu(gz);
        ((bf16_t*)(c.ws + WS_MIXO))[(size_t)(NP + b) * D + 512 + h * 128 + tid] = (bf16_t)(pk2(o, 0.f) & 0xffffu); }
    __syncthreads();
}
DI void unit_a_sample(const Ctx& c0, int l, int b, int h) {
    const Ctx c = fresh(c0);
    const Args& a = *c.a; const int tid = c.tid, lane = c.lane, wave = c.wave;
    LAS float* fqv = (LAS float*)c.lds;
    LAS float* scl = fqv + 384;
    LAS float* red = scl + 8;
    LAS float* full = red + 2048;
    const ProjPtr proj = ProjPtr{(const float*)(c.ws + WS_PROJ)} + (long)(NP + b) * NINP;
    const int e4 = (tid & 31) * 4, d0 = (tid >> 5) * 8;
    const size_t sidx = (((size_t)l * NS + b) * 4 + h) * 16384;
    const float* Sin = inp(a, I_SHG) + sidx; float* Sout = c.out + O_HGS + sidx;
    f32x4 S8[8];
#pragma unroll
    for (int i = 0; i < 8; ++i) S8[i] = *(const f32x4*)(Sin + (size_t)(d0 + i) * 128 + e4);
    float gz = 0.f, nwt = 0.f;
    if (tid < 128) { gz = proj[C_AG + h * 128 + tid]; nwt = inp(a, I_ANORM)[l * 128 + tid]; }
    if (tid < 384) { const int part = tid >> 7, idx = tid & 127;
        if (part == 0) { const float lb = lb_of(a, l, h * 128 + idx); fqv[tid] = lb + (1.f - lb) * sigm(proj[C_AF + h * 128 + idx]); }
        else if (part == 1) fqv[tid] = silu(proj[C_AQ + h * 128 + idx]);
        else fqv[tid] = proj[C_AI + h * 128 + idx]; }
    __syncthreads();
    const f32x4 v4 = *(const LAS f32x4*)(fqv + 256 + e4);
    float po[4] = {0.f, 0.f, 0.f, 0.f};
#pragma unroll
    for (int i = 0; i < 8; ++i) { const float f = fqv[d0 + i], q = fqv[128 + d0 + i]; f32x4 S = S8[i];
        S = S * f + v4 * (1.f - f); *(f32x4*)(Sout + (size_t)(d0 + i) * 128 + e4) = S;
        po[0] += q * S.x; po[1] += q * S.y; po[2] += q * S.z; po[3] += q * S.w; }
    block_reduce_cols(red, full, po, tid, 1.f);
    if (wave < 2) { const float o = full[wave * 64 + lane]; const float ss = wave_sum_fast(o * o); if (lane == 0) scl[4 + wave] = ss; }
    __syncthreads();
    if (tid < 128) { const float rms = rsqrtf((scl[4] + scl[5]) * (1.f / 128.f) + NORM_EPS);
        const float o = full[tid] * rms * nwt * silu(gz);
        ((bf16_t*)(c.ws + WS_MIXO))[(size_t)(NP + b) * D + h * 128 + tid] = (bf16_t)(pk2(o, 0.f) & 0xffffu); }
    __syncthreads();
}
DI void unit_c_sample(const Ctx& c0, int l, int b) {
    const Ctx c = fresh(c0);
    const Args& a = *c.a; const int tid = c.tid;
    LAS float* xc = (LAS float*)c.lds;
    const ProjPtr proj = ProjPtr{(const float*)(c.ws + WS_PROJ)} + (long)(NP + b) * NINP;
    const float* ccw = inp(a, I_CCW) + (size_t)l * 4 * 512; const float* st = inp(a, I_SRC) + (((size_t)l * NS + b) * 3) * 512;
    const float x0 = st[tid], x1 = st[512 + tid], x2 = st[1024 + tid], x3 = proj[C_CX + tid];
    const float xv = ccw[tid] * x0 + ccw[512 + tid] * x1 + ccw[1024 + tid] * x2 + ccw[1536 + tid] * x3 + inp(a, I_CCB)[l * 512 + tid];
    xc[tid] = xv;
    { float* so = c.out + O_RCS + (((size_t)l * NS + b) * 3) * 512; so[tid] = x1; so[512 + tid] = x2; so[1024 + tid] = x3; }
    __syncthreads();
    const int n = tid >> 6, j = tid & 63;
    const float* wa = inp(a, I_CWA) + ((size_t)l * 8 + n) * 4096 + j; const float* wx = inp(a, I_CWX) + ((size_t)l * 8 + n) * 4096 + j;
    float sa = 0.f, sx = 0.f;
#pragma unroll 8
    for (int i = 0; i < 64; ++i) { const float x = xc[n * 64 + i]; sa += x * wa[i * 64]; sx += x * wx[i * 64]; }
    const float r = sigm(sa + inp(a, I_CBA)[l * 512 + tid]), ig = sigm(sx + inp(a, I_CBX)[l * 512 + tid]);
    const float la = -8.f * r * softplus(-inp(a, I_CLAM)[l * 512 + tid]); const float at = __expf(la); const float mult = sqrtf(fmaxf(0.f, -expm1f(2.f * la)));
    const float h0 = inp(a, I_SRH)[((size_t)l * NS + b) * 512 + tid];
    const float hh = at * h0 + mult * (ig * xv);
    c.out[O_RHS + ((size_t)l * NS + b) * 512 + tid] = hh;
    ((bf16_t*)(c.ws + WS_MIXO))[(size_t)(NP + b) * D + 1536 + tid] = (bf16_t)(pk2(hh * gelu_tanh(proj[C_CG + tid]), 0.f) & 0xffffu);
    __syncthreads();
}


DI void phase_m2(const Ctx& c, int l) {
    int w = blockIdx.x; asm volatile("" : "+s"(w));
    if (w < 48) {
        const int isB = w < 32; const int u = isB ? w : w - 32;
        for (int rep = 0; rep < (PROBE_SUB == 4 ? 2 : 1); ++rep) m2_unit_head(c, l, isB, isB ? (u >> 3) : (u >> 2), isB ? (u & 7) : (u & 3));
    } else {
        const int nw = GRID - 48;
        for (int rep = 0; rep < (PROBE_SUB == 5 ? 2 : 1); ++rep)
        for (int u = w - 48; u < 512 + 1664; u += nw) {
            if (u < 512) m2_unit_cfin(c, l, u);
            else { const int v = u - 512;
                if (v < 1024) unit_b_sample(c, l, v >> 3, v & 7);
                else if (v < 1536) { const int x = v - 1024; unit_a_sample(c, l, x >> 2, x & 3); }
                else unit_c_sample(c, l, v - 1536); }
        }
        { const Ctx cv = fresh(c); __syncthreads();
          convert_range(cv, l == 0 ? CV_IN : CV_LAYER + CV_IN, l == 0 ? CV_LAYER + CV_IN : 2 * CV_LAYER, (w - 48) * 8 + cv.wave, nw * 8); }
        const Ctx cc = fresh(c); const ProjPtr proj{(const float*)(cc.ws + WS_PROJ)};
        const int gt_ = (w - 48) * 512 + cc.tid, NT = nw * 512;
        for (int i = gt_; i < BATCH * 3 * 3072; i += NT) { const int b = i / (3 * 3072), r = i - b * 3 * 3072, j = r / 3072, ch = r - j * 3072;
            cc.out[O_GCP + (size_t)l * BATCH * 3 * 3072 + i] = proj[((size_t)b * SEQ + SEQ - 3 + j) * NINP + C_BQ + ch]; }
        for (int i = gt_; i < BATCH * 3 * 512; i += NT) { const int b = i / (3 * 512), r = i - b * 3 * 512, j = r / 512, ch = r - j * 512;
            cc.out[O_RCP + (size_t)l * BATCH * 3 * 512 + i] = proj[((size_t)b * SEQ + SEQ - 3 + j) * NINP + C_CX + ch]; }
    }
}


#define XB_TMO      128
#define XB_XCNT(j)  (256  + 64 * (j))
#define XB_XSUB(j)  (1280 + 64 * (j))
#define XB_XGEN(j)  (2304 + 64 * (j))
#define XB_TOP      3328
#define XB_TOPGEN   3392
#define XCD_BAR_WORDS 3456
#define XB_SPIN_CAP (1u << 20)
DI unsigned xb_ld(unsigned* p)              { return __hip_atomic_load(p, __ATOMIC_RELAXED, __HIP_MEMORY_SCOPE_AGENT); }
DI unsigned xb_add(unsigned* p, unsigned v) { return __hip_atomic_fetch_add(p, v, __ATOMIC_RELAXED, __HIP_MEMORY_SCOPE_AGENT); }
DI unsigned xb_xcc_id() { return (unsigned)__builtin_amdgcn_s_getreg((3 << 11) | 20) & 0xFu; }
#define XB_SPIN(cond, bar) do { unsigned _sp = 0; while (cond) { __builtin_amdgcn_s_sleep(1); \
    if ((++_sp & 255u) == 0u) { if (xb_ld(&(bar)[XB_TMO])) break; if (_sp > XB_SPIN_CAP) { atomicAdd(&(bar)[XB_TMO], 1u); break; } } } } while (0)
DI void xcd_barrier_post(unsigned* bar) { if (threadIdx.x == 0) (void)xb_add(&bar[XB_XCNT(xb_xcc_id())], 1u); }
DI void xcd_barrier_complete(unsigned* bar, unsigned x, unsigned& nloc, unsigned& nx) {
    const unsigned G = gridDim.x * gridDim.y * gridDim.z;
    unsigned sum, cnt, mine, sp = 0u;
    for (;;) {
        sum = 0u; cnt = 0u; mine = 0u;
#pragma unroll
        for (unsigned j = 0; j < 16; ++j) { const unsigned c = xb_ld(&bar[XB_XCNT(j)]); sum += c; cnt += (c > 0u) ? 1u : 0u; mine = (j == x) ? c : mine; }
        if (sum == G) break;
        __builtin_amdgcn_s_sleep(1);
        if ((++sp & 255u) == 0u) { if (xb_ld(&bar[XB_TMO])) break; if (sp > XB_SPIN_CAP) { atomicAdd(&bar[XB_TMO], 1u); break; } }
    }
    nloc = mine > 0u ? mine : 1u; nx = cnt > 0u ? cnt : 1u;
}
DI void xcd_barrier(unsigned* bar, volatile LAS unsigned* st) {
    asm volatile("s_waitcnt vmcnt(0)" ::: "memory");
    __syncthreads();
    if (threadIdx.x == 0) {
        const unsigned x = xb_xcc_id();
        __builtin_amdgcn_s_waitcnt(0);
        unsigned nloc = st[0], nx = st[1];
        if (nloc == 0u) { xcd_barrier_complete(bar, x, nloc, nx); st[0] = nloc; st[1] = nx; }
        const unsigned old = xb_add(&bar[XB_XSUB(x)], 1u);
        const unsigned gen = old / nloc;
        if (old + 1u == (gen + 1u) * nloc) {
            __builtin_amdgcn_fence(__ATOMIC_RELEASE, "agent");
            asm volatile("s_waitcnt vmcnt(0)" ::: "memory");
            const unsigned og = xb_add(&bar[XB_TOP], 1u);
            const unsigned tg = og / nx;
            if (og + 1u == (tg + 1u) * nx) xb_add(&bar[XB_TOPGEN], 1u);
            else XB_SPIN(xb_ld(&bar[XB_TOPGEN]) == tg, bar);
            __builtin_amdgcn_fence(__ATOMIC_ACQUIRE, "agent");
            xb_add(&bar[XB_XGEN(x)], 1u);
            asm volatile("s_waitcnt vmcnt(0)" ::: "memory");
        } else {
            XB_SPIN(xb_ld(&bar[XB_XGEN(x)]) == gen, bar);
            __builtin_amdgcn_fence(__ATOMIC_ACQUIRE, "agent");
            asm volatile("s_waitcnt vmcnt(0)" ::: "memory");
        }
    }
    __syncthreads();
}

__global__ void __launch_bounds__(512, 2) fwd_megakernel(Args args) {
    extern __shared__ __attribute__((aligned(16))) unsigned char lds_raw[];
    Ctx c0; c0.a = &args; c0.ws = nullptr; c0.out = nullptr; c0.lds = (LAS unsigned char*)lds_raw; c0.tid = 0; c0.lane = 0; c0.wave = 0; c0.G = GRID; c0.bid = 0;
    const int lo = args.ph_lo, hi = args.ph_hi;
    volatile LAS unsigned* bst = (volatile LAS unsigned*)((LAS unsigned char*)lds_raw + LDS_BYTES - 16);
    if (threadIdx.x == 0) { bst[0] = 0u; bst[1] = 0u; }
    __syncthreads();
    xcd_barrier_post((unsigned*)(args.ws + WS_CTL) + 1024);
#pragma unroll 1
    for (int ph2 = 2 * lo; ph2 < 2 * hi; ++ph2) {
        const int ph = ph2 >> 1;
        const int l = (ph - 1) >> 3, k = (ph == 0) ? -1 : ((ph - 1) & 7);
        if ((ph2 & 1) && k != PROBE_REP) continue;
        if (k == -1) phase_p0(c0);
        else if (k == 0 || k == 3 || k == 5 || k == 6) {
            const Ctx c = fresh(c0); unsigned char* ws = c.ws;
            pg8::Gemm g; pg8::EpiAny E; E.mode = 2; E.C = nullptr; E.O = (bf16_t*)(ws + WS_MIXF); E.ldc = D;
            if (k == 0)      { g.A = (const bf16_t*)(ws + WS_HBUF); g.Bt = (const bf16_t*)(ws + WS_WIN + l * SZ_WIN);   g.N = NINP; g.K = D;   E.mode = 0; E.C = (float*)(ws + WS_PROJ); E.ldc = NINP; }
            else if (k == 3) { g.A = (const bf16_t*)(ws + WS_MIXO); g.Bt = (const bf16_t*)(ws + WS_WOUT + l * SZ_WOUT); g.N = D;    g.K = D; }
            else if (k == 5) { g.A = (const bf16_t*)(ws + WS_HBUF); g.Bt = (const bf16_t*)(ws + WS_WGU + l * SZ_WGU);   g.N = NGU;  g.K = D;   E.mode = 1; E.O = (bf16_t*)(ws + WS_PROJ); E.ldc = DFF; }
            else             { g.A = (const bf16_t*)(ws + WS_PROJ); g.Bt = (const bf16_t*)(ws + WS_WDN + l * SZ_WDN);   g.N = D;    g.K = DFF; }
            g.M = (k == 3 || k == 6) ? NP : MPAD;
            pg8::StaticOrder S; S.init(g.M, g.N, GRID, c.bid);
            pg8::gemm_phase<pg8::EpiAny, pg8::StaticOrder, true, true>(c.lds, g, S, E);
            if (k == 3 || k == 6) sample_pieces(c0, g.A + (size_t)NP * g.K, g.Bt, g.K, (float*)(ws + WS_SLAB));
        }
        else if (k == 1) phase_m1(c0, l);
        else if (k == 2) phase_m2(c0, l);
        else {
            const Ctx c = fresh(c0); unsigned char* ws = c.ws;
            float* mixf = (float*)(ws + WS_MIXF); float* x1 = (float*)(ws + WS_X1); bf16_t* hb = (bf16_t*)(ws + WS_HBUF);
            if (k == 4) {
                const float* xa = (l == 0) ? inp(args, I_XP) : c.out; const float* xb = (l == 0) ? inp(args, I_XS) : c.out + (size_t)NP * D;
                row_phase(c0, (const bf16_t*)mixf, (const float*)(ws + WS_SLAB), xa, xb, x1, inp(args, I_LN2) + l * D, inp(args, I_LN3) + l * D, hb);
            } else {
                row_phase(c0, (const bf16_t*)mixf, (const float*)(ws + WS_SLAB), x1, x1 + (size_t)NP * D, c.out, inp(args, I_LN4) + l * D, l == 0 ? inp(args, I_LN1) + D : nullptr, hb);
            }
        }
        if (ph2 + 1 < 2 * hi) {
            if (args.ph_hi < 0) cg::this_grid().sync();
            xcd_barrier((unsigned*)(args.ws + WS_CTL) + 1024, bst);
        }
    }
}

extern "C" void kernel_launch(void* const* d_in, const int* in_sizes, int n_in, void* d_out, int out_size, void* d_ws, size_t ws_size, hipStream_t stream) {
    static int grid = 0;
    if (grid == 0) {
        if (n_in != 29 || (size_t)out_size != O_END || ws_size < WS_END) { fprintf(stderr, "kernel_launch: unexpected shapes: n_in %d out %d ws %zu (need %zu)\n", n_in, out_size, ws_size, (size_t)WS_END); grid = -1; return; }
        int dev = 0, cus = 0, per_cu = 0;
        hipGetDevice(&dev); hipDeviceGetAttribute(&cus, hipDeviceAttributeMultiprocessorCount, dev);
        if (hipFuncSetAttribute((const void*)fwd_megakernel, hipFuncAttributeMaxDynamicSharedMemorySize, LDS_BYTES) != hipSuccess) { fprintf(stderr, "kernel_launch: hipFuncSetAttribute failed\n"); grid = -1; return; }
        if (hipOccupancyMaxActiveBlocksPerMultiprocessor(&per_cu, (const void*)fwd_megakernel, 512, LDS_BYTES) != hipSuccess || per_cu < 1) { fprintf(stderr, "kernel_launch: occupancy query says %d\n", per_cu); grid = -1; return; }
        if (cus < GRID) { fprintf(stderr, "kernel_launch: needs %d CUs, got %d\n", GRID, cus); grid = -1; return; }
        grid = GRID;
    }
    if (grid < 0) return;
    hipMemsetAsync((char*)d_ws + WS_CTL, 0, CTL_BYTES, stream);
    Args a{};
    for (int i = 0; i < 29; ++i) a.in[i] = (const float*)d_in[i];
    a.out = (float*)d_out; a.ws = (unsigned char*)d_ws;
#if MK_MULTI
    for (int ph = 0; ph < NPHASE; ++ph) { a.ph_lo = ph; a.ph_hi = ph + 1; hipLaunchKernelGGL(fwd_megakernel, dim3(grid), dim3(512), LDS_BYTES, stream, a); }
#else
    a.ph_lo = 0; a.ph_hi = NPHASE;
    void* kargs[] = {&a};
    hipError_t e = hipLaunchCooperativeKernel((const void*)fwd_megakernel, dim3(grid), dim3(512), kargs, LDS_BYTES, stream);
    if (e != hipSuccess) fprintf(stderr, "cooperative launch failed: %s (grid %d)\n", hipGetErrorString(e), grid);
#endif
}
```

```cpp
#include <hip/hip_runtime.h>
#include <hip/hip_cooperative_groups.h>
#include <cstdio>
#include <cstdint>
namespace cg = cooperative_groups;

#ifndef MK_MULTI
#define MK_MULTI 0
#endif

#ifndef PROBE_REP
#define PROBE_REP (-2)
#endif
#ifndef PROBE_SUB
#define PROBE_SUB 0
#endif
#ifndef PROBE_SEG
#define PROBE_SEG 0
#endif
#define SEG_T0(id) unsigned long long seg_t0_##id = 0; if (PROBE_SEG == (id)) seg_t0_##id = __builtin_amdgcn_s_memrealtime();
#define SEG_T1(id) if (PROBE_SEG == (id)) { const unsigned long long t1_ = __builtin_amdgcn_s_memrealtime(); const unsigned long long d_ = (t1_ - seg_t0_##id) * 8ull; \
        while (__builtin_amdgcn_s_memrealtime() - t1_ < d_) __builtin_amdgcn_s_sleep(2); }
#define DI __device__ __forceinline__
#define LAS __attribute__((address_space(3)))
#define GAS __attribute__((address_space(1)))
typedef unsigned short bf16_t;
typedef float f32x4 __attribute__((ext_vector_type(4)));
typedef float f32x2 __attribute__((ext_vector_type(2)));
typedef unsigned u32x4 __attribute__((ext_vector_type(4)));
typedef unsigned u32x2 __attribute__((ext_vector_type(2)));
typedef short bf16x8 __attribute__((ext_vector_type(8)));
typedef __bf16 bf16v2 __attribute__((ext_vector_type(2)));

constexpr int D = 2048, SEQ = 2048, BATCH = 4, NP = BATCH * SEQ, NS = 128, MT = NP + NS, MPAD = 8448;
constexpr int NIN = 7184, NINP = 7424, DFF = 5632, NGU = 2 * DFF;
constexpr int C_AQ = 0, C_AF = 512, C_AI = 1024, C_AG = 1536, C_BQ = 2048, C_BK = 3072, C_BV = 4096, C_BZ = 5120, C_BB = 6144, C_BA = 6152, C_CX = 6160, C_CG = 6672;
constexpr float NORM_EPS = 1e-6f, L2_EPS = 1e-6f;
constexpr int NPHASE = 17;
constexpr int GRID = 256;

constexpr size_t O_YP = 0, O_YS = O_YP + (size_t)NP * D, O_HGP = O_YS + (size_t)NS * D, O_HGS = O_HGP + 2ull * 4 * 4 * 16384,
                 O_GDP = O_HGS + 2ull * 128 * 4 * 16384, O_GDS = O_GDP + 2ull * 4 * 8 * 16384, O_GCP = O_GDS + 2ull * 128 * 8 * 16384,
                 O_GCS = O_GCP + 2ull * 4 * 3 * 3072, O_RHP = O_GCS + 2ull * 128 * 3 * 3072, O_RHS = O_RHP + 2ull * 4 * 512,
                 O_RCP = O_RHS + 2ull * 128 * 512, O_RCS = O_RCP + 2ull * 4 * 3 * 512, O_END = O_RCS + 2ull * 128 * 3 * 512;

constexpr size_t MiB = 1ull << 20;
constexpr size_t WS_CTL = 0, CTL_BYTES = 1 * MiB;
constexpr size_t WS_WIN = 1 * MiB, SZ_WIN = 29 * MiB, WS_WOUT = WS_WIN + 2 * SZ_WIN, SZ_WOUT = 8 * MiB, WS_WGU = WS_WOUT + 2 * SZ_WOUT, SZ_WGU = 44 * MiB,
                 WS_WDN = WS_WGU + 2 * SZ_WGU, SZ_WDN = 22 * MiB;
constexpr size_t WS_PROJ = WS_WDN + 2 * SZ_WDN, SZ_PROJ = 240 * MiB;
constexpr size_t WS_HBUF = WS_PROJ + SZ_PROJ, SZ_HBUF = 33 * MiB;
constexpr size_t WS_MIXO = WS_HBUF + SZ_HBUF;
constexpr size_t WS_MIXF = WS_MIXO + SZ_HBUF, SZ_MIXF = 66 * MiB;
constexpr size_t WS_X1 = WS_MIXF + SZ_MIXF, WS_END = WS_X1 + SZ_MIXF + 25 * MiB;
static_assert((size_t)NINP * D * 2 == SZ_WIN && (size_t)NGU * D * 2 == SZ_WGU && (size_t)D * DFF * 2 == SZ_WDN && (size_t)D * D * 2 == SZ_WOUT, "weight sizes");
static_assert((size_t)MPAD * NINP * 4 <= SZ_PROJ && (size_t)MPAD * D * 2 <= SZ_HBUF && (size_t)MPAD * D * 4 <= SZ_MIXF, "ws map");

constexpr int LDS_BYTES = 147456;

DI unsigned pk2(float lo, float hi) { f32x2 x = {lo, hi}; bf16v2 y = __builtin_convertvector(x, bf16v2); return __builtin_bit_cast(unsigned, y); }
DI float bflo(unsigned x) { return __uint_as_float(x << 16); }
DI float bfhi(unsigned x) { return __uint_as_float(x & 0xffff0000u); }
struct ProjPtr { const bf16_t* p;
    DI float operator[](long i) const { return __uint_as_float((unsigned)p[i] << 16); }
    DI unsigned p2(long i) const { return *(const unsigned*)(p + i); }
    DI ProjPtr operator+(long o) const { return ProjPtr{p + o}; } };
DI float wave_sum(float v) {
#pragma unroll
    for (int o = 1; o < 64; o <<= 1) v += __shfl_xor(v, o);
    return v;
}
template <int CTRL> DI float dpp_mov(float v) { return __int_as_float(__builtin_amdgcn_update_dpp(0, __float_as_int(v), CTRL, 0xF, 0xF, true)); }
DI float row16_sum(float v) {
    v += dpp_mov<0xB1>(v); v += dpp_mov<0x4E>(v); v += dpp_mov<0x124>(v); v += dpp_mov<0x128>(v); return v;
}
DI float rl(float v, int l) { return __int_as_float(__builtin_amdgcn_readlane(__float_as_int(v), l)); }
DI float wave_sum_fast(float v) { v = row16_sum(v); return (rl(v, 0) + rl(v, 16)) + (rl(v, 32) + rl(v, 48)); }
DI float sigm(float x) { return __builtin_amdgcn_rcpf(1.f + __expf(-x)); }
DI float silu(float x) { return x * __builtin_amdgcn_rcpf(1.f + __expf(-x)); }
DI float softplus(float x) { return x > 20.f ? x : log1pf(__expf(x)); }
DI float gelu_tanh(float x) { const float y = 0.7978845608028654f * (x + 0.044715f * x * x * x); return 0.5f * x * (1.f + tanhf(y)); }
#define LDS_WAIT() asm volatile("s_waitcnt lgkmcnt(0)" ::: "memory")
#define MFMA16(a, b, c) __builtin_amdgcn_mfma_f32_16x16x32_bf16((a), (b), (c), 0, 0, 0)

namespace pg8 {
#define PG8_LAS __attribute__((address_space(3)))
constexpr int BM = 256, BK = 64, HALF = 128, HTB = HALF * BK * 2, STAGE_BYTES = 8 * HTB, NXCD = 8, WGM = 8;
__host__ __device__ __forceinline__ int lds_byte(int r, int c) { const int st = (r >> 4) * 2 + (c >> 5), rr = r & 15, cc = c & 31, ob = rr * 64 + cc * 2; return st * 1024 + (ob ^ (((ob >> 9) & 1) << 5)); }
__host__ __device__ __forceinline__ void stage_rc(int b, int& R, int& C) { const int st = b / 1024, sb = b % 1024, swz = sb ^ (((sb >> 9) & 1) << 5); R = (st >> 1) * 16 + swz / 64; C = (st & 1) * 32 + (swz % 64) / 2; }
struct Unit { int pm, pn; };
struct Gemm { const bf16_t* A; const bf16_t* Bt; int M, N, K; };
struct StaticOrder {
    int nM, nN, nwg, G, c;
    __host__ __device__ void init(int M, int N, int G_, int c_) { nM = M / BM; nN = N / BM; nwg = nM * nN; G = G_; c = c_; }
    __host__ __device__ bool next(int i, Unit& u) const {
        const long L = (long)i * G + c; if (L >= nwg) return false;
        int wgid = (int)L; { const int q = nwg / NXCD, r = nwg % NXCD, xcd = wgid % NXCD, off = wgid / NXCD; wgid = (xcd < r ? xcd * (q + 1) : r * (q + 1) + (xcd - r) * q) + off; }
        const int nig = WGM * nN, gid = wgid / nig, fm = gid * WGM, gsz = (nM - fm) < WGM ? (nM - fm) : WGM;
        u.pm = fm + ((wgid % nig) % gsz); u.pn = (wgid % nig) / gsz; return true;
    }
    __device__ __forceinline__ void a_ready(const Unit&) const {}
    __device__ __forceinline__ void done(const Unit&) const {}
};
struct EpiAny {
    static constexpr bool PERM = false, AFTER_DRAIN = false;
    int mode; float* C; bf16_t* O; int ldc;
    __device__ __forceinline__ void operator()(const f32x4 (&acc)[2][2][4][2], const Unit& u, int wr, int wc, int fr, int fq) const {
        const int row0 = u.pm * BM + wr * 64 + fr;
        if (mode == 2) {
            const int col0 = u.pn * BM + wc * 32 + 4 * fq;
#pragma unroll
            for (int ai = 0; ai < 2; ++ai)
#pragma unroll
                for (int m = 0; m < 4; ++m) { bf16_t* rowp = O + (size_t)(row0 + ai * HALF + m * 16) * ldc + col0;
#pragma unroll
                    for (int bj = 0; bj < 2; ++bj)
#pragma unroll
                        for (int n = 0; n < 2; ++n) { const f32x4 v = acc[ai][bj][m][n]; *(u32x2*)(rowp + bj * HALF + n * 16) = (u32x2){pk2(v[0], v[1]), pk2(v[2], v[3])}; } }
        } else {
#pragma unroll
            for (int ai = 0; ai < 2; ++ai)
#pragma unroll
                for (int m = 0; m < 4; ++m) { bf16_t* rowp = O + (size_t)(row0 + ai * HALF + m * 16) * ldc;
#pragma unroll
                    for (int bj = 0; bj < 2; ++bj) { const int G = 8 * u.pn + 4 * bj + wc; const f32x4 g = acc[ai][bj][m][0], up = acc[ai][bj][m][1];
                        u32x2 w; w.x = pk2(silu(g[0]) * up[0], silu(g[1]) * up[1]); w.y = pk2(silu(g[2]) * up[2], silu(g[3]) * up[3]);
                        *(u32x2*)(rowp + 16 * G + 4 * fq) = w; } }
        }
    }
};

template <class Epi, class Sched, bool ALIGN_EPI = false, bool SP2 = false>
__device__ __forceinline__ void gemm_phase(PG8_LAS unsigned char* lds, const Gemm g, const Sched& S, const Epi& E) {
    int tid_ = threadIdx.x; asm volatile("" : "+v"(tid_));
    const int tid = tid_, wid = __builtin_amdgcn_readfirstlane(tid >> 6), lane = tid & 63, wr = wid >> 2, wc = wid & 3, fr = lane & 15, fq = lane >> 4;
    const int K = g.K, nt = K / BK;
    unsigned voffA[2], voffB[2];
#pragma unroll
    for (int i = 0; i < 2; ++i) { int R, C; stage_rc(tid * 16 + i * 8192, R, C); voffA[i] = (unsigned)(R * K + C) * 2u; voffB[i] = (unsigned)(R * K + C) * 2u; }
    const size_t kstep = (size_t)(BK * 2);
    const size_t hstep = (size_t)HALF * K * 2;
    const size_t tstep = 2 * hstep;
    const unsigned ldsw = (unsigned)wid * 1024u;
    const int aoff = lds_byte(wr * 64 + fr, fq * 8), boff = lds_byte(wc * 32 + fr, fq * 8);
#define PG8_SA(b, h) (((b) * 2 + (h)) * HTB)
#define PG8_SB(b, h) ((4 + (b) * 2 + (h)) * HTB)
#define PG8_STAGE(bufoff, gbase, voff) do { _Pragma("unroll") for (int _i = 0; _i < 2; ++_i) \
        __builtin_amdgcn_global_load_lds((const unsigned*)((const char*)(gbase) + (voff)[_i]), (PG8_LAS unsigned*)(lds + (bufoff) + ldsw + _i * 8192), 16, 0, 0); } while (0)
#define PG8_LDA(dst, b, h) do { _Pragma("unroll") for (int m = 0; m < 4; ++m) _Pragma("unroll") for (int k = 0; k < 2; ++k) dst[m][k] = *(const PG8_LAS bf16x8*)(lds + PG8_SA(b, h) + aoff + m * 2048 + k * 1024); } while (0)
#define PG8_LDB(dst, b, h) do { _Pragma("unroll") for (int n = 0; n < 2; ++n) _Pragma("unroll") for (int k = 0; k < 2; ++k) dst[n][k] = *(const PG8_LAS bf16x8*)(lds + PG8_SB(b, h) + boff + n * 2048 + k * 1024); } while (0)
#define PG8_MMA(ai, bj, At, Bt) do { __builtin_amdgcn_s_setprio(1); _Pragma("unroll") for (int m = 0; m < 4; ++m) _Pragma("unroll") for (int n = 0; n < 2; ++n) _Pragma("unroll") for (int k = 0; k < 2; ++k) \
        acc[ai][bj][m][n] = __builtin_amdgcn_mfma_f32_16x16x32_bf16(Bt[n][k], At[m][k], acc[ai][bj][m][n], 0, 0, 0); __builtin_amdgcn_s_setprio(0); } while (0)
#define PG8_WAIT_V(n) asm volatile("s_waitcnt vmcnt(" #n ")" ::: "memory")
#define PG8_WAIT_L(n) asm volatile("s_waitcnt lgkmcnt(" #n ")" ::: "memory")
#define PG8_BAR __builtin_amdgcn_s_barrier()
#define PG8_SCHED __builtin_amdgcn_sched_barrier(0)
    Unit cur, nxt; int ui = 0;
    if (!S.next(0, cur)) return;
    f32x4 acc[2][2][4][2];
#pragma unroll
    for (int a = 0; a < 2; ++a)
#pragma unroll
        for (int b = 0; b < 2; ++b)
#pragma unroll
            for (int m = 0; m < 4; ++m)
#pragma unroll
                for (int n = 0; n < 2; ++n) acc[a][b][m][n] = (f32x4){0.f, 0.f, 0.f, 0.f};
    bf16x8 At[4][2], B0[2][2], B1[2][2];
    const char* cA = (const char*)g.A + (size_t)cur.pm * tstep; const char* cB = (const char*)g.Bt + (size_t)cur.pn * tstep;
    S.a_ready(cur);
    if constexpr (SP2) {
        PG8_STAGE(PG8_SB(0, 0), cB, voffB); PG8_STAGE(PG8_SB(0, 1), cB + hstep, voffB); PG8_STAGE(PG8_SA(0, 0), cA, voffA); PG8_STAGE(PG8_SA(0, 1), cA + hstep, voffA);
        if (wr == 1) PG8_BAR;
        PG8_WAIT_V(2); PG8_BAR;
        PG8_STAGE(PG8_SB(1, 0), cB + kstep, voffB); PG8_STAGE(PG8_SA(1, 0), cA + kstep, voffA); PG8_STAGE(PG8_SB(1, 1), cB + hstep + kstep, voffB);
        PG8_WAIT_V(6); PG8_BAR;
    } else {
        PG8_STAGE(PG8_SB(0, 0), cB, voffB); PG8_STAGE(PG8_SA(0, 0), cA, voffA); PG8_STAGE(PG8_SB(0, 1), cB + hstep, voffB); PG8_STAGE(PG8_SA(0, 1), cA + hstep, voffA);
        if (wr == 1) PG8_BAR;
        PG8_WAIT_V(4); PG8_BAR;
        PG8_STAGE(PG8_SB(1, 0), cB + kstep, voffB); PG8_STAGE(PG8_SA(1, 0), cA + kstep, voffA); PG8_STAGE(PG8_SB(1, 1), cB + hstep + kstep, voffB);
        PG8_WAIT_V(6); PG8_BAR;
    }
    for (;;) {
        const bool has_next = S.next(ui + 1, nxt);
        const char* nA = has_next ? (const char*)g.A + (size_t)nxt.pm * tstep : cA; const char* nB = has_next ? (const char*)g.Bt + (size_t)nxt.pn * tstep : cB;
        for (int t = 0; t < nt; t += 2) {
            const bool last = (t == nt - 2);
            const char* a1 = cA + (size_t)(t + 1) * kstep;
            const char* a2 = last ? nA : cA + (size_t)(t + 2) * kstep; const char* b2 = last ? nB : cB + (size_t)(t + 2) * kstep;
            const char* a3 = a2 + kstep; const char* b3 = b2 + kstep;
            if (last && has_next) S.a_ready(nxt);
            if constexpr (SP2) {
            PG8_LDB(B0, 0, 0); PG8_LDB(B1, 0, 1); PG8_SCHED; PG8_LDA(At, 0, 0); PG8_STAGE(PG8_SA(1, 1), a1 + hstep, voffA);
            PG8_WAIT_V(8); PG8_WAIT_L(0); PG8_BAR; PG8_MMA(0, 0, At, B0); PG8_MMA(0, 1, At, B1); PG8_BAR; PG8_SCHED;
            PG8_LDA(At, 0, 1); PG8_STAGE(PG8_SB(0, 0), b2, voffB); PG8_STAGE(PG8_SB(0, 1), b2 + hstep, voffB); PG8_STAGE(PG8_SA(0, 0), a2, voffA);
            PG8_WAIT_V(8); PG8_WAIT_L(0); PG8_BAR; PG8_MMA(1, 0, At, B0); PG8_MMA(1, 1, At, B1); PG8_BAR; PG8_SCHED;
            PG8_LDB(B0, 1, 0); PG8_LDB(B1, 1, 1); PG8_SCHED; PG8_LDA(At, 1, 0); PG8_STAGE(PG8_SA(0, 1), a2 + hstep, voffA);
            PG8_WAIT_V(8); PG8_WAIT_L(0); PG8_BAR; PG8_MMA(0, 0, At, B0); PG8_MMA(0, 1, At, B1); PG8_BAR; PG8_SCHED;
            PG8_LDA(At, 1, 1); PG8_STAGE(PG8_SB(1, 0), b3, voffB); PG8_STAGE(PG8_SB(1, 1), b3 + hstep, voffB); PG8_STAGE(PG8_SA(1, 0), a3, voffA);
            PG8_WAIT_V(8); PG8_WAIT_L(0); PG8_BAR; PG8_MMA(1, 0, At, B0); PG8_MMA(1, 1, At, B1); PG8_BAR; PG8_SCHED;
            } else {
            PG8_LDB(B0, 0, 0); PG8_SCHED; PG8_LDA(At, 0, 0); PG8_STAGE(PG8_SA(1, 1), a1 + hstep, voffA);
            PG8_WAIT_L(8); PG8_BAR; PG8_WAIT_L(0); PG8_MMA(0, 0, At, B0); PG8_BAR; PG8_SCHED;
            PG8_LDB(B1, 0, 1); PG8_STAGE(PG8_SB(0, 0), b2, voffB);
            PG8_BAR; PG8_WAIT_L(0); PG8_MMA(0, 1, At, B1); PG8_BAR;
            PG8_LDA(At, 0, 1); PG8_STAGE(PG8_SA(0, 0), a2, voffA);
            PG8_BAR; PG8_WAIT_L(0); PG8_MMA(1, 0, At, B0); PG8_BAR; PG8_SCHED;
            PG8_STAGE(PG8_SB(0, 1), b2 + hstep, voffB);
            PG8_WAIT_V(6); PG8_BAR; PG8_MMA(1, 1, At, B1); PG8_BAR;
            PG8_LDB(B0, 1, 0); PG8_SCHED; PG8_LDA(At, 1, 0); PG8_STAGE(PG8_SA(0, 1), a2 + hstep, voffA);
            PG8_WAIT_L(8); PG8_BAR; PG8_WAIT_L(0); PG8_MMA(0, 0, At, B0); PG8_BAR; PG8_SCHED;
            PG8_LDB(B1, 1, 1); PG8_STAGE(PG8_SB(1, 0), b3, voffB);
            PG8_BAR; PG8_WAIT_L(0); PG8_MMA(0, 1, At, B1); PG8_BAR;
            PG8_LDA(At, 1, 1); PG8_STAGE(PG8_SA(1, 0), a3, voffA);
            PG8_BAR; PG8_WAIT_L(0); PG8_MMA(1, 0, At, B0); PG8_BAR; PG8_SCHED;
            PG8_STAGE(PG8_SB(1, 1), b3 + hstep, voffB);
            PG8_WAIT_V(6); PG8_BAR; PG8_MMA(1, 1, At, B1); PG8_BAR;
            }
        }
        if constexpr (ALIGN_EPI) { if (wr == 0) PG8_BAR; }
        if constexpr (!Epi::AFTER_DRAIN) { E(acc, cur, wr, wc, fr, fq); S.done(cur); }
        if (!has_next) break;
#pragma unroll
        for (int a = 0; a < 2; ++a)
#pragma unroll
            for (int b = 0; b < 2; ++b)
#pragma unroll
                for (int m = 0; m < 4; ++m)
#pragma unroll
                    for (int n = 0; n < 2; ++n) acc[a][b][m][n] = (f32x4){0.f, 0.f, 0.f, 0.f};
        cur = nxt; cA = nA; cB = nB; ++ui;
        if constexpr (ALIGN_EPI) { if (wr == 1) PG8_BAR; }
    }
    PG8_WAIT_V(0);
    if constexpr (!ALIGN_EPI) { if (wr == 0) PG8_BAR; }
    PG8_BAR;
#undef PG8_SA
#undef PG8_SB
#undef PG8_STAGE
#undef PG8_LDA
#undef PG8_LDB
#undef PG8_MMA
#undef PG8_WAIT_V
#undef PG8_WAIT_L
#undef PG8_BAR
#undef PG8_SCHED
}
}

struct Args { const float* in[29]; float* out; unsigned char* ws; int ph_lo, ph_hi; };
enum { I_XP = 0, I_XS, I_SHG, I_SGD, I_SGC, I_SRH, I_SRC, I_LN1, I_LN2, I_LN3, I_LN4, I_WIN, I_WOUT, I_LB, I_ANORM, I_BCW, I_BALOG, I_BDT, I_BNORM,
       I_CCW, I_CCB, I_CWA, I_CBA, I_CWX, I_CBX, I_CLAM, I_WG, I_WU, I_WD };

struct Ctx {
    const Args* a; unsigned char* ws; float* out; LAS unsigned char* lds; int tid, lane, wave, G, bid;
};
DI Ctx fresh(const Ctx& o) {
    Ctx c = o; int t = threadIdx.x; asm volatile("" : "+v"(t)); c.tid = t; c.lane = t & 63; c.wave = __builtin_amdgcn_readfirstlane(t >> 6);
    size_t z = 0; asm volatile("" : "+s"(z)); c.ws = o.a->ws + z; c.out = o.a->out + z;
    int b = blockIdx.x; asm volatile("" : "+s"(b)); c.bid = b; return c;
}
DI const float* inp(const Args& a, int idx) { int z = idx; asm volatile("" : "+s"(z)); return (const float*)(const GAS float*)a.in[z]; }

template <int MODE>
DI void transpose_item(const float* W, int K, int Nsrc, int nblk, bf16_t* WT, LAS float* scr, int item, int lane) {
    const int kb = item / nblk, nb = item - kb * nblk, k0 = 64 * kb, n0 = 32 * nb;
    const int nn = n0 + (lane & 31); const bool ok = nn < Nsrc;
    float v[32];
#pragma unroll
    for (int i = 0; i < 32; ++i) { const int kk = 2 * i + (lane >> 5); v[i] = ok ? W[(size_t)(k0 + kk) * Nsrc + nn] : 0.f; }
#pragma unroll
    for (int i = 0; i < 32; ++i) { const int kk = 2 * i + (lane >> 5); scr[kk * 33 + (lane & 31)] = v[i]; }
    LDS_WAIT(); asm volatile("" ::: "memory");
    const int c = lane & 7;
#pragma unroll
    for (int j = 0; j < 4; ++j) { const int nl = (lane >> 3) + 8 * j; const LAS float* s = scr + (8 * c) * 33 + nl;
        u32x4 o; o.x = pk2(s[0 * 33], s[1 * 33]); o.y = pk2(s[2 * 33], s[3 * 33]); o.z = pk2(s[4 * 33], s[5 * 33]); o.w = pk2(s[6 * 33], s[7 * 33]);
        const int n = n0 + nl; const int drow = (MODE == 0) ? n : ((n >> 4) * 32 + (n & 15) + (MODE == 2 ? 16 : 0));
        *(u32x4*)(WT + (size_t)drow * K + k0 + 8 * c) = o; }
    LDS_WAIT(); asm volatile("" ::: "memory");
}
DI void norm_row_to_bf16(const float* xr, const float* g, bf16_t* orow, int lane) {
    f32x4 v[8]; float s = 0.f;
#pragma unroll
    for (int j = 0; j < 8; ++j) { v[j] = ((const f32x4*)xr)[lane + 64 * j]; s += (v[j].x * v[j].x + v[j].y * v[j].y) + (v[j].z * v[j].z + v[j].w * v[j].w); }
    const float r = rsqrtf(wave_sum_fast(s) * (1.f / D) + NORM_EPS);
#pragma unroll
    for (int j = 0; j < 8; ++j) { const f32x4 gg = ((const f32x4*)g)[lane + 64 * j]; u32x2 w; w.x = pk2(v[j].x * r * gg.x, v[j].y * r * gg.y); w.y = pk2(v[j].z * r * gg.z, v[j].w * r * gg.w);
        ((u32x2*)orow)[lane + 64 * j] = w; }
}
constexpr int CV_IN = (D / 64) * (NINP / 32), CV_OUT = (D / 64) * (D / 32), CV_G = (D / 64) * (DFF / 32), CV_D = (DFF / 64) * (D / 32), CV_LAYER = CV_IN + CV_OUT + 2 * CV_G + CV_D;
DI void convert_range(const Ctx& c, int lo, int hi, int gw, int NGW) {
    const Args& a = *c.a;
    LAS float* scr = (LAS float*)(c.lds + c.wave * 16384);
    for (int it = lo + gw; it < hi; it += NGW) {
        const int l = it / CV_LAYER; int r = it - l * CV_LAYER;
        if (r < CV_IN) { transpose_item<0>(inp(a, I_WIN) + (size_t)l * D * NIN, D, NIN, NINP / 32, (bf16_t*)(c.ws + WS_WIN + l * SZ_WIN), scr, r, c.lane); continue; } r -= CV_IN;
        if (r < CV_OUT) { transpose_item<0>(inp(a, I_WOUT) + (size_t)l * D * D, D, D, D / 32, (bf16_t*)(c.ws + WS_WOUT + l * SZ_WOUT), scr, r, c.lane); continue; } r -= CV_OUT;
        if (r < CV_G) { transpose_item<1>(inp(a, I_WG) + (size_t)l * D * DFF, D, DFF, DFF / 32, (bf16_t*)(c.ws + WS_WGU + l * SZ_WGU), scr, r, c.lane); continue; } r -= CV_G;
        if (r < CV_G) { transpose_item<2>(inp(a, I_WU) + (size_t)l * D * DFF, D, DFF, DFF / 32, (bf16_t*)(c.ws + WS_WGU + l * SZ_WGU), scr, r, c.lane); continue; } r -= CV_G;
        transpose_item<0>(inp(a, I_WD) + (size_t)l * DFF * D, DFF, D, D / 32, (bf16_t*)(c.ws + WS_WDN + l * SZ_WDN), scr, r, c.lane);
    }
}
DI void phase_p0(const Ctx& c0) {
    const Ctx c = fresh(c0);
    const Args& a = *c.a;
    const int gw = c.bid * 8 + c.wave, NGW = GRID * 8;
    convert_range(c, 0, CV_IN, gw, NGW);
    bf16_t* hb = (bf16_t*)(c.ws + WS_HBUF);
    { const float* xp = inp(a, I_XP); const float* xs = inp(a, I_XS); const float* g1 = inp(a, I_LN1);
      for (int m = gw; m < MT; m += NGW) norm_row_to_bf16(m < NP ? xp + (size_t)m * D : xs + (size_t)(m - NP) * D, g1, hb + (size_t)m * D, c.lane); }
    unsigned z0 = 0u; asm volatile("" : "+v"(z0)); const u32x4 z4 = {z0, z0, z0, z0};
    for (int i = gw * 64 + c.lane; i < (MPAD - MT) * D / 8; i += NGW * 64) {
        ((u32x4*)(hb + (size_t)MT * D))[i] = z4;
        ((u32x4*)((bf16_t*)(c.ws + WS_MIXO) + (size_t)MT * D))[i] = z4;
    }
}

DI void row_phase(const Ctx& c0, const bf16_t* y, const float* slabs, const float* xa, const float* xb, float* xout, const float* g_post, const float* g_next, bf16_t* hb) {
    const Ctx c = fresh(c0);
    const int gw = c.bid * 8 + c.wave, NGW = GRID * 8, lane = c.lane;
    f32x4 v[8], vn[8];
#define Y_LOAD(dst, row) do { _Pragma("unroll") for (int j = 0; j < 8; ++j) { const u32x2 w_ = ((const u32x2*)(y + (size_t)(row) * D))[lane + 64 * j]; \
        dst[j] = (f32x4){__uint_as_float(w_.x << 16), __uint_as_float(w_.x & 0xffff0000u), __uint_as_float(w_.y << 16), __uint_as_float(w_.y & 0xffff0000u)}; } } while (0)
    if (gw < NP) Y_LOAD(v, gw);
    for (int m = gw; m < MT; m += NGW) {
        const float* xr = m < NP ? xa + (size_t)m * D : xb + (size_t)(m - NP) * D;
        const int mn = m + NGW;
        f32x4 xx[8];
#pragma unroll
        for (int j = 0; j < 8; ++j) xx[j] = ((const f32x4*)xr)[lane + 64 * j];
        if (mn < NP) Y_LOAD(vn, mn);
        if (m >= NP) { const float* yr = slabs + (size_t)(m - NP) * D;
#pragma unroll
            for (int j = 0; j < 8; ++j) v[j] = ((const f32x4*)yr)[lane + 64 * j] + ((const f32x4*)(yr + (size_t)NS * D))[lane + 64 * j];
#pragma unroll 1
            for (int ks = 2; ks < 8; ks += 2) {
                f32x4 t0[8], t1[8];
#pragma unroll
                for (int j = 0; j < 8; ++j) { t0[j] = ((const f32x4*)(yr + (size_t)ks * NS * D))[lane + 64 * j]; t1[j] = ((const f32x4*)(yr + (size_t)(ks + 1) * NS * D))[lane + 64 * j]; }
#pragma unroll
                for (int j = 0; j < 8; ++j) v[j] = v[j] + t0[j] + t1[j]; }
        }
        float s = 0.f;
#pragma unroll
        for (int j = 0; j < 8; ++j) s += (v[j].x * v[j].x + v[j].y * v[j].y) + (v[j].z * v[j].z + v[j].w * v[j].w);
        const float r = rsqrtf(wave_sum_fast(s) * (1.f / D) + NORM_EPS);
        float s2 = 0.f;
#pragma unroll
        for (int j = 0; j < 8; ++j) { const f32x4 gg = ((const f32x4*)g_post)[lane + 64 * j];
            v[j] = xx[j] + v[j] * r * gg; s2 += (v[j].x * v[j].x + v[j].y * v[j].y) + (v[j].z * v[j].z + v[j].w * v[j].w);
            ((f32x4*)(xout + (size_t)m * D))[lane + 64 * j] = v[j]; }
        if (g_next) {
            const float r2 = rsqrtf(wave_sum_fast(s2) * (1.f / D) + NORM_EPS);
#pragma unroll
            for (int j = 0; j < 8; ++j) { const f32x4 gg = ((const f32x4*)g_next)[lane + 64 * j]; u32x2 w; w.x = pk2(v[j].x * r2 * gg.x, v[j].y * r2 * gg.y); w.y = pk2(v[j].z * r2 * gg.z, v[j].w * r2 * gg.w);
                ((u32x2*)(hb + (size_t)m * D))[lane + 64 * j] = w; }
        }
#pragma unroll
        for (int j = 0; j < 8; ++j) v[j] = vn[j];
    }
}

DI void sample_pieces(const Ctx& c0, const bf16_t* A  , const bf16_t* Bt  , int K, float* slabs) {
    const Ctx c = fresh(c0); const int tid = c.tid, lane = c.lane, wave = c.wave, i = lane & 15, g = lane >> 4;
    constexpr int KC = 256, PPR = KC / 8, NJ = 192 * PPR / 512, RS = KC * 2 + 16;
    const int klen = K / 8;
    for (int p = c.bid; p < 256; p += GRID) {
        const int jt = p & 31, ks = p >> 5;
        f32x4 acc[4];
#pragma unroll
        for (int q = 0; q < 4; ++q) acc[q] = (f32x4){0.f, 0.f, 0.f, 0.f};
#pragma unroll 1
        for (int kc = 0; kc < klen; kc += KC) {
            const int k0 = ks * klen + kc;
            u32x4 v[NJ];
#pragma unroll
            for (int j = 0; j < NJ; ++j) { const int pc = tid + 512 * j; const int row = pc / PPR, col = pc - row * PPR;
                const bf16_t* src = (row < 128 ? A + (size_t)row * K : Bt + (size_t)(64 * jt + row - 128) * K) + k0 + 8 * col;
                v[j] = *(const u32x4*)src; }
            __syncthreads();
#pragma unroll
            for (int j = 0; j < NJ; ++j) { const int pc = tid + 512 * j; const int row = pc / PPR, col = pc - row * PPR;
                *(LAS u32x4*)(c.lds + row * RS + col * 16) = v[j]; }
            __syncthreads();
            const int nk = (klen - kc) >= KC ? KC / 32 : (klen - kc) / 32;
#pragma unroll 2
            for (int kk = 0; kk < nk; ++kk) {
                const bf16x8 av = *(const LAS bf16x8*)(c.lds + (16 * wave + i) * RS + (32 * kk + 8 * g) * 2);
#pragma unroll
                for (int q = 0; q < 4; ++q) acc[q] = MFMA16(av, *(const LAS bf16x8*)(c.lds + (128 + 16 * q + i) * RS + (32 * kk + 8 * g) * 2), acc[q]);
            }
        }
        float* so = slabs + (size_t)ks * NS * D + (size_t)(16 * wave + 4 * g) * D + 64 * jt + i;
#pragma unroll
        for (int q = 0; q < 4; ++q)
#pragma unroll
            for (int r = 0; r < 4; ++r) so[(size_t)r * D + 16 * q] = acc[q][r];
    }
    __syncthreads();
}

DI int perm32(int x) { return 8 * ((x >> 2) & 3) + 4 * (x >> 4) + (x & 3); }
DI int kpos(int k) { return (k & ~31) + perm32(k & 31); }
DI float lb_of(const Args& a, int l, int c) { if (l == 0) return 0.f; const float l0 = inp(a, I_LB)[c], l1 = inp(a, I_LB)[512 + c]; return 1.f / (1.f + __expf(l0 - l1)); }
DI bf16_t bf1(float x) { return (bf16_t)(pk2(x, 0.f) & 0xffffu); }

constexpr size_t IB_W = WS_MIXF, IB_Q = IB_W + 16 * MiB, IB_KT = IB_Q + 16 * MiB, IB_P = IB_KT + 16 * MiB, IB_U0 = IB_P + 8 * MiB,
                 IA_Q = IB_U0 + 32 * MiB, IA_KT = IA_Q + 8 * MiB, IA_P = IA_KT + 8 * MiB, IA_V = IA_P + 4 * MiB,
                 IC_A = IA_V + 16 * MiB, IC_B = IC_A + 16 * MiB, IMISC = IC_B + 16 * MiB, IB_DEC = IMISC, IA_DEC = IMISC + 65536, IC_TOT = IMISC + 524288, I_END = IMISC + 1 * MiB;
static_assert(I_END <= WS_END, "mixer intermediates must fit");
constexpr size_t IG_B = WS_HBUF, IG_A = WS_HBUF + 16 * MiB;
static_assert(IG_A + 8 * MiB <= WS_HBUF + SZ_HBUF, "gate buffers");
constexpr size_t WS_SLAB = WS_X1 + SZ_MIXF;
static_assert(WS_SLAB + 8 * MiB <= WS_END, "slabs");

struct M1BRegs { unsigned x[3][11], gz[8]; float w[3][4][2], nwt[2], bb, ba; };
DI void m1b_load(const Ctx& c, int l, int u, M1BRegs& R) {
    const Args& a = *c.a; const int tid = c.tid;
    const int b = u >> 8, h = (u >> 5) & 7, ci = u & 31;
    const ProjPtr proj{(const bf16_t*)(c.ws + WS_PROJ)};
    const long rowb = (long)b * SEQ + 64 * ci; const int tg0 = 64 * ci;
    const float* cw = inp(a, I_BCW) + (size_t)l * 4 * 3072;
    const int jp = tid & 63, tq = tid >> 6;
#pragma unroll
    for (int i = 0; i < 8; ++i) R.gz[i] = proj.p2((rowb + 8 * tq + i) * NINP + C_BZ + h * 128 + 2 * jp);
    { const f32x2 nv = *(const f32x2*)(inp(a, I_BNORM) + l * 128 + 2 * jp); R.nwt[0] = nv.x; R.nwt[1] = nv.y; }
    R.bb = proj[(rowb + (tid & 63)) * NINP + C_BB + h]; R.ba = proj[(rowb + (tid & 63)) * NINP + C_BA + h];
#pragma unroll
    for (int p = 0; p < 3; ++p) { const int ch = p * 1024 + h * 128 + 2 * jp;
#pragma unroll
        for (int j = 0; j < 4; ++j) { const f32x2 wv = *(const f32x2*)(cw + j * 3072 + ch); R.w[p][j][0] = wv.x; R.w[p][j][1] = wv.y; }
#pragma unroll
        for (int j = 0; j < 11; ++j) { const int t = 8 * tq - 3 + j; R.x[p][j] = (tg0 + t >= 0) ? proj.p2((rowb + t) * NINP + C_BQ + ch) : 0u; } }
}
DI void m1_unit_b(const Ctx& c0, int l, int u, int unext, M1BRegs& R) {
    const Ctx c = fresh(c0); const Args& a = *c.a; const int tid = c.tid, lane = c.lane, wave = c.wave;
    const int b = u >> 8, h = (u >> 5) & 7, ci = u & 31;
    LAS float* Kf = (LAS float*)c.lds;
    LAS float* Vf = Kf + 8192;
    LAS float* Qf = Vf + 8192;
    LAS float* Amat = Qf;
    LAS bf16_t* Pl = (LAS bf16_t*)(Qf + 64 * 68);
    LAS bf16_t* Qb = (LAS bf16_t*)(Qf + 8192);
    LAS bf16_t* Kb = Qb + 64 * 136;
    LAS float* scal = (LAS float*)(Kb + 64 * 136);
    const ProjPtr proj{(const bf16_t*)(c.ws + WS_PROJ)};
    const long rowb = (long)b * SEQ + 64 * ci; const int tg0 = 64 * ci;
    SEG_T0(10)
    {
        const int jp = tid & 63, tq = tid >> 6;
#pragma unroll
        for (int p = 0; p < 3; ++p) { LAS float* dst = (p == 0 ? Qf : (p == 1 ? Kf : Vf)) + 2 * jp;
#pragma unroll
            for (int i = 0; i < 8; ++i) {
                const float y0 = R.w[p][0][0] * bflo(R.x[p][i]) + R.w[p][1][0] * bflo(R.x[p][i + 1]) + R.w[p][2][0] * bflo(R.x[p][i + 2]) + R.w[p][3][0] * bflo(R.x[p][i + 3]);
                const float y1 = R.w[p][0][1] * bfhi(R.x[p][i]) + R.w[p][1][1] * bfhi(R.x[p][i + 1]) + R.w[p][2][1] * bfhi(R.x[p][i + 2]) + R.w[p][3][1] * bfhi(R.x[p][i + 3]);
                *(LAS f32x2*)(dst + (8 * tq + i) * 128) = (f32x2){silu(y0), silu(y1)}; } }
        bf16_t* gg = (bf16_t*)(c.ws + IG_B) + ((size_t)u * 64 + 8 * tq) * 128 + 2 * jp;
#pragma unroll
        for (int i = 0; i < 8; ++i) *(unsigned*)(gg + i * 128) = pk2(silu(bflo(R.gz[i])) * R.nwt[0], silu(bfhi(R.gz[i])) * R.nwt[1]);
    }
    SEG_T1(10)
    __syncthreads();
    SEG_T0(11)
    for (int i = 0; i < 8; ++i) { const int t = wave * 8 + i; const float q0 = Qf[t * 128 + lane], q1 = Qf[t * 128 + 64 + lane], k0 = Kf[t * 128 + lane], k1 = Kf[t * 128 + 64 + lane];
        const float sq = wave_sum_fast(q0 * q0 + q1 * q1), sk = wave_sum_fast(k0 * k0 + k1 * k1);
        if (lane == 0) { scal[t * 8 + 3] = rsqrtf(sq + L2_EPS) * 0.08838834764831845f; scal[t * 8 + 4] = rsqrtf(sk + L2_EPS); } }
    if (wave == 0) { const int t = lane; const float bb = R.bb, ba = R.ba;
        const float gt = -__expf(inp(a, I_BALOG)[l * 8 + h]) * softplus(ba + inp(a, I_BDT)[l * 8 + h]);
        float x = gt;
#pragma unroll
        for (int o = 1; o < 64; o <<= 1) { const float y = __shfl_up(x, o); if (lane >= o) x += y; }
        const float bC = __shfl(x, 63);
        scal[t * 8 + 0] = sigm(bb); scal[t * 8 + 1] = x; scal[t * 8 + 2] = __expf(x); scal[t * 8 + 5] = __expf(bC - x);
        if (lane == 63) ((float*)(c.ws + IB_DEC))[u] = __expf(x); }
    SEG_T1(11)
    __syncthreads();
    SEG_T0(12)
    {
        const int t = tid >> 3, d0 = (tid & 7) * 16; const float sq = scal[t * 8 + 3], sk = scal[t * 8 + 4], s2 = sq * scal[t * 8 + 2];
        bf16_t* gq = (bf16_t*)(c.ws + IB_Q) + ((size_t)u * 64 + t) * 128;
#pragma unroll
        for (int m = 0; m < 4; ++m) { const int d = d0 + 4 * m; const f32x4 q = *(const LAS f32x4*)(Qf + t * 128 + d), k = *(const LAS f32x4*)(Kf + t * 128 + d);
            *(LAS u32x2*)(Qb + t * 136 + d) = (u32x2){pk2(q.x * sq, q.y * sq), pk2(q.z * sq, q.w * sq)};
            *(LAS u32x2*)(Kb + t * 136 + d) = (u32x2){pk2(k.x * sk, k.y * sk), pk2(k.z * sk, k.w * sk)};
            *(u32x2*)(gq + kpos(d)) = (u32x2){pk2(q.x * s2, q.y * s2), pk2(q.z * s2, q.w * s2)}; }
    }
    SEG_T1(12)
    __syncthreads();
    SEG_T0(13)
    {
        const int i = lane & 15, g = lane >> 4;
#pragma unroll
        for (int q2 = 0; q2 < 2; ++q2) { const int idx = 2 * wave + q2, tt = idx >> 2, st = idx & 3; const int s = 16 * st + i;
            if (st <= tt) {
                f32x4 akk = {0.f, 0.f, 0.f, 0.f}, aqk = {0.f, 0.f, 0.f, 0.f};
#pragma unroll
                for (int ks = 0; ks < 4; ++ks) { const bf16x8 bk = *(const LAS bf16x8*)(Kb + (16 * st + i) * 136 + 32 * ks + 8 * g);
                    const bf16x8 ak = *(const LAS bf16x8*)(Kb + (16 * tt + i) * 136 + 32 * ks + 8 * g), aq = *(const LAS bf16x8*)(Qb + (16 * tt + i) * 136 + 32 * ks + 8 * g);
                    akk = MFMA16(ak, bk, akk); aqk = MFMA16(aq, bk, aqk); }
                const float bs = scal[s * 8 + 1];
#pragma unroll
                for (int r = 0; r < 4; ++r) { const int t = 16 * tt + 4 * g + r; const float gam = __expf(fminf(scal[t * 8 + 1] - bs, 0.f));
                    Amat[t * 68 + s] = (s < t) ? scal[t * 8 + 0] * akk[r] * gam : 0.f;
                    Pl[t * 72 + kpos(s)] = bf1((s <= t) ? aqk[r] * gam : 0.f); }
            } else {
#pragma unroll
                for (int r = 0; r < 4; ++r) Pl[(16 * tt + 4 * g + r) * 72 + kpos(s)] = 0;
            }
        }
    }
    SEG_T1(13)
    __syncthreads();
    SEG_T0(14)
    LAS float* Tm = scal + 512;
    LAS bf16_t* KTs = Qb;
    LAS bf16_t* Wst = Qb + 128 * 72;
    if (unext < 1024) m1b_load(c, l, unext, R);
    if (wave >= 4) {
#pragma unroll
        for (int k = 0; k < 2; ++k) { const int p = (tid - 256) + 256 * k, row = p >> 3, c16 = p & 7;
            *(u32x4*)((bf16_t*)(c.ws + IB_P) + (size_t)u * 4096 + row * 64 + c16 * 8) = *(const LAS u32x4*)(Pl + row * 72 + c16 * 8); }
        const int d = tid & 127, s0 = ((tid >> 7) & 1) * 32;
#pragma unroll
        for (int m = 0; m < 8; ++m) { float v[4];
#pragma unroll
            for (int j = 0; j < 4; ++j) { const int s_ = s0 + 4 * m + j; v[j] = Kf[s_ * 128 + d] * scal[s_ * 8 + 4] * scal[s_ * 8 + 5]; }
            *(LAS u32x2*)(KTs + d * 72 + kpos(s0 + 4 * m)) = (u32x2){pk2(v[0], v[1]), pk2(v[2], v[3])}; }
    } else if (lane < 16) {
        const LAS float* Ab = Amat + (16 * wave) * 68 + 16 * wave;
        f32x4 ar[16][4];
#pragma unroll
        for (int r = 1; r < 16; ++r)
#pragma unroll
            for (int q4 = 0; q4 < (r + 3) / 4; ++q4) ar[r][q4] = *(const LAS f32x4*)(Ab + r * 68 + 4 * q4);
        float xk[16];
#pragma unroll
        for (int r = 0; r < 16; ++r) { float acc = (r == lane) ? 1.f : 0.f;
#pragma unroll
            for (int q = 0; q < r; ++q) acc -= ar[r][q >> 2][q & 3] * xk[q];
            xk[r] = acc; Tm[(wave * 16 + r) * 20 + lane] = acc; }
    }
    __syncthreads();
    {
        const int i = lane & 15, g = lane >> 4;
#pragma unroll
        for (int q2 = 0; q2 < 2; ++q2) { const int ct = 2 * wave + q2;
            f32x4 X[4];
#pragma unroll
            for (int I = 0; I < 4; ++I) {
                f32x4 acc;
#pragma unroll
                for (int r = 0; r < 4; ++r) { const int t = 16 * I + 4 * g + r;
                    acc[r] = (ct < 8) ? scal[t * 8 + 0] * Vf[t * 128 + 16 * ct + i] : scal[t * 8 + 0] * scal[t * 8 + 2] * scal[t * 8 + 4] * Kf[t * 128 + 16 * (ct - 8) + i]; }
#pragma unroll
                for (int J = 0; J < I; ++J) { const f32x4 a4 = *(const LAS f32x4*)(Amat + (16 * I + i) * 68 + 16 * J + 4 * g);
#pragma unroll
                    for (int kk = 0; kk < 4; ++kk) acc = __builtin_amdgcn_mfma_f32_16x16x4f32(-a4[kk], X[J][kk], acc, 0, 0, 0); }
                const f32x4 t4 = *(const LAS f32x4*)(Tm + (16 * I + i) * 20 + 4 * g);
                f32x4 xi = {0.f, 0.f, 0.f, 0.f};
#pragma unroll
                for (int kk = 0; kk < 4; ++kk) xi = __builtin_amdgcn_mfma_f32_16x16x4f32(t4[kk], acc[kk], xi, 0, 0, 0);
                X[I] = xi;
            }
            if (ct < 8) { float* g0 = (float*)(c.ws + IB_U0) + (size_t)u * 8192;
#pragma unroll
                for (int I = 0; I < 4; ++I) *(f32x4*)(g0 + ((I * 8 + ct) * 64 + lane) * 4) = X[I];
            } else { const int dp = kpos(16 * (ct - 8) + i);
#pragma unroll
                for (int I = 0; I < 4; ++I)
#pragma unroll
                    for (int r = 0; r < 4; ++r) Wst[(16 * I + 4 * g + r) * 128 + dp] = bf1(X[I][r]); }
        }
    }
    SEG_T1(14)
    __syncthreads();
    SEG_T0(15)
#pragma unroll
    for (int k = 0; k < 2; ++k) { const int p = tid + 512 * k, row = p >> 3, c16 = p & 7;
        *(u32x4*)((bf16_t*)(c.ws + IB_KT) + (size_t)u * 8192 + row * 64 + c16 * 8) = *(const LAS u32x4*)(KTs + row * 72 + c16 * 8);
        *(u32x4*)((bf16_t*)(c.ws + IB_W) + (size_t)u * 8192 + p * 8) = *(const LAS u32x4*)(Wst + p * 8); }
    SEG_T1(15)
    __syncthreads();
}

DI void m1_unit_a(const Ctx& c0, int l, int u) {
    const Ctx c = fresh(c0); const Args& a = *c.a; const int tid = c.tid, lane = c.lane, wave = c.wave;
    const int b = u >> 7, h = (u >> 5) & 3, ci = u & 31;
    LAS float* Bf = (LAS float*)c.lds;
    LAS float* Qf = Bf + 8192;
    LAS float* Kf = Qf + 8192;
    LAS bf16_t* Pl = (LAS bf16_t*)Qf;
    LAS bf16_t* Qh = (LAS bf16_t*)(Kf + 8192);
    LAS bf16_t* Kd = Qh + 64 * 136;
    LAS bf16_t* Ko = Kd + 64 * 136;
    LAS float* tot = (LAS float*)(Ko + 32 * 136);
    const ProjPtr proj{(const bf16_t*)(c.ws + WS_PROJ)};
    const long rowb = (long)b * SEQ + 64 * ci;
    {
        float* gv = (float*)(c.ws + IA_V) + (size_t)u * 8192;
        const int jp = tid & 63, tq = tid >> 6;
        unsigned x[4][8];
#pragma unroll
        for (int i = 0; i < 8; ++i) { const long o = (rowb + 8 * tq + i) * NINP + h * 128 + 2 * jp; x[0][i] = proj.p2(o + C_AF); x[1][i] = proj.p2(o + C_AQ); x[2][i] = proj.p2(o + C_AI); x[3][i] = proj.p2(o + C_AG); }
        const float lb0 = lb_of(a, l, h * 128 + 2 * jp), lb1 = lb_of(a, l, h * 128 + 2 * jp + 1);
        const f32x2 nv = *(const f32x2*)(inp(a, I_ANORM) + l * 128 + 2 * jp); bf16_t* gg = (bf16_t*)(c.ws + IG_A) + ((size_t)u * 64 + 8 * tq) * 128 + 2 * jp;
#pragma unroll
        for (int i = 0; i < 8; ++i) { const int t = 8 * tq + i; const float f0 = lb0 + (1.f - lb0) * sigm(bflo(x[0][i])), f1 = lb1 + (1.f - lb1) * sigm(bfhi(x[0][i]));
            *(LAS f32x2*)(Bf + t * 128 + 2 * jp) = (f32x2){fmaxf(__logf(f0), -80.f), fmaxf(__logf(f1), -80.f)};
            *(LAS f32x2*)(Kf + t * 128 + 2 * jp) = (f32x2){1.f - f0, 1.f - f1};
            *(LAS f32x2*)(Qf + t * 128 + 2 * jp) = (f32x2){silu(bflo(x[1][i])), silu(bfhi(x[1][i]))};
            const int e = 2 * jp; float* gp = gv + (((t >> 4) * 8 + (e >> 4)) * 64 + (e & 15) + 16 * ((t >> 2) & 3)) * 4 + (t & 3);
            gp[0] = bflo(x[2][i]); gp[4] = bfhi(x[2][i]);
            *(unsigned*)(gg + i * 128) = pk2(silu(bflo(x[3][i])) * nv.x, silu(bfhi(x[3][i])) * nv.y); }
    }
    __syncthreads();
    {
        const int d = tid & 127, q4 = tid >> 7; float run = 0.f;
#pragma unroll
        for (int i = 0; i < 16; ++i) { run += Bf[(16 * q4 + i) * 128 + d]; Bf[(16 * q4 + i) * 128 + d] = run; }
        tot[q4 * 128 + d] = run;
        __syncthreads();
        float off = 0.f;
        for (int q = 0; q < q4; ++q) off += tot[q * 128 + d];
        if (q4 > 0) {
#pragma unroll
            for (int i = 0; i < 16; ++i) Bf[(16 * q4 + i) * 128 + d] += off; }
    }
    __syncthreads();
    {
        const int t = tid >> 3, d0 = (tid & 7) * 16; bf16_t* gq = (bf16_t*)(c.ws + IA_Q) + ((size_t)u * 64 + t) * 128;
#pragma unroll
        for (int m = 0; m < 4; ++m) { const int d = d0 + 4 * m; const f32x4 bb = *(const LAS f32x4*)(Bf + t * 128 + d), q = *(const LAS f32x4*)(Qf + t * 128 + d), k = *(const LAS f32x4*)(Kf + t * 128 + d);
            const f32x4 b31 = *(const LAS f32x4*)(Bf + 31 * 128 + d); const f32x4 rr = b31 * ((t >= 32) ? 1.f : 0.f);
            *(u32x2*)(gq + kpos(d)) = (u32x2){pk2(q.x * __expf(bb.x), q.y * __expf(bb.y)), pk2(q.z * __expf(bb.z), q.w * __expf(bb.w))};
            *(LAS u32x2*)(Qh + t * 136 + d) = (u32x2){pk2(q.x * __expf(bb.x - rr.x), q.y * __expf(bb.y - rr.y)), pk2(q.z * __expf(bb.z - rr.z), q.w * __expf(bb.w - rr.w))};
            *(LAS u32x2*)(Kd + t * 136 + d) = (u32x2){pk2(k.x * __expf(fminf(rr.x - bb.x, 80.f)), k.y * __expf(fminf(rr.y - bb.y, 80.f))), pk2(k.z * __expf(fminf(rr.z - bb.z, 80.f)), k.w * __expf(fminf(rr.w - bb.w, 80.f)))};
            if (t < 32) *(LAS u32x2*)(Ko + t * 136 + d) = (u32x2){pk2(k.x * __expf(b31.x - bb.x), k.y * __expf(b31.y - bb.y)), pk2(k.z * __expf(b31.z - bb.z), k.w * __expf(b31.w - bb.w))}; }
        const int d = tid & 127, s0 = (tid >> 7) * 16; bf16_t* gk = (bf16_t*)(c.ws + IA_KT) + ((size_t)u * 128 + d) * 64; const float bC = Bf[63 * 128 + d];
#pragma unroll
        for (int m = 0; m < 4; ++m) { float v[4];
#pragma unroll
            for (int j = 0; j < 4; ++j) { const int s = s0 + 4 * m + j; v[j] = Kf[s * 128 + d] * __expf(bC - Bf[s * 128 + d]); }
            *(u32x2*)(gk + kpos(s0 + 4 * m)) = (u32x2){pk2(v[0], v[1]), pk2(v[2], v[3])}; }
        if (tid < 128) ((float*)(c.ws + IA_DEC))[(size_t)u * 128 + tid] = __expf(bC);
    }
    __syncthreads();
    {
        const int i = lane & 15, g = lane >> 4;
#pragma unroll
        for (int q2 = 0; q2 < 2; ++q2) { const int idx = 2 * wave + q2, tt = idx >> 2, st = idx & 3, I = tt >> 1, J = st >> 1; const int s = 16 * st + i;
            if (J <= I) {
                const LAS bf16_t* bsrc = (I == J ? Kd : Ko) + (16 * st + i) * 136;
                f32x4 acc = {0.f, 0.f, 0.f, 0.f};
#pragma unroll
                for (int ks = 0; ks < 4; ++ks) acc = MFMA16(*(const LAS bf16x8*)(Qh + (16 * tt + i) * 136 + 32 * ks + 8 * g), *(const LAS bf16x8*)(bsrc + 32 * ks + 8 * g), acc);
#pragma unroll
                for (int r = 0; r < 4; ++r) { const int t = 16 * tt + 4 * g + r; Pl[t * 72 + kpos(s)] = bf1((s <= t) ? acc[r] : 0.f); }
            } else {
#pragma unroll
                for (int r = 0; r < 4; ++r) Pl[(16 * tt + 4 * g + r) * 72 + kpos(s)] = 0;
            }
        }
    }
    __syncthreads();
    { const int row = tid >> 3, c16 = tid & 7; *(u32x4*)((bf16_t*)(c.ws + IA_P) + (size_t)u * 4096 + row * 64 + c16 * 8) = *(const LAS u32x4*)(Pl + row * 72 + c16 * 8); }
    __syncthreads();
}

DI void m1_unit_c(const Ctx& c0, int l, int u) {
    const Ctx c = fresh(c0); const Args& a = *c.a; const int tid = c.tid, lane = c.lane, wave = c.wave;
    const int b = u >> 7, n = (u >> 4) & 7, ti = u & 15;
    constexpr int TT = 128;
    LAS float* xcv = (LAS float*)c.lds;
    LAS float* ra = xcv + TT * 64;
    LAS float* ia = ra + TT * 64;
    LAS float* segA = ia + TT * 64;
    LAS float* segB = segA + 512;
    LAS bf16_t* xb = (LAS bf16_t*)(segB + 512);
    LAS bf16_t* Wt = xb + TT * 72;
    const ProjPtr proj{(const bf16_t*)(c.ws + WS_PROJ)};
    const long rowb = (long)b * SEQ + TT * ti; const int tg0 = TT * ti;
    const int cch = tid & 63, seg = tid >> 6, chg = n * 64 + cch;
    {
        const float* wa = inp(a, I_CWA) + ((size_t)l * 8 + n) * 4096; const float* wx = inp(a, I_CWX) + ((size_t)l * 8 + n) * 4096;
        float wv_[16];
#pragma unroll
        for (int k = 0; k < 16; ++k) { const int e = tid + 512 * k; wv_[k] = (e < 4096 ? wa : wx)[e & 4095]; }
        const int jp = tid & 31, sg = tid >> 5, ch2 = n * 64 + 2 * jp;
        const float* ccw = inp(a, I_CCW) + (size_t)l * 4 * 512;
        f32x2 wv[4];
#pragma unroll
        for (int j = 0; j < 4; ++j) wv[j] = *(const f32x2*)(ccw + j * 512 + ch2);
        const f32x2 cbv = *(const f32x2*)(inp(a, I_CCB) + l * 512 + ch2);
        unsigned x[11];
#pragma unroll
        for (int jx = 0; jx < 11; ++jx) { const int t = 8 * sg - 3 + jx; x[jx] = (tg0 + t >= 0) ? proj.p2((rowb + t) * NINP + C_CX + ch2) : 0u; }
#pragma unroll
        for (int k = 0; k < 16; ++k) { const int e = tid + 512 * k, gate = e >> 12, i = (e >> 6) & 63, j = e & 63; Wt[(gate * 64 + j) * 72 + i] = bf1(wv_[k]); }
#pragma unroll
        for (int i = 0; i < 8; ++i) { const float y0 = wv[0].x * bflo(x[i]) + wv[1].x * bflo(x[i + 1]) + wv[2].x * bflo(x[i + 2]) + wv[3].x * bflo(x[i + 3]) + cbv.x;
            const float y1 = wv[0].y * bfhi(x[i]) + wv[1].y * bfhi(x[i + 1]) + wv[2].y * bfhi(x[i + 2]) + wv[3].y * bfhi(x[i + 3]) + cbv.y;
            *(LAS f32x2*)(xcv + (8 * sg + i) * 64 + 2 * jp) = (f32x2){y0, y1}; *(LAS unsigned*)(xb + (8 * sg + i) * 72 + 2 * jp) = pk2(y0, y1); }
    }
    __syncthreads();
    {
        const int i = lane & 15, g = lane >> 4;
        const bf16x8 a0 = *(const LAS bf16x8*)(xb + (16 * wave + i) * 72 + 8 * g), a1 = *(const LAS bf16x8*)(xb + (16 * wave + i) * 72 + 32 + 8 * g);
        const float* bsa = inp(a, I_CBA) + l * 512 + n * 64; const float* bsx = inp(a, I_CBX) + l * 512 + n * 64;
#pragma unroll
        for (int jt = 0; jt < 8; ++jt) { f32x4 acc = {0.f, 0.f, 0.f, 0.f};
            acc = MFMA16(a0, *(const LAS bf16x8*)(Wt + (16 * jt + i) * 72 + 8 * g), acc);
            acc = MFMA16(a1, *(const LAS bf16x8*)(Wt + (16 * jt + i) * 72 + 32 + 8 * g), acc);
            const int jc = 16 * (jt & 3) + i; const float bias = (jt < 4 ? bsa : bsx)[jc]; LAS float* dst = (jt < 4 ? ra : ia);
#pragma unroll
            for (int r = 0; r < 4; ++r) dst[(16 * wave + 4 * g + r) * 64 + jc] = sigm(acc[r] + bias); }
    }
    __syncthreads();
    const float spl = softplus(-inp(a, I_CLAM)[l * 512 + chg]);
    {
        float A = 1.f, B = 0.f;
        for (int i = 0; i < 16; ++i) { const int tt = seg * 16 + i; const float r = ra[tt * 64 + cch], ig = ia[tt * 64 + cch], x = xcv[tt * 64 + cch];
            const float la = -8.f * r * spl; const float at = __expf(la); float mult = sqrtf(fmaxf(0.f, -expm1f(2.f * la)));
            if (tg0 + tt == 0) mult = 1.f;
            const float bt = mult * (ig * x); ra[tt * 64 + cch] = at; ia[tt * 64 + cch] = bt; A *= at; B = at * B + bt; }
        segA[seg * 64 + cch] = A; segB[seg * 64 + cch] = B;
    }
    __syncthreads();
    {
        float Ac = 1.f, Bc = 0.f;
        for (int s = 0; s < seg; ++s) { const float sa = segA[s * 64 + cch], sb = segB[s * 64 + cch]; Bc = sa * Bc + sb; Ac *= sa; }
        float* ga = (float*)(c.ws + IC_A); float* gb = (float*)(c.ws + IC_B);
        for (int i = 0; i < 16; ++i) { const int tt = seg * 16 + i; const float at = ra[tt * 64 + cch], bt = ia[tt * 64 + cch]; Ac *= at; Bc = at * Bc + bt;
            ga[(rowb + tt) * 512 + chg] = Ac; gb[(rowb + tt) * 512 + chg] = Bc; }
        if (seg == 7) { float* gt = (float*)(c.ws + IC_TOT) + (((size_t)b * 16 + ti) * 2) * 512; gt[chg] = Ac; gt[512 + chg] = Bc; }
    }
    __syncthreads();
}

DI void phase_m1(const Ctx& c, int l) {
    int w = blockIdx.x; asm volatile("" : "+s"(w));
    for (int rep = 0; rep < (PROBE_SUB == 1 ? 2 : 1); ++rep) {
        M1BRegs R; { const Ctx cl = fresh(c); if (w < 1024) m1b_load(cl, l, w, R); }
        for (int u = w; u < 1024; u += GRID) m1_unit_b(c, l, u, u + GRID, R); }
    for (int rep = 0; rep < (PROBE_SUB == 2 ? 2 : 1); ++rep) for (int u = w; u < 512; u += GRID) m1_unit_a(c, l, u);
    for (int rep = 0; rep < (PROBE_SUB == 3 ? 2 : 1); ++rep) for (int u = w; u < 512; u += GRID) m1_unit_c(c, l, u);
}

DI void m2_unit_head(const Ctx& c0, int l, int isB, int b, int h) {
    const Ctx c = fresh(c0); const Args& a = *c.a; const int tid = c.tid, lane = c.lane, wave = c.wave;
    LAS unsigned char* Wl = c.lds;
    LAS unsigned char* Ql = Wl + 64 * 272;
    LAS unsigned char* KTl = Ql + 64 * 272;
    LAS unsigned char* Pl = KTl + 128 * 144;
    LAS float* ob = (LAS float*)(Pl + 64 * 144);
    LAS float* decl = ob + 64 * 132;
    const int i = lane & 15, g = lane >> 4, e0 = 16 * wave;
    const int ubase = isB ? ((b * 8 + h) * 32) : ((b * 4 + h) * 32);
    const unsigned char* gW = c.ws + IB_W; const unsigned char* gQ = c.ws + (isB ? IB_Q : IA_Q); const unsigned char* gKT = c.ws + (isB ? IB_KT : IA_KT);
    const unsigned char* gP = c.ws + (isB ? IB_P : IA_P); const float* gU = (const float*)(c.ws + (isB ? IB_U0 : IA_V));
    const ProjPtr proj{(const bf16_t*)(c.ws + WS_PROJ)}; bf16_t* mixo = (bf16_t*)(c.ws + WS_MIXO);
    const bf16_t* gG = (const bf16_t*)(c.ws + (isB ? IG_B : IG_A));
    const int ocol = isB ? (512 + h * 128) : (h * 128);
    f32x4 S[8];
#pragma unroll
    for (int dt = 0; dt < 8; ++dt) S[dt] = (f32x4){0.f, 0.f, 0.f, 0.f};
    u32x4 pw[2], pq[2], pk[2], pp, pd = {0u, 0u, 0u, 0u};
    const int r16 = tid >> 4, c16 = tid & 15, r8 = tid >> 3, c8 = tid & 7;
#define M2_LOAD(ch) do { const size_t uu = (size_t)(ubase + (ch)); \
        if (isB) { pw[0] = *(const u32x4*)(gW + uu * 16384 + tid * 16); pw[1] = *(const u32x4*)(gW + uu * 16384 + (tid + 512) * 16); } \
        pq[0] = *(const u32x4*)(gQ + uu * 16384 + tid * 16); pq[1] = *(const u32x4*)(gQ + uu * 16384 + (tid + 512) * 16); \
        pk[0] = *(const u32x4*)(gKT + uu * 16384 + tid * 16); pk[1] = *(const u32x4*)(gKT + uu * 16384 + (tid + 512) * 16); \
        pp = *(const u32x4*)(gP + uu * 8192 + tid * 16); \
        if (!isB && tid < 32) pd = *(const u32x4*)(c.ws + IA_DEC + uu * 512 + tid * 16); } while (0)
#define M2_STORE() do { \
        if (isB) { *(LAS u32x4*)(Wl + r16 * 272 + c16 * 16) = pw[0]; *(LAS u32x4*)(Wl + (r16 + 32) * 272 + c16 * 16) = pw[1]; } \
        *(LAS u32x4*)(Ql + r16 * 272 + c16 * 16) = pq[0]; *(LAS u32x4*)(Ql + (r16 + 32) * 272 + c16 * 16) = pq[1]; \
        *(LAS u32x4*)(KTl + r8 * 144 + c8 * 16) = pk[0]; *(LAS u32x4*)(KTl + (r8 + 64) * 144 + c8 * 16) = pk[1]; \
        *(LAS u32x4*)(Pl + r8 * 144 + c8 * 16) = pp; \
        if (!isB && tid < 32) *(LAS u32x4*)((LAS unsigned char*)decl + tid * 16) = pd; } while (0)
    M2_LOAD(0);
    M2_STORE();
    f32x4 U[4]; unsigned gt[8], gtn[8], outp[8]; float dec = 0.f, decn = 0.f;
#define M2_LOADU(ch) do { const size_t uu_ = (size_t)(ubase + (ch)); \
        _Pragma("unroll") for (int tt = 0; tt < 4; ++tt) U[tt] = *(const f32x4*)(gU + uu_ * 8192 + ((tt * 8 + wave) * 64 + lane) * 4); } while (0)
#define M2_LOADR(ch, GT, DEC) do { const size_t uu_ = (size_t)(ubase + (ch)); \
        _Pragma("unroll") for (int k = 0; k < 8; ++k) GT[k] = *(const unsigned*)(gG + (uu_ * 64 + 8 * wave + k) * 128 + 2 * lane); \
        if (isB) DEC = ((const float*)(c.ws + IB_DEC))[uu_]; } while (0)
    M2_LOADU(0);
    M2_LOADR(0, gt, dec);
    __syncthreads();
    for (int ci = 0; ci < 32; ++ci) {
        const long row0 = (long)b * SEQ + 64 * ci;
        SEG_T0(20)
        asm volatile("" : "+v"(U[0]), "+v"(U[1]), "+v"(U[2]), "+v"(U[3]), "+v"(dec));
        asm volatile("" : "+v"(gt[0]), "+v"(gt[1]), "+v"(gt[2]), "+v"(gt[3]), "+v"(gt[4]), "+v"(gt[5]), "+v"(gt[6]), "+v"(gt[7]));
        if (ci > 0) {
#pragma unroll
            for (int k = 0; k < 8; ++k) *(unsigned*)(mixo + (row0 - 64 + 8 * wave + k) * D + ocol + 2 * lane) = outp[k]; }
        if (ci + 1 < 32) { M2_LOAD(ci + 1); M2_LOADR(ci + 1, gtn, decn); }
        bf16x8 Sb[4];
#pragma unroll
        for (int ks = 0; ks < 4; ++ks) { u32x4 p; p.x = pk2(S[2 * ks][0], S[2 * ks][1]); p.y = pk2(S[2 * ks][2], S[2 * ks][3]); p.z = pk2(S[2 * ks + 1][0], S[2 * ks + 1][1]); p.w = pk2(S[2 * ks + 1][2], S[2 * ks + 1][3]); Sb[ks] = __builtin_bit_cast(bf16x8, p); }
#define M2_SCHED() __builtin_amdgcn_sched_barrier(0)
        if (isB) {
#pragma unroll
            for (int hf = 0; hf < 2; ++hf) { bf16x8 fr[8];
#pragma unroll
                for (int j = 0; j < 8; ++j) fr[j] = *(const LAS bf16x8*)(Wl + (16 * (2 * hf + (j >> 2)) + i) * 272 + (32 * (j & 3) + 8 * g) * 2);
                M2_SCHED();
                f32x4 a0 = {0.f, 0.f, 0.f, 0.f}, a1 = {0.f, 0.f, 0.f, 0.f};
#pragma unroll
                for (int ks = 0; ks < 4; ++ks) { a0 = MFMA16(fr[ks], Sb[ks], a0); a1 = MFMA16(fr[4 + ks], Sb[ks], a1); }
                U[2 * hf] = U[2 * hf] - a0; U[2 * hf + 1] = U[2 * hf + 1] - a1;
                M2_SCHED(); }
        }
        bf16x8 Ub[2];
#pragma unroll
        for (int k = 0; k < 2; ++k) { u32x4 p; p.x = pk2(U[2 * k][0], U[2 * k][1]); p.y = pk2(U[2 * k][2], U[2 * k][3]); p.z = pk2(U[2 * k + 1][0], U[2 * k + 1][1]); p.w = pk2(U[2 * k + 1][2], U[2 * k + 1][3]); Ub[k] = __builtin_bit_cast(bf16x8, p); }
        SEG_T1(20)
        SEG_T0(21)
        asm volatile("" : "+v"(Ub[0]), "+v"(Ub[1]));
        if (ci + 1 < 32) M2_LOADU(ci + 1);
#pragma unroll
        for (int hf = 0; hf < 2; ++hf) { bf16x8 fq[8], fp[4];
#pragma unroll
            for (int j = 0; j < 8; ++j) fq[j] = *(const LAS bf16x8*)(Ql + (16 * (2 * hf + (j >> 2)) + i) * 272 + (32 * (j & 3) + 8 * g) * 2);
            M2_SCHED();
            f32x4 a0 = {0.f, 0.f, 0.f, 0.f}, a1 = {0.f, 0.f, 0.f, 0.f};
#pragma unroll
            for (int ks = 0; ks < 4; ++ks) { a0 = MFMA16(fq[ks], Sb[ks], a0); a1 = MFMA16(fq[4 + ks], Sb[ks], a1); }
            M2_SCHED();
#pragma unroll
            for (int j = 0; j < 4; ++j) fp[j] = *(const LAS bf16x8*)(Pl + (16 * (2 * hf + (j >> 1)) + i) * 144 + (32 * (j & 1) + 8 * g) * 2);
            M2_SCHED();
#pragma unroll
            for (int k = 0; k < 2; ++k) { a0 = MFMA16(fp[k], Ub[k], a0); a1 = MFMA16(fp[2 + k], Ub[k], a1); }
#pragma unroll
            for (int r = 0; r < 4; ++r) { ob[(16 * (2 * hf) + 4 * g + r) * 132 + e0 + i] = a0[r]; ob[(16 * (2 * hf + 1) + 4 * g + r) * 132 + e0 + i] = a1[r]; }
            M2_SCHED(); }
        if (isB) {
#pragma unroll
            for (int dt = 0; dt < 8; ++dt) S[dt] = S[dt] * dec;
        } else {
#pragma unroll
            for (int dt = 0; dt < 8; ++dt) S[dt] = S[dt] * *(const LAS f32x4*)(decl + 16 * dt + 4 * g); }
#pragma unroll
        for (int hf = 0; hf < 2; ++hf) { bf16x8 fk[8];
#pragma unroll
            for (int j = 0; j < 8; ++j) fk[j] = *(const LAS bf16x8*)(KTl + (16 * (4 * hf + (j >> 1)) + i) * 144 + (32 * (j & 1) + 8 * g) * 2);
            M2_SCHED();
#pragma unroll
            for (int j = 0; j < 8; ++j) S[4 * hf + (j >> 1)] = MFMA16(fk[j], Ub[j & 1], S[4 * hf + (j >> 1)]);
            M2_SCHED(); }
#undef M2_SCHED
        SEG_T1(21)
        SEG_T0(22)
        __syncthreads();
        SEG_T1(22)
        SEG_T0(23)
        { f32x2 vv[8]; float ss[8];
#pragma unroll
          for (int k = 0; k < 8; ++k) vv[k] = *(const LAS f32x2*)(ob + (8 * wave + k) * 132 + 2 * lane);
#pragma unroll
          for (int k = 0; k < 8; ++k) ss[k] = row16_sum(vv[k].x * vv[k].x + vv[k].y * vv[k].y);
#pragma unroll
          for (int k = 0; k < 8; ++k) ss[k] = __int_as_float(__builtin_amdgcn_readlane(__float_as_int(ss[k]), 0)) + __int_as_float(__builtin_amdgcn_readlane(__float_as_int(ss[k]), 16)) +
              __int_as_float(__builtin_amdgcn_readlane(__float_as_int(ss[k]), 32)) + __int_as_float(__builtin_amdgcn_readlane(__float_as_int(ss[k]), 48));
#pragma unroll
          for (int k = 0; k < 8; ++k) { const float r = rsqrtf(ss[k] * (1.f / 128.f) + NORM_EPS);
            outp[k] = pk2(vv[k].x * r * __uint_as_float(gt[k] << 16), vv[k].y * r * __uint_as_float(gt[k] & 0xffff0000u)); } }
        SEG_T1(23)
        SEG_T0(24)
        if (ci + 1 < 32) { M2_STORE();
#pragma unroll
            for (int k = 0; k < 8; ++k) gt[k] = gtn[k];
            dec = decn; }
        __syncthreads();
        SEG_T1(24)
    }
#pragma unroll
    for (int k = 0; k < 8; ++k) *(unsigned*)(mixo + ((long)b * SEQ + 64 * 31 + 8 * wave + k) * D + ocol + 2 * lane) = outp[k];
#undef M2_LOADR
#undef M2_LOADU
#undef M2_LOAD
#undef M2_STORE
    float* so = c.out + (isB ? O_GDP + (((size_t)l * BATCH + b) * 8 + h) * 16384 : O_HGP + (((size_t)l * BATCH + b) * 4 + h) * 16384);
#pragma unroll
    for (int dt = 0; dt < 8; ++dt)
#pragma unroll
        for (int r = 0; r < 4; ++r) so[(size_t)(16 * dt + 4 * g + r) * 128 + e0 + i] = S[dt][r];
}

DI void m2_unit_cfin(const Ctx& c0, int l, int u) {
    const Ctx c = fresh(c0); const int tid = c.tid;
    const int b = u >> 7, n = (u >> 4) & 7, ti = u & 15;
    const int cch = tid & 63, seg = tid >> 6, chg = n * 64 + cch;
    const ProjPtr proj{(const bf16_t*)(c.ws + WS_PROJ)}; bf16_t* mixo = (bf16_t*)(c.ws + WS_MIXO);
    const float* ga = (const float*)(c.ws + IC_A); const float* gb = (const float*)(c.ws + IC_B);
    const float* gt = (const float*)(c.ws + IC_TOT) + ((size_t)b * 16 * 2) * 512;
    float hs = 0.f;
    { float ta[15], tb[15];
#pragma unroll
      for (int k = 0; k < 15; ++k) { ta[k] = gt[(k * 2) * 512 + chg]; tb[k] = gt[(k * 2 + 1) * 512 + chg]; }
#pragma unroll
      for (int k = 0; k < 15; ++k) if (k < ti) hs = ta[k] * hs + tb[k]; }
    const long rowb = (long)b * SEQ + 128 * ti;
    float hh = 0.f;
    { float va[16], vb[16], vg[16];
#pragma unroll
      for (int i = 0; i < 16; ++i) { const long row = rowb + seg * 16 + i; va[i] = ga[row * 512 + chg]; vb[i] = gb[row * 512 + chg]; vg[i] = proj[row * NINP + C_CG + chg]; }
#pragma unroll
      for (int i = 0; i < 16; ++i) { const long row = rowb + seg * 16 + i; hh = vb[i] + va[i] * hs; mixo[row * D + 1536 + chg] = bf1(hh * gelu_tanh(vg[i])); } }
    if (ti == 15 && seg == 7) c.out[O_RHP + ((size_t)l * BATCH + b) * 512 + chg] = hh;
}

DI void block_reduce_cols(LAS float* red, LAS float* full, const float (&p)[4], int tid, float scale) {
    const int e4 = (tid & 31) * 4, dgp = tid >> 5;
    *(LAS f32x4*)(red + dgp * 128 + e4) = (f32x4){p[0], p[1], p[2], p[3]};
    __syncthreads();
    if (tid < 128) { float s = 0.f;
#pragma unroll
        for (int k = 0; k < 16; ++k) s += red[k * 128 + tid];
        full[tid] = s * scale; }
    __syncthreads();
}
DI void unit_b_sample(const Ctx& c0, int l, int b, int h) {
    const Ctx c = fresh(c0);
    const Args& a = *c.a; const int tid = c.tid, lane = c.lane, wave = c.wave;
    LAS float* qkv = (LAS float*)c.lds;
    LAS float* scl = qkv + 384;
    LAS float* red = scl + 8;
    LAS float* full = red + 2048;
    LAS float* uu = full + 128;
    const ProjPtr proj = ProjPtr{(const bf16_t*)(c.ws + WS_PROJ)} + (long)(NP + b) * NINP;
    const int e4 = (tid & 31) * 4, d0 = (tid >> 5) * 8;
    const size_t sidx = (((size_t)l * NS + b) * 8 + h) * 16384;
    const float* Sin = inp(a, I_SGD) + sidx; float* Sout = c.out + O_GDS + sidx;
    f32x4 S[8];
#pragma unroll
    for (int i = 0; i < 8; ++i) S[i] = *(const f32x4*)(Sin + (size_t)(d0 + i) * 128 + e4);
    float gz = 0.f, nwt = 0.f;
    if (tid < 128) { gz = proj[C_BZ + h * 128 + tid]; nwt = inp(a, I_BNORM)[l * 128 + tid]; }
    if (tid < 384) { const int part = tid >> 7, idx = tid & 127, cc = part * 1024 + h * 128 + idx;
        const float* cw = inp(a, I_BCW) + (size_t)l * 4 * 3072; const float* st = inp(a, I_SGC) + (((size_t)l * NS + b) * 3) * 3072;
        const float x0 = st[cc], x1 = st[3072 + cc], x2 = st[2 * 3072 + cc], x3 = proj[C_BQ + cc];
        qkv[tid] = silu(cw[cc] * x0 + cw[3072 + cc] * x1 + cw[2 * 3072 + cc] * x2 + cw[3 * 3072 + cc] * x3);
        float* so = c.out + O_GCS + (((size_t)l * NS + b) * 3) * 3072; so[cc] = x1; so[3072 + cc] = x2; so[2 * 3072 + cc] = x3; }
    if (tid == 384) { const float bb = proj[C_BB + h], ba = proj[C_BA + h]; scl[0] = sigm(bb); scl[1] = __expf(-__expf(inp(a, I_BALOG)[l * 8 + h]) * softplus(ba + inp(a, I_BDT)[l * 8 + h])); }
    __syncthreads();
    if (wave < 2) { const float x0 = qkv[wave * 128 + lane], x1 = qkv[wave * 128 + 64 + lane]; const float ss = wave_sum_fast(x0 * x0 + x1 * x1);
        if (lane == 0) scl[2 + wave] = rsqrtf(ss + L2_EPS) * (wave == 0 ? 0.08838834764831845f : 1.f); }
    __syncthreads();
    const float beta = scl[0], eg = scl[1], sq = scl[2], sk = scl[3];
    float p[4] = {0.f, 0.f, 0.f, 0.f};
#pragma unroll
    for (int i = 0; i < 8; ++i) { const float k = qkv[128 + d0 + i]; p[0] += k * S[i].x; p[1] += k * S[i].y; p[2] += k * S[i].z; p[3] += k * S[i].w; }
    block_reduce_cols(red, full, p, tid, sk);
    if (tid < 128) uu[tid] = beta * (qkv[256 + tid] - eg * full[tid]) * sk;
    __syncthreads();
    const f32x4 u4 = *(const LAS f32x4*)(uu + e4);
    float po[4] = {0.f, 0.f, 0.f, 0.f};
#pragma unroll
    for (int i = 0; i < 8; ++i) { const float k = qkv[128 + d0 + i], q = qkv[d0 + i]; S[i] = S[i] * eg + u4 * k; *(f32x4*)(Sout + (size_t)(d0 + i) * 128 + e4) = S[i];
        po[0] += q * S[i].x; po[1] += q * S[i].y; po[2] += q * S[i].z; po[3] += q * S[i].w; }
    block_reduce_cols(red, full, po, tid, sq);
    if (wave < 2) { const float o = full[wave * 64 + lane]; const float ss = wave_sum_fast(o * o); if (lane == 0) scl[4 + wave] = ss; }
    __syncthreads();
    if (tid < 128) { const float rms = rsqrtf((scl[4] + scl[5]) * (1.f / 128.f) + NORM_EPS);
        const float o = full[tid] * rms * nwt * silu(gz);
        ((bf16_t*)(c.ws + WS_MIXO))[(size_t)(NP + b) * D + 512 + h * 128 + tid] = (bf16_t)(pk2(o, 0.f) & 0xffffu); }
    __syncthreads();
}
DI void unit_a_sample(const Ctx& c0, int l, int b, int h) {
    const Ctx c = fresh(c0);
    const Args& a = *c.a; const int tid = c.tid, lane = c.lane, wave = c.wave;
    LAS float* fqv = (LAS float*)c.lds;
    LAS float* scl = fqv + 384;
    LAS float* red = scl + 8;
    LAS float* full = red + 2048;
    const ProjPtr proj = ProjPtr{(const bf16_t*)(c.ws + WS_PROJ)} + (long)(NP + b) * NINP;
    const int e4 = (tid & 31) * 4, d0 = (tid >> 5) * 8;
    const size_t sidx = (((size_t)l * NS + b) * 4 + h) * 16384;
    const float* Sin = inp(a, I_SHG) + sidx; float* Sout = c.out + O_HGS + sidx;
    f32x4 S8[8];
#pragma unroll
    for (int i = 0; i < 8; ++i) S8[i] = *(const f32x4*)(Sin + (size_t)(d0 + i) * 128 + e4);
    float gz = 0.f, nwt = 0.f;
    if (tid < 128) { gz = proj[C_AG + h * 128 + tid]; nwt = inp(a, I_ANORM)[l * 128 + tid]; }
    if (tid < 384) { const int part = tid >> 7, idx = tid & 127;
        if (part == 0) { const float lb = lb_of(a, l, h * 128 + idx); fqv[tid] = lb + (1.f - lb) * sigm(proj[C_AF + h * 128 + idx]); }
        else if (part == 1) fqv[tid] = silu(proj[C_AQ + h * 128 + idx]);
        else fqv[tid] = proj[C_AI + h * 128 + idx]; }
    __syncthreads();
    const f32x4 v4 = *(const LAS f32x4*)(fqv + 256 + e4);
    float po[4] = {0.f, 0.f, 0.f, 0.f};
#pragma unroll
    for (int i = 0; i < 8; ++i) { const float f = fqv[d0 + i], q = fqv[128 + d0 + i]; f32x4 S = S8[i];
        S = S * f + v4 * (1.f - f); *(f32x4*)(Sout + (size_t)(d0 + i) * 128 + e4) = S;
        po[0] += q * S.x; po[1] += q * S.y; po[2] += q * S.z; po[3] += q * S.w; }
    block_reduce_cols(red, full, po, tid, 1.f);
    if (wave < 2) { const float o = full[wave * 64 + lane]; const float ss = wave_sum_fast(o * o); if (lane == 0) scl[4 + wave] = ss; }
    __syncthreads();
    if (tid < 128) { const float rms = rsqrtf((scl[4] + scl[5]) * (1.f / 128.f) + NORM_EPS);
        const float o = full[tid] * rms * nwt * silu(gz);
        ((bf16_t*)(c.ws + WS_MIXO))[(size_t)(NP + b) * D + h * 128 + tid] = (bf16_t)(pk2(o, 0.f) & 0xffffu); }
    __syncthreads();
}
DI void unit_c_sample(const Ctx& c0, int l, int b) {
    const Ctx c = fresh(c0);
    const Args& a = *c.a; const int tid = c.tid;
    LAS float* xc = (LAS float*)c.lds;
    const ProjPtr proj = ProjPtr{(const bf16_t*)(c.ws + WS_PROJ)} + (long)(NP + b) * NINP;
    const float* ccw = inp(a, I_CCW) + (size_t)l * 4 * 512; const float* st = inp(a, I_SRC) + (((size_t)l * NS + b) * 3) * 512;
    const float x0 = st[tid], x1 = st[512 + tid], x2 = st[1024 + tid], x3 = proj[C_CX + tid];
    const float xv = ccw[tid] * x0 + ccw[512 + tid] * x1 + ccw[1024 + tid] * x2 + ccw[1536 + tid] * x3 + inp(a, I_CCB)[l * 512 + tid];
    xc[tid] = xv;
    { float* so = c.out + O_RCS + (((size_t)l * NS + b) * 3) * 512; so[tid] = x1; so[512 + tid] = x2; so[1024 + tid] = x3; }
    __syncthreads();
    const int n = tid >> 6, j = tid & 63;
    const float* wa = inp(a, I_CWA) + ((size_t)l * 8 + n) * 4096 + j; const float* wx = inp(a, I_CWX) + ((size_t)l * 8 + n) * 4096 + j;
    float sa = 0.f, sx = 0.f;
#pragma unroll 8
    for (int i = 0; i < 64; ++i) { const float x = xc[n * 64 + i]; sa += x * wa[i * 64]; sx += x * wx[i * 64]; }
    const float r = sigm(sa + inp(a, I_CBA)[l * 512 + tid]), ig = sigm(sx + inp(a, I_CBX)[l * 512 + tid]);
    const float la = -8.f * r * softplus(-inp(a, I_CLAM)[l * 512 + tid]); const float at = __expf(la); const float mult = sqrtf(fmaxf(0.f, -expm1f(2.f * la)));
    const float h0 = inp(a, I_SRH)[((size_t)l * NS + b) * 512 + tid];
    const float hh = at * h0 + mult * (ig * xv);
    c.out[O_RHS + ((size_t)l * NS + b) * 512 + tid] = hh;
    ((bf16_t*)(c.ws + WS_MIXO))[(size_t)(NP + b) * D + 1536 + tid] = (bf16_t)(pk2(hh * gelu_tanh(proj[C_CG + tid]), 0.f) & 0xffffu);
    __syncthreads();
}


DI void phase_m2(const Ctx& c, int l) {
    int w = blockIdx.x; asm volatile("" : "+s"(w));
    if (w < 48) {
        const int isB = w < 32; const int u = isB ? w : w - 32;
        for (int rep = 0; rep < (PROBE_SUB == 4 ? 2 : 1); ++rep) m2_unit_head(c, l, isB, isB ? (u >> 3) : (u >> 2), isB ? (u & 7) : (u & 3));
    } else {
        const int nw = GRID - 48;
        for (int rep = 0; rep < (PROBE_SUB == 5 ? 2 : 1); ++rep)
        for (int u = w - 48; u < 512 + 1664; u += nw) {
            if (u < 512) m2_unit_cfin(c, l, u);
            else { const int v = u - 512;
                if (v < 1024) unit_b_sample(c, l, v >> 3, v & 7);
                else if (v < 1536) { const int x = v - 1024; unit_a_sample(c, l, x >> 2, x & 3); }
                else unit_c_sample(c, l, v - 1536); }
        }
        { const Ctx cv = fresh(c); __syncthreads();
          convert_range(cv, l == 0 ? CV_IN : CV_LAYER + CV_IN, l == 0 ? CV_LAYER + CV_IN : 2 * CV_LAYER, (w - 48) * 8 + cv.wave, nw * 8); }
        const Ctx cc = fresh(c); const ProjPtr proj{(const bf16_t*)(cc.ws + WS_PROJ)};
        const int gt_ = (w - 48) * 512 + cc.tid, NT = nw * 512;
        for (int i = gt_; i < BATCH * 3 * 3072; i += NT) { const int b = i / (3 * 3072), r = i - b * 3 * 3072, j = r / 3072, ch = r - j * 3072;
            cc.out[O_GCP + (size_t)l * BATCH * 3 * 3072 + i] = proj[((size_t)b * SEQ + SEQ - 3 + j) * NINP + C_BQ + ch]; }
        for (int i = gt_; i < BATCH * 3 * 512; i += NT) { const int b = i / (3 * 512), r = i - b * 3 * 512, j = r / 512, ch = r - j * 512;
            cc.out[O_RCP + (size_t)l * BATCH * 3 * 512 + i] = proj[((size_t)b * SEQ + SEQ - 3 + j) * NINP + C_CX + ch]; }
    }
}


#define XB_TMO      128
#define XB_XCNT(j)  (256  + 64 * (j))
#define XB_XSUB(j)  (1280 + 64 * (j))
#define XB_XGEN(j)  (2304 + 64 * (j))
#define XB_TOP      3328
#define XB_TOPGEN   3392
#define XCD_BAR_WORDS 3456
#define XB_SPIN_CAP (1u << 20)
DI unsigned xb_ld(unsigned* p)              { return __hip_atomic_load(p, __ATOMIC_RELAXED, __HIP_MEMORY_SCOPE_AGENT); }
DI unsigned xb_add(unsigned* p, unsigned v) { return __hip_atomic_fetch_add(p, v, __ATOMIC_RELAXED, __HIP_MEMORY_SCOPE_AGENT); }
DI unsigned xb_xcc_id() { return (unsigned)__builtin_amdgcn_s_getreg((3 << 11) | 20) & 0xFu; }
#define XB_SPIN(cond, bar) do { unsigned _sp = 0; while (cond) { __builtin_amdgcn_s_sleep(1); \
    if ((++_sp & 255u) == 0u) { if (xb_ld(&(bar)[XB_TMO])) break; if (_sp > XB_SPIN_CAP) { atomicAdd(&(bar)[XB_TMO], 1u); break; } } } } while (0)
DI void xcd_barrier_post(unsigned* bar) { if (threadIdx.x == 0) (void)xb_add(&bar[XB_XCNT(xb_xcc_id())], 1u); }
DI void xcd_barrier_complete(unsigned* bar, unsigned x, unsigned& nloc, unsigned& nx) {
    const unsigned G = gridDim.x * gridDim.y * gridDim.z;
    unsigned sum, cnt, mine, sp = 0u;
    for (;;) {
        sum = 0u; cnt = 0u; mine = 0u;
#pragma unroll
        for (unsigned j = 0; j < 16; ++j) { const unsigned c = xb_ld(&bar[XB_XCNT(j)]); sum += c; cnt += (c > 0u) ? 1u : 0u; mine = (j == x) ? c : mine; }
        if (sum == G) break;
        __builtin_amdgcn_s_sleep(1);
        if ((++sp & 255u) == 0u) { if (xb_ld(&bar[XB_TMO])) break; if (sp > XB_SPIN_CAP) { atomicAdd(&bar[XB_TMO], 1u); break; } }
    }
    nloc = mine > 0u ? mine : 1u; nx = cnt > 0u ? cnt : 1u;
}
DI void xcd_barrier(unsigned* bar, volatile LAS unsigned* st) {
    asm volatile("s_waitcnt vmcnt(0)" ::: "memory");
    __syncthreads();
    if (threadIdx.x == 0) {
        const unsigned x = xb_xcc_id();
        __builtin_amdgcn_s_waitcnt(0);
        unsigned nloc = st[0], nx = st[1];
        if (nloc == 0u) { xcd_barrier_complete(bar, x, nloc, nx); st[0] = nloc; st[1] = nx; }
        const unsigned old = xb_add(&bar[XB_XSUB(x)], 1u);
        const unsigned gen = old / nloc;
        if (old + 1u == (gen + 1u) * nloc) {
            __builtin_amdgcn_fence(__ATOMIC_RELEASE, "agent");
            asm volatile("s_waitcnt vmcnt(0)" ::: "memory");
            const unsigned og = xb_add(&bar[XB_TOP], 1u);
            const unsigned tg = og / nx;
            if (og + 1u == (tg + 1u) * nx) xb_add(&bar[XB_TOPGEN], 1u);
            else XB_SPIN(xb_ld(&bar[XB_TOPGEN]) == tg, bar);
            __builtin_amdgcn_fence(__ATOMIC_ACQUIRE, "agent");
            xb_add(&bar[XB_XGEN(x)], 1u);
            asm volatile("s_waitcnt vmcnt(0)" ::: "memory");
        } else {
            XB_SPIN(xb_ld(&bar[XB_XGEN(x)]) == gen, bar);
            __builtin_amdgcn_fence(__ATOMIC_ACQUIRE, "agent");
            asm volatile("s_waitcnt vmcnt(0)" ::: "memory");
        }
    }
    __syncthreads();
}

__global__ void __launch_bounds__(512, 2) fwd_megakernel(Args args) {
    extern __shared__ __attribute__((aligned(16))) unsigned char lds_raw[];
    Ctx c0; c0.a = &args; c0.ws = nullptr; c0.out = nullptr; c0.lds = (LAS unsigned char*)lds_raw; c0.tid = 0; c0.lane = 0; c0.wave = 0; c0.G = GRID; c0.bid = 0;
    const int lo = args.ph_lo, hi = args.ph_hi;
    volatile LAS unsigned* bst = (volatile LAS unsigned*)((LAS unsigned char*)lds_raw + LDS_BYTES - 16);
    if (threadIdx.x == 0) { bst[0] = 0u; bst[1] = 0u; }
    __syncthreads();
    xcd_barrier_post((unsigned*)(args.ws + WS_CTL) + 1024);
#pragma unroll 1
    for (int ph2 = 2 * lo; ph2 < 2 * hi; ++ph2) {
        const int ph = ph2 >> 1;
        const int l = (ph - 1) >> 3, k = (ph == 0) ? -1 : ((ph - 1) & 7);
        if ((ph2 & 1) && k != PROBE_REP) continue;
        if (k == -1) phase_p0(c0);
        else if (k == 0 || k == 3 || k == 5 || k == 6) {
            const Ctx c = fresh(c0); unsigned char* ws = c.ws;
            pg8::Gemm g; pg8::EpiAny E; E.mode = 2; E.C = nullptr; E.O = (bf16_t*)(ws + WS_MIXF); E.ldc = D;
            if (k == 0)      { g.A = (const bf16_t*)(ws + WS_HBUF); g.Bt = (const bf16_t*)(ws + WS_WIN + l * SZ_WIN);   g.N = NINP; g.K = D;   E.mode = 2; E.O = (bf16_t*)(ws + WS_PROJ); E.ldc = NINP; }
            else if (k == 3) { g.A = (const bf16_t*)(ws + WS_MIXO); g.Bt = (const bf16_t*)(ws + WS_WOUT + l * SZ_WOUT); g.N = D;    g.K = D; }
            else if (k == 5) { g.A = (const bf16_t*)(ws + WS_HBUF); g.Bt = (const bf16_t*)(ws + WS_WGU + l * SZ_WGU);   g.N = NGU;  g.K = D;   E.mode = 1; E.O = (bf16_t*)(ws + WS_PROJ); E.ldc = DFF; }
            else             { g.A = (const bf16_t*)(ws + WS_PROJ); g.Bt = (const bf16_t*)(ws + WS_WDN + l * SZ_WDN);   g.N = D;    g.K = DFF; }
            g.M = (k == 3 || k == 6) ? NP : MPAD;
            pg8::StaticOrder S; S.init(g.M, g.N, GRID, c.bid);
            pg8::gemm_phase<pg8::EpiAny, pg8::StaticOrder, true, true>(c.lds, g, S, E);
            if (k == 3 || k == 6) sample_pieces(c0, g.A + (size_t)NP * g.K, g.Bt, g.K, (float*)(ws + WS_SLAB));
        }
        else if (k == 1) phase_m1(c0, l);
        else if (k == 2) phase_m2(c0, l);
        else {
            const Ctx c = fresh(c0); unsigned char* ws = c.ws;
            float* mixf = (float*)(ws + WS_MIXF); float* x1 = (float*)(ws + WS_X1); bf16_t* hb = (bf16_t*)(ws + WS_HBUF);
            if (k == 4) {
                const float* xa = (l == 0) ? inp(args, I_XP) : c.out; const float* xb = (l == 0) ? inp(args, I_XS) : c.out + (size_t)NP * D;
                row_phase(c0, (const bf16_t*)mixf, (const float*)(ws + WS_SLAB), xa, xb, x1, inp(args, I_LN2) + l * D, inp(args, I_LN3) + l * D, hb);
            } else {
                row_phase(c0, (const bf16_t*)mixf, (const float*)(ws + WS_SLAB), x1, x1 + (size_t)NP * D, c.out, inp(args, I_LN4) + l * D, l == 0 ? inp(args, I_LN1) + D : nullptr, hb);
            }
        }
        if (ph2 + 1 < 2 * hi) {
            if (args.ph_hi < 0) cg::this_grid().sync();
            xcd_barrier((unsigned*)(args.ws + WS_CTL) + 1024, bst);
        }
    }
}

extern "C" void kernel_launch(void* const* d_in, const int* in_sizes, int n_in, void* d_out, int out_size, void* d_ws, size_t ws_size, hipStream_t stream) {
    static int grid = 0;
    if (grid == 0) {
        if (n_in != 29 || (size_t)out_size != O_END || ws_size < WS_END) { fprintf(stderr, "kernel_launch: unexpected shapes: n_in %d out %d ws %zu (need %zu)\n", n_in, out_size, ws_size, (size_t)WS_END); grid = -1; return; }
        int dev = 0, cus = 0, per_cu = 0;
        hipGetDevice(&dev); hipDeviceGetAttribute(&cus, hipDeviceAttributeMultiprocessorCount, dev);
        if (hipFuncSetAttribute((const void*)fwd_megakernel, hipFuncAttributeMaxDynamicSharedMemorySize, LDS_BYTES) != hipSuccess) { fprintf(stderr, "kernel_launch: hipFuncSetAttribute failed\n"); grid = -1; return; }
        if (hipOccupancyMaxActiveBlocksPerMultiprocessor(&per_cu, (const void*)fwd_megakernel, 512, LDS_BYTES) != hipSuccess || per_cu < 1) { fprintf(stderr, "kernel_launch: occupancy query says %d\n", per_cu); grid = -1; return; }
        if (cus < GRID) { fprintf(stderr, "kernel_launch: needs %d CUs, got %d\n", GRID, cus); grid = -1; return; }
        grid = GRID;
    }
    if (grid < 0) return;
    hipMemsetAsync((char*)d_ws + WS_CTL, 0, CTL_BYTES, stream);
    Args a{};
    for (int i = 0; i < 29; ++i) a.in[i] = (const float*)d_in[i];
    a.out = (float*)d_out; a.ws = (unsigned char*)d_ws;
#if MK_MULTI
    for (int ph = 0; ph < NPHASE; ++ph) { a.ph_lo = ph; a.ph_hi = ph + 1; hipLaunchKernelGGL(fwd_megakernel, dim3(grid), dim3(512), LDS_BYTES, stream, a); }
#else
    a.ph_lo = 0; a.ph_hi = NPHASE;
    void* kargs[] = {&a};
    hipError_t e = hipLaunchCooperativeKernel((const void*)fwd_megakernel, dim3(grid), dim3(512), kargs, LDS_BYTES, stream);
    if (e != hipSuccess) fprintf(stderr, "cooperative launch failed: %s (grid %d)\n", hipGetErrorString(e), grid);
#endif
}
```
